# Optimizing an MI355X kernel written in HIP

```python
import math
import jax
import jax.numpy as jnp
from jax import lax
import numpy as np

D_MODEL = 1024
BATCH = 8
SEQ = 2048
DEPTH = 2

CHUNK = 64
N_BRANCH = 4
BRANCH_DIM = D_MODEL // 2
NORM_EPS = 1e-6

RWKV_HEAD_DIM = 64
RWKV_HEADS = BRANCH_DIM // RWKV_HEAD_DIM
RWKV_DIM = RWKV_HEADS * RWKV_HEAD_DIM
RWKV_DECAY_RANK = 64
RWKV_A_RANK = 64
RWKV_V_RANK = 32
RWKV_GATE_RANK = 160
RWKV_LN_EPS = 64e-5

SSM_HEAD_DIM = 64
SSM_HEADS = BRANCH_DIM // SSM_HEAD_DIM
SSM_DIM = SSM_HEADS * SSM_HEAD_DIM
SSM_GROUPS = 2
SSM_STATE = 128
SSM_CONV = 4
SSM_XBC = SSM_DIM + 2 * SSM_GROUPS * SSM_STATE

ATT_HEAD_DIM = 64
ATT_HEADS = BRANCH_DIM // ATT_HEAD_DIM
ATT_DIM = ATT_HEADS * ATT_HEAD_DIM
ATT_LEFT_CHUNKS = 8
ATT_BAND = (ATT_LEFT_CHUNKS + 1) * CHUNK
REL_CLIP = 2 * CHUNK

GLA_HEADS = 4
GLA_KEY_DIM = BRANCH_DIM // 2
GLA_VAL_DIM = BRANCH_DIM
GLA_GATE_RANK = 16
GLA_GATE_NORM = 16.0

RWKV_COLS = 3 * RWKV_DIM + RWKV_DECAY_RANK + RWKV_A_RANK + RWKV_GATE_RANK
SSM_COLS = SSM_DIM + SSM_XBC + SSM_HEADS
ATT_COLS = 3 * ATT_DIM
GLA_COLS = 2 * GLA_KEY_DIM + 2 * GLA_VAL_DIM + GLA_GATE_RANK
GATE_COLS = N_BRANCH * D_MODEL
IN_COLS = RWKV_COLS + SSM_COLS + ATT_COLS + GLA_COLS + GATE_COLS

FFN_DIM = 2816
N_EXPERTS = 8
TOP_K = 2
EXPERT_DIM = 3584
MOE_ROWS = 256
N_DENSE = (DEPTH + 1) // 2
N_MOE = DEPTH // 2
N_VRES = DEPTH - 1

kernel_name = 'hybrid_streaming_block'


def _split(z, sizes):
    return jnp.split(z, np.cumsum(sizes)[:-1].tolist(), axis=-1)


def _rms(x, g, eps=NORM_EPS):
    xf = x.astype(jnp.float32)
    y = xf * lax.rsqrt(jnp.mean(xf * xf, axis=-1, keepdims=True) + eps)
    return (y * g.astype(jnp.float32)).astype(x.dtype)


def _shift(z):
    return jnp.pad(z, ((0, 0), (1, 0), (0, 0)))[:, :-1]


def _chunks(t, *tail):
    return t.reshape(t.shape[0], t.shape[1] // CHUNK, CHUNK, *tail)


def _chunk_scan(contrib, decay):
    def step(state, inp):
        inc, dec = inp
        return state * dec + inc, state
    init = jnp.zeros_like(contrib[:, 0])
    _, entering = lax.scan(step, init, (jnp.moveaxis(contrib, 1, 0), jnp.moveaxis(decay, 1, 0)))
    return jnp.moveaxis(entering, 0, 1)


def _causal_dwconv(x, w, b):
    width = w.shape[0]
    y = lax.conv_general_dilated(x, w[:, None, :].astype(x.dtype), window_strides=(1,),
                                 padding=[(width - 1, 0)], dimension_numbers=('NWC', 'WIO', 'NWC'),
                                 feature_group_count=x.shape[-1])
    return y + b


def _rwkv7_scan(r, w, k, v, a, b):
    bsz, _, heads, n = r.shape
    seq_in = tuple(jnp.moveaxis(t.astype(jnp.float32), 1, 0) for t in (r, w, k, v, a, b))

    def step(state, inp):
        rt, wt, kt, vt, at, bt = inp
        sa = jnp.einsum('bhij,bhj->bhi', state, at)
        state = (state * wt[:, :, None, :] + vt[..., None] * kt[:, :, None, :]
                 + sa[..., None] * bt[:, :, None, :])
        return state, jnp.einsum('bhij,bhj->bhi', state, rt)

    s0 = jnp.zeros((bsz, heads, n, n), jnp.float32)
    _, y = lax.scan(step, s0, seq_in)
    return jnp.moveaxis(y, 0, 1)


def _rwkv7(za, mu, decay_up, w0, a_up, a0, gate_up, k_k, k_a, r_k, ln_w, ln_b, v_first, v_mix):
    bsz, seq, _ = za.shape
    f32 = jnp.float32
    za = za + (_shift(za) - za) * mu
    r, k, v, xw, xa, xg = _split(za, [RWKV_DIM, RWKV_DIM, RWKV_DIM, RWKV_DECAY_RANK, RWKV_A_RANK, RWKV_GATE_RANK])
    w_log = -jax.nn.softplus(-(w0 + jnp.tanh(xw) @ decay_up).astype(f32)) - 0.5
    decay = jnp.exp(-jnp.exp(w_log))
    a = jax.nn.sigmoid(a0 + xa @ a_up)
    g = jax.nn.sigmoid(xg) @ gate_up
    v_raw = v
    if v_mix is not None:
        v = v + (v_first - v) * v_mix
    kk = k * k_k
    k = k * (1.0 + (a - 1.0) * k_a)

    def heads(t):
        return t.astype(f32).reshape(bsz, seq, RWKV_HEADS, RWKV_HEAD_DIM)

    r, k, v, a, kk, decay = (heads(t) for t in (r, k, v, a, kk, decay))
    kk = kk / jnp.maximum(jnp.sqrt(jnp.sum(kk * kk, axis=-1, keepdims=True)), 1e-12)
    y = _rwkv7_scan(r, decay, k, v, -kk, kk * a)
    mean = jnp.mean(y, axis=-1, keepdims=True)
    var = jnp.mean(jnp.square(y - mean), axis=-1, keepdims=True)
    y = (y - mean) * lax.rsqrt(var + RWKV_LN_EPS)
    y = (y * ln_w.astype(f32).reshape(RWKV_HEADS, RWKV_HEAD_DIM)
         + ln_b.astype(f32).reshape(RWKV_HEADS, RWKV_HEAD_DIM))
    y = y + jnp.sum(r * k * r_k.astype(f32), axis=-1, keepdims=True) * v
    out = y.reshape(bsz, seq, RWKV_DIM) * g.astype(f32)
    return out.astype(za.dtype), v_raw


def _mamba2(zb, conv_w, conv_b, dt_bias, a_log, d_skip, norm_w):
    bsz, seq, _ = zb.shape
    f32 = jnp.float32
    e = SSM_HEADS // SSM_GROUPS
    gate, xbc, dt = _split(zb, [SSM_DIM, SSM_XBC, SSM_HEADS])
    xbc = jax.nn.silu(_causal_dwconv(xbc, conv_w, conv_b))
    xs, bm, cm = _split(xbc, [SSM_DIM, SSM_GROUPS * SSM_STATE, SSM_GROUPS * SSM_STATE])
    xs = _chunks(xs.astype(f32), SSM_GROUPS, e, SSM_HEAD_DIM)
    bm = _chunks(bm.astype(f32), SSM_GROUPS, SSM_STATE)
    cm = _chunks(cm.astype(f32), SSM_GROUPS, SSM_STATE)
    dt = _chunks(jax.nn.softplus(dt.astype(f32) + dt_bias.astype(f32)), SSM_GROUPS, e)
    a = -jnp.exp(a_log.astype(f32)).reshape(SSM_GROUPS, e)
    acs = jnp.cumsum(dt * a, axis=2)
    xdt = xs * dt[..., None]
    causal = jnp.tril(jnp.ones((CHUNK, CHUNK), bool))
    seg = acs[:, :, :, None] - acs[:, :, None, :]
    lmat = jnp.exp(jnp.where(causal[:, :, None, None], seg, -jnp.inf))
    cb = jnp.einsum('bclgn,bcsgn->bclsg', cm, bm)
    y = jnp.einsum('bclsg,bclsge,bcsgep->bclgep', cb, lmat, xdt)
    decay_to_end = jnp.exp(acs[:, :, -1:] - acs)
    states = jnp.einsum('bclgn,bclge,bclgep->bcgepn', bm, decay_to_end, xdt)
    entering = _chunk_scan(states, jnp.exp(acs[:, :, -1])[..., None, None])
    y = y + jnp.einsum('bclgn,bcgepn,bclge->bclgep', cm, entering, jnp.exp(acs))
    y = y + xs * d_skip.astype(f32).reshape(SSM_GROUPS, e, 1)
    y = y.reshape(bsz, seq, SSM_DIM) * jax.nn.silu(gate.astype(f32))
    y = _rms(y.reshape(bsz, seq, SSM_GROUPS, SSM_DIM // SSM_GROUPS), norm_w.reshape(SSM_GROUPS, -1))
    return y.reshape(bsz, seq, SSM_DIM).astype(zb.dtype)


def _band_attention(zc, q_gain, k_gain, rel_bias):
    bsz, seq, _ = zc.shape
    nc = seq // CHUNK
    q, k, v = _split(zc, [ATT_DIM, ATT_DIM, ATT_DIM])
    q = _chunks(_rms(q.reshape(bsz, seq, ATT_HEADS, ATT_HEAD_DIM), q_gain), ATT_HEADS, ATT_HEAD_DIM)
    k = _chunks(_rms(k.reshape(bsz, seq, ATT_HEADS, ATT_HEAD_DIM), k_gain), ATT_HEADS, ATT_HEAD_DIM)
    v = _chunks(v, ATT_HEADS, ATT_HEAD_DIM)
    pad = ((0, 0), (ATT_LEFT_CHUNKS, 0), (0, 0), (0, 0), (0, 0))
    kp = jnp.pad(k, pad)
    vp = jnp.pad(v, pad)
    k_band = jnp.concatenate([kp[:, i:i + nc] for i in range(ATT_LEFT_CHUNKS + 1)], axis=2)
    v_band = jnp.concatenate([vp[:, i:i + nc] for i in range(ATT_LEFT_CHUNKS + 1)], axis=2)
    scores = jnp.einsum('bclhd,bckhd->bhclk', q, k_band,
                        preferred_element_type=jnp.float32) * (ATT_HEAD_DIM ** -0.5)
    q_pos = ATT_LEFT_CHUNKS * CHUNK + jnp.arange(CHUNK)
    k_pos = jnp.arange(ATT_BAND)
    rel = jnp.clip(k_pos[None, :] - q_pos[:, None], -REL_CLIP, REL_CLIP) + REL_CLIP
    bias = rel_bias.astype(jnp.float32)[:, rel]
    key_chunk = jnp.arange(nc)[:, None] - ATT_LEFT_CHUNKS + k_pos[None, :] // CHUNK
    scores = jnp.where((key_chunk >= 0)[None, None, :, None, :], scores + bias[:, None], -jnp.inf)
    probs = jax.nn.softmax(scores, axis=-1)
    o = jnp.einsum('bhclk,bckhd->bclhd', probs.astype(v.dtype), v_band)
    return o.reshape(bsz, seq, ATT_DIM)


def _gla(zd, gate_up, gate_bias, norm_w):
    bsz, seq, _ = zd.shape
    f32 = jnp.float32
    dk = GLA_KEY_DIM // GLA_HEADS
    dv = GLA_VAL_DIM // GLA_HEADS
    q, k, v, xgk, g = _split(zd, [GLA_KEY_DIM, GLA_KEY_DIM, GLA_VAL_DIM, GLA_GATE_RANK, GLA_VAL_DIM])
    log_a = jax.nn.log_sigmoid((xgk @ gate_up + gate_bias).astype(f32)) / GLA_GATE_NORM
    q = _chunks(q.astype(f32) * (dk ** -0.5), GLA_HEADS, dk)
    k = _chunks(k.astype(f32), GLA_HEADS, dk)
    v = _chunks(v.astype(f32), GLA_HEADS, dv)
    bcum = jnp.cumsum(_chunks(log_a, GLA_HEADS, dk), axis=2)
    blast = bcum[:, :, -1:]
    qg = q * jnp.exp(bcum)
    kg = k * jnp.exp(-bcum)
    kd = k * jnp.exp(blast - bcum)
    causal = jnp.tril(jnp.ones((CHUNK, CHUNK), bool))
    att = jnp.where(causal, jnp.einsum('bclhk,bcshk->bchls', qg, kg), 0.0)
    o = jnp.einsum('bchls,bcshv->bclhv', att, v)
    contrib = jnp.einsum('bclhk,bclhv->bchkv', kd, v)
    entering = _chunk_scan(contrib, jnp.exp(blast[:, :, 0])[..., None])
    o = o + jnp.einsum('bclhk,bchkv->bclhv', qg, entering)
    o = _rms(o.reshape(bsz, seq, GLA_HEADS, dv), norm_w)
    o = o.reshape(bsz, seq, GLA_VAL_DIM) * jax.nn.silu(g.astype(f32))
    return o.astype(zd.dtype)


def _swiglu(x, w1, w3, w2):
    return (jax.nn.silu(x @ w1) * (x @ w3)) @ w2


def _moe(x, w_router, w1, w3, w2):
    bsz, seq, d = x.shape
    n_tok = bsz * seq
    n_pair = n_tok * TOP_K
    xf = x.reshape(n_tok, d)
    logits = (xf @ w_router).astype(jnp.float32)
    top_val, top_idx = lax.top_k(logits, TOP_K)
    gate = jax.nn.softmax(top_val, axis=-1)
    e_pair = top_idx.reshape(-1)
    t_pair = jnp.arange(n_pair) // TOP_K
    g_pair = gate.reshape(-1)
    order = jnp.argsort(e_pair)
    e_sorted = e_pair[order]
    counts = jnp.bincount(e_pair, length=N_EXPERTS)
    padded = (counts + MOE_ROWS - 1) // MOE_ROWS * MOE_ROWS
    start_sorted = jnp.cumsum(counts) - counts
    end_padded = jnp.cumsum(padded)
    start_padded = end_padded - padded
    dest = start_padded[e_sorted] + jnp.arange(n_pair) - start_sorted[e_sorted]
    n_groups = (n_pair + MOE_ROWS - 1) // MOE_ROWS + N_EXPERTS
    n_rows = n_groups * MOE_ROWS
    row_token = jnp.full((n_rows,), n_tok, jnp.int32).at[dest].set(t_pair[order].astype(jnp.int32))
    row_gate = jnp.zeros((n_rows,), jnp.float32).at[dest].set(g_pair[order])
    group_expert = jnp.minimum(jnp.searchsorted(end_padded, jnp.arange(n_groups) * MOE_ROWS, side='right'),
                               N_EXPERTS - 1)
    x_pad = jnp.concatenate([xf, jnp.zeros((1, d), xf.dtype)], axis=0)
    xg = x_pad[row_token].reshape(n_groups, MOE_ROWS, d)

    def expert_rows(args):
        rows, e = args
        return _swiglu(rows, w1[e], w3[e], w2[e])

    yg = lax.map(expert_rows, (xg, group_expert)).reshape(n_rows, d)
    out = jnp.zeros((n_tok + 1, d), jnp.float32).at[row_token].add(yg.astype(jnp.float32) * row_gate[:, None])
    return out[:n_tok].reshape(bsz, seq, d).astype(x.dtype)


def setup_inputs(seed: int = 0) -> dict:
    key = jax.random.key(seed)
    ks = iter(jax.random.split(key, 64))
    f32 = jnp.float32

    def nrm(shape, scale):
        return jax.random.normal(next(ks), shape, f32) * scale

    def uni(shape, lo, hi):
        return jax.random.uniform(next(ks), shape, f32, lo, hi)

    L = DEPTH
    dt0 = jnp.exp(uni((L, SSM_HEADS), math.log(1e-3), math.log(1e-1)))
    return {
        'x': nrm((BATCH, SEQ, D_MODEL), 1.0),
        'w_in': nrm((L, D_MODEL, IN_COLS), D_MODEL ** -0.5),
        'norm_mix': 1.0 + nrm((L, D_MODEL), 0.02),
        'rwkv_mu': uni((L, RWKV_COLS), 0.0, 1.0),
        'rwkv_decay_up': nrm((L, RWKV_DECAY_RANK, RWKV_DIM), RWKV_DECAY_RANK ** -0.5),
        'rwkv_w0': uni((L, RWKV_DIM), -6.0, 0.0),
        'rwkv_a_up': nrm((L, RWKV_A_RANK, RWKV_DIM), RWKV_A_RANK ** -0.5),
        'rwkv_a0': nrm((L, RWKV_DIM), 0.1),
        'rwkv_gate_up': nrm((L, RWKV_GATE_RANK, RWKV_DIM), RWKV_GATE_RANK ** -0.5),
        'rwkv_k_k': 0.85 + nrm((L, RWKV_DIM), 0.02),
        'rwkv_k_a': 1.0 + nrm((L, RWKV_DIM), 0.02),
        'rwkv_r_k': nrm((L, RWKV_HEADS, RWKV_HEAD_DIM), 0.1),
        'rwkv_ln_w': 1.0 + nrm((L, RWKV_DIM), 0.02),
        'rwkv_ln_b': nrm((L, RWKV_DIM), 0.02),
        'vres_down': nrm((N_VRES, D_MODEL, RWKV_V_RANK), D_MODEL ** -0.5),
        'vres_up': nrm((N_VRES, RWKV_V_RANK, RWKV_DIM), RWKV_V_RANK ** -0.5),
        'vres_v0': 1.0 + nrm((N_VRES, RWKV_DIM), 0.1),
        'ssm_conv_w': nrm((L, SSM_CONV, SSM_XBC), SSM_CONV ** -0.5),
        'ssm_conv_b': nrm((L, SSM_XBC), 0.02),
        'ssm_dt_bias': dt0 + jnp.log(-jnp.expm1(-dt0)),
        'ssm_a_log': jnp.log(uni((L, SSM_HEADS), 1.0, 16.0)),
        'ssm_d': 1.0 + nrm((L, SSM_HEADS), 0.1),
        'ssm_norm_w': 1.0 + nrm((L, SSM_DIM), 0.02),
        'att_q_gain': 1.0 + nrm((L, ATT_HEAD_DIM), 0.02),
        'att_k_gain': 1.0 + nrm((L, ATT_HEAD_DIM), 0.02),
        'att_rel_bias': nrm((ATT_HEADS, 2 * REL_CLIP + 1), 0.2),
        'gla_gate_up': nrm((L, GLA_GATE_RANK, GLA_KEY_DIM), GLA_GATE_RANK ** -0.5),
        'gla_gate_bias': nrm((L, GLA_KEY_DIM), 0.1),
        'gla_norm_w': 1.0 + nrm((L, GLA_VAL_DIM // GLA_HEADS), 0.02),
        'w_branch': nrm((L, N_BRANCH, BRANCH_DIM, D_MODEL), BRANCH_DIM ** -0.5),
        'w_out': nrm((L, D_MODEL, D_MODEL), D_MODEL ** -0.5),
        'norm_ffn': 1.0 + nrm((L, D_MODEL), 0.02),
        'ffn_w1': nrm((N_DENSE, D_MODEL, FFN_DIM), D_MODEL ** -0.5),
        'ffn_w3': nrm((N_DENSE, D_MODEL, FFN_DIM), D_MODEL ** -0.5),
        'ffn_w2': nrm((N_DENSE, FFN_DIM, D_MODEL), FFN_DIM ** -0.5),
        'moe_router': nrm((N_MOE, D_MODEL, N_EXPERTS), D_MODEL ** -0.5),
        'moe_w1': nrm((N_MOE, N_EXPERTS, D_MODEL, EXPERT_DIM), D_MODEL ** -0.5),
        'moe_w3': nrm((N_MOE, N_EXPERTS, D_MODEL, EXPERT_DIM), D_MODEL ** -0.5),
        'moe_w2': nrm((N_MOE, N_EXPERTS, EXPERT_DIM, D_MODEL), EXPERT_DIM ** -0.5),
    }


def reference(x, w_in, norm_mix, rwkv_mu, rwkv_decay_up, rwkv_w0, rwkv_a_up, rwkv_a0, rwkv_gate_up,
              rwkv_k_k, rwkv_k_a, rwkv_r_k, rwkv_ln_w, rwkv_ln_b, vres_down, vres_up, vres_v0,
              ssm_conv_w, ssm_conv_b, ssm_dt_bias, ssm_a_log, ssm_d, ssm_norm_w,
              att_q_gain, att_k_gain, att_rel_bias, gla_gate_up, gla_gate_bias, gla_norm_w,
              w_branch, w_out, norm_ffn, ffn_w1, ffn_w3, ffn_w2, moe_router, moe_w1, moe_w3, moe_w2):
    bsz, seq, _ = x.shape
    v_first = None
    for l in range(DEPTH):
        h = _rms(x, norm_mix[l])
        z = h @ w_in[l]
        za, zb, zc, zd, zg = _split(z, [RWKV_COLS, SSM_COLS, ATT_COLS, GLA_COLS, GATE_COLS])
        v_mix = None
        if l > 0:
            v_mix = jax.nn.sigmoid(vres_v0[l - 1] + (h @ vres_down[l - 1]) @ vres_up[l - 1])
        o_a, v_raw = _rwkv7(za, rwkv_mu[l], rwkv_decay_up[l], rwkv_w0[l], rwkv_a_up[l], rwkv_a0[l],
                            rwkv_gate_up[l], rwkv_k_k[l], rwkv_k_a[l], rwkv_r_k[l], rwkv_ln_w[l],
                            rwkv_ln_b[l], v_first, v_mix)
        if l == 0:
            v_first = v_raw
        o_b = _mamba2(zb, ssm_conv_w[l], ssm_conv_b[l], ssm_dt_bias[l], ssm_a_log[l], ssm_d[l], ssm_norm_w[l])
        o_c = _band_attention(zc, att_q_gain[l], att_k_gain[l], att_rel_bias)
        o_d = _gla(zd, gla_gate_up[l], gla_gate_bias[l], gla_norm_w[l])
        branches = jnp.stack([o_a, o_b, o_c, o_d], axis=2).astype(x.dtype)
        u = jnp.einsum('bsnc,ncd->bsnd', branches, w_branch[l])
        gates = jax.nn.sigmoid(zg.reshape(bsz, seq, N_BRANCH, D_MODEL))
        x = x + jnp.sum(gates * u, axis=2) @ w_out[l]
        hf = _rms(x, norm_ffn[l])
        if l % 2 == 0:
            x = x + _swiglu(hf, ffn_w1[l // 2], ffn_w3[l // 2], ffn_w2[l // 2])
        else:
            x = x + _moe(hf, moe_router[l // 2], moe_w1[l // 2], moe_w3[l // 2], moe_w2[l // 2])
    return x
```

```cpp
#include <hip/hip_runtime.h>
#include <hip/hip_cooperative_groups.h>
#include <cstdio>
#include <cstdint>
namespace cg = cooperative_groups;

#ifndef MK_PER_PHASE
#define MK_PER_PHASE 1
#endif

#define LAS __attribute__((address_space(3)))
typedef unsigned short bf16;
typedef short bf16x8 __attribute__((ext_vector_type(8)));
typedef float f32x4 __attribute__((ext_vector_type(4)));
typedef float f32x2 __attribute__((ext_vector_type(2)));
typedef unsigned u32x4 __attribute__((ext_vector_type(4)));
typedef unsigned u32x2 __attribute__((ext_vector_type(2)));

constexpr int BATCH = 8, SEQ = 2048, DM = 1024, T = BATCH * SEQ;
constexpr int CHUNK = 64, NCH = SEQ / CHUNK;
constexpr int IN_COLS = 10552, MIXC = 6456;
constexpr int ZC = 6656;
constexpr int C_RWKV = 0, C_SSM = 1824, C_ATT = 3368, C_GLA = 4904, C_HV = 6456;
constexpr int FFN = 2816, NEXP = 8, EDIM = 3584;
constexpr int MOE_ROWS = 2 * T + NEXP * 256;
constexpr float NORM_EPS = 1e-6f;

constexpr size_t MiB = 1u << 20;
constexpr size_t WS_CTL = 0;
constexpr size_t CTL_BYTES = 1 * MiB;
constexpr size_t WS_SMALL = WS_CTL + CTL_BYTES;
constexpr size_t SM_SS = 0;
constexpr size_t SM_MSSQ = SM_SS + 3 * (size_t)T * 16 * 4;
constexpr size_t SM_TOKE = SM_MSSQ + (size_t)T * 8 * 4;
constexpr size_t SM_TOKG = SM_TOKE + (size_t)T * 2 * 4;
constexpr size_t SM_TOKRS = SM_TOKG + (size_t)T * 2 * 4;
constexpr size_t SM_TOKSLOT = SM_TOKRS + (size_t)T * 4;
constexpr size_t SM_ROWTOK = SM_TOKSLOT + (size_t)T * 2 * 4;
constexpr size_t SM_ROWGATE = SM_ROWTOK + (size_t)MOE_ROWS * 4;
constexpr size_t SM_ROWRS = SM_ROWGATE + (size_t)MOE_ROWS * 4;
constexpr size_t SM_END = SM_ROWRS + (size_t)MOE_ROWS * 4;
static_assert(SM_END <= 6 * MiB, "small region");
constexpr size_t WS_XB = WS_SMALL + 6 * MiB;
constexpr size_t WS_X = WS_XB + (size_t)T * DM * 2;
constexpr size_t X_VFIRST = 0;
constexpr size_t X_MIXED = X_VFIRST + (size_t)T * 512 * 2;
constexpr size_t X_O = X_MIXED + (size_t)T * DM * 2;
constexpr size_t X_W = X_O + (size_t)T * 2048 * 2;
constexpr size_t W_IN = 0;
constexpr size_t W_G = W_IN + 2 * (size_t)ZC * DM * 2;
constexpr size_t W_B = W_G + 2 * (size_t)4096 * DM * 2;
constexpr size_t W_O = W_B + 2 * 4 * (size_t)DM * 512 * 2;
constexpr size_t W_13 = W_O + 2 * (size_t)DM * DM * 2;
constexpr size_t W_2 = W_13 + (size_t)2 * FFN * DM * 2;
constexpr size_t W_END = W_2 + (size_t)DM * FFN * 2;
constexpr size_t X_BYTES = X_W + W_END;
constexpr size_t MOE_W13 = 0;
constexpr size_t MOE_W2 = MOE_W13 + (size_t)NEXP * 2 * EDIM * DM * 2;
constexpr size_t MOE_WEND = MOE_W2 + (size_t)NEXP * DM * EDIM * 2;
static_assert(MOE_WEND <= X_BYTES, "MoE weights must fit the X region");
constexpr size_t WS_Z = WS_X + X_BYTES;
constexpr size_t Z_BYTES = (size_t)MOE_ROWS * EDIM * 2;
static_assert((size_t)T * ZC * 2 <= Z_BYTES, "z fits");
constexpr size_t WS_XG = WS_Z + Z_BYTES;
constexpr size_t XG_BYTES = (size_t)MOE_ROWS * DM * 2;
static_assert(4 * (size_t)T * 512 * 2 <= XG_BYTES, "rwkv arrays fit");
constexpr size_t WS_END = WS_XG + XG_BYTES;

constexpr int CW_MOECNT = 64;
constexpr int CW_MOECUR = 128;
constexpr int CW_BAR = 1024;

__device__ __forceinline__ float bf2f(bf16 v) { return __builtin_bit_cast(float, (unsigned)v << 16); }
__device__ __forceinline__ unsigned f2bf(float f) { unsigned u = __builtin_bit_cast(unsigned, f); return (u + 0x7fffu + ((u >> 16) & 1u)) >> 16; }
__device__ __forceinline__ unsigned pk2(float lo, float hi) { return f2bf(lo) | (f2bf(hi) << 16); }
__device__ __forceinline__ float lo2f(unsigned w) { return __builtin_bit_cast(float, w << 16); }
__device__ __forceinline__ float hi2f(unsigned w) { return __builtin_bit_cast(float, w & 0xffff0000u); }
__device__ __forceinline__ float sigmoidf_(float x) { return 1.0f / (1.0f + __expf(-x)); }
__device__ __forceinline__ float siluf_(float x) { return x / (1.0f + __expf(-x)); }
__device__ __forceinline__ float softplusf_(float x) { return x > 20.f ? x : log1pf(__expf(x)); }
__device__ __forceinline__ float wave_sum(float v) {
#pragma unroll
    for (int o = 1; o < 64; o <<= 1) v += __shfl_xor(v, o);
    return v;
}
__device__ __forceinline__ float rdlane(float v, int l) { return __builtin_bit_cast(float, __builtin_amdgcn_readlane(__builtin_bit_cast(int, v), l)); }

namespace pg8 {
constexpr int BM = 256, BK = 64, HALF = 128, HTB = HALF * BK * 2, STAGE_BYTES = 8 * HTB, NXCD = 8, WGM = 8;
__host__ __device__ __forceinline__ int lds_byte(int r, int c) { const int st = (r >> 4) * 2 + (c >> 5), rr = r & 15, cc = c & 31, ob = rr * 64 + cc * 2; return st * 1024 + (ob ^ (((ob >> 9) & 1) << 5)); }
__host__ __device__ __forceinline__ void stage_rc(int b, int& R, int& C) { const int st = b / 1024, sb = b % 1024, swz = sb ^ (((sb >> 9) & 1) << 5); R = (st >> 1) * 16 + swz / 64; C = (st & 1) * 32 + (swz % 64) / 2; }
__host__ __device__ __forceinline__ int perm32(int rho) { const int n = rho >> 4, i = rho & 15; return 8 * (i >> 2) + 4 * n + (i & 3); }

struct Unit { int pm, pn, e; };
struct Gemm { int lda, ldb, K; };

struct StaticOrder {
    const char* A; const char* Bt; size_t tstepA, tstepB;
    int nM, nN, nwg, G, c;
    __device__ __forceinline__ void init(const void* A_, const void* Bt_, int lda, int ldb, int M, int N, int G_, int c_) { A = (const char*)A_; Bt = (const char*)Bt_; tstepA = (size_t)BM * lda * 2; tstepB = (size_t)BM * ldb * 2; nM = M / BM; nN = N / BM; nwg = nM * nN; G = G_; c = c_; }
    __device__ __forceinline__ bool next(int i, Unit& u) const {
        const long L = (long)i * G + c; if (L >= nwg) return false;
        int wgid = (int)L; { const int q = nwg / NXCD, r = nwg % NXCD, xcd = wgid % NXCD, off = wgid / NXCD; wgid = (xcd < r ? xcd * (q + 1) : r * (q + 1) + (xcd - r) * q) + off; }
        const int nig = WGM * nN, gid = wgid / nig, fm = gid * WGM, gsz = (nM - fm) < WGM ? (nM - fm) : WGM;
        u.pm = fm + ((wgid % nig) % gsz); u.pn = (wgid % nig) / gsz; u.e = 0; return true;
    }
    __device__ __forceinline__ const char* a_ptr(const Unit& u) const { return A + (size_t)u.pm * tstepA; }
    __device__ __forceinline__ const char* b_ptr(const Unit& u) const { return Bt + (size_t)u.pn * tstepB; }
};

__device__ __forceinline__ unsigned cvt_pk_bf16(float lo, float hi) { unsigned r; asm volatile("v_cvt_pk_bf16_f32 %0, %1, %2" : "=v"(r) : "v"(lo), "v"(hi)); return r; }

template <class Epi, class Sched>
__device__ __forceinline__ void gemm_phase(LAS unsigned char* lds, const Gemm g, const Sched& S, const Epi& E) {
    const int tid = threadIdx.x, wid = __builtin_amdgcn_readfirstlane(tid >> 6), lane = tid & 63, wr = wid >> 2, wc = wid & 3, fr = lane & 15, fq = lane >> 4;
    const int nt = g.K / BK;
    unsigned voffA[2], voffB[2];
#pragma unroll
    for (int i = 0; i < 2; ++i) { int R, C; stage_rc(tid * 16 + i * 8192, R, C); const int Rb = Epi::PERM ? ((R & ~31) + perm32(R & 31)) : R;
        voffA[i] = (unsigned)(R * g.lda + C) * 2u; voffB[i] = (unsigned)(Rb * g.ldb + C) * 2u; }
    const size_t kstep = (size_t)(BK * 2);
    const size_t hstepA = (size_t)HALF * g.lda * 2, hstepB = (size_t)HALF * g.ldb * 2;
    const unsigned ldsw = (unsigned)wid * 1024u;
    const int aoff = lds_byte(wr * 64 + fr, fq * 8), boff = lds_byte(wc * 32 + fr, fq * 8);
#define PG8_SA(b, h) (((b) * 2 + (h)) * HTB)
#define PG8_SB(b, h) ((4 + (b) * 2 + (h)) * HTB)
#define PG8_STAGE(bufoff, gbase, voff) do { _Pragma("unroll") for (int _i = 0; _i < 2; ++_i) \
        __builtin_amdgcn_global_load_lds((const unsigned*)((const char*)(gbase) + (voff)[_i]), (LAS unsigned*)(lds + (bufoff) + ldsw + _i * 8192), 16, 0, 0); } while (0)
#define PG8_LDA(dst, b, h) do { _Pragma("unroll") for (int m = 0; m < 4; ++m) _Pragma("unroll") for (int k = 0; k < 2; ++k) dst[m][k] = *(const LAS bf16x8*)(lds + PG8_SA(b, h) + aoff + m * 2048 + k * 1024); } while (0)
#define PG8_LDB(dst, b, h) do { _Pragma("unroll") for (int n = 0; n < 2; ++n) _Pragma("unroll") for (int k = 0; k < 2; ++k) dst[n][k] = *(const LAS bf16x8*)(lds + PG8_SB(b, h) + boff + n * 2048 + k * 1024); } while (0)
#define PG8_MMA(ai, bj, At, Bt) do { __builtin_amdgcn_s_setprio(1); _Pragma("unroll") for (int m = 0; m < 4; ++m) _Pragma("unroll") for (int n = 0; n < 2; ++n) _Pragma("unroll") for (int k = 0; k < 2; ++k) \
        acc[ai][bj][m][n] = __builtin_amdgcn_mfma_f32_16x16x32_bf16(Bt[n][k], At[m][k], acc[ai][bj][m][n], 0, 0, 0); __builtin_amdgcn_s_setprio(0); } while (0)
#define PG8_WAIT_V(n) asm volatile("s_waitcnt vmcnt(" #n ")" ::: "memory")
#define PG8_WAIT_L(n) asm volatile("s_waitcnt lgkmcnt(" #n ")" ::: "memory")
#define PG8_BAR __builtin_amdgcn_s_barrier()
#define PG8_SCHED __builtin_amdgcn_sched_barrier(0)
    Unit cur, nxt; int ui = 0;
    if (!S.next(0, cur)) return;
    f32x4 acc[2][2][4][2];
#pragma unroll
    for (int a = 0; a < 2; ++a)
#pragma unroll
        for (int b = 0; b < 2; ++b)
#pragma unroll
            for (int m = 0; m < 4; ++m)
#pragma unroll
                for (int n = 0; n < 2; ++n) acc[a][b][m][n] = (f32x4){0.f, 0.f, 0.f, 0.f};
    bf16x8 At[4][2], B0[2][2], B1[2][2];
    const char* cA = S.a_ptr(cur); const char* cB = S.b_ptr(cur);
    PG8_STAGE(PG8_SB(0, 0), cB, voffB); PG8_STAGE(PG8_SB(0, 1), cB + hstepB, voffB); PG8_STAGE(PG8_SA(0, 0), cA, voffA); PG8_STAGE(PG8_SA(0, 1), cA + hstepA, voffA);
    if (wr == 1) PG8_BAR;
    PG8_WAIT_V(2); PG8_BAR;
    PG8_STAGE(PG8_SB(1, 0), cB + kstep, voffB); PG8_STAGE(PG8_SA(1, 0), cA + kstep, voffA); PG8_STAGE(PG8_SB(1, 1), cB + hstepB + kstep, voffB);
    PG8_WAIT_V(6); PG8_BAR;
    for (;;) {
        const bool has_next = S.next(ui + 1, nxt);
        const char* nA = has_next ? S.a_ptr(nxt) : cA; const char* nB = has_next ? S.b_ptr(nxt) : cB;
        for (int t = 0; t < nt; t += 2) {
            const bool last = (t == nt - 2);
            const char* a1 = cA + (size_t)(t + 1) * kstep;
            const char* a2 = last ? nA : cA + (size_t)(t + 2) * kstep; const char* b2 = last ? nB : cB + (size_t)(t + 2) * kstep;
            const char* a3 = a2 + kstep; const char* b3 = b2 + kstep;
            PG8_LDB(B0, 0, 0); PG8_LDB(B1, 0, 1); PG8_SCHED; PG8_LDA(At, 0, 0); PG8_STAGE(PG8_SA(1, 1), a1 + hstepA, voffA);
            PG8_WAIT_V(8); PG8_WAIT_L(0); PG8_BAR; PG8_MMA(0, 0, At, B0); PG8_MMA(0, 1, At, B1); PG8_BAR; PG8_SCHED;
            PG8_LDA(At, 0, 1); PG8_STAGE(PG8_SB(0, 0), b2, voffB); PG8_STAGE(PG8_SB(0, 1), b2 + hstepB, voffB); PG8_STAGE(PG8_SA(0, 0), a2, voffA);
            PG8_WAIT_V(8); PG8_WAIT_L(0); PG8_BAR; PG8_MMA(1, 0, At, B0); PG8_MMA(1, 1, At, B1); PG8_BAR; PG8_SCHED;
            PG8_LDB(B0, 1, 0); PG8_LDB(B1, 1, 1); PG8_SCHED; PG8_LDA(At, 1, 0); PG8_STAGE(PG8_SA(0, 1), a2 + hstepA, voffA);
            PG8_WAIT_V(8); PG8_WAIT_L(0); PG8_BAR; PG8_MMA(0, 0, At, B0); PG8_MMA(0, 1, At, B1); PG8_BAR; PG8_SCHED;
            PG8_LDA(At, 1, 1); PG8_STAGE(PG8_SB(1, 0), b3, voffB); PG8_STAGE(PG8_SB(1, 1), b3 + hstepB, voffB); PG8_STAGE(PG8_SA(1, 0), a3, voffA);
            PG8_WAIT_V(8); PG8_WAIT_L(0); PG8_BAR; PG8_MMA(1, 0, At, B0); PG8_MMA(1, 1, At, B1); PG8_BAR; PG8_SCHED;
        }
        if (wr == 0) PG8_BAR;
        E(acc, cur, wr, wc, fr, fq);
        if (!has_next) break;
        if constexpr (!Epi::CHAIN) {
#pragma unroll
        for (int a = 0; a < 2; ++a)
#pragma unroll
            for (int b = 0; b < 2; ++b)
#pragma unroll
                for (int m = 0; m < 4; ++m)
#pragma unroll
                    for (int n = 0; n < 2; ++n) acc[a][b][m][n] = (f32x4){0.f, 0.f, 0.f, 0.f};
        }
        cur = nxt; cA = nA; cB = nB; ++ui;
        if (wr == 1) PG8_BAR;
    }
    PG8_WAIT_V(0);
    PG8_BAR;
#undef PG8_SA
#undef PG8_SB
#undef PG8_STAGE
#undef PG8_LDA
#undef PG8_LDB
#undef PG8_MMA
#undef PG8_WAIT_V
#undef PG8_WAIT_L
#undef PG8_BAR
#undef PG8_SCHED
}
}

using pg8::Unit;
__device__ __forceinline__ u32x4 pack8(f32x4 v0, f32x4 v1) { u32x4 w; w.x = pg8::cvt_pk_bf16(v0[0], v0[1]); w.y = pg8::cvt_pk_bf16(v0[2], v0[3]); w.z = pg8::cvt_pk_bf16(v1[0], v1[1]); w.w = pg8::cvt_pk_bf16(v1[2], v1[3]); return w; }
__device__ __forceinline__ f32x4 sig4(f32x4 v) { return (f32x4){sigmoidf_(v[0]), sigmoidf_(v[1]), sigmoidf_(v[2]), sigmoidf_(v[3])}; }
__device__ __forceinline__ void unpack8(u32x4 w, f32x4& a, f32x4& b) { a = (f32x4){lo2f(w.x), hi2f(w.x), lo2f(w.y), hi2f(w.y)}; b = (f32x4){lo2f(w.z), hi2f(w.z), lo2f(w.w), hi2f(w.w)}; }

__device__ __forceinline__ float rs_from_parts(const float* ss, int row) { const f32x4* pp = (const f32x4*)(ss + (size_t)row * 16); const f32x4 p0 = pp[0], p1 = pp[1], p2 = pp[2], p3 = pp[3];
    const float tot = (((p0[0] + p0[1]) + (p0[2] + p0[3])) + ((p1[0] + p1[1]) + (p1[2] + p1[3]))) + (((p2[0] + p2[1]) + (p2[2] + p2[3])) + ((p3[0] + p3[1]) + (p3[2] + p3[3])));
    return rsqrtf(tot * (1.0f / DM) + NORM_EPS); }
template <int ACT> struct EpiScaleBf16 {
    static constexpr bool PERM = true, CHAIN = false;
    bf16* O; int ldc; const float* ss;
    __device__ __forceinline__ void operator()(f32x4 (&acc)[2][2][4][2], const Unit& u, int wr, int wc, int fr, int fq) const {
        const int row0 = u.pm * 256 + wr * 64 + fr, col0 = u.pn * 256 + wc * 32 + 8 * fq;
#pragma unroll
        for (int ai = 0; ai < 2; ++ai)
#pragma unroll
            for (int m = 0; m < 4; ++m) { const int row = row0 + ai * 128 + m * 16; const float s = rs_from_parts(ss, row);
                bf16* rowp = O + (size_t)row * ldc + col0;
#pragma unroll
                for (int bj = 0; bj < 2; ++bj) { f32x4 v0 = acc[ai][bj][m][0] * s, v1 = acc[ai][bj][m][1] * s;
                    if (ACT == 1) { v0 = sig4(v0); v1 = sig4(v1); }
                    *(u32x4*)(rowp + bj * 128) = pack8(v0, v1); }
                asm volatile("" ::: "memory"); }
    }
};
template <bool MOE> struct EpiSwiglu {
    static constexpr bool PERM = true, CHAIN = false;
    bf16* O; int ldc; const float* rsrc;
    __device__ __forceinline__ void operator()(f32x4 (&acc)[2][2][4][2], const Unit& u, int wr, int wc, int fr, int fq) const {
        const int row0 = u.pm * 256 + wr * 64 + fr, col0 = u.pn * 128 + wc * 32 + 8 * fq;
#pragma unroll
        for (int ai = 0; ai < 2; ++ai)
#pragma unroll
            for (int m = 0; m < 4; ++m) { const int row = row0 + ai * 128 + m * 16; const float s = MOE ? rsrc[row] : rs_from_parts(rsrc, row);
                f32x4 o[2];
#pragma unroll
                for (int n = 0; n < 2; ++n) { const f32x4 a = acc[ai][0][m][n] * s, b = acc[ai][1][m][n] * s;
                    o[n] = (f32x4){siluf_(a[0]) * b[0], siluf_(a[1]) * b[1], siluf_(a[2]) * b[2], siluf_(a[3]) * b[3]}; }
                *(u32x4*)(O + (size_t)row * ldc + col0) = pack8(o[0], o[1]);
                asm volatile("" ::: "memory"); }
    }
};
struct EpiResid {
    static constexpr bool PERM = false, CHAIN = false;
    const float* xin; float* out; bf16* xb; float* ss;
    __device__ __forceinline__ void operator()(f32x4 (&acc)[2][2][4][2], const Unit& u, int wr, int wc, int fr, int fq) const {
        const int row0 = u.pm * 256 + wr * 64 + fr, col0 = u.pn * 256 + wc * 32 + 4 * fq;
#pragma unroll
        for (int ai = 0; ai < 2; ++ai)
#pragma unroll
            for (int m = 0; m < 4; ++m) { const int row = row0 + ai * 128 + m * 16; const size_t off = (size_t)row * DM + col0; float q = 0.f;
#pragma unroll
                for (int bj = 0; bj < 2; ++bj)
#pragma unroll
                    for (int n = 0; n < 2; ++n) { const f32x4 xi = *(const f32x4*)(xin + off + bj * 128 + n * 16); const f32x4 v = xi + acc[ai][bj][m][n];
                        *(f32x4*)(out + off + bj * 128 + n * 16) = v; u32x2 w; w.x = pg8::cvt_pk_bf16(v[0], v[1]); w.y = pg8::cvt_pk_bf16(v[2], v[3]);
                        *(u32x2*)(xb + off + bj * 128 + n * 16) = w; q += (v[0] * v[0] + v[1] * v[1]) + (v[2] * v[2] + v[3] * v[3]); }
                q += __shfl_xor(q, 16); q += __shfl_xor(q, 32);
                if (fq == 0 && ss) ss[(size_t)row * 16 + u.pn * 4 + wc] = q;
                asm volatile("" ::: "memory"); }
    }
};
struct EpiMix {
    static constexpr bool PERM = true, CHAIN = true;
    const bf16* gates; bf16* mixed;
    __device__ __forceinline__ void operator()(f32x4 (&acc)[2][2][4][2], const Unit& u, int wr, int wc, int fr, int fq) const {
        const int row0 = u.pm * 256 + wr * 64 + fr, col0 = u.pn * 256 + wc * 32 + 8 * fq; const int i = u.e;
#pragma unroll
        for (int ai = 0; ai < 2; ++ai)
#pragma unroll
            for (int m = 0; m < 4; ++m) { const int row = row0 + ai * 128 + m * 16;
#pragma unroll
                for (int bj = 0; bj < 2; ++bj) { const bf16* gp = gates + (size_t)row * 4096 + i * 1024 + col0 + bj * 128;
                    f32x4 g0, g1; unpack8(*(const u32x4*)gp, g0, g1);
#pragma unroll
                    for (int j = 0; j < 4; ++j) { g0[j] = fmaxf(g0[j], 1e-30f); g1[j] = fmaxf(g1[j], 1e-30f); }
                    if (i < 3) { f32x4 h0, h1; unpack8(*(const u32x4*)(gp + 1024), h0, h1);
#pragma unroll
                        for (int j = 0; j < 4; ++j) { h0[j] = fmaxf(h0[j], 1e-30f); h1[j] = fmaxf(h1[j], 1e-30f); }
                        acc[ai][bj][m][0] = acc[ai][bj][m][0] * (g0 / h0); acc[ai][bj][m][1] = acc[ai][bj][m][1] * (g1 / h1);
                    } else {
                        *(u32x4*)(mixed + (size_t)row * DM + col0 + bj * 128) = pack8(acc[ai][bj][m][0] * g0, acc[ai][bj][m][1] * g1);
                        acc[ai][bj][m][0] = (f32x4){0.f, 0.f, 0.f, 0.f}; acc[ai][bj][m][1] = (f32x4){0.f, 0.f, 0.f, 0.f};
                    } } }
    }
};
struct EpiMoeDown {
    static constexpr bool PERM = true, CHAIN = false;
    bf16* Y; const float* rgate;
    __device__ __forceinline__ void operator()(f32x4 (&acc)[2][2][4][2], const Unit& u, int wr, int wc, int fr, int fq) const {
        const int row0 = u.pm * 256 + wr * 64 + fr, col0 = u.pn * 256 + wc * 32 + 8 * fq;
#pragma unroll
        for (int ai = 0; ai < 2; ++ai)
#pragma unroll
            for (int m = 0; m < 4; ++m) { const int row = row0 + ai * 128 + m * 16; const float s = rgate[row];
#pragma unroll
                for (int bj = 0; bj < 2; ++bj) *(u32x4*)(Y + (size_t)row * DM + col0 + bj * 128) = pack8(acc[ai][bj][m][0] * s, acc[ai][bj][m][1] * s); }
    }
};
struct MixOrder {
    const char* O; const char* Wb; int G, c;
    __device__ __forceinline__ bool next(int i, Unit& u) const {
        const int grp = (i >> 2) * G + c; if (grp >= 256) return false;
        int wgid = grp; { const int xcd = wgid % 8, off = wgid / 8; wgid = xcd * 32 + off; }
        const int nig = 8 * 4, gid = wgid / nig; u.pm = gid * 8 + ((wgid % nig) % 8); u.pn = (wgid % nig) / 8; u.e = i & 3; return true;
    }
    __device__ __forceinline__ const char* a_ptr(const Unit& u) const { return O + ((size_t)u.pm * 256 * 2048 + (size_t)u.e * 512) * 2; }
    __device__ __forceinline__ const char* b_ptr(const Unit& u) const { return Wb + ((size_t)u.e * DM * 512 + (size_t)u.pn * 256 * 512) * 2; }
};
struct MoeOrder {
    const char* A; const char* Bt; size_t tstepA, tstepB, estepB; int nN, ntiles, G, c;
    int te0, te1, te2, te3, te4, te5, te6;
    __device__ __forceinline__ void init(const void* A_, int lda, const void* Bt_, int ldb, size_t estepB_, int nN_, const unsigned* cnt, int G_, int c_) {
        A = (const char*)A_; Bt = (const char*)Bt_; tstepA = (size_t)256 * lda * 2; tstepB = (size_t)256 * ldb * 2; estepB = estepB_; nN = nN_; G = G_; c = c_;
        int acc = 0; acc += (int)((cnt[0] + 255u) >> 8); te0 = acc; acc += (int)((cnt[1] + 255u) >> 8); te1 = acc; acc += (int)((cnt[2] + 255u) >> 8); te2 = acc; acc += (int)((cnt[3] + 255u) >> 8); te3 = acc;
        acc += (int)((cnt[4] + 255u) >> 8); te4 = acc; acc += (int)((cnt[5] + 255u) >> 8); te5 = acc; acc += (int)((cnt[6] + 255u) >> 8); te6 = acc; acc += (int)((cnt[7] + 255u) >> 8); ntiles = acc;
    }
    __device__ __forceinline__ bool next(int i, Unit& u) const {
        const long L = (long)i * G + c; if (L >= (long)ntiles * nN) return false;
        const int mt = (int)(L / nN); u.pm = mt; u.pn = (int)(L % nN);
        u.e = (mt >= te0) + (mt >= te1) + (mt >= te2) + (mt >= te3) + (mt >= te4) + (mt >= te5) + (mt >= te6); return true;
    }
    __device__ __forceinline__ const char* a_ptr(const Unit& u) const { return A + (size_t)u.pm * tstepA; }
    __device__ __forceinline__ const char* b_ptr(const Unit& u) const { return Bt + (size_t)u.e * estepB + (size_t)u.pn * tstepB; }
};

enum { I_X = 0, I_WIN, I_NORM_MIX, I_RW_MU, I_RW_DECAY_UP, I_RW_W0, I_RW_A_UP, I_RW_A0, I_RW_GATE_UP, I_RW_KK, I_RW_KA, I_RW_RK, I_RW_LNW, I_RW_LNB,
       I_VRES_DOWN, I_VRES_UP, I_VRES_V0, I_SSM_CONVW, I_SSM_CONVB, I_SSM_DTB, I_SSM_ALOG, I_SSM_D, I_SSM_NORMW, I_ATT_QG, I_ATT_KG, I_ATT_BIAS,
       I_GLA_GUP, I_GLA_GB, I_GLA_NW, I_WBRANCH, I_WOUT, I_NORM_FFN, I_FFN_W1, I_FFN_W3, I_FFN_W2, I_MOE_ROUTER, I_MOE_W1, I_MOE_W3, I_MOE_W2, N_IN };
struct Args { const float* in[N_IN]; float* out; unsigned char* ws; };
static_assert(sizeof(Args) == (N_IN + 2) * 8, "Args has no padding");

struct PT { const LAS unsigned long long* tab;
    __device__ __forceinline__ const float* operator[](int i) const { const unsigned long long v = tab[i];
        const unsigned lo = __builtin_amdgcn_readfirstlane((unsigned)v), hi = __builtin_amdgcn_readfirstlane((unsigned)(v >> 32)); return (const float*)(((unsigned long long)hi << 32) | lo); } };
struct ArgsD { PT in;
    __device__ __forceinline__ float* out() const { return (float*)in[N_IN]; }
    __device__ __forceinline__ unsigned char* ws() const { return (unsigned char*)in[N_IN + 1]; } };
constexpr int NWAVES = 8, NTHREADS = 512;
constexpr int LDS_MAIN = 131072;
constexpr int LDS_CTL_OFF = LDS_MAIN;
constexpr int LDS_BYTES = LDS_MAIN + 1024;

__device__ __forceinline__ void cvt_item(const float* __restrict__ W, int ld, int k0, int csrc, int ncv, const float* __restrict__ gs, bf16* dst, int dstK, int drow, LAS float* scr, int lane) {
    const int n = lane & 31;
#pragma unroll 8
    for (int i = 0; i < 32; ++i) { const int kk = 2 * i + (lane >> 5); float v = (n < ncv) ? W[(size_t)(k0 + kk) * ld + csrc + n] : 0.f; if (gs) v *= gs[k0 + kk]; scr[kk * 33 + n] = v; }
    asm volatile("s_waitcnt lgkmcnt(0)" ::: "memory");
    const int c = lane & 7;
#pragma unroll
    for (int j = 0; j < 4; ++j) { const int nn = (lane >> 3) + 8 * j; const LAS float* s = scr + (8 * c) * 33 + nn;
        u32x4 o; o.x = pk2(s[0 * 33], s[1 * 33]); o.y = pk2(s[2 * 33], s[3 * 33]); o.z = pk2(s[4 * 33], s[5 * 33]); o.w = pk2(s[6 * 33], s[7 * 33]);
        if (nn < ncv) *(u32x4*)(dst + (size_t)(drow + nn) * dstK + k0 + 8 * c) = o; }
    asm volatile("s_waitcnt lgkmcnt(0)" ::: "memory");
}
struct CvtCtx { int gw, ngw, base, lane; LAS float* scr; };
__device__ __forceinline__ void cvt_job(CvtCtx& cx, const float* W, int ld, int K, int csrc0, int ncols, const float* gs, bf16* dst, int drow_base, int rs128) {
    const int nnb = (ncols + 31) >> 5, nit = (K >> 6) * nnb;
    int first = cx.gw - (cx.base % cx.ngw); if (first < 0) first += cx.ngw;
    for (int it = first; it < nit; it += cx.ngw) { const int kb = it / nnb, nb = it - kb * nnb, c = nb * 32; const int ncv = (ncols - c) < 32 ? (ncols - c) : 32;
        cvt_item(W, ld, kb * 64, csrc0 + c, ncv, gs, dst, K, drow_base + (c >> 7) * rs128 + (c & 127), cx.scr, cx.lane); }
    cx.base += nit;
}
__device__ __forceinline__ void zero_rows_bf16(int gtid, int nthr, bf16* dst, size_t nelem) {
    u32x4 z = {0u, 0u, 0u, 0u};
    for (size_t i = (size_t)gtid * 8; i < nelem; i += (size_t)nthr * 8) *(u32x4*)(dst + i) = z;
}

__device__ __forceinline__ float ldz(const bf16* z, size_t row, int col) { return bf2f(z[row * ZC + col]); }

__device__ __forceinline__ void rwkv_prep_task(const ArgsD& a, int l, int tg, LAS float* scr, int lane, const bf16* z, bf16* rw, bf16* vfirst) {
    const float* mu = a.in[I_RW_MU] + l * 1824;
    const int row0 = tg * 4;
#pragma unroll
    for (int j = 0; j < 4; ++j) { const size_t row = row0 + j; const bool first = ((row & (SEQ - 1)) == 0);
#pragma unroll
        for (int s = 0; s < 5; ++s) { const int k = lane + 64 * s; if (k < 288) { const int col = 1536 + k; const float cur = ldz(z, row, col); const float prv = first ? 0.f : ldz(z, row - 1, col);
                float v = cur + (prv - cur) * mu[col]; v = (k < 64) ? tanhf(v) : (k < 128 ? v : sigmoidf_(v)); scr[k * 4 + j] = v; } }
        if (lane < 32) scr[(288 + lane) * 4 + j] = (l == 1) ? ldz(z, row, C_HV + lane) : 0.f;
    }
    __builtin_amdgcn_wave_barrier();
    const float* dup = a.in[I_RW_DECAY_UP] + (size_t)l * 64 * 512; const float* aup = a.in[I_RW_A_UP] + (size_t)l * 64 * 512; const float* gup = a.in[I_RW_GATE_UP] + (size_t)l * 160 * 512;
    const float* vup = a.in[I_VRES_UP]; const LAS f32x4* inp = (const LAS f32x4*)scr;
#pragma unroll 1
    for (int h = 0; h < 8; ++h) { const int C = h * 64 + lane;
        f32x4 dw = {0.f, 0.f, 0.f, 0.f}, da = dw, gg = dw, vm = dw;
#pragma unroll 4
        for (int k = 0; k < 64; ++k) { dw += inp[k] * dup[k * 512 + C]; da += inp[64 + k] * aup[k * 512 + C]; }
#pragma unroll 4
        for (int k = 0; k < 160; ++k) gg += inp[128 + k] * gup[k * 512 + C];
        if (l == 1) {
#pragma unroll 4
            for (int k = 0; k < 32; ++k) vm += inp[288 + k] * vup[k * 512 + C]; }
        const float w0 = a.in[I_RW_W0][l * 512 + C], a0 = a.in[I_RW_A0][l * 512 + C], v0 = a.in[I_VRES_V0][C], muv = mu[1024 + C];
#pragma unroll
        for (int j = 0; j < 4; ++j) { const size_t row = row0 + j; const bool first = ((row & (SEQ - 1)) == 0);
            const float cur = ldz(z, row, 1024 + C), prv = first ? 0.f : ldz(z, row - 1, 1024 + C); const float zv = cur + (prv - cur) * muv;
            const float e = 0.60653066f * sigmoidf_(w0 + dw[j]); const float av = sigmoidf_(a0 + da[j]);
            float v = zv; if (l == 1) v = zv + (bf2f(vfirst[row * 512 + C]) - zv) * sigmoidf_(v0 + vm[j]); else vfirst[row * 512 + C] = (bf16)f2bf(zv);
            rw[row * 512 + C] = (bf16)f2bf(e); rw[(size_t)T * 512 + row * 512 + C] = (bf16)f2bf(av); rw[(size_t)2 * T * 512 + row * 512 + C] = (bf16)f2bf(v); rw[(size_t)3 * T * 512 + row * 512 + C] = (bf16)f2bf(gg[j]); }
    }
    __builtin_amdgcn_wave_barrier();
}
__device__ __forceinline__ void rwkv_scan_task(const ArgsD& a, int l, int bh, int lane, const bf16* z, const bf16* rw, bf16* o) {
    const int b = bh >> 3, h = bh & 7, C = h * 64 + lane;
    const float* mu = a.in[I_RW_MU] + l * 1824;
    const float mur = mu[C], muk = mu[512 + C], kkc = a.in[I_RW_KK][l * 512 + C], kac = a.in[I_RW_KA][l * 512 + C], rkc = a.in[I_RW_RK][l * 512 + C], lnw = a.in[I_RW_LNW][l * 512 + C], lnb = a.in[I_RW_LNB][l * 512 + C];
    float S[64];
#pragma unroll
    for (int j = 0; j < 64; ++j) S[j] = 0.f;
    float zrp = 0.f, zkp = 0.f;
    size_t row = (size_t)b * SEQ;
    float n_zr = ldz(z, row, C), n_zk = ldz(z, row, 512 + C), n_e = bf2f(rw[row * 512 + C]), n_a = bf2f(rw[(size_t)T * 512 + row * 512 + C]), n_v = bf2f(rw[(size_t)2 * T * 512 + row * 512 + C]), n_g = bf2f(rw[(size_t)3 * T * 512 + row * 512 + C]);
    for (int t = 0; t < SEQ; ++t, ++row) {
        const float zr = n_zr, zk = n_zk, e = n_e, av = n_a, v = n_v, g = n_g;
        if (t + 1 < SEQ) { const size_t r1 = row + 1; n_zr = ldz(z, r1, C); n_zk = ldz(z, r1, 512 + C); n_e = bf2f(rw[r1 * 512 + C]); n_a = bf2f(rw[(size_t)T * 512 + r1 * 512 + C]); n_v = bf2f(rw[(size_t)2 * T * 512 + r1 * 512 + C]); n_g = bf2f(rw[(size_t)3 * T * 512 + r1 * 512 + C]); }
        const float r = zr + (zrp - zr) * mur, kraw = zk + (zkp - zk) * muk; zrp = zr; zkp = zk;
        const float w = __expf(-e); const float kk = kraw * kkc; const float n2 = wave_sum(kk * kk); const float kkn = kk / fmaxf(sqrtf(n2), 1e-12f);
        const float k = kraw * (1.0f + (av - 1.0f) * kac); const float ap = -kkn, bp = kkn * av;
        float sa = 0.f;
#pragma unroll
        for (int j = 0; j < 64; ++j) sa += S[j] * rdlane(ap, j);
        float y = 0.f;
#pragma unroll
        for (int j = 0; j < 64; ++j) { S[j] = S[j] * rdlane(w, j) + (v * rdlane(k, j) + sa * rdlane(bp, j)); y += S[j] * rdlane(r, j); }
        const float mean = wave_sum(y) * (1.0f / 64.0f); const float d = y - mean; const float var = wave_sum(d * d) * (1.0f / 64.0f);
        float yn = d * rsqrtf(var + 64e-5f) * lnw + lnb;
        const float bonus = wave_sum(r * k * rkc); yn += bonus * v;
        o[row * 2048 + C] = (bf16)f2bf(yn * g);
    }
}
__device__ __forceinline__ void mamba_conv_task(const ArgsD& a, int l, int row, int lane, const bf16* z, bf16* xact) {
    const float* cw = a.in[I_SSM_CONVW] + (size_t)l * 4 * 1024; const float* cb = a.in[I_SSM_CONVB] + l * 1024;
    const int tpos = row & (SEQ - 1);
#pragma unroll
    for (int hh = 0; hh < 2; ++hh) { const int ch = hh * 512 + lane * 8; f32x4 acc0 = *(const f32x4*)(cb + ch), acc1 = *(const f32x4*)(cb + ch + 4);
#pragma unroll
        for (int j = 0; j < 4; ++j) { const int dtk = 3 - j; if (tpos >= dtk) { const u32x4 w = *(const u32x4*)(z + (size_t)(row - dtk) * ZC + C_SSM + 512 + ch); f32x4 x0, x1; unpack8(w, x0, x1);
                acc0 += x0 * *(const f32x4*)(cw + j * 1024 + ch); acc1 += x1 * *(const f32x4*)(cw + j * 1024 + ch + 4); } }
#pragma unroll
        for (int q = 0; q < 4; ++q) { acc0[q] = siluf_(acc0[q]); acc1[q] = siluf_(acc1[q]); }
        *(u32x4*)(xact + (size_t)row * 1024 + ch) = pack8(acc0, acc1); }
}
__device__ __forceinline__ void mamba_task(const ArgsD& a, int l, int bh, int lane, LAS float* scr, const bf16* z, const bf16* xact, bf16* o, float* mssq) {
    const int b = bh >> 3, hd = bh & 7, g = hd >> 2;
    const float dtb = a.in[I_SSM_DTB][l * 8 + hd], Aneg = -__expf(a.in[I_SSM_ALOG][l * 8 + hd]), Dk = a.in[I_SSM_D][l * 8 + hd];
    float hs[128];
#pragma unroll
    for (int n = 0; n < 128; ++n) hs[n] = 0.f;
    size_t row = (size_t)b * SEQ;
    const int cx = hd * 64 + lane, cB0 = 512 + g * 128 + lane, cB1 = cB0 + 64, cC0 = 768 + g * 128 + lane, cC1 = cC0 + 64, cg = C_SSM + hd * 64 + lane, cdt = C_SSM + 1536 + hd;
    for (int t = 0; t < SEQ; ++t, ++row) {
        const float xc = bf2f(xact[row * 1024 + cx]), Bc0 = bf2f(xact[row * 1024 + cB0]), Bc1 = bf2f(xact[row * 1024 + cB1]), Cc0 = bf2f(xact[row * 1024 + cC0]), Cc1 = bf2f(xact[row * 1024 + cC1]), gz = ldz(z, row, cg), dtr = ldz(z, row, cdt);
        const float dt = softplusf_(dtr + dtb); const float dA = __expf(dt * Aneg); const float xdt = xc * dt;
        float y = 0.f;
        __builtin_amdgcn_wave_barrier();
        scr[lane] = Bc0; scr[64 + lane] = Bc1; scr[128 + lane] = Cc0; scr[192 + lane] = Cc1;
        __builtin_amdgcn_wave_barrier();
#pragma unroll
        for (int n = 0; n < 128; n += 4) { const f32x4 Bv = *(const LAS f32x4*)(scr + n), Cv = *(const LAS f32x4*)(scr + 128 + n);
            hs[n] = hs[n] * dA + xdt * Bv[0]; hs[n + 1] = hs[n + 1] * dA + xdt * Bv[1]; hs[n + 2] = hs[n + 2] * dA + xdt * Bv[2]; hs[n + 3] = hs[n + 3] * dA + xdt * Bv[3];
            y += hs[n] * Cv[0] + hs[n + 1] * Cv[1] + hs[n + 2] * Cv[2] + hs[n + 3] * Cv[3]; }
        y += xc * Dk; y *= siluf_(gz);
        o[row * 2048 + 512 + hd * 64 + lane] = (bf16)f2bf(y);
        const float q = wave_sum(y * y); if (lane == 0) mssq[row * 8 + hd] = q;
    }
}
__device__ __forceinline__ void gla_task(const ArgsD& a, int l, int bh, int lane, const bf16* z, bf16* o) {
    const int b = bh >> 2, h = bh & 3;
    float gu[16];
#pragma unroll
    for (int r = 0; r < 16; ++r) gu[r] = a.in[I_GLA_GUP][(size_t)l * 16 * 256 + r * 256 + h * 64 + lane];
    const float gb = a.in[I_GLA_GB][l * 256 + h * 64 + lane], nw0 = a.in[I_GLA_NW][l * 128 + lane], nw1 = a.in[I_GLA_NW][l * 128 + 64 + lane];
    float S0[64], S1[64];
#pragma unroll
    for (int k = 0; k < 64; ++k) { S0[k] = 0.f; S1[k] = 0.f; }
    size_t row = (size_t)b * SEQ;
    for (int t = 0; t < SEQ; ++t, ++row) {
        const bf16* zr = z + row * ZC + C_GLA;
        const u32x4 x0 = *(const u32x4*)(zr + 1024), x1 = *(const u32x4*)(zr + 1032);
        const float q = bf2f(zr[h * 64 + lane]) * 0.125f, kv = bf2f(zr[256 + h * 64 + lane]), v0 = bf2f(zr[512 + h * 128 + lane]), v1 = bf2f(zr[512 + h * 128 + 64 + lane]);
        const float g0 = bf2f(zr[1040 + h * 128 + lane]), g1 = bf2f(zr[1040 + h * 128 + 64 + lane]);
        float la = gb + lo2f(x0.x) * gu[0] + hi2f(x0.x) * gu[1] + lo2f(x0.y) * gu[2] + hi2f(x0.y) * gu[3] + lo2f(x0.z) * gu[4] + hi2f(x0.z) * gu[5] + lo2f(x0.w) * gu[6] + hi2f(x0.w) * gu[7]
                 + lo2f(x1.x) * gu[8] + hi2f(x1.x) * gu[9] + lo2f(x1.y) * gu[10] + hi2f(x1.y) * gu[11] + lo2f(x1.z) * gu[12] + hi2f(x1.z) * gu[13] + lo2f(x1.w) * gu[14] + hi2f(x1.w) * gu[15];
        const float ls = fminf(la, 0.f) - log1pf(__expf(-fabsf(la)));
        const float dec = __expf(ls * (1.0f / 16.0f));
        float o0 = 0.f, o1 = 0.f;
#pragma unroll
        for (int k = 0; k < 64; ++k) { const float d = rdlane(dec, k), kk = rdlane(kv, k), qq = rdlane(q, k);
            S0[k] = S0[k] * d + kk * v0; S1[k] = S1[k] * d + kk * v1; o0 += qq * S0[k]; o1 += qq * S1[k]; }
        const float ms = wave_sum(o0 * o0 + o1 * o1) * (1.0f / 128.0f); const float sc = rsqrtf(ms + NORM_EPS);
        o[row * 2048 + 1536 + h * 128 + lane] = (bf16)f2bf(o0 * sc * nw0 * siluf_(g0));
        o[row * 2048 + 1536 + h * 128 + 64 + lane] = (bf16)f2bf(o1 * sc * nw1 * siluf_(g1));
    }
}
__device__ __forceinline__ void attn_task(const ArgsD& a, int l, int task, int lane, LAS unsigned char* scr, const bf16* z, bf16* o) {
    const int qh = task & 1, h = (task >> 1) & 7, c = (task >> 4) & 31, b = task >> 9;
    constexpr int KST = 144;
    LAS unsigned char* Ks = scr; LAS unsigned char* Vs = scr + 64 * KST; LAS float* bias = (LAS float*)(scr + 2 * 64 * KST);
    { const float* rb = a.in[I_ATT_BIAS]; for (int i = lane; i < 257; i += 64) bias[i] = rb[h * 257 + i]; }
    const float* qgp = a.in[I_ATT_QG] + l * 64; const float* kgp = a.in[I_ATT_KG] + l * 64;
    const int ql = qh * 32 + (lane >> 1), dh = lane & 1;
    const size_t qrow = (size_t)b * SEQ + c * 64 + ql;
    float q[32], oacc[32];
    { const bf16* qp = z + qrow * ZC + C_ATT + h * 64 + 32 * dh; float ss = 0.f;
#pragma unroll
      for (int i = 0; i < 4; ++i) { const u32x4 w = *(const u32x4*)(qp + 8 * i); q[8 * i] = lo2f(w.x); q[8 * i + 1] = hi2f(w.x); q[8 * i + 2] = lo2f(w.y); q[8 * i + 3] = hi2f(w.y); q[8 * i + 4] = lo2f(w.z); q[8 * i + 5] = hi2f(w.z); q[8 * i + 6] = lo2f(w.w); q[8 * i + 7] = hi2f(w.w); }
#pragma unroll
      for (int d = 0; d < 32; ++d) ss += q[d] * q[d];
      ss += __shfl_xor(ss, 1);
      const float sc = rsqrtf(ss * (1.0f / 64.0f) + NORM_EPS) * 0.125f;
#pragma unroll
      for (int d = 0; d < 32; ++d) { q[d] *= sc * qgp[32 * dh + d] * kgp[32 * dh + d]; oacc[d] = 0.f; } }
    float m = -1e30f, lsum = 0.f;
    for (int j = (c >= 8 ? 0 : 8 - c); j <= 8; ++j) {
        const size_t krow = (size_t)b * SEQ + (c - 8 + j) * 64 + lane;
        const bf16* kp = z + krow * ZC + C_ATT + 512 + h * 64; const bf16* vp = kp + 512;
        float kss = 0.f;
        __builtin_amdgcn_wave_barrier();
#pragma unroll
        for (int i = 0; i < 8; ++i) { const u32x4 w = *(const u32x4*)(kp + 8 * i); *(LAS u32x4*)(Ks + lane * KST + 16 * i) = w;
            kss += lo2f(w.x) * lo2f(w.x) + hi2f(w.x) * hi2f(w.x) + lo2f(w.y) * lo2f(w.y) + hi2f(w.y) * hi2f(w.y) + lo2f(w.z) * lo2f(w.z) + hi2f(w.z) * hi2f(w.z) + lo2f(w.w) * lo2f(w.w) + hi2f(w.w) * hi2f(w.w);
            *(LAS u32x4*)(Vs + lane * KST + 16 * i) = *(const u32x4*)(vp + 8 * i); }
        const float ksc = rsqrtf(kss * (1.0f / 64.0f) + NORM_EPS);
        __builtin_amdgcn_wave_barrier();
        const int relbase = (j - 8) * 64 - ql;
        for (int s4 = 0; s4 < 64; s4 += 4) {
            float sc[4];
#pragma unroll
            for (int u = 0; u < 4; ++u) { const int s = s4 + u; float dot = 0.f;
#pragma unroll
                for (int i = 0; i < 4; ++i) { const u32x4 w = *(const LAS u32x4*)(Ks + s * KST + 64 * dh + 16 * i);
                    dot += q[8 * i] * lo2f(w.x) + q[8 * i + 1] * hi2f(w.x) + q[8 * i + 2] * lo2f(w.y) + q[8 * i + 3] * hi2f(w.y) + q[8 * i + 4] * lo2f(w.z) + q[8 * i + 5] * hi2f(w.z) + q[8 * i + 6] * lo2f(w.w) + q[8 * i + 7] * hi2f(w.w); }
                dot += __shfl_xor(dot, 1);
                int rel = relbase + s; rel = rel < -128 ? -128 : (rel > 128 ? 128 : rel);
                sc[u] = dot * __builtin_bit_cast(float, __builtin_amdgcn_readlane(__builtin_bit_cast(int, ksc), s)) + bias[rel + 128]; }
            const float mn = fmaxf(fmaxf(fmaxf(sc[0], sc[1]), fmaxf(sc[2], sc[3])), m);
            const float alpha = __expf(m - mn); m = mn; lsum *= alpha;
#pragma unroll
            for (int d = 0; d < 32; ++d) oacc[d] *= alpha;
#pragma unroll
            for (int u = 0; u < 4; ++u) { const int s = s4 + u; const float p = __expf(sc[u] - mn); lsum += p;
#pragma unroll
                for (int i = 0; i < 4; ++i) { const u32x4 w = *(const LAS u32x4*)(Vs + s * KST + 64 * dh + 16 * i);
                    oacc[8 * i] += p * lo2f(w.x); oacc[8 * i + 1] += p * hi2f(w.x); oacc[8 * i + 2] += p * lo2f(w.y); oacc[8 * i + 3] += p * hi2f(w.y);
                    oacc[8 * i + 4] += p * lo2f(w.z); oacc[8 * i + 5] += p * hi2f(w.z); oacc[8 * i + 6] += p * lo2f(w.w); oacc[8 * i + 7] += p * hi2f(w.w); } }
        }
    }
    const float inv = 1.0f / lsum; bf16* op = o + qrow * 2048 + 1024 + h * 64 + 32 * dh;
#pragma unroll
    for (int i = 0; i < 4; ++i) { u32x4 w; w.x = pk2(oacc[8 * i] * inv, oacc[8 * i + 1] * inv); w.y = pk2(oacc[8 * i + 2] * inv, oacc[8 * i + 3] * inv); w.z = pk2(oacc[8 * i + 4] * inv, oacc[8 * i + 5] * inv); w.w = pk2(oacc[8 * i + 6] * inv, oacc[8 * i + 7] * inv);
        *(u32x4*)(op + 8 * i) = w; }
    __builtin_amdgcn_wave_barrier();
}
constexpr int LDS_WSCR = 19968;
constexpr int LDS_TOTAL = NWAVES * LDS_WSCR + 1024;
static_assert(LDS_TOTAL <= 163840 && NWAVES * LDS_WSCR >= LDS_MAIN, "LDS map");
constexpr int NPH = 20;
#ifndef MIXMASK
#define MIXMASK 15
#endif
#define MIX_T(bit, call) do { if ((MIXMASK) & (bit)) { call; } } while (0)

#define PHASE_PTRS \
    unsigned char* ws = a.ws(); float* a_out = a.out(); (void)a_out; \
    unsigned* ctl = (unsigned*)(ws + WS_CTL); (void)ctl; \
    float* ssb = (float*)(ws + WS_SMALL + SM_SS); (void)ssb; \
    float* mssq = (float*)(ws + WS_SMALL + SM_MSSQ); (void)mssq; \
    int* tok_e = (int*)(ws + WS_SMALL + SM_TOKE); float* tok_g = (float*)(ws + WS_SMALL + SM_TOKG); float* tok_rs = (float*)(ws + WS_SMALL + SM_TOKRS); (void)tok_e; (void)tok_g; (void)tok_rs; \
    int* tok_slot = (int*)(ws + WS_SMALL + SM_TOKSLOT); int* row_tok = (int*)(ws + WS_SMALL + SM_ROWTOK); float* row_gate = (float*)(ws + WS_SMALL + SM_ROWGATE); float* row_rs = (float*)(ws + WS_SMALL + SM_ROWRS); (void)tok_slot; (void)row_tok; (void)row_gate; (void)row_rs; \
    bf16* xb = (bf16*)(ws + WS_XB); (void)xb; \
    bf16* vfirst = (bf16*)(ws + WS_X + X_VFIRST); bf16* mixed = (bf16*)(ws + WS_X + X_MIXED); bf16* obuf = (bf16*)(ws + WS_X + X_O); (void)vfirst; (void)mixed; (void)obuf; \
    unsigned char* wreg = ws + WS_X + X_W; (void)wreg; \
    bf16* zbuf = (bf16*)(ws + WS_Z); bf16* gates = zbuf; bf16* hidden = zbuf; bf16* act = zbuf; (void)gates; (void)hidden; (void)act; \
    bf16* xg = (bf16*)(ws + WS_XG); bf16* ybuf = xg; bf16* rwarr = xg; (void)ybuf; (void)rwarr; \
    bf16* moe_w13 = (bf16*)(ws + WS_X + MOE_W13); bf16* moe_w2 = (bf16*)(ws + WS_X + MOE_W2); (void)moe_w13; (void)moe_w2;

template <int LO, int HI>
__device__ __forceinline__ void mk_body(const Args& ka) {
    extern __shared__ __attribute__((aligned(16))) unsigned char lds_raw[];
    LAS unsigned char* lds = (LAS unsigned char*)lds_raw;
    LAS unsigned* lctl = (LAS unsigned*)(lds + NWAVES * LDS_WSCR);
    const int tid = threadIdx.x, lane = tid & 63, wid = __builtin_amdgcn_readfirstlane(tid >> 6);
    const int G = gridDim.x, bx = blockIdx.x;
    const int gw = bx * NWAVES + wid, ngw = G * NWAVES;
    LAS unsigned long long* ptab = (LAS unsigned long long*)(lds + NWAVES * LDS_WSCR + 640);
    if (tid < N_IN) ptab[tid] = (unsigned long long)ka.in[tid];
    if (tid == N_IN) ptab[tid] = (unsigned long long)ka.out;
    if (tid == N_IN + 1) ptab[tid] = (unsigned long long)ka.ws;
    __syncthreads();
    ArgsD a; a.in.tab = ptab;
#if MK_PER_PHASE
#define GRID_BAR() do { } while (0)
#else
    cg::grid_group grid = cg::this_grid();
#define GRID_BAR() do { grid.sync(); } while (0)
#endif
#define IN(k) (LO <= (k) && (k) < HI)
#define SEAM(k) do { if (IN(k) && IN((k) + 1)) GRID_BAR(); } while (0)

    if (IN(0)) { PHASE_PTRS
        CvtCtx cx; cx.gw = gw; cx.ngw = ngw; cx.base = 0; cx.lane = lane; cx.scr = (LAS float*)(lds + wid * LDS_WSCR);
        for (int l = 0; l < 2; ++l) {
            const float* win = a.in[I_WIN] + (size_t)l * DM * IN_COLS; const float* nm = a.in[I_NORM_MIX] + l * DM;
            bf16* winT = (bf16*)(wreg + W_IN) + (size_t)l * ZC * DM; bf16* wgT = (bf16*)(wreg + W_G) + (size_t)l * 4096 * DM;
            cvt_job(cx, win, IN_COLS, DM, 0, MIXC, nm, winT, 0, 128);
            if (l == 1) cvt_job(cx, a.in[I_VRES_DOWN], 32, DM, 0, 32, nm, winT, C_HV, 128);
            { const int r0 = (l == 1) ? C_HV + 32 : C_HV; zero_rows_bf16(bx * NTHREADS + tid, G * NTHREADS, winT + (size_t)r0 * DM, (size_t)(ZC - r0) * DM); }
            cvt_job(cx, win, IN_COLS, DM, MIXC, 4096, nm, wgT, 0, 128);
            for (int i = 0; i < 4; ++i) cvt_job(cx, a.in[I_WBRANCH] + ((size_t)l * 4 + i) * 512 * DM, DM, 512, 0, DM, nullptr, (bf16*)(wreg + W_B) + ((size_t)l * 4 + i) * DM * 512, 0, 128);
            cvt_job(cx, a.in[I_WOUT] + (size_t)l * DM * DM, DM, DM, 0, DM, nullptr, (bf16*)(wreg + W_O) + (size_t)l * DM * DM, 0, 128);
        }
        cvt_job(cx, a.in[I_FFN_W1], FFN, DM, 0, FFN, a.in[I_NORM_FFN], (bf16*)(wreg + W_13), 0, 256);
        cvt_job(cx, a.in[I_FFN_W3], FFN, DM, 0, FFN, a.in[I_NORM_FFN], (bf16*)(wreg + W_13), 128, 256);
        cvt_job(cx, a.in[I_FFN_W2], DM, FFN, 0, DM, nullptr, (bf16*)(wreg + W_2), 0, 128);
        const float* x = a.in[I_X];
        for (int m = gw; m < T; m += ngw) { const f32x4* xr = (const f32x4*)(x + (size_t)m * DM) + lane; float s = 0.f;
#pragma unroll
            for (int j = 0; j < 4; ++j) { const f32x4 v = xr[64 * j]; s += (v[0] * v[0] + v[1] * v[1]) + (v[2] * v[2] + v[3] * v[3]); u32x2 w; w.x = pk2(v[0], v[1]); w.y = pk2(v[2], v[3]); *((u32x2*)(xb + (size_t)m * DM) + lane + 64 * j) = w; }
            s = wave_sum(s); if (lane < 16) ssb[(size_t)m * 16 + lane] = (lane == 0) ? s : 0.f; }
    }
    SEAM(0);

#pragma unroll
    for (int l = 0; l < 2; ++l) {
        const int pb = 1 + 8 * l;
#define ss_mix (ssb + (size_t)(l == 0 ? 0 : 2) * T * 16)
#define ss_ffn (l == 0 ? ssb + (size_t)T * 16 : (float*)nullptr)
        if (IN(pb + 0)) { PHASE_PTRS
            pg8::Gemm g{DM, DM, DM}; pg8::StaticOrder S; S.init(xb, (bf16*)(wreg + W_IN) + (size_t)l * ZC * DM, DM, DM, T, ZC, G, bx);
            EpiScaleBf16<0> E{zbuf, ZC, ss_mix};
            pg8::gemm_phase(lds, g, S, E);
        }
        SEAM(pb + 0);
        if (IN(pb + 1)) { PHASE_PTRS for (int tg = gw; tg < T / 4; tg += ngw) rwkv_prep_task(a, l, tg, (LAS float*)(lds + wid * LDS_WSCR), lane, zbuf, rwarr, vfirst);
            for (int m = gw; m < T; m += ngw) mamba_conv_task(a, l, m, lane, zbuf, mixed); }
        SEAM(pb + 1);
        if (IN(pb + 2)) { PHASE_PTRS
            if (wid == 0) { for (int lt = bx; lt < 160; lt += G) { if (lt < 64) { MIX_T(1, rwkv_scan_task(a, l, lt, lane, zbuf, rwarr, obuf)); } else if (lt < 128) { MIX_T(2, mamba_task(a, l, lt - 64, lane, (LAS float*)(lds + wid * LDS_WSCR), zbuf, mixed, obuf, mssq)); } else { MIX_T(4, gla_task(a, l, lt - 128, lane, zbuf, obuf)); } } }
            else { for (int at = bx * 7 + wid - 1; at < BATCH * NCH * 16; at += G * 7) { MIX_T(8, attn_task(a, l, at, lane, lds + wid * LDS_WSCR, zbuf, obuf)); } }
        }
        SEAM(pb + 2);
        if (IN(pb + 3)) { PHASE_PTRS
            const float* nw = a.in[I_SSM_NORMW] + l * 512;
            for (int m = gw; m < T; m += ngw) { const int g = lane >> 5; const float* q = mssq + (size_t)m * 8 + g * 4; const float sc = rsqrtf((q[0] + q[1] + q[2] + q[3]) * (1.0f / 256.0f) + NORM_EPS);
                bf16* p = obuf + (size_t)m * 2048 + 512 + lane * 8; const u32x4 w = *(const u32x4*)p; f32x4 v0, v1; unpack8(w, v0, v1);
                const f32x4 n0 = *(const f32x4*)(nw + lane * 8), n1 = *(const f32x4*)(nw + lane * 8 + 4);
                *(u32x4*)p = pack8(v0 * n0 * sc, v1 * n1 * sc); }
            pg8::Gemm g{DM, DM, DM}; pg8::StaticOrder S; S.init(xb, (bf16*)(wreg + W_G) + (size_t)l * 4096 * DM, DM, DM, T, 4096, G, bx);
            EpiScaleBf16<1> E{gates, 4096, ss_mix};
            pg8::gemm_phase(lds, g, S, E);
        }
        SEAM(pb + 3);
        if (IN(pb + 4)) { PHASE_PTRS
            pg8::Gemm g{2048, 512, 512}; MixOrder S{(const char*)obuf, (const char*)((bf16*)(wreg + W_B) + (size_t)l * 4 * DM * 512), G, bx};
            EpiMix E{gates, mixed};
            pg8::gemm_phase(lds, g, S, E);
        }
        SEAM(pb + 4);
        if (IN(pb + 5)) { PHASE_PTRS
            pg8::Gemm g{DM, DM, DM}; pg8::StaticOrder S; S.init(mixed, (bf16*)(wreg + W_O) + (size_t)l * DM * DM, DM, DM, T, DM, G, bx);
            EpiResid E{l == 0 ? a.in[I_X] : a_out, a_out, xb, ss_ffn};
            pg8::gemm_phase(lds, g, S, E);
        }
        SEAM(pb + 5);
        if (l == 0) {
            if (IN(pb + 6)) { PHASE_PTRS
                pg8::Gemm g{DM, DM, DM}; pg8::StaticOrder S; S.init(xb, (bf16*)(wreg + W_13), DM, DM, T, 2 * FFN, G, bx);
                EpiSwiglu<false> E{hidden, FFN, ss_ffn};
                pg8::gemm_phase(lds, g, S, E);
            }
            SEAM(pb + 6);
            if (IN(pb + 7)) { PHASE_PTRS
                pg8::Gemm g{FFN, FFN, FFN}; pg8::StaticOrder S; S.init(hidden, (bf16*)(wreg + W_2), FFN, FFN, T, DM, G, bx);
                EpiResid E{a_out, a_out, xb, ssb + (size_t)2 * T * 16};
                pg8::gemm_phase(lds, g, S, E);
            }
            SEAM(pb + 7);
        }
    }
    if (IN(15)) { PHASE_PTRS
        if (tid < 8) lctl[tid] = 0u;
        __syncthreads();
        const float* nf = a.in[I_NORM_FFN] + DM; const float* wr = a.in[I_MOE_ROUTER];
        for (int m = gw; m < T; m += ngw) { const f32x4* xr = (const f32x4*)(a_out + (size_t)m * DM) + lane; f32x4 v[4]; float s = 0.f;
#pragma unroll
            for (int j = 0; j < 4; ++j) { v[j] = xr[64 * j]; s += (v[j][0] * v[j][0] + v[j][1] * v[j][1]) + (v[j][2] * v[j][2] + v[j][3] * v[j][3]); }
            const float rs = rsqrtf(wave_sum(s) * (1.0f / DM) + NORM_EPS);
            float lg[8];
#pragma unroll
            for (int e = 0; e < 8; ++e) lg[e] = 0.f;
#pragma unroll
            for (int j = 0; j < 4; ++j) { const int k0 = 4 * (lane + 64 * j); const f32x4 gn = *(const f32x4*)(nf + k0);
#pragma unroll
                for (int q = 0; q < 4; ++q) { const float hf = v[j][q] * rs * gn[q]; const f32x4 w0 = *(const f32x4*)(wr + (size_t)(k0 + q) * 8), w1 = *(const f32x4*)(wr + (size_t)(k0 + q) * 8 + 4);
                    lg[0] += hf * w0[0]; lg[1] += hf * w0[1]; lg[2] += hf * w0[2]; lg[3] += hf * w0[3]; lg[4] += hf * w1[0]; lg[5] += hf * w1[1]; lg[6] += hf * w1[2]; lg[7] += hf * w1[3]; } }
#pragma unroll
            for (int e = 0; e < 8; ++e) lg[e] = wave_sum(lg[e]);
            int e0 = 0; float v0 = lg[0];
#pragma unroll
            for (int e = 1; e < 8; ++e) if (lg[e] > v0) { v0 = lg[e]; e0 = e; }
            int e1 = -1; float v1 = -3.0e38f;
#pragma unroll
            for (int e = 0; e < 8; ++e) if (e != e0 && lg[e] > v1) { v1 = lg[e]; e1 = e; }
            const float g0 = 1.0f / (1.0f + __expf(v1 - v0));
            if (lane == 0) { tok_e[2 * m] = e0; tok_e[2 * m + 1] = e1; tok_g[2 * m] = g0; tok_g[2 * m + 1] = 1.0f - g0; tok_rs[m] = rs;
                __hip_atomic_fetch_add(lctl + e0, 1u, __ATOMIC_RELAXED, __HIP_MEMORY_SCOPE_WORKGROUP); __hip_atomic_fetch_add(lctl + e1, 1u, __ATOMIC_RELAXED, __HIP_MEMORY_SCOPE_WORKGROUP); } }
        __syncthreads();
        if (tid < 8) atomicAdd(ctl + CW_MOECNT + tid, lctl[tid]);
        CvtCtx cx; cx.gw = gw; cx.ngw = ngw; cx.base = 0; cx.lane = lane; cx.scr = (LAS float*)(lds + wid * LDS_WSCR);
        for (int e = 0; e < NEXP; ++e) {
            cvt_job(cx, a.in[I_MOE_W1] + (size_t)e * DM * EDIM, EDIM, DM, 0, EDIM, nf, moe_w13 + (size_t)e * 2 * EDIM * DM, 0, 256);
            cvt_job(cx, a.in[I_MOE_W3] + (size_t)e * DM * EDIM, EDIM, DM, 0, EDIM, nf, moe_w13 + (size_t)e * 2 * EDIM * DM, 128, 256);
            cvt_job(cx, a.in[I_MOE_W2] + (size_t)e * EDIM * DM, DM, EDIM, 0, DM, nullptr, moe_w2 + (size_t)e * DM * EDIM, 0, 128);
        }
    }
    SEAM(15);
    if (IN(16)) { PHASE_PTRS
        unsigned cnt[8]; int base[8];
        { int acc = 0;
#pragma unroll
          for (int e = 0; e < 8; ++e) { cnt[e] = __hip_atomic_load(ctl + CW_MOECNT + e, __ATOMIC_RELAXED, __HIP_MEMORY_SCOPE_AGENT); base[e] = acc; acc += (int)((cnt[e] + 255u) & ~255u); } }
        LAS unsigned* lcnt = lctl; LAS int* lstart = (LAS int*)(lctl + 8); LAS int* pslot = (LAS int*)(lctl + 16);
        for (int tgp = bx; tgp < T / 64; tgp += G) {
            if (tid < 8) lcnt[tid] = 0u;
            __syncthreads();
            int e0 = 0, e1 = 0, r0 = 0, r1 = 0; const int tok = tgp * 64 + tid;
            if (tid < 64) { e0 = tok_e[2 * tok]; e1 = tok_e[2 * tok + 1]; r0 = (int)__hip_atomic_fetch_add(lcnt + e0, 1u, __ATOMIC_RELAXED, __HIP_MEMORY_SCOPE_WORKGROUP); r1 = (int)__hip_atomic_fetch_add(lcnt + e1, 1u, __ATOMIC_RELAXED, __HIP_MEMORY_SCOPE_WORKGROUP); }
            __syncthreads();
            if (tid < 8) { int bsel = 0;
#pragma unroll
                for (int e = 0; e < 8; ++e) bsel = (tid == e) ? base[e] : bsel;
                lstart[tid] = bsel + (int)atomicAdd(ctl + CW_MOECUR + tid, lcnt[tid]); }
            __syncthreads();
            if (tid < 64) { const int s0 = lstart[e0] + r0, s1 = lstart[e1] + r1; pslot[2 * tid] = s0; pslot[2 * tid + 1] = s1;
                tok_slot[2 * tok] = s0; tok_slot[2 * tok + 1] = s1; const float rs = tok_rs[tok];
                row_tok[s0] = tok; row_tok[s1] = tok; row_gate[s0] = tok_g[2 * tok]; row_gate[s1] = tok_g[2 * tok + 1]; row_rs[s0] = rs; row_rs[s1] = rs; }
            __syncthreads();
            for (int q = 0; q < 8; ++q) { const int tl = wid * 8 + q; const u32x4* src = (const u32x4*)(xb + (size_t)(tgp * 64 + tl) * DM);
                const u32x4 w0 = src[lane], w1 = src[lane + 64];
#pragma unroll
                for (int k = 0; k < 2; ++k) { u32x4* dst = (u32x4*)(xg + (size_t)pslot[2 * tl + k] * DM); dst[lane] = w0; dst[lane + 64] = w1; } }
            __syncthreads();
        }
        for (int idx = gw; idx < 8 * 256; idx += ngw) { const int e = idx >> 8, r = idx & 255; unsigned ce = 0; int be = 0;
#pragma unroll
            for (int q = 0; q < 8; ++q) { ce = (e == q) ? cnt[q] : ce; be = (e == q) ? base[q] : be; }
            const int rem = (int)(ce & 255u);
            if (rem != 0 && r >= rem) { const int slot = be + (int)(ce & ~255u) + r; u32x4 zz = {0u, 0u, 0u, 0u}; u32x4* dst = (u32x4*)(xg + (size_t)slot * DM); dst[lane] = zz; dst[lane + 64] = zz;
                if (lane == 0) { row_tok[slot] = -1; row_gate[slot] = 0.f; row_rs[slot] = 0.f; } } }
    }
    SEAM(16);
    if (IN(17)) { PHASE_PTRS
        unsigned cnt[8];
#pragma unroll
        for (int e = 0; e < 8; ++e) cnt[e] = __hip_atomic_load(ctl + CW_MOECNT + e, __ATOMIC_RELAXED, __HIP_MEMORY_SCOPE_AGENT);
        pg8::Gemm g{DM, DM, DM}; MoeOrder S; S.init(xg, DM, moe_w13, DM, (size_t)2 * EDIM * DM * 2, 2 * EDIM / 256, cnt, G, bx);
        EpiSwiglu<true> E{act, EDIM, row_rs};
        pg8::gemm_phase(lds, g, S, E);
    }
    SEAM(17);
    if (IN(18)) { PHASE_PTRS
        unsigned cnt[8];
#pragma unroll
        for (int e = 0; e < 8; ++e) cnt[e] = __hip_atomic_load(ctl + CW_MOECNT + e, __ATOMIC_RELAXED, __HIP_MEMORY_SCOPE_AGENT);
        pg8::Gemm g{EDIM, EDIM, EDIM}; MoeOrder S; S.init(act, EDIM, moe_w2, EDIM, (size_t)DM * EDIM * 2, DM / 256, cnt, G, bx);
        EpiMoeDown E{ybuf, row_gate};
        pg8::gemm_phase(lds, g, S, E);
    }
    SEAM(18);
    if (IN(19)) { PHASE_PTRS
        for (int m = gw; m < T; m += ngw) { const int s0 = tok_slot[2 * m], s1 = tok_slot[2 * m + 1]; f32x4* xr = (f32x4*)(a_out + (size_t)m * DM) + lane;
            const u32x2* y0 = (const u32x2*)(ybuf + (size_t)s0 * DM) + lane; const u32x2* y1 = (const u32x2*)(ybuf + (size_t)s1 * DM) + lane;
#pragma unroll
            for (int j = 0; j < 4; ++j) { f32x4 v = xr[64 * j]; const u32x2 p = y0[64 * j], q = y1[64 * j];
                v[0] += lo2f(p.x) + lo2f(q.x); v[1] += hi2f(p.x) + hi2f(q.x); v[2] += lo2f(p.y) + lo2f(q.y); v[3] += hi2f(p.y) + hi2f(q.y); xr[64 * j] = v; } }
    }
#undef IN
#undef SEAM
#undef GRID_BAR
#undef ss_mix
#undef ss_ffn
}
template <int LO, int HI> __global__ void __launch_bounds__(NTHREADS, 2) mk_fwd(Args a) { mk_body<LO, HI>(a); }

template <int PH> static void set_attr(bool& ok) { if constexpr (PH < NPH) { ok = ok && (hipFuncSetAttribute((const void*)mk_fwd<PH, PH + 1>, hipFuncAttributeMaxDynamicSharedMemorySize, LDS_TOTAL) == hipSuccess); set_attr<PH + 1>(ok); } }
template <int PH> static void launch_phases(const Args& a, int grid, hipStream_t stream) { if constexpr (PH < NPH) { hipLaunchKernelGGL((mk_fwd<PH, PH + 1>), dim3(grid), dim3(NTHREADS), LDS_TOTAL, stream, a); launch_phases<PH + 1>(a, grid, stream); } }
extern "C" void kernel_launch(void* const* d_in, const int* in_sizes, int n_in, void* d_out, int out_size, void* d_ws, size_t ws_size, hipStream_t stream) {
    static int grid = 0;
    if (!grid) {
        if (n_in != N_IN || out_size != T * DM || ws_size < WS_END) { fprintf(stderr, "kernel_launch: unexpected problem: n_in %d out %d ws %zu (need %zu)\n", n_in, out_size, ws_size, (size_t)WS_END); grid = -1; return; }
        int dev = 0, cus = 0, per_cu = 0;
        hipGetDevice(&dev); hipDeviceGetAttribute(&cus, hipDeviceAttributeMultiprocessorCount, dev);
#if MK_PER_PHASE
        { bool ok = true; set_attr<0>(ok); if (!ok) { fprintf(stderr, "kernel_launch: hipFuncSetAttribute failed\n"); grid = -1; return; } per_cu = 1; }
#else
        if (hipFuncSetAttribute((const void*)mk_fwd<0, NPH>, hipFuncAttributeMaxDynamicSharedMemorySize, LDS_TOTAL) != hipSuccess) { fprintf(stderr, "kernel_launch: hipFuncSetAttribute failed\n"); grid = -1; return; }
        if (hipOccupancyMaxActiveBlocksPerMultiprocessor(&per_cu, (const void*)mk_fwd<0, NPH>, NTHREADS, LDS_TOTAL) != hipSuccess || per_cu < 1) { fprintf(stderr, "kernel_launch: occupancy query failed (%d)\n", per_cu); grid = -1; return; }
#endif
        grid = cus;
    }
    if (grid <= 0) return;
    hipMemsetAsync((char*)d_ws + WS_CTL, 0, CTL_BYTES, stream);
    Args a{};
    for (int i = 0; i < N_IN; ++i) a.in[i] = (const float*)d_in[i];
    a.out = (float*)d_out; a.ws = (unsigned char*)d_ws;
#if MK_PER_PHASE
    launch_phases<0>(a, grid, stream);
#else
    void* args[] = {&a};
    hipError_t e = hipLaunchCooperativeKernel((const void*)mk_fwd<0, NPH>, dim3(grid), dim3(NTHREADS), args, LDS_TOTAL, stream);
    if (e != hipSuccess) fprintf(stderr, "cooperative launch failed: %s (grid %d)\n", hipGetErrorString(e), grid);
#endif
}
```

```cpp
#include <hip/hip_runtime.h>
#include <hip/hip_cooperative_groups.h>
#include <cstdio>
#include <cstdint>
namespace cg = cooperative_groups;

#ifndef FFN_FP8
#define FFN_FP8 0
#endif
#ifndef MK_PER_PHASE
#define MK_PER_PHASE 0
#endif

#define LAS __attribute__((address_space(3)))
typedef unsigned short bf16;
typedef short bf16x8 __attribute__((ext_vector_type(8)));
typedef float f32x4 __attribute__((ext_vector_type(4)));
typedef float f32x2 __attribute__((ext_vector_type(2)));
typedef unsigned u32x4 __attribute__((ext_vector_type(4)));
typedef unsigned u32x2 __attribute__((ext_vector_type(2)));

constexpr int BATCH = 8, SEQ = 2048, DM = 1024, T = BATCH * SEQ;
constexpr int CHUNK = 64, NCH = SEQ / CHUNK;
constexpr int IN_COLS = 10552, MIXC = 6456;
constexpr int ZC = 6656;
constexpr int C_RWKV = 0, C_SSM = 1824, C_ATT = 3368, C_GLA = 4904, C_HV = 6456;
constexpr int FFN = 2816, NEXP = 8, EDIM = 3584;
constexpr int MOE_ROWS = 2 * T + NEXP * 256;
constexpr float NORM_EPS = 1e-6f;

constexpr size_t MiB = 1u << 20;
constexpr size_t WS_CTL = 0;
constexpr size_t CTL_BYTES = 1 * MiB;
constexpr size_t WS_SMALL = WS_CTL + CTL_BYTES;
constexpr size_t SM_SS = 0;
constexpr size_t SM_MSSQ = SM_SS + 3 * (size_t)T * 16 * 4;
constexpr size_t SM_TOKE = SM_MSSQ + (size_t)T * 8 * 4;
constexpr size_t SM_TOKG = SM_TOKE + (size_t)T * 2 * 4;
constexpr size_t SM_TOKRS = SM_TOKG + (size_t)T * 2 * 4;
constexpr size_t SM_TOKSLOT = SM_TOKRS + (size_t)T * 4;
constexpr size_t SM_ROWTOK = SM_TOKSLOT + (size_t)T * 2 * 4;
constexpr size_t SM_ROWGATE = SM_ROWTOK + (size_t)MOE_ROWS * 4;
constexpr size_t SM_ROWRS = SM_ROWGATE + (size_t)MOE_ROWS * 4;
constexpr size_t SM_END = SM_ROWRS + (size_t)MOE_ROWS * 4;
static_assert(SM_END <= 6 * MiB, "small region");
constexpr size_t WS_XB = WS_SMALL + 6 * MiB;
constexpr size_t WS_X = WS_XB + (size_t)T * DM * 2;
constexpr size_t X_VFIRST = 0;
constexpr size_t X_MIXED = X_VFIRST + (size_t)T * 512 * 2;
constexpr size_t X_O = X_MIXED + (size_t)T * DM * 2;
constexpr size_t X_W = X_O + (size_t)T * 2048 * 2;
constexpr size_t W_IN = 0;
constexpr size_t W_G = W_IN + 2 * (size_t)ZC * DM * 2;
constexpr size_t W_B = W_G + 2 * (size_t)4096 * DM * 2;
constexpr size_t W_O = W_B + 2 * 4 * (size_t)DM * 512 * 2;
constexpr size_t W_13 = W_O + 2 * (size_t)DM * DM * 2;
constexpr size_t W_2 = W_13 + (size_t)2 * FFN * DM * 2;
constexpr size_t W_END = W_2 + (size_t)DM * FFN * 2;
constexpr size_t X_BYTES = X_W + W_END;
constexpr size_t MOE_W13 = 0;
constexpr size_t MOE_W2 = MOE_W13 + (size_t)NEXP * 2 * EDIM * DM * 2;
constexpr size_t MOE_WEND = MOE_W2 + (size_t)NEXP * DM * EDIM * 2;
static_assert(MOE_WEND <= X_BYTES, "MoE weights must fit the X region");
constexpr size_t WS_Z = WS_X + X_BYTES;
constexpr size_t Z_BYTES = (size_t)MOE_ROWS * EDIM * 2;
static_assert((size_t)T * ZC * 2 <= Z_BYTES, "z fits");
constexpr size_t WS_XG = WS_Z + Z_BYTES;
constexpr size_t XG_BYTES = (size_t)MOE_ROWS * DM * 2;
static_assert(4 * (size_t)T * 512 * 2 <= XG_BYTES, "rwkv arrays fit");
constexpr size_t WS_BCV = WS_XG + (size_t)4 * BATCH * (SEQ / 32) * 29184;
constexpr size_t WS_GEND = WS_BCV + (size_t)T * 512 * 2;
constexpr size_t WS_END = (WS_XG + XG_BYTES > WS_GEND + (size_t)BATCH * 4 * NCH * 64 * 4) ? WS_XG + XG_BYTES : WS_GEND + (size_t)BATCH * 4 * NCH * 64 * 4;

constexpr int CW_MOECNT = 64;
constexpr int CW_MOECUR = 128;
constexpr int CW_ATTQ = 192;
constexpr int CW_SPLIT = 256;
constexpr int CW_BAR = 1024;

__device__ __forceinline__ float bf2f(bf16 v) { return __builtin_bit_cast(float, (unsigned)v << 16); }
typedef __bf16 bf16x2_hw __attribute__((ext_vector_type(2)));
__device__ __forceinline__ unsigned pk2(float lo, float hi) { const f32x2 v = {lo, hi}; return __builtin_bit_cast(unsigned, __builtin_convertvector(v, bf16x2_hw)); }
__device__ __forceinline__ unsigned f2bf(float f) { return pk2(f, 0.f) & 0xffffu; }
__device__ __forceinline__ float lo2f(unsigned w) { return __builtin_bit_cast(float, w << 16); }
__device__ __forceinline__ float hi2f(unsigned w) { return __builtin_bit_cast(float, w & 0xffff0000u); }
__device__ __forceinline__ float sigmoidf_(float x) { return __builtin_amdgcn_rcpf(1.0f + __expf(-x)); }
__device__ __forceinline__ float siluf_(float x) { return x * __builtin_amdgcn_rcpf(1.0f + __expf(-x)); }
__device__ __forceinline__ float tanhf_(float x) { return 2.0f * __builtin_amdgcn_rcpf(1.0f + __expf(-2.0f * x)) - 1.0f; }
__device__ __forceinline__ float softplusf_(float x) { return x > 20.f ? x : __logf(1.0f + __expf(x)); }
template <int CTRL, int ROWMASK = 0xF, bool BOUND = true> __device__ __forceinline__ float dpp_f(float x) { return __builtin_bit_cast(float, __builtin_amdgcn_update_dpp(0, __builtin_bit_cast(int, x), CTRL, ROWMASK, 0xF, BOUND)); }
__device__ __forceinline__ float red8_sum(float x) { x += dpp_f<0xB1>(x); x += dpp_f<0x4E>(x); x += dpp_f<0x141>(x); return x; }
__device__ __forceinline__ float red16_sum(float x) { x = red8_sum(x); x += dpp_f<0x140>(x); return x; }
__device__ __forceinline__ float scan16(float x) { x += dpp_f<0x111>(x); x += dpp_f<0x112>(x); x += dpp_f<0x114>(x); x += dpp_f<0x118>(x); return x; }
__device__ __forceinline__ float scan32(float x) { x = scan16(x); x += dpp_f<0x142, 0xA, false>(x); return x; }
__device__ __forceinline__ float scan64(float x) { x = scan32(x); x += dpp_f<0x143, 0xC, false>(x); return x; }
__device__ __forceinline__ float xrows_sum(float v) { const int x = __builtin_bit_cast(int, v); const auto a = __builtin_amdgcn_permlane16_swap(x, x, false, false); v = __builtin_bit_cast(float, (int)a[0]) + __builtin_bit_cast(float, (int)a[1]);
    const int y = __builtin_bit_cast(int, v); const auto b = __builtin_amdgcn_permlane32_swap(y, y, false, false); return __builtin_bit_cast(float, (int)b[0]) + __builtin_bit_cast(float, (int)b[1]); }
__device__ __forceinline__ float xrows_max(float v) { const int x = __builtin_bit_cast(int, v); const auto a = __builtin_amdgcn_permlane16_swap(x, x, false, false); v = fmaxf(__builtin_bit_cast(float, (int)a[0]), __builtin_bit_cast(float, (int)a[1]));
    const int y = __builtin_bit_cast(int, v); const auto b = __builtin_amdgcn_permlane32_swap(y, y, false, false); return fmaxf(__builtin_bit_cast(float, (int)b[0]), __builtin_bit_cast(float, (int)b[1])); }
__device__ __forceinline__ float wave_sum(float v) { return xrows_sum(red16_sum(v)); }
__device__ __forceinline__ int opq_v(int x) { asm volatile("" : "+v"(x)); return x; }
__device__ __forceinline__ int opq_s(int x) { asm volatile("" : "+s"(x)); return x; }
__device__ __forceinline__ float rdlane(float v, int l) { return __builtin_bit_cast(float, __builtin_amdgcn_readlane(__builtin_bit_cast(int, v), l)); }

namespace pg8 {
constexpr int BM = 256, BK = 64, HALF = 128, HTB = HALF * BK * 2, STAGE_BYTES = 8 * HTB, NXCD = 8, WGM = 8;
__host__ __device__ __forceinline__ int lds_byte(int r, int c) { const int st = (r >> 4) * 2 + (c >> 5), rr = r & 15, cc = c & 31, ob = rr * 64 + cc * 2; return st * 1024 + (ob ^ (((ob >> 9) & 1) << 5)); }
__host__ __device__ __forceinline__ void stage_rc(int b, int& R, int& C) { const int st = b / 1024, sb = b % 1024, swz = sb ^ (((sb >> 9) & 1) << 5); R = (st >> 1) * 16 + swz / 64; C = (st & 1) * 32 + (swz % 64) / 2; }
__host__ __device__ __forceinline__ int perm32(int rho) { const int n = rho >> 4, i = rho & 15; return 8 * (i >> 2) + 4 * n + (i & 3); }

typedef int v4i __attribute__((ext_vector_type(4)));
typedef int v8i __attribute__((ext_vector_type(8)));
struct Unit { int pm, pn, e, kq; };
struct Gemm { int lda, ldb, K; };

struct StaticOrder {
    static constexpr bool VARNT = false;
    const char* A; const char* Bt; size_t tstepA, tstepB;
    int nM, nN, nwg, G, c;
    __device__ __forceinline__ void init(const void* A_, const void* Bt_, int lda, int ldb, int M, int N, int G_, int c_) { A = (const char*)A_; Bt = (const char*)Bt_; tstepA = (size_t)BM * lda * 2; tstepB = (size_t)BM * ldb * 2; nM = M / BM; nN = N / BM; nwg = nM * nN; G = G_; c = c_; }
    __device__ __forceinline__ bool next(int i, Unit& u) const {
        const long L = (long)i * G + c; if (L >= nwg) return false;
        int wgid = (int)L; { const int q = nwg / NXCD, r = nwg % NXCD, xcd = wgid % NXCD, off = wgid / NXCD; wgid = (xcd < r ? xcd * (q + 1) : r * (q + 1) + (xcd - r) * q) + off; }
        const int nig = WGM * nN, gid = wgid / nig, fm = gid * WGM, gsz = (nM - fm) < WGM ? (nM - fm) : WGM;
        u.pm = fm + ((wgid % nig) % gsz); u.pn = (wgid % nig) / gsz; u.e = 0; return true;
    }
    __device__ __forceinline__ const char* a_ptr(const Unit& u) const { return A + (size_t)u.pm * tstepA; }
    __device__ __forceinline__ const char* b_ptr(const Unit& u) const { return Bt + (size_t)u.pn * tstepB; }
};

typedef __bf16 bf16x2_t __attribute__((ext_vector_type(2)));
__device__ __forceinline__ unsigned cvt_pk_bf16(float lo, float hi) { const f32x2 v = {lo, hi}; return __builtin_bit_cast(unsigned, __builtin_convertvector(v, bf16x2_t)); }

template <class Epi, class Sched>
__device__ __forceinline__ void gemm_phase(LAS unsigned char* lds, const Gemm g, const Sched& S, const Epi& E) {
    const int tid = opq_v((int)threadIdx.x), wid = __builtin_amdgcn_readfirstlane(tid >> 6), lane = tid & 63, wr = wid >> 2, wc = wid & 3, fr = lane & 15, fq = lane >> 4;
    const int nt = opq_s(g.K / BK);
    unsigned voffA[2], voffB[2];
#pragma unroll
    for (int i = 0; i < 2; ++i) { int R, C; stage_rc(tid * 16 + i * 8192, R, C); const int Rb = Epi::PERM ? ((R & ~31) + perm32(R & 31)) : R;
        voffA[i] = (unsigned)(R * g.lda + C) * 2u; voffB[i] = (unsigned)(Rb * g.ldb + C) * 2u; }
    const size_t kstep = (size_t)(BK * 2);
    const size_t hstepA = (size_t)HALF * g.lda * 2, hstepB = (size_t)HALF * g.ldb * 2;
    const unsigned ldsw = (unsigned)wid * 1024u;
    const int aoff = lds_byte(wr * 64 + fr, fq * 8), boff = lds_byte(wc * 32 + fr, fq * 8);
#define PG8_SA(b, h) (((b) * 2 + (h)) * HTB)
#define PG8_SB(b, h) ((4 + (b) * 2 + (h)) * HTB)
#define PG8_STAGE(bufoff, gbase, voff) do { _Pragma("unroll") for (int _i = 0; _i < 2; ++_i) \
        __builtin_amdgcn_global_load_lds((const unsigned*)((const char*)(gbase) + (voff)[_i]), (LAS unsigned*)(lds + (bufoff) + ldsw + _i * 8192), 16, 0, 0); } while (0)
#define PG8_LDA(dst, b, h) do { _Pragma("unroll") for (int m = 0; m < 4; ++m) { if constexpr (Epi::F8) { const v4i lo_ = *(const LAS v4i*)(lds + PG8_SA(b, h) + aoff + m * 2048), hi_ = *(const LAS v4i*)(lds + PG8_SA(b, h) + aoff + m * 2048 + 1024); \
            dst##8[m] = __builtin_shufflevector(lo_, hi_, 0, 1, 2, 3, 4, 5, 6, 7); } else { _Pragma("unroll") for (int k = 0; k < 2; ++k) dst[m][k] = *(const LAS bf16x8*)(lds + PG8_SA(b, h) + aoff + m * 2048 + k * 1024); } } } while (0)
#define PG8_LDB(dst, b, h) do { _Pragma("unroll") for (int n = 0; n < 2; ++n) { if constexpr (Epi::F8) { const v4i lo_ = *(const LAS v4i*)(lds + PG8_SB(b, h) + boff + n * 2048), hi_ = *(const LAS v4i*)(lds + PG8_SB(b, h) + boff + n * 2048 + 1024); \
            dst##8[n] = __builtin_shufflevector(lo_, hi_, 0, 1, 2, 3, 4, 5, 6, 7); } else { _Pragma("unroll") for (int k = 0; k < 2; ++k) dst[n][k] = *(const LAS bf16x8*)(lds + PG8_SB(b, h) + boff + n * 2048 + k * 1024); } } } while (0)
#define PG8_MMA(ai, bj, At, Bt) do { __builtin_amdgcn_s_setprio(1); _Pragma("unroll") for (int m = 0; m < 4; ++m) _Pragma("unroll") for (int n = 0; n < 2; ++n) { \
        if constexpr (Epi::F8) asm volatile("v_mfma_scale_f32_16x16x128_f8f6f4 %0, %1, %2, %0, %3, %3 op_sel_hi:[0,0,0]" : "+v"(acc[ai][bj][m][n]) : "v"(Bt##8[n]), "v"(At##8[m]), "v"(f8scale));   \
        else { _Pragma("unroll") for (int k = 0; k < 2; ++k) acc[ai][bj][m][n] = __builtin_amdgcn_mfma_f32_16x16x32_bf16(Bt[n][k], At[m][k], acc[ai][bj][m][n], 0, 0, 0); } } \
        __builtin_amdgcn_s_setprio(0); } while (0)
#define PG8_WAIT_V(n) asm volatile("s_waitcnt vmcnt(" #n ")" ::: "memory")
#define PG8_WAIT_L(n) asm volatile("s_waitcnt lgkmcnt(" #n ")" ::: "memory")
#define PG8_BAR __builtin_amdgcn_s_barrier()
#define PG8_SCHED __builtin_amdgcn_sched_barrier(0)
    Unit cur, nxt; int ui = 0;
    if (!S.next(0, cur)) return;
    f32x4 acc[2][2][4][2];
#pragma unroll
    for (int a = 0; a < 2; ++a)
#pragma unroll
        for (int b = 0; b < 2; ++b)
#pragma unroll
            for (int m = 0; m < 4; ++m)
#pragma unroll
                for (int n = 0; n < 2; ++n) acc[a][b][m][n] = (f32x4){0.f, 0.f, 0.f, 0.f};
    const int f8scale = opq_v(0x7f7f7f7f);
    bf16x8 At[4][2], B0[2][2], B1[2][2]; v8i At8[4], B08[2], B18[2];
    const char* cA = S.a_ptr(cur); const char* cB = S.b_ptr(cur);
    PG8_STAGE(PG8_SB(0, 0), cB, voffB); PG8_STAGE(PG8_SB(0, 1), cB + hstepB, voffB); PG8_STAGE(PG8_SA(0, 0), cA, voffA); PG8_STAGE(PG8_SA(0, 1), cA + hstepA, voffA);
    if (wr == 1) PG8_BAR;
    PG8_WAIT_V(2); PG8_BAR;
    PG8_STAGE(PG8_SB(1, 0), cB + kstep, voffB); PG8_STAGE(PG8_SA(1, 0), cA + kstep, voffA); PG8_STAGE(PG8_SB(1, 1), cB + hstepB + kstep, voffB);
    PG8_WAIT_V(6); PG8_BAR;
    for (;;) {
        const bool has_next = S.next(ui + 1, nxt);
        int ntc = nt; if constexpr (Sched::VARNT) ntc = opq_s(S.nt_of(cur));
        const char* nA = has_next ? S.a_ptr(nxt) : cA; const char* nB = has_next ? S.b_ptr(nxt) : cB;
#pragma unroll 1
        for (int t = 0; t < ntc; t += 2) {
            const bool last = (t == ntc - 2);
            const char* a1 = cA + (size_t)(t + 1) * kstep;
            const char* a2 = last ? nA : cA + (size_t)(t + 2) * kstep; const char* b2 = last ? nB : cB + (size_t)(t + 2) * kstep;
            const char* a3 = a2 + kstep; const char* b3 = b2 + kstep;
            PG8_LDB(B0, 0, 0); PG8_LDB(B1, 0, 1); PG8_SCHED; PG8_LDA(At, 0, 0); PG8_STAGE(PG8_SA(1, 1), a1 + hstepA, voffA);
            PG8_WAIT_V(8); PG8_WAIT_L(0); PG8_BAR; PG8_MMA(0, 0, At, B0); PG8_MMA(0, 1, At, B1); PG8_BAR; PG8_SCHED;
            PG8_LDA(At, 0, 1); PG8_STAGE(PG8_SB(0, 0), b2, voffB); PG8_STAGE(PG8_SB(0, 1), b2 + hstepB, voffB); PG8_STAGE(PG8_SA(0, 0), a2, voffA);
            PG8_WAIT_V(8); PG8_WAIT_L(0); PG8_BAR; PG8_MMA(1, 0, At, B0); PG8_MMA(1, 1, At, B1); PG8_BAR; PG8_SCHED;
            PG8_LDB(B0, 1, 0); PG8_LDB(B1, 1, 1); PG8_SCHED; PG8_LDA(At, 1, 0); PG8_STAGE(PG8_SA(0, 1), a2 + hstepA, voffA);
            PG8_WAIT_V(8); PG8_WAIT_L(0); PG8_BAR; PG8_MMA(0, 0, At, B0); PG8_MMA(0, 1, At, B1); PG8_BAR; PG8_SCHED;
            PG8_LDA(At, 1, 1); PG8_STAGE(PG8_SB(1, 0), b3, voffB); PG8_STAGE(PG8_SB(1, 1), b3 + hstepB, voffB); PG8_STAGE(PG8_SA(1, 0), a3, voffA);
            PG8_WAIT_V(8); PG8_WAIT_L(0); PG8_BAR; PG8_MMA(1, 0, At, B0); PG8_MMA(1, 1, At, B1); PG8_BAR; PG8_SCHED;
        }
        if (wr == 0) PG8_BAR;
        if constexpr (Epi::F8) asm volatile("s_nop 15\n\ts_nop 15" ::: "memory");
        E(acc, cur, wr, wc, fr, fq);
        if (!has_next) break;
        if constexpr (!Epi::CHAIN) {
#pragma unroll
        for (int a = 0; a < 2; ++a)
#pragma unroll
            for (int b = 0; b < 2; ++b)
#pragma unroll
                for (int m = 0; m < 4; ++m)
#pragma unroll
                    for (int n = 0; n < 2; ++n) acc[a][b][m][n] = (f32x4){0.f, 0.f, 0.f, 0.f};
        }
        cur = nxt; cA = nA; cB = nB; ++ui;
        if (wr == 1) PG8_BAR;
    }
    PG8_WAIT_V(0);
    PG8_BAR;
#undef PG8_SA
#undef PG8_SB
#undef PG8_STAGE
#undef PG8_LDA
#undef PG8_LDB
#undef PG8_MMA
#undef PG8_WAIT_V
#undef PG8_WAIT_L
#undef PG8_BAR
#undef PG8_SCHED
}
}

using pg8::Unit;
__device__ __forceinline__ u32x4 pack8(f32x4 v0, f32x4 v1) { u32x4 w; w.x = pg8::cvt_pk_bf16(v0[0], v0[1]); w.y = pg8::cvt_pk_bf16(v0[2], v0[3]); w.z = pg8::cvt_pk_bf16(v1[0], v1[1]); w.w = pg8::cvt_pk_bf16(v1[2], v1[3]); return w; }
__device__ __forceinline__ f32x4 sig4(f32x4 v) { return (f32x4){sigmoidf_(v[0]), sigmoidf_(v[1]), sigmoidf_(v[2]), sigmoidf_(v[3])}; }
__device__ __forceinline__ void unpack8(u32x4 w, f32x4& a, f32x4& b) { a = (f32x4){lo2f(w.x), hi2f(w.x), lo2f(w.y), hi2f(w.y)}; b = (f32x4){lo2f(w.z), hi2f(w.z), lo2f(w.w), hi2f(w.w)}; }

__device__ __forceinline__ void rs8_from_parts(const float* ss, int row0, int fq, float (&rs)[2][4]) {
    f32x4 p[2][4];
#pragma unroll
    for (int ai = 0; ai < 2; ++ai)
#pragma unroll
        for (int m = 0; m < 4; ++m) p[ai][m] = *(const f32x4*)(ss + (size_t)(row0 + ai * 128 + m * 16) * 16 + 4 * fq);
#pragma unroll
    for (int ai = 0; ai < 2; ++ai)
#pragma unroll
        for (int m = 0; m < 4; ++m) { float t = (p[ai][m][0] + p[ai][m][1]) + (p[ai][m][2] + p[ai][m][3]); t = xrows_sum(t); rs[ai][m] = __builtin_amdgcn_rsqf(t * (1.0f / DM) + NORM_EPS); }
}
template <int ACT> struct EpiScaleBf16 {
    static constexpr bool PERM = true, CHAIN = false, F8 = false;
    bf16* O; int ldc; const float* ss;
    __device__ __forceinline__ void operator()(f32x4 (&acc)[2][2][4][2], const Unit& u, int wr, int wc, int fr, int fq) const {
        const int row0 = u.pm * 256 + wr * 64 + fr, col0 = u.pn * 256 + wc * 32 + 8 * fq;
        float rs[2][4]; rs8_from_parts(ss, row0, fq, rs);
#pragma unroll
        for (int ai = 0; ai < 2; ++ai)
#pragma unroll
            for (int m = 0; m < 4; ++m) { const int row = row0 + ai * 128 + m * 16; const float s = rs[ai][m];
                bf16* rowp = O + (size_t)row * ldc + col0;
#pragma unroll
                for (int bj = 0; bj < 2; ++bj) { f32x4 v0 = acc[ai][bj][m][0] * s, v1 = acc[ai][bj][m][1] * s;
                    if (ACT == 1) { v0 = sig4(v0); v1 = sig4(v1); }
                    *(u32x4*)(rowp + bj * 128) = pack8(v0, v1); }
                asm volatile("" ::: "memory"); }
    }
};
struct EpiGateRatio {
    static constexpr bool PERM = true, CHAIN = false, F8 = false;
    bf16* O; const float* ss;
    __device__ __forceinline__ void operator()(const f32x4 (&acc)[2][2][4][2], const Unit& u, int wr, int wc, int fr, int fq) const {
        const int row0 = u.pm * 256 + wr * 64 + fr, c0 = u.pn * 64 + wc * 16 + 4 * fq;
        float rs[2][4]; rs8_from_parts(ss, row0, fq, rs);
#pragma unroll
        for (int ai = 0; ai < 2; ++ai)
#pragma unroll
            for (int m = 0; m < 4; ++m) { const int row = row0 + ai * 128 + m * 16; const float s = rs[ai][m];
                f32x4 g[4];
#pragma unroll
                for (int i = 0; i < 4; ++i) { g[i] = sig4(acc[ai][i >> 1][m][i & 1] * s);
#pragma unroll
                    for (int j = 0; j < 4; ++j) g[i][j] = fmaxf(g[i][j], 1e-30f); }
                bf16* rowp = O + (size_t)row * 4096 + c0;
#pragma unroll
                for (int i = 0; i < 4; ++i) { f32x4 r = g[i];
                    if (i < 3) {
#pragma unroll
                        for (int j = 0; j < 4; ++j) r[j] = g[i][j] * __builtin_amdgcn_rcpf(g[i + 1][j]); }
                    u32x2 w; w.x = pg8::cvt_pk_bf16(r[0], r[1]); w.y = pg8::cvt_pk_bf16(r[2], r[3]); *(u32x2*)(rowp + i * 1024) = w; }
                asm volatile("" ::: "memory"); }
    }
};
template <bool MOE, bool F8_ = MOE> struct EpiSwiglu {
    static constexpr bool PERM = true, CHAIN = false, F8 = F8_;
    bf16* O; int ldc; const float* rsrc;
    __device__ __forceinline__ void operator()(f32x4 (&acc)[2][2][4][2], const Unit& u, int wr, int wc, int fr, int fq) const {
        const int row0 = u.pm * 256 + wr * 64 + fr, col0 = u.pn * 128 + wc * 32 + 8 * fq;
        float rs[2][4];
        if (MOE) {
#pragma unroll
            for (int ai = 0; ai < 2; ++ai)
#pragma unroll
                for (int m = 0; m < 4; ++m) rs[ai][m] = rsrc[row0 + ai * 128 + m * 16]; }
        else rs8_from_parts(rsrc, row0, fq, rs);
        if (F8) {
#pragma unroll
            for (int ai = 0; ai < 2; ++ai)
#pragma unroll
                for (int m = 0; m < 4; ++m) rs[ai][m] *= (1.0f / 32.0f); }
#pragma unroll
        for (int ai = 0; ai < 2; ++ai)
#pragma unroll
            for (int m = 0; m < 4; ++m) { const int row = row0 + ai * 128 + m * 16; const float s = rs[ai][m];
                f32x4 o[2];
#pragma unroll
                for (int n = 0; n < 2; ++n) { const f32x4 a = acc[ai][0][m][n] * s, b = acc[ai][1][m][n] * s;
                    o[n] = (f32x4){siluf_(a[0]) * b[0], siluf_(a[1]) * b[1], siluf_(a[2]) * b[2], siluf_(a[3]) * b[3]}; }
                if constexpr (F8) { u32x2 w8; int t0_ = 0, t1_ = 0; t0_ = __builtin_amdgcn_cvt_pk_fp8_f32(o[0][0], o[0][1], t0_, false); t0_ = __builtin_amdgcn_cvt_pk_fp8_f32(o[0][2], o[0][3], t0_, true);
                    t1_ = __builtin_amdgcn_cvt_pk_fp8_f32(o[1][0], o[1][1], t1_, false); t1_ = __builtin_amdgcn_cvt_pk_fp8_f32(o[1][2], o[1][3], t1_, true); w8.x = (unsigned)t0_; w8.y = (unsigned)t1_;
                    *(u32x2*)((unsigned char*)O + (size_t)row * ldc + col0) = w8; }
                else *(u32x4*)(O + (size_t)row * ldc + col0) = pack8(o[0], o[1]);
                asm volatile("" ::: "memory"); }
    }
};
template <bool F8_ = false> struct EpiResid {
    static constexpr bool PERM = false, CHAIN = false, F8 = F8_;
    const float* xin; float* out; bf16* xb; float* ss; unsigned char* xb8;
    __device__ __forceinline__ void operator()(f32x4 (&acc)[2][2][4][2], const Unit& u, int wr, int wc, int fr, int fq) const {
        const int row0 = u.pm * 256 + wr * 64 + fr, col0 = u.pn * 256 + wc * 32 + 4 * fq;
#pragma unroll
        for (int ai = 0; ai < 2; ++ai)
#pragma unroll
            for (int m = 0; m < 4; ++m) { const int row = row0 + ai * 128 + m * 16; const size_t off = (size_t)row * DM + col0; float q = 0.f;
#pragma unroll
                for (int bj = 0; bj < 2; ++bj)
#pragma unroll
                    for (int n = 0; n < 2; ++n) { const f32x4 xi = *(const f32x4*)(xin + off + bj * 128 + n * 16); const f32x4 v = F8 ? xi + acc[ai][bj][m][n] * (1.0f / 64.0f) : xi + acc[ai][bj][m][n];
                        *(f32x4*)(out + off + bj * 128 + n * 16) = v; u32x2 w; w.x = pg8::cvt_pk_bf16(v[0], v[1]); w.y = pg8::cvt_pk_bf16(v[2], v[3]);
                        *(u32x2*)(xb + off + bj * 128 + n * 16) = w;
                        if (xb8) { int t8 = 0; t8 = __builtin_amdgcn_cvt_pk_fp8_f32(v[0], v[1], t8, false); t8 = __builtin_amdgcn_cvt_pk_fp8_f32(v[2], v[3], t8, true); *(int*)(xb8 + off + bj * 128 + n * 16) = t8; }
                        q += (v[0] * v[0] + v[1] * v[1]) + (v[2] * v[2] + v[3] * v[3]); }
                q = xrows_sum(q);
                if (fq == 0 && ss) ss[(size_t)row * 16 + u.pn * 4 + wc] = q;
                if (m & 1) asm volatile("" ::: "memory"); }
    }
};
struct EpiMix {
    static constexpr bool PERM = true, CHAIN = true, F8 = false;
    const bf16* gates; bf16* mixed;
    __device__ __forceinline__ void operator()(f32x4 (&acc)[2][2][4][2], const Unit& u, int wr, int wc, int fr, int fq) const {
        const int row0 = u.pm * 256 + wr * 64 + fr, col0 = u.pn * 256 + wc * 32 + 8 * fq; const int i = u.e;
#pragma unroll
        for (int ai = 0; ai < 2; ++ai)
#pragma unroll
            for (int m = 0; m < 4; ++m) { const int row = row0 + ai * 128 + m * 16;
#pragma unroll
                for (int bj = 0; bj < 2; ++bj) { const bf16* gp = gates + (size_t)row * 4096 + i * 1024 + col0 + bj * 128;
                    f32x4 r0, r1; unpack8(*(const u32x4*)gp, r0, r1);
                    if (i < 3) { acc[ai][bj][m][0] = acc[ai][bj][m][0] * r0; acc[ai][bj][m][1] = acc[ai][bj][m][1] * r1; }
                    else {
                        *(u32x4*)(mixed + (size_t)row * DM + col0 + bj * 128) = pack8(acc[ai][bj][m][0] * r0, acc[ai][bj][m][1] * r1);
                        acc[ai][bj][m][0] = (f32x4){0.f, 0.f, 0.f, 0.f}; acc[ai][bj][m][1] = (f32x4){0.f, 0.f, 0.f, 0.f};
                    } } }
    }
};
struct MixOrder {
    static constexpr bool VARNT = false;
    const char* O; const char* Wb; int G, c;
    __device__ __forceinline__ bool next(int i, Unit& u) const {
        const int grp = (i >> 2) * G + c; if (grp >= 256) return false;
        int wgid = grp; { const int xcd = wgid % 8, off = wgid / 8; wgid = xcd * 32 + off; }
        const int nig = 8 * 4, gid = wgid / nig; u.pm = gid * 8 + ((wgid % nig) % 8); u.pn = (wgid % nig) / 8; u.e = i & 3; return true;
    }
    __device__ __forceinline__ const char* a_ptr(const Unit& u) const { return O + ((size_t)u.pm * 256 * 2048 + (size_t)u.e * 512) * 2; }
    __device__ __forceinline__ const char* b_ptr(const Unit& u) const { return Wb + ((size_t)u.e * DM * 512 + (size_t)u.pn * 256 * 512) * 2; }
};
struct MoeOrder {
    static constexpr bool VARNT = false;
    const char* A; const char* Bt; size_t tstepA, tstepB, estepB; int nN, ntiles, G, c;
    int te0, te1, te2, te3, te4, te5, te6;
    __device__ __forceinline__ void init(const void* A_, int lda, const void* Bt_, int ldb, size_t estepB_, int nN_, const unsigned* cnt, int G_, int c_) {
        A = (const char*)A_; Bt = (const char*)Bt_; tstepA = (size_t)256 * lda * 2; tstepB = (size_t)256 * ldb * 2; estepB = estepB_; nN = nN_; G = G_; c = c_;
        int acc = 0; acc += (int)((cnt[0] + 255u) >> 8); te0 = acc; acc += (int)((cnt[1] + 255u) >> 8); te1 = acc; acc += (int)((cnt[2] + 255u) >> 8); te2 = acc; acc += (int)((cnt[3] + 255u) >> 8); te3 = acc;
        acc += (int)((cnt[4] + 255u) >> 8); te4 = acc; acc += (int)((cnt[5] + 255u) >> 8); te5 = acc; acc += (int)((cnt[6] + 255u) >> 8); te6 = acc; acc += (int)((cnt[7] + 255u) >> 8); ntiles = acc;
    }
    __device__ __forceinline__ bool next(int i, Unit& u) const {
        const long L = (long)i * G + c; if (L >= (long)ntiles * nN) return false;
        const int mt = (int)(L / nN); u.pm = mt; u.pn = (int)(L % nN);
        u.e = (mt >= te0) + (mt >= te1) + (mt >= te2) + (mt >= te3) + (mt >= te4) + (mt >= te5) + (mt >= te6); return true;
    }
    __device__ __forceinline__ const char* a_ptr(const Unit& u) const { return A + (size_t)u.pm * tstepA; }
    __device__ __forceinline__ const char* b_ptr(const Unit& u) const { return Bt + (size_t)u.e * estepB + (size_t)u.pn * tstepB; }
};

constexpr int MD_KSPLIT = 7, MD_KTILES = 4;
struct MoeDownOrder {
    static constexpr bool VARNT = true;
    const char* A; const char* Bt; size_t tstepA, tstepB, estepB; int G, c, nsplit, nfull4;
    int tb[8], fe[8];
    unsigned pmask;
    __device__ __forceinline__ void init(const void* A_, int lda, const void* Bt_, int ldb, size_t estepB_, const unsigned* cnt, int G_, int c_) {
        A = (const char*)A_; Bt = (const char*)Bt_; tstepA = (size_t)256 * lda * 2; tstepB = (size_t)256 * ldb * 2; estepB = estepB_; G = G_; c = c_;
        int acc = 0, np = 0, nf = 0; pmask = 0u;
#pragma unroll
        for (int e = 0; e < 8; ++e) { tb[e] = acc; fe[e] = (int)(cnt[e] >> 8); const int p = (cnt[e] & 255u) ? 1 : 0; pmask |= (unsigned)p << e; acc += fe[e] + p; np += p; nf += fe[e]; }
        nsplit = np * 4 * MD_KSPLIT; nfull4 = nf * 4;
    }
    __device__ __forceinline__ bool next(int i, Unit& u) const {
        const long L = (long)i * G + c; if (L >= (long)nsplit + nfull4) return false;
        if (L < nsplit) { const int sidx = (int)L, pi = sidx / (4 * MD_KSPLIT), w = sidx - pi * (4 * MD_KSPLIT); u.pn = w / MD_KSPLIT; u.kq = w - u.pn * MD_KSPLIT;
            int e = 0, seen = 0;
#pragma unroll
            for (int q = 0; q < 8; ++q) { const int has = (int)((pmask >> q) & 1u); if (has && seen == pi) e = q; seen += has; }
            int tbe = 0, fee = 0;
#pragma unroll
            for (int q = 0; q < 8; ++q) { tbe = (e == q) ? tb[q] : tbe; fee = (e == q) ? fe[q] : fee; }
            u.e = e; u.pm = tbe + fee; u.kq |= pi << 8; }
        else { const int f = (int)L - nsplit, ft = f >> 2; u.pn = f & 3; u.kq = -1; int e = 0, rem = ft, pm = 0, done = 0;
#pragma unroll
            for (int q = 0; q < 8; ++q) { if (!done) { if (rem < fe[q]) { e = q; pm = tb[q] + rem; done = 1; } else rem -= fe[q]; } }
            u.e = e; u.pm = pm; }
        return true;
    }
    __device__ __forceinline__ int nt_of(const Unit& u) const { return u.kq < 0 ? MD_KSPLIT * MD_KTILES : MD_KTILES; }
    __device__ __forceinline__ const char* a_ptr(const Unit& u) const { return A + (size_t)u.pm * tstepA + (u.kq < 0 ? (size_t)0 : (size_t)(u.kq & 255) * (MD_KTILES * 128)); }
    __device__ __forceinline__ const char* b_ptr(const Unit& u) const { return Bt + (size_t)u.e * estepB + (size_t)u.pn * tstepB + (u.kq < 0 ? (size_t)0 : (size_t)(u.kq & 255) * (MD_KTILES * 128)); }
};
struct EpiMoeDownSplit {
    static constexpr bool PERM = true, CHAIN = false, F8 = true;
    bf16* Y; bf16* Yp; const float* rgate;
    __device__ __forceinline__ void operator()(f32x4 (&acc)[2][2][4][2], const Unit& u, int wr, int wc, int fr, int fq) const {
        const int rl0 = wr * 64 + fr, col0 = u.pn * 256 + wc * 32 + 8 * fq;
        bf16* dst = (u.kq < 0) ? Y + (size_t)u.pm * 256 * DM : Yp + ((size_t)(u.kq & 255) * (8 * 256) + (size_t)(u.kq >> 8) * 256) * DM;
#pragma unroll
        for (int ai = 0; ai < 2; ++ai)
#pragma unroll
            for (int m = 0; m < 4; ++m) { const int rl = rl0 + ai * 128 + m * 16; const float s = rgate[u.pm * 256 + rl] * (1.0f / 64.0f);
#pragma unroll
                for (int bj = 0; bj < 2; ++bj) *(u32x4*)(dst + (size_t)rl * DM + col0 + bj * 128) = pack8(acc[ai][bj][m][0] * s, acc[ai][bj][m][1] * s); }
    }
};

enum { I_X = 0, I_WIN, I_NORM_MIX, I_RW_MU, I_RW_DECAY_UP, I_RW_W0, I_RW_A_UP, I_RW_A0, I_RW_GATE_UP, I_RW_KK, I_RW_KA, I_RW_RK, I_RW_LNW, I_RW_LNB,
       I_VRES_DOWN, I_VRES_UP, I_VRES_V0, I_SSM_CONVW, I_SSM_CONVB, I_SSM_DTB, I_SSM_ALOG, I_SSM_D, I_SSM_NORMW, I_ATT_QG, I_ATT_KG, I_ATT_BIAS,
       I_GLA_GUP, I_GLA_GB, I_GLA_NW, I_WBRANCH, I_WOUT, I_NORM_FFN, I_FFN_W1, I_FFN_W3, I_FFN_W2, I_MOE_ROUTER, I_MOE_W1, I_MOE_W3, I_MOE_W2, N_IN };
struct Args { const float* in[N_IN]; float* out; unsigned char* ws; };
static_assert(sizeof(Args) == (N_IN + 2) * 8, "Args has no padding");

struct PT { const LAS unsigned long long* tab;
    __device__ __forceinline__ const float* operator[](int i) const { const unsigned long long v = tab[i];
        const unsigned lo = __builtin_amdgcn_readfirstlane((unsigned)v), hi = __builtin_amdgcn_readfirstlane((unsigned)(v >> 32)); return (const float*)(const __attribute__((address_space(1))) float*)(((unsigned long long)hi << 32) | lo); } };
struct ArgsD { PT in;
    __device__ __forceinline__ float* out() const { return (float*)in[N_IN]; }
    __device__ __forceinline__ unsigned char* ws() const { return (unsigned char*)in[N_IN + 1]; } };
constexpr int NWAVES = 8, NTHREADS = 512;
constexpr int LDS_MAIN = 131072;
constexpr int LDS_CTL_OFF = LDS_MAIN;
constexpr int LDS_BYTES = LDS_MAIN + 1024;

template <bool GPERM = false> __device__ __forceinline__ void cvt_item(const float* __restrict__ W, int ld, int k0, int csrc, int ncv, const float* __restrict__ gs, bf16* dst, int dstK, int drow, LAS float* scr, int lane) {
    const int lc = (lane < ncv) ? lane : ncv - 1;
    const float* wp = W + (size_t)k0 * ld + csrc + lc;
#pragma unroll
    for (int kb = 0; kb < 64; kb += 16) { float v[16];
#pragma unroll
        for (int j = 0; j < 16; ++j) v[j] = __builtin_nontemporal_load(wp + (size_t)(kb + j) * ld);
#pragma unroll
        for (int j = 0; j < 16; ++j) scr[(kb + j) * 65 + lane] = v[j]; }
    asm volatile("s_waitcnt lgkmcnt(0)" ::: "memory");
    const int kc = lane & 7;
    f32x4 g0 = {1.f, 1.f, 1.f, 1.f}, g1 = g0; if (gs) { g0 = *(const f32x4*)(gs + k0 + 8 * kc); g1 = *(const f32x4*)(gs + k0 + 8 * kc + 4); }
#pragma unroll
    for (int i = 0; i < 8; ++i) { const int nn = (lane >> 3) + 8 * i; const LAS float* sp = scr + (8 * kc) * 65 + nn;
        u32x4 o; o.x = pk2(sp[0 * 65] * g0[0], sp[1 * 65] * g0[1]); o.y = pk2(sp[2 * 65] * g0[2], sp[3 * 65] * g0[3]); o.z = pk2(sp[4 * 65] * g1[0], sp[5 * 65] * g1[1]); o.w = pk2(sp[6 * 65] * g1[2], sp[7 * 65] * g1[3]);
        const int rr = GPERM ? 32 * ((nn >> 4) & 3) + 8 * ((nn >> 2) & 3) + (nn & 3) : nn;
        if (nn < ncv) *(u32x4*)(dst + (size_t)(drow + rr) * dstK + k0 + 8 * kc) = o; }
    asm volatile("s_waitcnt lgkmcnt(0)" ::: "memory");
}
__device__ __forceinline__ void cvt_item8(const float* __restrict__ W, int ld, int k0, int csrc, int ncv, const float* __restrict__ gs, float scale, unsigned char* dst, int dstK, int drow, LAS float* scr, int lane) {
    const int lc = (lane < ncv) ? lane : ncv - 1;
    const float* wp = W + (size_t)k0 * ld + csrc + lc;
#pragma unroll
    for (int kb = 0; kb < 64; kb += 16) { float v[16];
#pragma unroll
        for (int j = 0; j < 16; ++j) v[j] = __builtin_nontemporal_load(wp + (size_t)(kb + j) * ld);
#pragma unroll
        for (int j = 0; j < 16; ++j) scr[(kb + j) * 65 + lane] = v[j]; }
    asm volatile("s_waitcnt lgkmcnt(0)" ::: "memory");
    const int kc = lane & 3; float gg[16];
#pragma unroll
    for (int j = 0; j < 16; ++j) gg[j] = gs ? gs[k0 + 16 * kc + j] * scale : scale;
#pragma unroll
    for (int i = 0; i < 4; ++i) { const int nn = (lane >> 2) + 16 * i; const LAS float* sp = scr + (16 * kc) * 65 + nn; u32x4 o;
#pragma unroll
        for (int q = 0; q < 4; ++q) { int t = 0; t = __builtin_amdgcn_cvt_pk_fp8_f32(sp[(4 * q) * 65] * gg[4 * q], sp[(4 * q + 1) * 65] * gg[4 * q + 1], t, false); t = __builtin_amdgcn_cvt_pk_fp8_f32(sp[(4 * q + 2) * 65] * gg[4 * q + 2], sp[(4 * q + 3) * 65] * gg[4 * q + 3], t, true); o[q] = (unsigned)t; }
        if (nn < ncv) *(u32x4*)(dst + (size_t)(drow + nn) * dstK + k0 + 16 * kc) = o; }
    asm volatile("s_waitcnt lgkmcnt(0)" ::: "memory");
}
struct CvtCtx { int gw, ngw, base, lane; LAS float* scr; };
__device__ __forceinline__ void cvt_job_gates(CvtCtx& cx, const float* W, int ld, int K, int csrc0, const float* gs, bf16* dst) {
    const int nnb = 64, nit = (K >> 6) * nnb;
    int first = cx.gw - (cx.base % cx.ngw); if (first < 0) first += cx.ngw;
    for (int it = first; it < nit; it += cx.ngw) { const int kb = it / nnb, nb = it - kb * nnb, i = nb >> 4, cc = (nb & 15) * 64;
        cvt_item<true>(W, ld, kb * 64, csrc0 + nb * 64, 64, gs, dst, K, 256 * (cc >> 6) + 128 * (i >> 1) + 4 * (i & 1), cx.scr, cx.lane); }
    cx.base += nit;
}
__device__ __forceinline__ void cvt_job(CvtCtx& cx, const float* W, int ld, int K, int csrc0, int ncols, const float* gs, bf16* dst, int drow_base, int rs128) {
    const int nnb = (ncols + 63) >> 6, nit = (K >> 6) * nnb;
    int first = cx.gw - (cx.base % cx.ngw); if (first < 0) first += cx.ngw;
    for (int it = first; it < nit; it += cx.ngw) { const int kb = it / nnb, nb = it - kb * nnb, c = nb * 64; const int ncv = (ncols - c) < 64 ? (ncols - c) : 64;
        cvt_item(W, ld, kb * 64, csrc0 + c, ncv, gs, dst, K, drow_base + (c >> 7) * rs128 + (c & 127), cx.scr, cx.lane); }
    cx.base += nit;
}
__device__ __forceinline__ void cvt_job8(CvtCtx& cx, const float* W, int ld, int K, int csrc0, int ncols, const float* gs, float scale, unsigned char* dst, int drow_base, int rs128) {
    const int nnb = (ncols + 63) >> 6, nit = (K >> 6) * nnb;
    int first = cx.gw - (cx.base % cx.ngw); if (first < 0) first += cx.ngw;
    for (int it = first; it < nit; it += cx.ngw) { const int kb = it / nnb, nb = it - kb * nnb, c = nb * 64; const int ncv = (ncols - c) < 64 ? (ncols - c) : 64;
        cvt_item8(W, ld, kb * 64, csrc0 + c, ncv, gs, scale, dst, K, drow_base + (c >> 7) * rs128 + (c & 127), cx.scr, cx.lane); }
    cx.base += nit;
}
__device__ __forceinline__ void zero_rows_bf16(int gtid, int nthr, bf16* dst, size_t nelem) {
    u32x4 z = {0u, 0u, 0u, 0u};
    for (size_t i = (size_t)gtid * 8; i < nelem; i += (size_t)nthr * 8) *(u32x4*)(dst + i) = z;
}


__device__ __forceinline__ int rcol(int t, int rot) { return ((((t >> 3) + rot) & 7) << 3) + (t & 7); }
__device__ __forceinline__ int rcol4(int t, int rot) { return ((((t >> 3) + rot) & 3) << 3) + (t & 7); }
constexpr int AT_ST = 72;
constexpr int AT_KS = 0, AT_VT = AT_KS + 2 * 64 * AT_ST * 2, AT_KSC = AT_VT + 2 * 64 * AT_ST * 2, AT_BUFB = AT_KSC + 2 * 64 * 4, AT_BIAS = 2 * AT_BUFB, AT_END = AT_BIAS + 8 * 264 * 4;
__device__ __forceinline__ void attn_drain(const ArgsD& a, int l, LAS unsigned char* lds, LAS unsigned* lctl, unsigned* qctr, const bf16* z, bf16* o) {
    const int tid = opq_v((int)threadIdx.x), lane = tid & 63, wid = __builtin_amdgcn_readfirstlane(tid >> 6);
    const int hs = wid >> 2, qb = wid & 3, fr = lane & 15, g = lane >> 4, ql = 16 * qb + fr, row = tid >> 3, ch = tid & 7;
    constexpr unsigned NU = BATCH * NCH * 4;
    __syncthreads();
    { const float* rb = a.in[I_ATT_BIAS]; LAS float* ball = (LAS float*)(lds + AT_BIAS); float bv[5];
#pragma unroll
      for (int j = 0; j < 5; ++j) { const int i = tid + 512 * j; bv[j] = rb[i < 8 * 257 ? i : 0]; }
#pragma unroll
      for (int j = 0; j < 5; ++j) { const int i = tid + 512 * j; if (i < 8 * 257) { const int hh = i / 257; ball[hh * 264 + (i - hh * 257)] = bv[j] * 1.44269504f; } } }
    f32x4 gq[4];
    { const float* qgp = a.in[I_ATT_QG] + l * 64; const float* kgp = a.in[I_ATT_KG] + l * 64;
      gq[0] = *(const f32x4*)(qgp + 8 * g) * *(const f32x4*)(kgp + 8 * g); gq[1] = *(const f32x4*)(qgp + 8 * g + 4) * *(const f32x4*)(kgp + 8 * g + 4);
      gq[2] = *(const f32x4*)(qgp + 32 + 8 * g) * *(const f32x4*)(kgp + 32 + 8 * g); gq[3] = *(const f32x4*)(qgp + 36 + 8 * g) * *(const f32x4*)(kgp + 36 + 8 * g); }
    if (tid == 0) lctl[32] = atomicAdd(qctr, 1u);
    __syncthreads();
    unsigned q = lctl[32], par = 0, un = 0;
    u32x4 wk[2], wv[2], wq0, wq1;
#define AT_KVPTR(q_, j_) (z + ((size_t)((int)((q_) & 7u)) * SEQ + ((31 - (int)((q_) >> 5)) - 8 + (j_)) * 64 + row) * ZC + C_ATT + 512 + (2 * (int)(((q_) >> 3) & 3u)) * 64 + 8 * ch)
#define AT_LOADKV(p_) do { wk[0] = *(const u32x4*)(p_); wv[0] = *(const u32x4*)((p_) + 512); wk[1] = *(const u32x4*)((p_) + 64); wv[1] = *(const u32x4*)((p_) + 576); } while (0)
#define AT_FETCHQ(q_) do { const int hp_ = (int)(((q_) >> 3) & 3u), c_ = 31 - (int)((q_) >> 5), b_ = (int)((q_) & 7u); const bf16* qp_ = z + ((size_t)b_ * SEQ + c_ * 64 + ql) * ZC + C_ATT + (2 * hp_ + hs) * 64 + 8 * g; \
        wq0 = *(const u32x4*)qp_; wq1 = *(const u32x4*)(qp_ + 32); } while (0)
    const bf16* kvp;
    { const unsigned q0_ = q < NU ? q : NU - 1; const int c0_ = 31 - (int)(q0_ >> 5); kvp = AT_KVPTR(q0_, (c0_ >= 8 ? 0 : 8 - c0_)); AT_LOADKV(kvp); AT_FETCHQ(q0_); }
    while (q < NU) {
        const int hp = (int)((q >> 3) & 3u), c = 31 - (int)(q >> 5), b = (int)(q & 7u), h = 2 * hp + hs;
        unsigned nq_r = NU; if (tid == 0) nq_r = atomicAdd(qctr, 1u);
        const LAS float* bias = (const LAS float*)(lds + AT_BIAS) + h * 264;
        bf16x8 qf[2];
        { f32x4 a0, a1, b0, b1; unpack8(wq0, a0, a1); unpack8(wq1, b0, b1);
          float ss = 0.f;
#pragma unroll
          for (int j = 0; j < 4; ++j) ss += a0[j] * a0[j] + a1[j] * a1[j] + b0[j] * b0[j] + b1[j] * b1[j];
          ss = xrows_sum(ss);
          const float sc = rsqrtf(ss * (1.0f / 64.0f) + NORM_EPS) * 0.125f;
          const u32x4 p0 = pack8(a0 * gq[0] * sc, a1 * gq[1] * sc), p1 = pack8(b0 * gq[2] * sc, b1 * gq[3] * sc);
          qf[0] = __builtin_bit_cast(bf16x8, p0); qf[1] = __builtin_bit_cast(bf16x8, p1); }
        f32x4 oT[4];
#pragma unroll
        for (int d = 0; d < 4; ++d) oT[d] = (f32x4){0.f, 0.f, 0.f, 0.f};
        float m = -1e30f, lsum = 0.f; unsigned nq = NU;
        for (int j = (c >= 8 ? 0 : 8 - c); j <= 8; ++j) {
            LAS unsigned char* buf = lds + par * AT_BUFB; par ^= 1u;
#pragma unroll
            for (int i = 0; i < 2; ++i) { const u32x4 wkk = wk[i], wvv = wv[i];
                *(LAS u32x4*)((LAS bf16*)(buf + AT_KS) + (i * 64 + row) * AT_ST + 8 * ch) = wkk;
                f32x4 k0, k1; unpack8(wkk, k0, k1); float q2 = 0.f;
#pragma unroll
                for (int e = 0; e < 4; ++e) q2 += k0[e] * k0[e] + k1[e] * k1[e];
                q2 = red8_sum(q2);
                if (ch == 0) ((LAS float*)(buf + AT_KSC))[i * 64 + row] = rsqrtf(q2 * (1.0f / 64.0f) + NORM_EPS) * 1.44269504f;
                LAS bf16* vt = (LAS bf16*)(buf + AT_VT) + (i * 64 + 8 * ch) * AT_ST + rcol(row, ch >> 1);
                vt[0 * AT_ST] = (bf16)(wvv.x & 0xffffu); vt[1 * AT_ST] = (bf16)(wvv.x >> 16); vt[2 * AT_ST] = (bf16)(wvv.y & 0xffffu); vt[3 * AT_ST] = (bf16)(wvv.y >> 16);
                vt[4 * AT_ST] = (bf16)(wvv.z & 0xffffu); vt[5 * AT_ST] = (bf16)(wvv.z >> 16); vt[6 * AT_ST] = (bf16)(wvv.w & 0xffffu); vt[7 * AT_ST] = (bf16)(wvv.w >> 16); }
            if (j == 8 && tid == 0) lctl[34 + (un & 1u)] = nq_r;
            __syncthreads();
            { const bf16* np = kvp + (size_t)64 * ZC;
              if (j == 8) { nq = lctl[34 + (un & 1u)]; const unsigned qn = nq < NU ? nq : NU - 1; const int cn_ = 31 - (int)(qn >> 5); np = AT_KVPTR(qn, (cn_ >= 8 ? 0 : 8 - cn_)); AT_FETCHQ(qn); }
              kvp = np; AT_LOADKV(kvp); }
            const LAS bf16* Ks = (const LAS bf16*)(buf + AT_KS) + hs * 64 * AT_ST; const LAS bf16* VT = (const LAS bf16*)(buf + AT_VT) + hs * 64 * AT_ST; const LAS float* ksc = (const LAS float*)(buf + AT_KSC) + hs * 64;
            f32x4 sT[4];
#pragma unroll
            for (int kb = 0; kb < 4; ++kb) { sT[kb] = (f32x4){0.f, 0.f, 0.f, 0.f};
#pragma unroll
                for (int ks = 0; ks < 2; ++ks) { const bf16x8 af = *(const LAS bf16x8*)(Ks + (16 * kb + fr) * AT_ST + 32 * ks + 8 * g); sT[kb] = __builtin_amdgcn_mfma_f32_16x16x32_bf16(af, qf[ks], sT[kb], 0, 0, 0); } }
            float mt = -1e30f;
            if (j <= 5) {
                const float bfar = bias[0];
#pragma unroll
                for (int kb = 0; kb < 4; ++kb) { const f32x4 kv = *(const LAS f32x4*)(ksc + 16 * kb + 4 * g);
#pragma unroll
                    for (int r = 0; r < 4; ++r) { const float sv = sT[kb][r] * kv[r] + bfar; sT[kb][r] = sv; mt = fmaxf(mt, sv); } }
            } else if (j >= 7) {
                const LAS float* bq = bias + ((j - 8) * 64 + 4 * g - ql + 128);
#pragma unroll
                for (int kb = 0; kb < 4; ++kb) { const f32x4 kv = *(const LAS f32x4*)(ksc + 16 * kb + 4 * g);
#pragma unroll
                    for (int r = 0; r < 4; ++r) { const float sv = sT[kb][r] * kv[r] + bq[16 * kb + r]; sT[kb][r] = sv; mt = fmaxf(mt, sv); } }
            } else {
#pragma unroll
                for (int kb = 0; kb < 4; ++kb) { const f32x4 kv = *(const LAS f32x4*)(ksc + 16 * kb + 4 * g);
#pragma unroll
                    for (int r = 0; r < 4; ++r) { int rel = -128 + 16 * kb + 4 * g + r - ql; rel = rel < -128 ? -128 : rel;
                        const float sv = sT[kb][r] * kv[r] + bias[rel + 128]; sT[kb][r] = sv; mt = fmaxf(mt, sv); } }
            }
            mt = xrows_max(mt);
            const float mn = fmaxf(m, mt); const float alpha = __builtin_amdgcn_exp2f(m - mn); m = mn; lsum *= alpha;
#pragma unroll
            for (int d = 0; d < 4; ++d) oT[d] = oT[d] * alpha;
#pragma unroll
            for (int kb = 0; kb < 4; ++kb)
#pragma unroll
                for (int r = 0; r < 4; ++r) { const float p = __builtin_amdgcn_exp2f(sT[kb][r] - mn); sT[kb][r] = p; lsum += p; }
#pragma unroll
            for (int ks = 0; ks < 2; ++ks) { u32x4 pw; pw.x = pg8::cvt_pk_bf16(sT[2 * ks][0], sT[2 * ks][1]); pw.y = pg8::cvt_pk_bf16(sT[2 * ks][2], sT[2 * ks][3]); pw.z = pg8::cvt_pk_bf16(sT[2 * ks + 1][0], sT[2 * ks + 1][1]); pw.w = pg8::cvt_pk_bf16(sT[2 * ks + 1][2], sT[2 * ks + 1][3]);
                const bf16x8 pf = __builtin_bit_cast(bf16x8, pw);
#pragma unroll
                for (int db = 0; db < 4; ++db) { const LAS bf16* vp = VT + (16 * db + fr) * AT_ST; const u32x2 v0 = *(const LAS u32x2*)(vp + rcol(32 * ks + 4 * g, db)), v1 = *(const LAS u32x2*)(vp + rcol(32 * ks + 4 * g + 16, db));
                    u32x4 vw; vw.x = v0.x; vw.y = v0.y; vw.z = v1.x; vw.w = v1.y;
                    oT[db] = __builtin_amdgcn_mfma_f32_16x16x32_bf16(__builtin_bit_cast(bf16x8, vw), pf, oT[db], 0, 0, 0); } }
        }
        lsum = xrows_sum(lsum);
        const float inv = 1.0f / lsum; bf16* op = o + ((size_t)b * SEQ + c * 64 + ql) * 2048 + 1024 + h * 64 + 4 * g;
#pragma unroll
        for (int db = 0; db < 4; ++db) { u32x2 w; w.x = pg8::cvt_pk_bf16(oT[db][0] * inv, oT[db][1] * inv); w.y = pg8::cvt_pk_bf16(oT[db][2] * inv, oT[db][3] * inv); *(u32x2*)(op + 16 * db) = w; }
        q = nq; ++un;
    }
#undef AT_KVPTR
#undef AT_LOADKV
#undef AT_FETCHQ
    __syncthreads();
}

typedef f32x4 acc4;
#define MFMA16(a_, b_, c_) __builtin_amdgcn_mfma_f32_16x16x32_bf16((a_), (b_), (c_), 0, 0, 0)
__device__ __forceinline__ bf16x8 frag_nat(const LAS bf16* base, int pitch, int row, int k0, int g) { return *(const LAS bf16x8*)(base + row * pitch + k0 + 8 * g); }
__device__ __forceinline__ bf16x8 frag_nat_rot(const LAS bf16* base, int row, int k0, int g) { return *(const LAS bf16x8*)(base + row * 72 + ((((k0 >> 3) + g + (row >> 4)) & 7) << 3)); }
__device__ __forceinline__ bf16x8 frag_perm(const LAS bf16* base, int pitch, int row, int k0, int g) { const LAS bf16* p = base + row * pitch + k0 + 4 * g; const u32x2 v0 = *(const LAS u32x2*)p, v1 = *(const LAS u32x2*)(p + 16);
    u32x4 w; w.x = v0.x; w.y = v0.y; w.z = v1.x; w.w = v1.y; return __builtin_bit_cast(bf16x8, w); }
__device__ __forceinline__ bf16x8 frag_acc(const acc4& lo, const acc4& hi) { u32x4 w; w.x = pg8::cvt_pk_bf16(lo[0], lo[1]); w.y = pg8::cvt_pk_bf16(lo[2], lo[3]); w.z = pg8::cvt_pk_bf16(hi[0], hi[1]); w.w = pg8::cvt_pk_bf16(hi[2], hi[3]); return __builtin_bit_cast(bf16x8, w); }
__device__ __forceinline__ float wave_incl_scan(float x, int lane) { (void)lane; return scan64(x); }

constexpr int P72 = 72, P136 = 136;
constexpr int MB_CM = 0, MB_BM = MB_CM + 64 * P136 * 2, MB_BMT = MB_BM + 64 * P136 * 2, MB_XDT = MB_BMT + 128 * P72 * 2, MB_XDTW = MB_XDT + 64 * P72 * 2, MB_P = MB_XDTW + 64 * P72 * 2,
              MB_Y = MB_P + 64 * P72 * 2, MB_ACS = MB_Y + 64 * 68 * 4, MB_DT = MB_ACS + 512, MB_END = MB_DT + 512;
static_assert(MB_END <= 159744, "mamba LDS");
__device__ __forceinline__ void mamba_bc_prepass(const ArgsD& a, int l, int gw, int ngw, int lane, const bf16* z, bf16* bcv) {
    const float* cw = a.in[I_SSM_CONVW] + (size_t)l * 4 * 1024 + 512 + 8 * lane; const float* cb = a.in[I_SSM_CONVB] + l * 1024 + 512 + 8 * lane;
    f32x4 w0[5], w1[5];
#pragma unroll
    for (int j = 0; j < 4; ++j) { w0[j] = *(const f32x4*)(cw + j * 1024); w1[j] = *(const f32x4*)(cw + j * 1024 + 4); }
    w0[4] = *(const f32x4*)cb; w1[4] = *(const f32x4*)(cb + 4);
    for (int rg = gw; rg < T / 8; rg += ngw) { const size_t t0 = (size_t)rg * 8; const bool first = ((rg * 8) & (SEQ - 1)) == 0;
        u32x4 rw[11];
#pragma unroll
        for (int i = 0; i < 11; ++i) { const size_t t = (first && i < 3) ? t0 : t0 + i - 3; rw[i] = *(const u32x4*)(z + t * ZC + C_SSM + 1024 + 8 * lane); }
        if (first) { rw[0] = (u32x4){0u, 0u, 0u, 0u}; rw[1] = rw[0]; rw[2] = rw[0]; }
#pragma unroll
        for (int i = 0; i < 8; ++i) { f32x4 o0 = w0[4], o1 = w1[4];
#pragma unroll
            for (int j = 0; j < 4; ++j) { f32x4 x0, x1; unpack8(rw[i + j], x0, x1); o0 += x0 * w0[j]; o1 += x1 * w1[j]; }
#pragma unroll
            for (int e = 0; e < 4; ++e) { o0[e] = siluf_(o0[e]); o1[e] = siluf_(o1[e]); }
            *(u32x4*)(bcv + (t0 + i) * 512 + 8 * lane) = pack8(o0, o1); } }
}
__device__ __forceinline__ void mamba_block_task(const ArgsD& a, int l, int bh, LAS unsigned char* lds, const bf16* z, const bf16* bcv, bf16* o, float* mssq) {
    const int tid = opq_v((int)threadIdx.x), lane = tid & 63, wid = __builtin_amdgcn_readfirstlane(tid >> 6), fr = lane & 15, g = lane >> 4;
    const int b = bh >> 3, hd = bh & 7, grp = hd >> 2;
    const float dtb = a.in[I_SSM_DTB][l * 8 + hd], Aneg = -__expf(a.in[I_SSM_ALOG][l * 8 + hd]), Dk = a.in[I_SSM_D][l * 8 + hd];
    LAS bf16* Cm = (LAS bf16*)(lds + MB_CM); LAS bf16* Bm = (LAS bf16*)(lds + MB_BM); LAS bf16* BmT = (LAS bf16*)(lds + MB_BMT); LAS bf16* xdtT = (LAS bf16*)(lds + MB_XDT); LAS bf16* xdtwT = (LAS bf16*)(lds + MB_XDTW);
    LAS bf16* Pm = (LAS bf16*)(lds + MB_P); LAS float* Yl = (LAS float*)(lds + MB_Y); LAS float* acs2 = (LAS float*)(lds + MB_ACS); LAS float* dts2 = (LAS float*)(lds + MB_DT);
    const int pb = wid & 3, lh = wid >> 2;
    const int row = tid >> 3, ch = tid & 7;
    f32x4 cw0[5], cw1[5];
    { const float* cw = a.in[I_SSM_CONVW] + (size_t)l * 4 * 1024 + hd * 64 + 8 * ch; const float* cb = a.in[I_SSM_CONVB] + l * 1024 + hd * 64 + 8 * ch;
#pragma unroll
      for (int j = 0; j < 4; ++j) { cw0[j] = *(const f32x4*)(cw + j * 1024); cw1[j] = *(const f32x4*)(cw + j * 1024 + 4); }
      cw0[4] = *(const f32x4*)cb; cw1[4] = *(const f32x4*)(cb + 4); }
    acc4 St[8];
#pragma unroll
    for (int nb = 0; nb < 8; ++nb) St[nb] = (acc4){0.f, 0.f, 0.f, 0.f};
    u32x4 n_gt, n_x[4], n_b0, n_b1, n_c0, n_c1; bf16 n_dt = 0;
#define MB_FETCH(cn_) do { const size_t tq_ = (size_t)b * SEQ + (cn_) * 64 + row; const bf16* zn_ = z + tq_ * ZC + C_SSM; n_gt = *(const u32x4*)(zn_ + hd * 64 + 8 * ch); \
        _Pragma("unroll") for (int k_ = 0; k_ < 4; ++k_) { const bool ok_ = ((cn_) * 64 + row - k_) >= 0; n_x[k_] = *(const u32x4*)(zn_ - (ok_ ? (size_t)k_ * ZC : (size_t)0) + 512 + hd * 64 + 8 * ch); }   \
        const bf16* bq_ = bcv + tq_ * 512 + grp * 128 + 8 * ch; n_b0 = *(const u32x4*)bq_; n_b1 = *(const u32x4*)(bq_ + 64); n_c0 = *(const u32x4*)(bq_ + 256); n_c1 = *(const u32x4*)(bq_ + 320); } while (0)
#define MB_DTSCAN(cn_) do { const float dt_ = softplusf_(bf2f(n_dt) + dtb); const float cs_ = wave_incl_scan(dt_ * Aneg, lane); dts2[((cn_) & 1) * 64 + lane] = dt_; acs2[((cn_) & 1) * 64 + lane] = cs_; } while (0)
    MB_FETCH(0);
    if (wid == 0) { n_dt = z[((size_t)b * SEQ + lane) * ZC + C_SSM + 1536 + hd]; MB_DTSCAN(0); n_dt = z[((size_t)b * SEQ + 64 + lane) * ZC + C_SSM + 1536 + hd]; }
    __syncthreads();
    for (int c = 0; c < NCH; ++c) {
        const size_t t0 = (size_t)b * SEQ + c * 64;
        const LAS float* acs = acs2 + (c & 1) * 64; const LAS float* dts = dts2 + (c & 1) * 64;
        const u32x4 c_gt = n_gt; u32x4 c_x;
        { const float dt = dts[row], wl = __expf(acs[63] - acs[row]);
          f32x4 x0 = cw0[4], x1 = cw1[4];
#pragma unroll
          for (int j = 0; j < 4; ++j) { f32x4 r0, r1; unpack8(n_x[3 - j], r0, r1); const float mk = (c * 64 + row - (3 - j) >= 0) ? 1.0f : 0.0f; x0 += r0 * (cw0[j] * mk); x1 += r1 * (cw1[j] * mk); }
#pragma unroll
          for (int e = 0; e < 4; ++e) { x0[e] = siluf_(x0[e]); x1[e] = siluf_(x1[e]); }
          c_x = pack8(x0, x1);
#pragma unroll
          for (int e = 0; e < 4; ++e) { const float v0 = x0[e] * dt, v1 = x1[e] * dt; xdtT[(8 * ch + e) * P72 + rcol(row, ch >> 1)] = (bf16)f2bf(v0); xdtT[(8 * ch + 4 + e) * P72 + rcol(row, ch >> 1)] = (bf16)f2bf(v1);
              xdtwT[(8 * ch + e) * P72 + rcol(row, ch >> 1)] = (bf16)f2bf(v0 * wl); xdtwT[(8 * ch + 4 + e) * P72 + rcol(row, ch >> 1)] = (bf16)f2bf(v1 * wl); }
#pragma unroll
          for (int i = 0; i < 2; ++i) { const int cc = ch + 8 * i; const u32x4 wb = i ? n_b1 : n_b0, wc = i ? n_c1 : n_c0;
              *(LAS u32x4*)(Bm + row * P136 + 8 * cc) = wb; *(LAS u32x4*)(Cm + row * P136 + 8 * cc) = wc;
              LAS bf16* bt = BmT + (8 * cc) * P72 + rcol(row, cc >> 1);
              bt[0 * P72] = (bf16)(wb.x & 0xffffu); bt[1 * P72] = (bf16)(wb.x >> 16); bt[2 * P72] = (bf16)(wb.y & 0xffffu); bt[3 * P72] = (bf16)(wb.y >> 16);
              bt[4 * P72] = (bf16)(wb.z & 0xffffu); bt[5 * P72] = (bf16)(wb.z >> 16); bt[6 * P72] = (bf16)(wb.w & 0xffffu); bt[7 * P72] = (bf16)(wb.w >> 16); } }
        __syncthreads();
        if (wid == 0 && c + 1 < NCH) MB_DTSCAN(c + 1);
        { const int lb = wid >> 1;
#pragma unroll
          for (int q = 0; q < 2; ++q) { const int sb = 2 * (wid & 1) + q; acc4 cb = (acc4){0.f, 0.f, 0.f, 0.f};
#pragma unroll
              for (int ks = 0; ks < 4; ++ks) cb = MFMA16(frag_nat(Cm, P136, 16 * lb + fr, 32 * ks, g), frag_nat(Bm, P136, 16 * sb + fr, 32 * ks, g), cb);
              const int sidx = 16 * sb + fr; const float as = acs[sidx];
#pragma unroll
              for (int r = 0; r < 4; ++r) { const int lidx = 16 * lb + 4 * g + r; const float v = (sidx <= lidx) ? cb[r] * __expf(acs[lidx] - as) : 0.f; Pm[lidx * P72 + sidx] = (bf16)f2bf(v); } } }
        __syncthreads();
        { const int cn = (c + 1 < NCH) ? c + 1 : c; MB_FETCH(cn); const int cd = (c + 2 < NCH) ? c + 2 : c; if (wid == 0) n_dt = z[((size_t)b * SEQ + cd * 64 + lane) * ZC + C_SSM + 1536 + hd]; }
#pragma unroll
        for (int q = 0; q < 2; ++q) { const int lb = 2 * lh + q; acc4 y = (acc4){0.f, 0.f, 0.f, 0.f};
#pragma unroll
            for (int kk = 0; kk < 4; ++kk) y = MFMA16(frag_perm(Cm, P136, 16 * lb + fr, 32 * kk, g), frag_acc(St[2 * kk], St[2 * kk + 1]), y);
#pragma unroll
            for (int r = 0; r < 4; ++r) y[r] *= __expf(acs[16 * lb + 4 * g + r]);
#pragma unroll
            for (int ks = 0; ks < 2; ++ks) y = MFMA16(frag_nat(Pm, P72, 16 * lb + fr, 32 * ks, g), frag_nat_rot(xdtT, 16 * pb + fr, 32 * ks, g), y);
#pragma unroll
            for (int r = 0; r < 4; ++r) Yl[(16 * lb + 4 * g + r) * 68 + 16 * pb + fr] = y[r]; }
        { const float dec = __expf(acs[63]);
#pragma unroll
          for (int nb = 0; nb < 8; ++nb) { St[nb] = St[nb] * dec;
#pragma unroll
              for (int ks = 0; ks < 2; ++ks) St[nb] = MFMA16(frag_nat_rot(BmT, 16 * nb + fr, 32 * ks, g), frag_nat_rot(xdtwT, 16 * pb + fr, 32 * ks, g), St[nb]); } }
        __syncthreads();
        { const size_t t = t0 + row;
          f32x4 x0, x1, g0, g1; unpack8(c_x, x0, x1); unpack8(c_gt, g0, g1);
          const f32x4 y0 = *(const LAS f32x4*)(Yl + row * 68 + 8 * ch), y1 = *(const LAS f32x4*)(Yl + row * 68 + 8 * ch + 4); f32x4 o0, o1; float q2 = 0.f;
#pragma unroll
          for (int e = 0; e < 4; ++e) { o0[e] = (y0[e] + x0[e] * Dk) * siluf_(g0[e]); o1[e] = (y1[e] + x1[e] * Dk) * siluf_(g1[e]); q2 += o0[e] * o0[e] + o1[e] * o1[e]; }
          *(u32x4*)(o + t * 2048 + 512 + hd * 64 + 8 * ch) = pack8(o0, o1);
          q2 = red8_sum(q2);
          if (ch == 0) mssq[t * 8 + hd] = q2; }
    }
#undef MB_FETCH
#undef MB_DTSCAN
    __syncthreads();
}

constexpr int P132 = 132;
constexpr int GL_BC = 0, GL_QG = GL_BC + 64 * 68 * 4, GL_KG = GL_QG + 64 * P72 * 2, GL_KDT = GL_KG + 64 * P72 * 2, GL_VT = GL_KDT + 64 * P72 * 2, GL_ATT = GL_VT + 128 * P72 * 2,
              GL_O = GL_ATT + 64 * P72 * 2, GL_GU = GL_O + 64 * P132 * 4, GL_END = GL_GU + 17 * 64 * 4;
static_assert(GL_END <= LDS_MAIN, "gla LDS");
constexpr int GP_GU = 0, GP_BC = GP_GU + 17 * 64 * 4, GP_END = GP_BC + 2 * 64 * 68 * 4;
__device__ __forceinline__ void gla_prepass(const ArgsD& a, int l, int bx, int G, LAS unsigned char* lds, bf16* z, float* gend) {
    const int tid = opq_v((int)threadIdx.x), lane = tid & 63, wid = __builtin_amdgcn_readfirstlane(tid >> 6), row = tid >> 3, ch = tid & 7;
    LAS float* gu = (LAS float*)(lds + GP_GU);
    constexpr int NUN = BATCH * 4 * NCH;
    int gu_h = -1; unsigned par = 0;
    u32x4 wx0, wx1, wq, wk;
#define GP_FETCH(u_) do { const int c_ = (u_) & 31, h_ = ((u_) >> 5) & 3, b_ = (u_) >> 7; const bf16* zn_ = z + ((size_t)b_ * SEQ + c_ * 64 + row) * ZC + C_GLA; \
        wx0 = *(const u32x4*)(zn_ + 1024); wx1 = *(const u32x4*)(zn_ + 1032); wq = *(const u32x4*)(zn_ + h_ * 64 + 8 * ch); wk = *(const u32x4*)(zn_ + 256 + h_ * 64 + 8 * ch); } while (0)
    { const int u0 = bx < NUN ? bx : NUN - 1; GP_FETCH(u0); }
    for (int u = bx; u < NUN; u += G) {
        const int c = u & 31, h = (u >> 5) & 3, b = u >> 7;
        if (gu_h != h) { gu_h = h; __syncthreads();
            const float* gup = a.in[I_GLA_GUP] + (size_t)l * 16 * 256 + h * 64; const float* gbp = a.in[I_GLA_GB] + l * 256 + h * 64; float gv[3];
#pragma unroll
            for (int j = 0; j < 3; ++j) { const int i = tid + 512 * j, ic = i < 17 * 64 ? i : 0, r = ic >> 6, k = ic & 63; gv[j] = (r < 16) ? gup[r * 256 + k] : gbp[k]; }
#pragma unroll
            for (int j = 0; j < 3; ++j) { const int i = tid + 512 * j; if (i < 17 * 64) gu[i] = gv[j]; }
            __syncthreads(); }
        LAS float* bc = (LAS float*)(lds + GP_BC) + par * (64 * 68); par ^= 1u;
        const u32x4 c_q = wq, c_k = wk; f32x4 xa, xb_, xc, xd; unpack8(wx0, xa, xb_); unpack8(wx1, xc, xd);
        { const int un = (u + G < NUN) ? u + G : u; GP_FETCH(un); }
        { f32x4 la0 = *(const LAS f32x4*)(gu + 16 * 64 + 8 * ch), la1 = *(const LAS f32x4*)(gu + 16 * 64 + 8 * ch + 4);
#pragma unroll
          for (int r = 0; r < 16; ++r) { const float xv = (r < 4) ? xa[r & 3] : (r < 8) ? xb_[r & 3] : (r < 12) ? xc[r & 3] : xd[r & 3];
              la0 += *(const LAS f32x4*)(gu + r * 64 + 8 * ch) * xv; la1 += *(const LAS f32x4*)(gu + r * 64 + 8 * ch + 4) * xv; }
#pragma unroll
          for (int e = 0; e < 4; ++e) { la0[e] = (fminf(la0[e], 0.f) - __logf(1.0f + __expf(-fabsf(la0[e])))) * (1.0f / 16.0f); la1[e] = (fminf(la1[e], 0.f) - __logf(1.0f + __expf(-fabsf(la1[e])))) * (1.0f / 16.0f); }
          *(LAS f32x4*)(bc + row * 68 + 8 * ch) = la0; *(LAS f32x4*)(bc + row * 68 + 8 * ch + 4) = la1; }
        __syncthreads();
#pragma unroll
        for (int q = 0; q < 8; ++q) { const int k = 8 * wid + q; const float v = scan64(bc[lane * 68 + k]); bc[lane * 68 + k] = v; }
        __syncthreads();
        { const f32x4 b0 = *(const LAS f32x4*)(bc + row * 68 + 8 * ch), b1 = *(const LAS f32x4*)(bc + row * 68 + 8 * ch + 4);
          f32x4 q0, q1, k0, k1, qa, qb_, ka, kb_; unpack8(c_q, q0, q1); unpack8(c_k, k0, k1);
#pragma unroll
          for (int e = 0; e < 4; ++e) { qa[e] = q0[e] * __expf(b0[e]) * 0.125f; qb_[e] = q1[e] * __expf(b1[e]) * 0.125f; ka[e] = k0[e] * __expf(-b0[e]); kb_[e] = k1[e] * __expf(-b1[e]); }
          bf16* zn = z + ((size_t)b * SEQ + c * 64 + row) * ZC + C_GLA; *(u32x4*)(zn + h * 64 + 8 * ch) = pack8(qa, qb_); *(u32x4*)(zn + 256 + h * 64 + 8 * ch) = pack8(ka, kb_);
          if (tid < 64) gend[(size_t)u * 64 + tid] = bc[63 * 68 + tid]; }
    }
#undef GP_FETCH
    __syncthreads();
}
__device__ __forceinline__ void gla_block_task(const ArgsD& a, int l, int bh, LAS unsigned char* lds, const bf16* z, const float* gend, bf16* o) {
    const int tid = opq_v((int)threadIdx.x), lane = tid & 63, wid = __builtin_amdgcn_readfirstlane(tid >> 6), fr = lane & 15, g = lane >> 4;
    const int b = bh >> 2, h = bh & 3;
    LAS float* endl = (LAS float*)(lds + GL_BC); LAS bf16* qg = (LAS bf16*)(lds + GL_QG); LAS bf16* kg = (LAS bf16*)(lds + GL_KG); LAS bf16* kgT = (LAS bf16*)(lds + GL_KDT); LAS bf16* vT = (LAS bf16*)(lds + GL_VT);
    LAS bf16* att = (LAS bf16*)(lds + GL_ATT); LAS float* Ol = (LAS float*)(lds + GL_O);
    const float* nwp = a.in[I_GLA_NW] + l * 128;
    acc4 St[4];
#pragma unroll
    for (int kb = 0; kb < 4; ++kb) St[kb] = (acc4){0.f, 0.f, 0.f, 0.f};
    const int row = tid >> 3, ch = tid & 7;
    const f32x4 nw0 = *(const f32x4*)(nwp + 16 * ch), nw1 = *(const f32x4*)(nwp + 16 * ch + 4), nw2 = *(const f32x4*)(nwp + 16 * ch + 8), nw3 = *(const f32x4*)(nwp + 16 * ch + 12);
    u32x4 n_q, n_k, n_v0, n_v1, n_g0, n_g1; float n_end = 0.f;
#define GL_FETCH(cn_) do { const bf16* zn_ = z + ((size_t)b * SEQ + (cn_) * 64 + row) * ZC + C_GLA; n_q = *(const u32x4*)(zn_ + h * 64 + 8 * ch); n_k = *(const u32x4*)(zn_ + 256 + h * 64 + 8 * ch); \
        n_v0 = *(const u32x4*)(zn_ + 512 + h * 128 + 8 * ch); n_v1 = *(const u32x4*)(zn_ + 512 + h * 128 + 8 * (ch + 8)); n_g0 = *(const u32x4*)(zn_ + 1040 + h * 128 + 16 * ch); n_g1 = *(const u32x4*)(zn_ + 1040 + h * 128 + 16 * ch + 8); \
        if (tid < 64) n_end = gend[((size_t)(b * 4 + h) * NCH + (cn_)) * 64 + tid]; } while (0)
    GL_FETCH(0);
    __syncthreads();
    for (int c = 0; c < NCH; ++c) {
        const size_t t0 = (size_t)b * SEQ + c * 64;
        const u32x4 c_g0 = n_g0, c_g1 = n_g1;
        { *(LAS u32x4*)(qg + row * P72 + 8 * ch) = n_q; *(LAS u32x4*)(kg + row * P72 + 8 * ch) = n_k;
          if (tid < 64) endl[tid] = n_end;
          { LAS bf16* kt = kgT + (8 * ch) * P72 + rcol(row, ch >> 1); const u32x4 wv = n_k;
            kt[0 * P72] = (bf16)(wv.x & 0xffffu); kt[1 * P72] = (bf16)(wv.x >> 16); kt[2 * P72] = (bf16)(wv.y & 0xffffu); kt[3 * P72] = (bf16)(wv.y >> 16);
            kt[4 * P72] = (bf16)(wv.z & 0xffffu); kt[5 * P72] = (bf16)(wv.z >> 16); kt[6 * P72] = (bf16)(wv.w & 0xffffu); kt[7 * P72] = (bf16)(wv.w >> 16); }
#pragma unroll
          for (int i = 0; i < 2; ++i) { const int cc = ch + 8 * i; const u32x4 wv = i ? n_v1 : n_v0; LAS bf16* vt = vT + (8 * cc) * P72 + rcol(row, cc >> 1);
              vt[0 * P72] = (bf16)(wv.x & 0xffffu); vt[1 * P72] = (bf16)(wv.x >> 16); vt[2 * P72] = (bf16)(wv.y & 0xffffu); vt[3 * P72] = (bf16)(wv.y >> 16);
              vt[4 * P72] = (bf16)(wv.z & 0xffffu); vt[5 * P72] = (bf16)(wv.z >> 16); vt[6 * P72] = (bf16)(wv.w & 0xffffu); vt[7 * P72] = (bf16)(wv.w >> 16); } }
        __syncthreads();
        { const int lb = wid >> 1;
#pragma unroll
          for (int q = 0; q < 2; ++q) { const int sb = 2 * (wid & 1) + q; acc4 at = (acc4){0.f, 0.f, 0.f, 0.f};
#pragma unroll
              for (int ks = 0; ks < 2; ++ks) at = MFMA16(frag_nat(qg, P72, 16 * lb + fr, 32 * ks, g), frag_nat(kg, P72, 16 * sb + fr, 32 * ks, g), at);
              const int sidx = 16 * sb + fr;
#pragma unroll
              for (int r = 0; r < 4; ++r) { const int lidx = 16 * lb + 4 * g + r; att[lidx * P72 + sidx] = (bf16)f2bf((sidx <= lidx) ? at[r] : 0.f); } } }
        __syncthreads();
        { const int cn = (c + 1 < NCH) ? c + 1 : c; GL_FETCH(cn); }
#pragma unroll
        for (int lb = 0; lb < 4; ++lb) { acc4 ov = (acc4){0.f, 0.f, 0.f, 0.f};
#pragma unroll
            for (int kk = 0; kk < 2; ++kk) ov = MFMA16(frag_perm(qg, P72, 16 * lb + fr, 32 * kk, g), frag_acc(St[2 * kk], St[2 * kk + 1]), ov);
#pragma unroll
            for (int ks = 0; ks < 2; ++ks) ov = MFMA16(frag_nat(att, P72, 16 * lb + fr, 32 * ks, g), frag_nat_rot(vT, 16 * wid + fr, 32 * ks, g), ov);
#pragma unroll
            for (int r = 0; r < 4; ++r) Ol[(16 * lb + 4 * g + r) * P132 + 16 * wid + fr] = ov[r]; }
#pragma unroll
        for (int kb = 0; kb < 4; ++kb) { const f32x4 bl = *(const LAS f32x4*)(endl + 16 * kb + 4 * g);
#pragma unroll
            for (int ks = 0; ks < 2; ++ks) St[kb] = MFMA16(frag_nat_rot(kgT, 16 * kb + fr, 32 * ks, g), frag_nat_rot(vT, 16 * wid + fr, 32 * ks, g), St[kb]);
#pragma unroll
            for (int r = 0; r < 4; ++r) St[kb][r] *= __expf(bl[r]); }
        __syncthreads();
        { const size_t t = t0 + row; float q2 = 0.f; f32x4 ov[4];
#pragma unroll
          for (int i = 0; i < 4; ++i) { ov[i] = *(const LAS f32x4*)(Ol + row * P132 + 16 * ch + 4 * i); q2 += ov[i][0] * ov[i][0] + ov[i][1] * ov[i][1] + ov[i][2] * ov[i][2] + ov[i][3] * ov[i][3]; }
          q2 = red8_sum(q2);
          const float sc = rsqrtf(q2 * (1.0f / 128.0f) + NORM_EPS);
#pragma unroll
          for (int i = 0; i < 2; ++i) { const u32x4 wg = i ? c_g1 : c_g0; f32x4 g0, g1; unpack8(wg, g0, g1);
              const f32x4 n0 = i ? nw2 : nw0, n1 = i ? nw3 : nw1; f32x4 r0, r1;
#pragma unroll
              for (int e = 0; e < 4; ++e) { r0[e] = ov[2 * i][e] * sc * n0[e] * siluf_(g0[e]); r1[e] = ov[2 * i + 1][e] * sc * n1[e] * siluf_(g1[e]); }
              *(u32x4*)(o + t * 2048 + 1536 + h * 128 + 16 * ch + 8 * i) = pack8(r0, r1); } }
    }
#undef GL_FETCH
    __syncthreads();
}

constexpr int RT = 32, P40 = 40, P328 = 328, P168 = 168;
constexpr int RW_REC = 29184;
constexpr int IM_AT = 0, IM_RT = IM_AT + RT * P72 * 2, IM_KPT = IM_RT + RT * P72 * 2, IM_BPT = IM_KPT + 64 * P40 * 2, IM_VT = IM_BPT + 64 * P40 * 2, IM_MAK = IM_VT + 64 * P40 * 2, IM_ARK = IM_MAK + RT * P40 * 2,
              IM_ARB = IM_ARK + RT * P40 * 2, IM_T1 = IM_ARB + RT * P40 * 2, IM_T2 = IM_T1 + 16 * P40 * 2, IM_GAM = IM_T2 + 16 * P40 * 2, IM_BON = IM_GAM + 256, IM_END = IM_BON + 128;
__device__ __forceinline__ int rw_piece_off(int p) {
    if (p < 512) { const int m = p >> 8, q = p & 255; return (m ? IM_RT : IM_AT) + (q >> 3) * (P72 * 2) + (q & 7) * 16; }
    p -= 512; if (p < 768) { const int m = p >> 8, q = p & 255; return IM_KPT + m * (64 * P40 * 2) + (q >> 2) * (P40 * 2) + (q & 3) * 16; }
    p -= 768; if (p < 384) { const int m = p >> 7, q = p & 127; return IM_MAK + m * (RT * P40 * 2) + (q >> 2) * (P40 * 2) + (q & 3) * 16; }
    p -= 384; if (p < 128) { const int m = p >> 6, q = p & 63; return IM_T1 + m * (16 * P40 * 2) + (q >> 2) * (P40 * 2) + (q & 3) * 16; }
    p -= 128; return IM_GAM + p * 16;
}
constexpr int RW_NPIECE = 1816;
__device__ __forceinline__ unsigned char* rw_rec_ptr(unsigned char* ws, int h, int b, int c) {
    unsigned char* base = (h < 4) ? ws + WS_XG : (h < 6) ? ws + WS_X + X_MIXED : ws + WS_Z + (size_t)T * ZC * 2;
    const int hl = (h < 4) ? h : (h < 6) ? h - 4 : h - 6;
    return base + ((size_t)(hl * BATCH + b) * (SEQ / RT) + c) * RW_REC;
}
static_assert((size_t)4 * BATCH * (SEQ / RT) * RW_REC <= XG_BYTES && (size_t)2 * BATCH * (SEQ / RT) * RW_REC <= (size_t)T * DM * 2 && (size_t)2 * BATCH * (SEQ / RT) * RW_REC <= Z_BYTES - (size_t)T * ZC * 2, "rwkv record regions");

constexpr int RW_WD = 0, RW_WA = RW_WD + 64 * P72 * 2, RW_WG = RW_WA + 64 * P72 * 2, RW_WV = RW_WG + 64 * P168 * 2, RW_HALF0 = RW_WV + 64 * P40 * 2;
constexpr int RH_XLR = 0, RH_LC = 0, RH_KH = RH_LC + RT * 68 * 4, RH_BH = RH_KH + RT * P72 * 2, RH_MAB = RH_BH + RT * P72 * 2, RH_R1_END = RH_MAB + RT * 33 * 4, RH_IMG = 22272, RH_PROJ = RH_IMG, RH_BYTES = RH_IMG + IM_END;
constexpr int RW_PAR = RW_HALF0 + 2 * RH_BYTES;
constexpr int RW_END = RW_PAR + 9 * 64 * 4;
static_assert(RH_R1_END <= RH_IMG && RT * P328 * 2 <= RH_IMG && 4 * RT * P72 * 2 <= IM_GAM && RW_END <= NWAVES * 20352 && (RH_IMG % 16) == 0 && (RH_BYTES % 16) == 0 && (RW_HALF0 % 16) == 0, "rwkv prep LDS");
constexpr int XLR_OFF = 512;
__device__ __forceinline__ void rwkv_xlr_prepass(const ArgsD& a, int l, int bx, int G, const bf16* z, bf16* o) {
    const int tid = opq_v((int)threadIdx.x);
    const float* mu = a.in[I_RW_MU] + l * 1824;
    for (int rb = bx; rb < T / 64; rb += G) {
        u32x4 wc_[5], wp_[5]; f32x4 m0_[5], m1_[5];
#pragma unroll
        for (int i = 0; i < 5; ++i) { const int it = tid + 512 * i, tk = it / 40, q = it - tk * 40; const size_t row = (size_t)rb * 64 + tk;
            const int col = (q < 36) ? 1536 + 8 * q : C_HV + 8 * (q - 36);
            const size_t prow = ((row & (SEQ - 1)) == 0) ? row : row - 1;
            wc_[i] = *(const u32x4*)(z + row * ZC + col); wp_[i] = *(const u32x4*)(z + prow * ZC + col);
            const int mcol = (q < 36) ? col : 1536;
            m0_[i] = *(const f32x4*)(mu + mcol); m1_[i] = *(const f32x4*)(mu + mcol + 4); }
#pragma unroll
        for (int i = 0; i < 5; ++i) { const int it = tid + 512 * i, tk = it / 40, q = it - tk * 40; const size_t row = (size_t)rb * 64 + tk; f32x4 c0v, c1v, p0v, p1v; unpack8(wc_[i], c0v, c1v); unpack8(wp_[i], p0v, p1v);
            if ((row & (SEQ - 1)) == 0) { p0v = (f32x4){0.f, 0.f, 0.f, 0.f}; p1v = p0v; }
            const f32x4 x0 = c0v + (p0v - c0v) * m0_[i], x1 = c1v + (p1v - c1v) * m1_[i];
            const float kk2 = (q < 8) ? 2.0f : 1.0f; f32x4 v0, v1;
#pragma unroll
            for (int e = 0; e < 4; ++e) { const float s0 = sigmoidf_(kk2 * x0[e]), s1 = sigmoidf_(kk2 * x1[e]);
                v0[e] = (q < 8) ? 2.0f * s0 - 1.0f : (q < 16) ? x0[e] : (q < 36) ? s0 : c0v[e]; v1[e] = (q < 8) ? 2.0f * s1 - 1.0f : (q < 16) ? x1[e] : (q < 36) ? s1 : c1v[e]; }
            *(u32x4*)(o + row * 2048 + XLR_OFF + 8 * q) = pack8(v0, v1); }
    }
}
struct PrepPf { u32x4 wzr, wzk, wzv, wpr, wpk, wpv, wvf, xl[5]; };
__device__ __forceinline__ void rwkv_prep_fetch(PrepPf& pf, int l, int h, int b, int cpair, const bf16* z, const bf16* vfirst, const bf16* o) {
    const int tid = opq_v((int)threadIdx.x), lt = tid & 255, c = cpair + (tid >> 8), tok = lt >> 3, C0 = h * 64 + 8 * (lt & 7);
    const size_t t0 = (size_t)b * SEQ + c * RT;
    const bf16* zp = z + (t0 + tok) * ZC + C0; pf.wzr = *(const u32x4*)zp; pf.wzk = *(const u32x4*)(zp + 512); pf.wzv = *(const u32x4*)(zp + 1024);
    const bf16* zq = (c == 0 && tok == 0) ? zp : zp - ZC; pf.wpr = *(const u32x4*)zq; pf.wpk = *(const u32x4*)(zq + 512); pf.wpv = *(const u32x4*)(zq + 1024);
    if (l == 1) pf.wvf = *(const u32x4*)(vfirst + (t0 + tok) * 512 + C0); else pf.wvf = (u32x4){0u, 0u, 0u, 0u};
#pragma unroll
    for (int i = 0; i < 5; ++i) { const int it = lt + 256 * i, tk = it / 40, q = it - tk * 40; pf.xl[i] = *(const u32x4*)(o + (t0 + tk) * 2048 + XLR_OFF + 8 * q); }
}
__device__ __forceinline__ void rwkv_prep_pair(const ArgsD& a, int l, int h, int b, int cpair, int nh, int nb, int ncpair, PrepPf& pf, int& wts_h, LAS unsigned char* lds, const bf16* z, bf16* vfirst, bf16* o, unsigned char* ws) {
    const int tid = opq_v((int)threadIdx.x), lane = tid & 63, wid = __builtin_amdgcn_readfirstlane(tid >> 6), fr = lane & 15, g = lane >> 4;
    const int hf = wid >> 2, lw = wid & 3, lt = tid & 255, c = cpair + hf;
    LAS bf16* Wd = (LAS bf16*)(lds + RW_WD); LAS bf16* Wa = (LAS bf16*)(lds + RW_WA); LAS bf16* Wg = (LAS bf16*)(lds + RW_WG); LAS bf16* Wv = (LAS bf16*)(lds + RW_WV);
    LAS unsigned char* hb_ = lds + RW_HALF0 + hf * RH_BYTES;
    LAS bf16* Xlr = (LAS bf16*)(hb_ + RH_XLR); LAS bf16* Proj = (LAS bf16*)(hb_ + RH_PROJ); LAS float* Lc = (LAS float*)(hb_ + RH_LC);
    LAS bf16* Kh = (LAS bf16*)(hb_ + RH_KH); LAS bf16* Bh = (LAS bf16*)(hb_ + RH_BH); LAS float* Mab = (LAS float*)(hb_ + RH_MAB); LAS unsigned char* img = hb_ + RH_IMG;
    LAS bf16* At = (LAS bf16*)(img + IM_AT); LAS bf16* Rt = (LAS bf16*)(img + IM_RT); LAS bf16* KpT = (LAS bf16*)(img + IM_KPT); LAS bf16* BpT = (LAS bf16*)(img + IM_BPT); LAS bf16* VT = (LAS bf16*)(img + IM_VT);
    LAS bf16* Mak = (LAS bf16*)(img + IM_MAK); LAS bf16* Ark = (LAS bf16*)(img + IM_ARK); LAS bf16* Arb = (LAS bf16*)(img + IM_ARB); LAS bf16* T1 = (LAS bf16*)(img + IM_T1); LAS bf16* T2 = (LAS bf16*)(img + IM_T2);
    LAS float* gam = (LAS float*)(img + IM_GAM); LAS float* bon = (LAS float*)(img + IM_BON);
    if (wts_h != h) { wts_h = h;
        const float* dup = a.in[I_RW_DECAY_UP] + (size_t)l * 64 * 512 + h * 64; const float* aup = a.in[I_RW_A_UP] + (size_t)l * 64 * 512 + h * 64; const float* gup = a.in[I_RW_GATE_UP] + (size_t)l * 160 * 512 + h * 64; const float* vup = a.in[I_VRES_UP] + h * 64;
        { const int k0 = tid >> 6, ch = tid & 63;
          float dv[8], av_[8], gv[20], vv_[4];
#pragma unroll
          for (int j = 0; j < 8; ++j) { dv[j] = dup[(k0 + 8 * j) * 512 + ch]; av_[j] = aup[(k0 + 8 * j) * 512 + ch]; }
#pragma unroll
          for (int j = 0; j < 4; ++j) vv_[j] = vup[(k0 + 8 * j) * 512 + ch];
#pragma unroll
          for (int j = 0; j < 20; ++j) gv[j] = gup[(k0 + 8 * j) * 512 + ch];
#pragma unroll
          for (int j = 0; j < 8; ++j) { Wd[ch * P72 + k0 + 8 * j] = (bf16)f2bf(dv[j]); Wa[ch * P72 + k0 + 8 * j] = (bf16)f2bf(av_[j]); }
#pragma unroll
          for (int j = 0; j < 4; ++j) Wv[ch * P40 + k0 + 8 * j] = (bf16)f2bf(vv_[j]);
#pragma unroll
          for (int j = 0; j < 20; ++j) Wg[ch * P168 + k0 + 8 * j] = (bf16)f2bf(gv[j]); }
        { const int p = tid >> 6, cc = h * 64 + (tid & 63); const float* mu_ = a.in[I_RW_MU] + l * 1824;
          float pv0 = 0.f, pv1 = 0.f;
          pv0 = (p == 0) ? mu_[cc] : (p == 1) ? mu_[512 + cc] : (p == 2) ? mu_[1024 + cc] : (p == 3) ? a.in[I_RW_W0][l * 512 + cc] : (p == 4) ? a.in[I_RW_A0][l * 512 + cc] : (p == 5) ? a.in[I_VRES_V0][cc] : (p == 6) ? a.in[I_RW_KK][l * 512 + cc] : a.in[I_RW_KA][l * 512 + cc];
          if (tid < 64) pv1 = a.in[I_RW_RK][l * 512 + cc];
          LAS float* par_ = (LAS float*)(lds + RW_PAR); par_[tid] = pv0; if (tid < 64) par_[512 + tid] = pv1; } }
    const float* mu = a.in[I_RW_MU] + l * 1824;
    const int tok = lt >> 3, c0 = 8 * (lt & 7), C0 = h * 64 + c0;
    const size_t t0 = (size_t)b * SEQ + c * RT;
    const u32x4 zz4 = {0u, 0u, 0u, 0u}; const bool ftok = (c == 0 && tok == 0);
    const u32x4 wzr = pf.wzr, wzk = pf.wzk, wzv = pf.wzv, wpr = ftok ? zz4 : pf.wpr, wpk = ftok ? zz4 : pf.wpk, wpv = ftok ? zz4 : pf.wpv, wvf = pf.wvf;
#pragma unroll
    for (int i = 0; i < 5; ++i) { const int it = lt + 256 * i, tk = it / 40, q = it - tk * 40; *(LAS u32x4*)(Xlr + tk * P328 + 8 * q) = pf.xl[i]; }
    __syncthreads();
    { const int cb = lw;
#pragma unroll
      for (int p = 0; p < 4; ++p) { const LAS bf16* Wp = (p == 0) ? Wd : (p == 1) ? Wa : (p == 2) ? Wg : Wv; const int wp = (p == 2) ? P168 : (p == 3) ? P40 : P72; const int kb0 = (p == 0) ? 0 : (p == 1) ? 64 : (p == 2) ? 128 : 288;
          const int nks = (p == 2) ? 5 : (p == 3) ? 1 : 2;
#pragma unroll
          for (int rb = 0; rb < 2; ++rb) { acc4 ac = (acc4){0.f, 0.f, 0.f, 0.f};
#pragma unroll
              for (int ks = 0; ks < nks; ++ks) ac = MFMA16(frag_nat(Xlr, P328, 16 * rb + fr, kb0 + 32 * ks, g), frag_nat(Wp, wp, 16 * cb + fr, 32 * ks, g), ac);
#pragma unroll
              for (int r = 0; r < 4; ++r) Proj[(p * RT + 16 * rb + 4 * g + r) * P72 + 16 * cb + fr] = (bf16)f2bf(ac[r]); } } }
    __syncthreads();
    f32x4 rr[2], kk_[2], vv[2], ap[2], bp[2];
    { const size_t row = t0 + tok; f32x4 zr[2], zk[2], zv[2], pr[2], pk[2], pv[2], dw[2], da[2], gg[2], vm[2], vf[2];
      unpack8(wzr, zr[0], zr[1]); unpack8(wzk, zk[0], zk[1]); unpack8(wzv, zv[0], zv[1]); unpack8(wpr, pr[0], pr[1]); unpack8(wpk, pk[0], pk[1]); unpack8(wpv, pv[0], pv[1]); unpack8(wvf, vf[0], vf[1]);
      unpack8(*(const LAS u32x4*)(Proj + (0 * RT + tok) * P72 + c0), dw[0], dw[1]); unpack8(*(const LAS u32x4*)(Proj + (1 * RT + tok) * P72 + c0), da[0], da[1]);
      unpack8(*(const LAS u32x4*)(Proj + (2 * RT + tok) * P72 + c0), gg[0], gg[1]); unpack8(*(const LAS u32x4*)(Proj + (3 * RT + tok) * P72 + c0), vm[0], vm[1]);
      f32x4 ee[2], av[2], vraw[2], kraw[2]; float n2 = 0.f;
#pragma unroll
      for (int hq = 0; hq < 2; ++hq) { const int Cq = C0 + 4 * hq;
          const LAS float* pq = (const LAS float*)(lds + RW_PAR) + c0 + 4 * hq; (void)Cq;
          const f32x4 mur = *(const LAS f32x4*)(pq), muk = *(const LAS f32x4*)(pq + 64), muv = *(const LAS f32x4*)(pq + 128);
          const f32x4 w0c = *(const LAS f32x4*)(pq + 192), a0c = *(const LAS f32x4*)(pq + 256), v0c = *(const LAS f32x4*)(pq + 320), kkc = *(const LAS f32x4*)(pq + 384);
          rr[hq] = zr[hq] + (pr[hq] - zr[hq]) * mur; kraw[hq] = zk[hq] + (pk[hq] - zk[hq]) * muk; vraw[hq] = zv[hq] + (pv[hq] - zv[hq]) * muv;
#pragma unroll
          for (int e = 0; e < 4; ++e) { ee[hq][e] = 0.60653066f * sigmoidf_(w0c[e] + dw[hq][e]); av[hq][e] = sigmoidf_(a0c[e] + da[hq][e]); const float kq = kraw[hq][e] * kkc[e]; n2 += kq * kq;
              vv[hq][e] = (l == 1) ? vraw[hq][e] + (vf[hq][e] - vraw[hq][e]) * sigmoidf_(v0c[e] + vm[hq][e]) : vraw[hq][e]; } }
      if (l == 0) *(u32x4*)(vfirst + row * 512 + C0) = pack8(vraw[0], vraw[1]);
      n2 = red8_sum(n2);
      const float inn = 1.0f / fmaxf(sqrtf(n2), 1e-12f); float bq = 0.f;
#pragma unroll
      for (int hq = 0; hq < 2; ++hq) { const LAS float* pq = (const LAS float*)(lds + RW_PAR) + c0 + 4 * hq; const f32x4 kkc = *(const LAS f32x4*)(pq + 384), kac = *(const LAS f32x4*)(pq + 448), rkc = *(const LAS f32x4*)(pq + 512);
#pragma unroll
          for (int e = 0; e < 4; ++e) { const float kkn = kraw[hq][e] * kkc[e] * inn; kk_[hq][e] = kraw[hq][e] * (1.0f + (av[hq][e] - 1.0f) * kac[e]); ap[hq][e] = -kkn; bp[hq][e] = kkn * av[hq][e]; bq += rr[hq][e] * kk_[hq][e] * rkc[e]; } }
      bq = red8_sum(bq);
      if ((lt & 7) == 0) bon[tok] = bq;
      *(LAS f32x4*)(Lc + tok * 68 + c0) = -ee[0]; *(LAS f32x4*)(Lc + tok * 68 + c0 + 4) = -ee[1];
      *(u32x4*)(o + row * 2048 + C0) = pack8(gg[0], gg[1]); }
    __syncthreads();
#pragma unroll
    for (int q = 0; q < 8; ++q) { const int ch = 16 * lw + 2 * q + (lane >> 5), tk = lane & 31; float x = Lc[tk * 68 + ch];
        x = scan32(x);
        Lc[tk * 68 + ch] = x; }
    __syncthreads();
#pragma unroll
    for (int hq = 0; hq < 2; ++hq) { const int cq = c0 + 4 * hq;
      const f32x4 Lt = *(const LAS f32x4*)(Lc + tok * 68 + cq), Ll = *(const LAS f32x4*)(Lc + (RT - 1) * 68 + cq); f32x4 Lp = (f32x4){0.f, 0.f, 0.f, 0.f}; if (tok > 0) Lp = *(const LAS f32x4*)(Lc + (tok - 1) * 68 + cq);
      f32x4 at_, rt_, kh_, bh_;
#pragma unroll
      for (int e = 0; e < 4; ++e) { const float ep = __expf(Lt[e]), em = __expf(-Lt[e]), el = __expf(Ll[e] - Lt[e]); at_[e] = ap[hq][e] * __expf(Lp[e]); rt_[e] = rr[hq][e] * ep; kh_[e] = kk_[hq][e] * em; bh_[e] = bp[hq][e] * em;
          const int tr_ = (cq + e) * P40 + rcol4(tok, cq >> 4);
          KpT[tr_] = (bf16)f2bf(kk_[hq][e] * el); BpT[tr_] = (bf16)f2bf(bp[hq][e] * el); VT[tr_] = (bf16)f2bf(vv[hq][e]); }
      u32x2 w; w.x = pk2(at_[0], at_[1]); w.y = pk2(at_[2], at_[3]); *(LAS u32x2*)(At + tok * P72 + cq) = w; w.x = pk2(rt_[0], rt_[1]); w.y = pk2(rt_[2], rt_[3]); *(LAS u32x2*)(Rt + tok * P72 + cq) = w;
      w.x = pk2(kh_[0], kh_[1]); w.y = pk2(kh_[2], kh_[3]); *(LAS u32x2*)(Kh + tok * P72 + cq) = w; w.x = pk2(bh_[0], bh_[1]); w.y = pk2(bh_[2], bh_[3]); *(LAS u32x2*)(Bh + tok * P72 + cq) = w;
      if (tok == 0) { f32x4 gv;
#pragma unroll
          for (int e = 0; e < 4; ++e) gv[e] = __expf(Ll[e]);
          *(LAS f32x4*)(gam + cq) = gv; } }
    __syncthreads();
    { const int rb = lw; const LAS bf16* Am = (rb < 2) ? At : Rt;
#pragma unroll
      for (int cb = 0; cb < 4; ++cb) { const LAS bf16* Bm_ = (cb < 2) ? Kh : Bh; acc4 gm = (acc4){0.f, 0.f, 0.f, 0.f};
#pragma unroll
          for (int ks = 0; ks < 2; ++ks) gm = MFMA16(frag_nat(Am, P72, 16 * (rb & 1) + fr, 32 * ks, g), frag_nat(Bm_, P72, 16 * (cb & 1) + fr, 32 * ks, g), gm);
          const int sidx = 16 * (cb & 1) + fr;
#pragma unroll
          for (int r = 0; r < 4; ++r) { const int tidx = 16 * (rb & 1) + 4 * g + r;
              if (rb < 2) { const float v = (sidx < tidx) ? gm[r] : 0.f; if (cb < 2) Mak[tidx * P40 + sidx] = (bf16)f2bf(v); else Mab[tidx * 33 + sidx] = v; }
              else { const float v = (sidx <= tidx) ? gm[r] : 0.f; if (cb < 2) Ark[tidx * P40 + sidx] = (bf16)f2bf(v); else Arb[tidx * P40 + sidx] = (bf16)f2bf(v); } } } }
    __syncthreads();
    rwkv_prep_fetch(pf, l, nh, nb, ncpair, z, vfirst, o);
    if (lw != 0) { unsigned char* rec = rw_rec_ptr(ws, h, b, c);
        for (int p = lt - 64; p < RW_NPIECE - 128; p += 192) { const int pp = (p < 1664) ? p : p + 128; *(u32x4*)(rec + 16 * pp) = *(const LAS u32x4*)(img + rw_piece_off(pp)); } }
    else {
        if (lane < 32) { const int blk = lane >> 4, cc = lane & 15; float x[16]; unsigned moff = (unsigned)((16 * blk) * 33 + 16 * blk) * 4u;
#pragma unroll
            for (int t = 0; t < 16; ++t) { float sacc = (t == cc) ? 1.0f : 0.f;
                if (t > 0) asm volatile("" : "+v"(moff) : "v"(x[t - 1]));
                const LAS float* mp = (const LAS float*)((LAS unsigned char*)Mab + moff) + t * 33;
#pragma unroll
                for (int s2 = 0; s2 < t; ++s2) sacc += mp[s2] * x[s2];
                x[t] = sacc; }
#pragma unroll
            for (int t = 0; t < 16; ++t) { if (blk == 0) { T1[t * P40 + cc] = (bf16)f2bf(x[t]); T1[t * P40 + 16 + cc] = 0; T2[t * P40 + cc] = (bf16)f2bf(Mab[(16 + t) * 33 + cc]); } else T2[t * P40 + 16 + cc] = (bf16)f2bf(x[t]); } }
        { unsigned char* rec = rw_rec_ptr(ws, h, b, c);
#pragma unroll
          for (int k = 0; k < 2; ++k) { const int p = 1664 + lane + 64 * k; *(u32x4*)(rec + 16 * p) = *(const LAS u32x4*)(img + rw_piece_off(p)); } }
    }
    __syncthreads();
}

constexpr int RC_IMG0 = 0, RC_IMG1 = ((IM_END + 255) / 256) * 256, RC_STAT = 2 * RC_IMG1, RC_DUMMY = RC_STAT + RT * 4 * 8, RC_END = RC_DUMMY + 256 * 16;
__device__ __forceinline__ void rwkv_chain_task(const ArgsD& a, int l, int bh, LAS unsigned char* lds, bf16* o, unsigned char* ws) {
    const int tid = opq_v((int)threadIdx.x), lane = tid & 63, wid = __builtin_amdgcn_readfirstlane(tid >> 6), fr = lane & 15, g = lane >> 4;
    const int b = bh >> 3, h = bh & 7;
    LAS f32x2* stat = (LAS f32x2*)(lds + RC_STAT);
    const int ib = wid & 3, Ci = h * 64 + 16 * ib + fr;
    const float lnw = a.in[I_RW_LNW][l * 512 + Ci], lnb = a.in[I_RW_LNB][l * 512 + Ci];
    acc4 St[4];
#pragma unroll
    for (int jb = 0; jb < 4; ++jb) St[jb] = (acc4){0.f, 0.f, 0.f, 0.f};
    u32x4 pv[8]; int poff[8];
#pragma unroll
    for (int i = 0; i < 8; ++i) { const int p = tid - 256 + 256 * i; poff[i] = (p >= 0 && p < RW_NPIECE) ? rw_piece_off(p) : RC_DUMMY + 16 * (tid & 255); pv[i] = (u32x4){0u, 0u, 0u, 0u}; }
#define RC_FETCH(rec_) do { _Pragma("unroll") for (int i_ = 0; i_ < 8; ++i_) { const int p_ = tid - 256 + 256 * i_; pv[i_] = *(const u32x4*)((rec_) + 16 * (p_ < RW_NPIECE ? p_ : 0)); } } while (0)
#define RC_PUT(dst_) do { _Pragma("unroll") for (int i_ = 0; i_ < 8; ++i_) { *(LAS u32x4*)(((i_ < 7 || tid < 256 + RW_NPIECE - 7 * 256) ? (dst_) : lds) + poff[i_]) = pv[i_]; } } while (0)
    if (wid >= 4) { RC_FETCH(rw_rec_ptr(ws, h, b, 0)); RC_PUT(lds + RC_IMG0); RC_FETCH(rw_rec_ptr(ws, h, b, 1)); }
    __syncthreads();
    for (int c = 0; c < SEQ / RT; ++c) {
        LAS unsigned char* img = lds + ((c & 1) ? RC_IMG1 : RC_IMG0);
        acc4 Y0 = (acc4){0.f, 0.f, 0.f, 0.f}, Y1 = Y0; unsigned gpk[2][4] = {{0, 0, 0, 0}, {0, 0, 0, 0}};
        if (wid >= 4) { RC_PUT(lds + ((c & 1) ? RC_IMG0 : RC_IMG1)); const int cf = (c + 2 < SEQ / RT) ? c + 2 : c; RC_FETCH(rw_rec_ptr(ws, h, b, cf)); }
        else {
            { const size_t tq = (size_t)b * SEQ + c * RT;
#pragma unroll
              for (int hb = 0; hb < 2; ++hb)
#pragma unroll
                  for (int r = 0; r < 4; ++r) gpk[hb][r] = o[(tq + 16 * hb + 4 * g + r) * 2048 + Ci]; }
            const LAS bf16* At = (const LAS bf16*)(img + IM_AT); const LAS bf16* Rt = (const LAS bf16*)(img + IM_RT); const LAS bf16* KpT = (const LAS bf16*)(img + IM_KPT); const LAS bf16* BpT = (const LAS bf16*)(img + IM_BPT); const LAS bf16* VT = (const LAS bf16*)(img + IM_VT);
            const LAS bf16* Mak = (const LAS bf16*)(img + IM_MAK); const LAS bf16* Ark = (const LAS bf16*)(img + IM_ARK); const LAS bf16* Arb = (const LAS bf16*)(img + IM_ARB); const LAS bf16* T1 = (const LAS bf16*)(img + IM_T1); const LAS bf16* T2 = (const LAS bf16*)(img + IM_T2);
            const LAS float* gam = (const LAS float*)(img + IM_GAM);
            const bf16x8 Sb0 = frag_acc(St[0], St[1]), Sb1 = frag_acc(St[2], St[3]); const bf16x8 vtf = *(const LAS bf16x8*)(VT + (16 * ib + fr) * P40 + rcol4(8 * g, ib));
            acc4 X0 = (acc4){0.f, 0.f, 0.f, 0.f}, X1 = X0;
            X0 = MFMA16(frag_perm(At, P72, fr, 0, g), Sb0, X0); X0 = MFMA16(frag_perm(At, P72, fr, 32, g), Sb1, X0); X0 = MFMA16(frag_nat(Mak, P40, fr, 0, g), vtf, X0);
            X1 = MFMA16(frag_perm(At, P72, 16 + fr, 0, g), Sb0, X1); X1 = MFMA16(frag_perm(At, P72, 16 + fr, 32, g), Sb1, X1); X1 = MFMA16(frag_nat(Mak, P40, 16 + fr, 0, g), vtf, X1);
            Y0 = MFMA16(frag_perm(Rt, P72, fr, 0, g), Sb0, Y0); Y0 = MFMA16(frag_perm(Rt, P72, fr, 32, g), Sb1, Y0); Y0 = MFMA16(frag_nat(Ark, P40, fr, 0, g), vtf, Y0);
            Y1 = MFMA16(frag_perm(Rt, P72, 16 + fr, 0, g), Sb0, Y1); Y1 = MFMA16(frag_perm(Rt, P72, 16 + fr, 32, g), Sb1, Y1); Y1 = MFMA16(frag_nat(Ark, P40, 16 + fr, 0, g), vtf, Y1);
            const acc4 zero4 = (acc4){0.f, 0.f, 0.f, 0.f};
            const acc4 U0 = MFMA16(frag_perm(T1, P40, fr, 0, g), frag_acc(X0, zero4), zero4);
            const bf16x8 t2f = frag_perm(T2, P40, fr, 0, g);
            const acc4 W1 = MFMA16(t2f, frag_acc(U0, zero4), X1);
            const acc4 U1 = MFMA16(t2f, frag_acc(zero4, W1), zero4);
            const bf16x8 Ub = frag_acc(U0, U1);
            Y0 = MFMA16(frag_perm(Arb, P40, fr, 0, g), Ub, Y0); Y1 = MFMA16(frag_perm(Arb, P40, 16 + fr, 0, g), Ub, Y1);
#pragma unroll
            for (int jb = 0; jb < 4; ++jb) { const f32x4 gm = *(const LAS f32x4*)(gam + 16 * jb + 4 * g); St[jb] = St[jb] * gm;
                const bf16x8 kpf = *(const LAS bf16x8*)(KpT + (16 * jb + fr) * P40 + rcol4(8 * g, jb));
                const LAS bf16* bpp = BpT + (16 * jb + fr) * P40; const u32x2 bv0 = *(const LAS u32x2*)(bpp + rcol4(4 * g, jb)), bv1 = *(const LAS u32x2*)(bpp + rcol4(4 * g + 16, jb)); u32x4 bw; bw.x = bv0.x; bw.y = bv0.y; bw.z = bv1.x; bw.w = bv1.y;
                St[jb] = MFMA16(kpf, vtf, St[jb]); St[jb] = MFMA16(__builtin_bit_cast(bf16x8, bw), Ub, St[jb]); }
#pragma unroll
            for (int r = 0; r < 4; ++r) { float s0 = Y0[r], q0 = Y0[r] * Y0[r], s1 = Y1[r], q1 = Y1[r] * Y1[r];
                s0 = red16_sum(s0); q0 = red16_sum(q0); s1 = red16_sum(s1); q1 = red16_sum(q1);
                if (fr == 0) { stat[(4 * g + r) * 4 + ib] = (f32x2){s0, q0}; stat[(16 + 4 * g + r) * 4 + ib] = (f32x2){s1, q1}; } }
        }
        __syncthreads();
        if (wid < 4) {
            const LAS bf16* VT = (const LAS bf16*)(img + IM_VT); const LAS float* bon = (const LAS float*)(img + IM_BON);
            const size_t t0 = (size_t)b * SEQ + c * RT;
#pragma unroll
            for (int hb = 0; hb < 2; ++hb) { const u32x2 vw = *(const LAS u32x2*)(VT + (16 * ib + fr) * P40 + rcol4(16 * hb + 4 * g, ib)); const f32x4 vv = (f32x4){lo2f(vw.x), hi2f(vw.x), lo2f(vw.y), hi2f(vw.y)};
#pragma unroll
                for (int r = 0; r < 4; ++r) { const int t = 16 * hb + 4 * g + r; const f32x2 s0 = stat[t * 4 + 0], s1 = stat[t * 4 + 1], s2 = stat[t * 4 + 2], s3 = stat[t * 4 + 3];
                    const float mean = ((s0.x + s1.x) + (s2.x + s3.x)) * (1.0f / 64.0f); const float ex2 = ((s0.y + s1.y) + (s2.y + s3.y)) * (1.0f / 64.0f);
                    const float rstd = rsqrtf(fmaxf(ex2 - mean * mean, 0.f) + 64e-5f); const float y = hb ? Y1[r] : Y0[r];
                    bf16* op = o + (t0 + t) * 2048 + Ci; const float gg = bf2f((bf16)gpk[hb][r]);
                    *op = (bf16)f2bf((((y - mean) * rstd * lnw + lnb) + bon[t] * vv[r]) * gg); } }
        }
        __syncthreads();
    }
}

#define XB_TMO      128
#define XB_XCNT(j)  (256  + 64 * (j))
#define XB_XSUB(j)  (1280 + 64 * (j))
#define XB_XGEN(j)  (2304 + 64 * (j))
#define XB_TOP      3328
#define XB_TOPGEN   3392
#define XCD_BAR_WORDS 3456
#define XB_SPIN_CAP (1u << 20)
__device__ __forceinline__ unsigned xb_ld(unsigned* p)              { return __hip_atomic_load(p, __ATOMIC_RELAXED, __HIP_MEMORY_SCOPE_AGENT); }
__device__ __forceinline__ unsigned xb_add(unsigned* p, unsigned v) { return __hip_atomic_fetch_add(p, v, __ATOMIC_RELAXED, __HIP_MEMORY_SCOPE_AGENT); }
__device__ __forceinline__ unsigned xb_xcc_id() { return (unsigned)__builtin_amdgcn_s_getreg((3 << 11) | 20) & 0xFu; }
#define XB_SPIN(cond, bar) do { unsigned _sp = 0; while (cond) { __builtin_amdgcn_s_sleep(1); \
    if ((++_sp & 255u) == 0u) { if (xb_ld(&(bar)[XB_TMO])) break; if (_sp > XB_SPIN_CAP) { atomicAdd(&(bar)[XB_TMO], 1u); break; } } } } while (0)
__device__ __forceinline__ void xcd_barrier_complete(unsigned* bar, unsigned x, unsigned& nloc, unsigned& nx) {
    const unsigned G = gridDim.x * gridDim.y * gridDim.z;
    unsigned sum, cnt, mine, sp = 0u;
    for (;;) {
        sum = 0u; cnt = 0u; mine = 0u;
#pragma unroll
        for (unsigned j = 0; j < 16; ++j) { const unsigned c = xb_ld(&bar[XB_XCNT(j)]); sum += c; cnt += (c > 0u) ? 1u : 0u; mine = (j == x) ? c : mine; }
        if (sum == G) break;
        __builtin_amdgcn_s_sleep(1);
        if ((++sp & 255u) == 0u) { if (xb_ld(&bar[XB_TMO])) break; if (sp > XB_SPIN_CAP) { atomicAdd(&bar[XB_TMO], 1u); break; } }
    }
    nloc = mine > 0u ? mine : 1u; nx = cnt > 0u ? cnt : 1u;
}
__device__ __forceinline__ void xcd_barrier(unsigned* bar, volatile LAS unsigned* st) {
    asm volatile("s_waitcnt vmcnt(0)" ::: "memory");
    __syncthreads();
    if (threadIdx.x == 0) {
        __builtin_amdgcn_s_waitcnt(0);
        unsigned nloc = st[0], nx = st[1]; const unsigned x = st[2];
        if (nloc == 0u) { xcd_barrier_complete(bar, x, nloc, nx); st[0] = nloc; st[1] = nx; }
        const unsigned old = xb_add(&bar[XB_XSUB(x)], 1u);
        const unsigned gen = old / nloc;
        if (old + 1u == (gen + 1u) * nloc) {
            __builtin_amdgcn_fence(__ATOMIC_RELEASE, "agent");
            asm volatile("s_waitcnt vmcnt(0)" ::: "memory");
            const unsigned og = xb_add(&bar[XB_TOP], 1u);
            const unsigned tg = og / nx;
            if (og + 1u == (tg + 1u) * nx) xb_add(&bar[XB_TOPGEN], 1u);
            else XB_SPIN(xb_ld(&bar[XB_TOPGEN]) == tg, bar);
            __builtin_amdgcn_fence(__ATOMIC_ACQUIRE, "agent");
            xb_add(&bar[XB_XGEN(x)], 1u);
            asm volatile("s_waitcnt vmcnt(0)" ::: "memory");
        } else {
            XB_SPIN(xb_ld(&bar[XB_XGEN(x)]) == gen, bar);
            __builtin_amdgcn_fence(__ATOMIC_ACQUIRE, "agent");
            asm volatile("s_waitcnt vmcnt(0)" ::: "memory");
        }
    }
    __syncthreads();
}

constexpr int LDS_WSCR = 20352;
constexpr int LDS_TOTAL = NWAVES * LDS_WSCR + 1024;
static_assert(LDS_TOTAL <= 163840 && NWAVES * LDS_WSCR >= LDS_MAIN, "LDS map");
constexpr int NPH = 22;
#ifndef MIXMASK
#define MIXMASK 15
#endif
#define MIX_T(bit, call) do { if ((MIXMASK) & (bit)) { call; } } while (0)

#define PHASE_PTRS \
    const int tid = opq_v((int)threadIdx.x), lane = tid & 63, wid = __builtin_amdgcn_readfirstlane(tid >> 6); (void)lane; (void)wid; \
    const int G = opq_s((int)gridDim.x), bx = opq_s((int)blockIdx.x); const int gw = bx * NWAVES + wid, ngw = G * NWAVES; (void)gw; (void)ngw; \
    LAS unsigned char* lds = (LAS unsigned char*)lds_raw; LAS unsigned* lctl = (LAS unsigned*)(lds + NWAVES * LDS_WSCR); (void)lctl; \
    ArgsD a; a.in.tab = (LAS unsigned long long*)(lds + NWAVES * LDS_WSCR + 640); \
    unsigned char* ws = a.ws(); float* a_out = a.out(); (void)a_out; \
    unsigned* ctl = (unsigned*)(ws + WS_CTL); (void)ctl; \
    float* ssb = (float*)(ws + WS_SMALL + SM_SS); (void)ssb; \
    float* mssq = (float*)(ws + WS_SMALL + SM_MSSQ); (void)mssq; \
    int* tok_e = (int*)(ws + WS_SMALL + SM_TOKE); float* tok_g = (float*)(ws + WS_SMALL + SM_TOKG); float* tok_rs = (float*)(ws + WS_SMALL + SM_TOKRS); (void)tok_e; (void)tok_g; (void)tok_rs; \
    int* tok_slot = (int*)(ws + WS_SMALL + SM_TOKSLOT); int* row_tok = (int*)(ws + WS_SMALL + SM_ROWTOK); float* row_gate = (float*)(ws + WS_SMALL + SM_ROWGATE); float* row_rs = (float*)(ws + WS_SMALL + SM_ROWRS); (void)tok_slot; (void)row_tok; (void)row_gate; (void)row_rs; \
    bf16* xb = (bf16*)(ws + WS_XB); (void)xb; \
    bf16* vfirst = (bf16*)(ws + WS_X + X_VFIRST); bf16* mixed = (bf16*)(ws + WS_X + X_MIXED); bf16* obuf = (bf16*)(ws + WS_X + X_O); (void)vfirst; (void)mixed; (void)obuf; \
    unsigned char* wreg = ws + WS_X + X_W; (void)wreg; \
    bf16* zbuf = (bf16*)(ws + WS_Z); bf16* gates = zbuf; bf16* hidden = zbuf; bf16* act = zbuf; (void)gates; (void)hidden; (void)act; \
    bf16* xg = (bf16*)(ws + WS_XG); bf16* ybuf = xg; bf16* rwarr = xg; (void)ybuf; (void)rwarr; bf16* ypart = (bf16*)(ws + WS_Z + (size_t)128 * MiB); (void)ypart; bf16* bcv = (bf16*)(ws + WS_BCV); (void)bcv; float* gend = (float*)(ws + WS_GEND); (void)gend; \
    bf16* moe_w13 = (bf16*)(ws + WS_X + MOE_W13); bf16* moe_w2 = (bf16*)(ws + WS_X + MOE_W2); (void)moe_w13; (void)moe_w2;

#define IDLE_CVT_BEGIN(nwg_) { const int p0_ = (nwg_) % G; if (bx >= p0_) { CvtCtx cx; cx.gw = (bx - p0_) * NWAVES + wid; cx.ngw = (G - p0_) * NWAVES; cx.base = 0; cx.lane = lane; cx.scr = (LAS float*)(lds + wid * LDS_WSCR); \
        const int zt_ = (bx - p0_) * NTHREADS + tid, zn_ = (G - p0_) * NTHREADS; (void)zt_; (void)zn_;
#define IDLE_CVT_END } }
#define CVT_LAYER_REST(l_) do { const float* win_ = a.in[I_WIN] + (size_t)(l_) * DM * IN_COLS; const float* nm_ = a.in[I_NORM_MIX] + (l_) * DM; \
        cvt_job_gates(cx, win_, IN_COLS, DM, MIXC, nm_, (bf16*)(wreg + W_G) + (size_t)(l_) * 4096 * DM); \
        for (int i_ = 0; i_ < 4; ++i_) cvt_job(cx, a.in[I_WBRANCH] + ((size_t)(l_) * 4 + i_) * 512 * DM, DM, 512, 0, DM, nullptr, (bf16*)(wreg + W_B) + ((size_t)(l_) * 4 + i_) * DM * 512, 0, 128); \
        cvt_job(cx, a.in[I_WOUT] + (size_t)(l_) * DM * DM, DM, DM, 0, DM, nullptr, (bf16*)(wreg + W_O) + (size_t)(l_) * DM * DM, 0, 128); } while (0)
template <int LO, int HI>
__device__ __forceinline__ void mk_body(const Args& ka) {
    extern __shared__ __attribute__((aligned(16))) unsigned char lds_raw[];
    { LAS unsigned long long* ptab = (LAS unsigned long long*)((LAS unsigned char*)lds_raw + NWAVES * LDS_WSCR + 640);
      const int t0 = threadIdx.x;
      if (t0 < N_IN) ptab[t0] = (unsigned long long)ka.in[t0];
      if (t0 == N_IN) ptab[t0] = (unsigned long long)ka.out;
      if (t0 == N_IN + 1) ptab[t0] = (unsigned long long)ka.ws;
#if !MK_PER_PHASE
      if (t0 == 64) { LAS unsigned* st = (LAS unsigned*)((LAS unsigned char*)lds_raw + NWAVES * LDS_WSCR + 992); st[0] = 0u; st[1] = 0u; const unsigned x = xb_xcc_id(); st[2] = x;
          (void)xb_add((unsigned*)(ka.ws + WS_CTL) + CW_BAR + XB_XCNT(x), 1u); }
#endif
      __syncthreads(); }
#if MK_PER_PHASE
#define GRID_BAR() do { } while (0)
#else
#define GRID_BAR() do { unsigned char* ws_ = ArgsD{PT{(LAS unsigned long long*)((LAS unsigned char*)lds_raw + NWAVES * LDS_WSCR + 640)}}.ws(); \
    xcd_barrier((unsigned*)(ws_ + WS_CTL) + CW_BAR, (volatile LAS unsigned*)((LAS unsigned char*)lds_raw + NWAVES * LDS_WSCR + 992)); } while (0)
#endif
#define IN(k) (LO <= (k) && (k) < HI)
#if MK_PER_PHASE
#define SPLIT_ARRIVE(w) do { } while (0)
#define SPLIT_WAIT(w) do { } while (0)
#else
#define SPLIT_ARRIVE(w) do { asm volatile("s_waitcnt vmcnt(0)" ::: "memory"); __syncthreads(); if (threadIdx.x == 0) { unsigned* c_ = (unsigned*)(ArgsD{PT{(LAS unsigned long long*)((LAS unsigned char*)lds_raw + NWAVES * LDS_WSCR + 640)}}.ws() + WS_CTL); \
        __builtin_amdgcn_fence(__ATOMIC_RELEASE, "agent"); asm volatile("s_waitcnt vmcnt(0)" ::: "memory"); xb_add(c_ + CW_SPLIT + 64 * (w), 1u); } } while (0)
#define SPLIT_WAIT(w) do { if (threadIdx.x == 0) { unsigned* c_ = (unsigned*)(ArgsD{PT{(LAS unsigned long long*)((LAS unsigned char*)lds_raw + NWAVES * LDS_WSCR + 640)}}.ws() + WS_CTL); \
        XB_SPIN(xb_ld(c_ + CW_SPLIT + 64 * (w)) < gridDim.x, c_ + CW_BAR); __builtin_amdgcn_fence(__ATOMIC_ACQUIRE, "agent"); asm volatile("s_waitcnt vmcnt(0)" ::: "memory"); } __syncthreads(); } while (0)
#endif
#define SEAM(k) do { if (IN(k) && IN((k) + 1)) GRID_BAR(); } while (0)

    if (IN(0)) { PHASE_PTRS
        CvtCtx cx; cx.gw = gw; cx.ngw = ngw; cx.base = 0; cx.lane = lane; cx.scr = (LAS float*)(lds + wid * LDS_WSCR);
        { const float* win = a.in[I_WIN]; const float* nm = a.in[I_NORM_MIX]; bf16* winT = (bf16*)(wreg + W_IN);
          cvt_job(cx, win, IN_COLS, DM, 0, MIXC, nm, winT, 0, 128);
          zero_rows_bf16(bx * NTHREADS + tid, G * NTHREADS, winT + (size_t)C_HV * DM, (size_t)(ZC - C_HV) * DM); }
        const float* x = a.in[I_X];
        for (int m = gw; m < T; m += ngw) { const f32x4* xr = (const f32x4*)(x + (size_t)m * DM) + lane; float s = 0.f;
#pragma unroll
            for (int j = 0; j < 4; ++j) { const f32x4 v = xr[64 * j]; s += (v[0] * v[0] + v[1] * v[1]) + (v[2] * v[2] + v[3] * v[3]); u32x2 w; w.x = pk2(v[0], v[1]); w.y = pk2(v[2], v[3]); *((u32x2*)(xb + (size_t)m * DM) + lane + 64 * j) = w; }
            s = wave_sum(s); if (lane < 16) ssb[(size_t)m * 16 + lane] = (lane == 0) ? s : 0.f; }
    }
#if MK_PER_PHASE
    SEAM(0);
#else
    if (IN(0) && IN(1)) { cg::this_grid().sync(); }
#endif

#pragma unroll
    for (int l = 0; l < 2; ++l) {
        const int pb = 1 + 9 * l;
#define ss_mix (ssb + (size_t)(l == 0 ? 0 : 2) * T * 16)
#define ss_ffn (l == 0 ? ssb + (size_t)T * 16 : (float*)nullptr)
        if (IN(pb + 0)) { PHASE_PTRS
            pg8::Gemm g{DM, DM, DM}; pg8::StaticOrder S; S.init(xb, (bf16*)(wreg + W_IN) + (size_t)l * ZC * DM, DM, DM, T, ZC, G, bx);
            EpiScaleBf16<0> E{zbuf, ZC, ss_mix};
            pg8::gemm_phase(lds, g, S, E);
            IDLE_CVT_BEGIN((T / 256) * (ZC / 256))
                CVT_LAYER_REST(l);
                if (l == 0) {
#if FFN_FP8
                    cvt_job8(cx, a.in[I_FFN_W1], FFN, DM, 0, FFN, a.in[I_NORM_FFN], 32.0f, wreg + W_13, 0, 256);
                    cvt_job8(cx, a.in[I_FFN_W3], FFN, DM, 0, FFN, a.in[I_NORM_FFN], 32.0f, wreg + W_13, 128, 256);
                    cvt_job8(cx, a.in[I_FFN_W2], DM, FFN, 0, DM, nullptr, 64.0f, wreg + W_2, 0, 128);
#else
                    cvt_job(cx, a.in[I_FFN_W1], FFN, DM, 0, FFN, a.in[I_NORM_FFN], (bf16*)(wreg + W_13), 0, 256);
                    cvt_job(cx, a.in[I_FFN_W3], FFN, DM, 0, FFN, a.in[I_NORM_FFN], (bf16*)(wreg + W_13), 128, 256);
                    cvt_job(cx, a.in[I_FFN_W2], DM, FFN, 0, DM, nullptr, (bf16*)(wreg + W_2), 0, 128);
#endif
                }
            IDLE_CVT_END
        }
        SEAM(pb + 0);
        if (IN(pb + 1)) { PHASE_PTRS
            mamba_bc_prepass(a, l, gw, ngw, lane, zbuf, bcv);
            rwkv_xlr_prepass(a, l, bx, G, zbuf, obuf);
            gla_prepass(a, l, bx, G, lds, zbuf, gend);
        }
        SEAM(pb + 1);
        if (IN(pb + 2)) { PHASE_PTRS
            const int npair = 8 * BATCH * (SEQ / RT) / 2, ppb = (npair + G - 1) / G; int wts_h = -1;
            const int u0 = bx * ppb, u1 = ((bx + 1) * ppb < npair) ? (bx + 1) * ppb : npair;
            if (u0 < u1) { PrepPf pf; rwkv_prep_fetch(pf, l, u0 >> 8, (u0 >> 5) & 7, 2 * (u0 & 31), zbuf, vfirst, obuf);
                for (int u = u0; u < u1; ++u) { const int un = (u + 1 < u1) ? u + 1 : u;
                    rwkv_prep_pair(a, l, u >> 8, (u >> 5) & 7, 2 * (u & 31), un >> 8, (un >> 5) & 7, 2 * (un & 31), pf, wts_h, lds, zbuf, vfirst, obuf, ws); } } }
        SEAM(pb + 2);
        if (IN(pb + 3)) { PHASE_PTRS
            if (bx < 64) { MIX_T(1, rwkv_chain_task(a, l, bx, lds, obuf, ws)); }
            else if (bx < 128) { MIX_T(2, mamba_block_task(a, l, bx - 64, lds, zbuf, bcv, obuf, mssq)); }
            else if (bx < 160) { MIX_T(4, gla_block_task(a, l, bx - 128, lds, zbuf, gend, obuf)); }
            MIX_T(8, attn_drain(a, l, lds, lctl, ctl + CW_ATTQ + l, zbuf, obuf));
        }
        SEAM(pb + 3);
        if (IN(pb + 4)) { PHASE_PTRS
            const float* nw = a.in[I_SSM_NORMW] + l * 512;
            for (int m = gw; m < T; m += ngw) { const int g = lane >> 5; const float* q = mssq + (size_t)m * 8 + g * 4; const float sc = rsqrtf((q[0] + q[1] + q[2] + q[3]) * (1.0f / 256.0f) + NORM_EPS);
                bf16* p = obuf + (size_t)m * 2048 + 512 + lane * 8; const u32x4 w = *(const u32x4*)p; f32x4 v0, v1; unpack8(w, v0, v1);
                const f32x4 n0 = *(const f32x4*)(nw + lane * 8), n1 = *(const f32x4*)(nw + lane * 8 + 4);
                *(u32x4*)p = pack8(v0 * n0 * sc, v1 * n1 * sc); }
            pg8::Gemm g{DM, DM, DM}; pg8::StaticOrder S; S.init(xb, (bf16*)(wreg + W_G) + (size_t)l * 4096 * DM, DM, DM, T, 4096, G, bx);
            EpiGateRatio E{gates, ss_mix};
            pg8::gemm_phase(lds, g, S, E);
        }
        SEAM(pb + 4);
        if (IN(pb + 5)) { PHASE_PTRS
            pg8::Gemm g{2048, 512, 512}; MixOrder S{(const char*)obuf, (const char*)((bf16*)(wreg + W_B) + (size_t)l * 4 * DM * 512), G, bx};
            EpiMix E{gates, mixed};
            pg8::gemm_phase(lds, g, S, E);
        }
        SEAM(pb + 5);
        if (IN(pb + 6)) { PHASE_PTRS
            pg8::Gemm g{DM, DM, DM}; pg8::StaticOrder S; S.init(mixed, (bf16*)(wreg + W_O) + (size_t)l * DM * DM, DM, DM, T, DM, G, bx);
            EpiResid<false> E{l == 0 ? a.in[I_X] : a_out, a_out, xb, ss_ffn, (FFN_FP8 && l == 0) ? (unsigned char*)xg : (unsigned char*)nullptr};
            pg8::gemm_phase(lds, g, S, E);
        }
        if (l == 0) SEAM(pb + 6); else if (IN(pb + 6) && IN(pb + 7)) SPLIT_ARRIVE(0);
        if (l == 0) {
            if (IN(pb + 7)) { PHASE_PTRS
#if FFN_FP8
                pg8::Gemm g{DM / 2, DM / 2, DM / 2}; pg8::StaticOrder S; S.init(xg, (bf16*)(wreg + W_13), DM / 2, DM / 2, T, 2 * FFN, G, bx);
                EpiSwiglu<false, true> E{hidden, FFN, ss_ffn};
#else
                pg8::Gemm g{DM, DM, DM}; pg8::StaticOrder S; S.init(xb, (bf16*)(wreg + W_13), DM, DM, T, 2 * FFN, G, bx);
                EpiSwiglu<false, false> E{hidden, FFN, ss_ffn};
#endif
                pg8::gemm_phase(lds, g, S, E);
                IDLE_CVT_BEGIN((T / 256) * (2 * FFN / 256))
                    const float* win = a.in[I_WIN] + (size_t)DM * IN_COLS; const float* nm = a.in[I_NORM_MIX] + DM; bf16* winT = (bf16*)(wreg + W_IN) + (size_t)ZC * DM;
                    cvt_job(cx, win, IN_COLS, DM, 0, MIXC, nm, winT, 0, 128);
                    cvt_job(cx, a.in[I_VRES_DOWN], 32, DM, 0, 32, nm, winT, C_HV, 128);
                    zero_rows_bf16(zt_, zn_, winT + (size_t)(C_HV + 32) * DM, (size_t)(ZC - C_HV - 32) * DM);
                IDLE_CVT_END
            }
            SEAM(pb + 7);
            if (IN(pb + 8)) { PHASE_PTRS
#if FFN_FP8
                pg8::Gemm g{FFN / 2, FFN / 2, FFN / 2}; pg8::StaticOrder S; S.init(hidden, (bf16*)(wreg + W_2), FFN / 2, FFN / 2, T, DM, G, bx);
                EpiResid<true> E{a_out, a_out, xb, ssb + (size_t)2 * T * 16, nullptr};
#else
                pg8::Gemm g{FFN, FFN, FFN}; pg8::StaticOrder S; S.init(hidden, (bf16*)(wreg + W_2), FFN, FFN, T, DM, G, bx);
                EpiResid<false> E{a_out, a_out, xb, ssb + (size_t)2 * T * 16, nullptr};
#endif
                pg8::gemm_phase(lds, g, S, E);
            }
            SEAM(pb + 8);
        }
    }
    if (IN(17)) { PHASE_PTRS
        if (tid < 8) lctl[tid] = 0u;
        __syncthreads();
        const float* nf_ = a.in[I_NORM_FFN] + DM;
        CvtCtx cx; cx.gw = gw; cx.ngw = ngw; cx.base = 0; cx.lane = lane; cx.scr = (LAS float*)(lds + wid * LDS_WSCR);
#define MOE_CVT13(e_) do { unsigned char* w13_8 = (unsigned char*)moe_w13 + (size_t)(e_) * 2 * EDIM * DM; \
            cvt_job8(cx, a.in[I_MOE_W1] + (size_t)(e_) * DM * EDIM, EDIM, DM, 0, EDIM, nf_, 32.0f, w13_8, 0, 256); cvt_job8(cx, a.in[I_MOE_W3] + (size_t)(e_) * DM * EDIM, EDIM, DM, 0, EDIM, nf_, 32.0f, w13_8, 128, 256); } while (0)
        for (int e = 0; e < NEXP; ++e) { unsigned char* w2_8 = (unsigned char*)moe_w13 + (size_t)NEXP * 2 * EDIM * DM + (size_t)e * DM * EDIM;
            cvt_job8(cx, a.in[I_MOE_W2] + (size_t)e * EDIM * DM, DM, EDIM, 0, DM, nullptr, 64.0f, w2_8, 0, 128); }
        for (int e = 0; e < 2; ++e) MOE_CVT13(e);
        if (IN(16)) SPLIT_WAIT(0);
        const float* nf = a.in[I_NORM_FFN] + DM; const float* wr = a.in[I_MOE_ROUTER];
        for (int m = gw; m < T; m += ngw) { const f32x4* xr = (const f32x4*)(a_out + (size_t)m * DM) + lane; f32x4 v[4]; float s = 0.f;
#pragma unroll
            for (int j = 0; j < 4; ++j) { v[j] = xr[64 * j]; s += (v[j][0] * v[j][0] + v[j][1] * v[j][1]) + (v[j][2] * v[j][2] + v[j][3] * v[j][3]); }
            const float rs = rsqrtf(wave_sum(s) * (1.0f / DM) + NORM_EPS);
            float lg[8];
#pragma unroll
            for (int e = 0; e < 8; ++e) lg[e] = 0.f;
#pragma unroll
            for (int j = 0; j < 4; ++j) { const int k0 = 4 * (lane + 64 * j); const f32x4 gn = *(const f32x4*)(nf + k0);
#pragma unroll
                for (int q = 0; q < 4; ++q) { const float hf = v[j][q] * rs * gn[q]; const f32x4 w0 = *(const f32x4*)(wr + (size_t)(k0 + q) * 8), w1 = *(const f32x4*)(wr + (size_t)(k0 + q) * 8 + 4);
                    lg[0] += hf * w0[0]; lg[1] += hf * w0[1]; lg[2] += hf * w0[2]; lg[3] += hf * w0[3]; lg[4] += hf * w1[0]; lg[5] += hf * w1[1]; lg[6] += hf * w1[2]; lg[7] += hf * w1[3]; } }
#pragma unroll
            for (int e = 0; e < 8; ++e) lg[e] = wave_sum(lg[e]);
            int e0 = 0; float v0 = lg[0];
#pragma unroll
            for (int e = 1; e < 8; ++e) if (lg[e] > v0) { v0 = lg[e]; e0 = e; }
            int e1 = -1; float v1 = -3.0e38f;
#pragma unroll
            for (int e = 0; e < 8; ++e) if (e != e0 && lg[e] > v1) { v1 = lg[e]; e1 = e; }
            if (e1 < 0) { e1 = (e0 == 0) ? 1 : 0; v1 = v0; }
            const float g0 = 1.0f / (1.0f + __expf(v1 - v0));
            if (lane == 0) { tok_e[2 * m] = e0; tok_e[2 * m + 1] = e1; tok_g[2 * m] = g0; tok_g[2 * m + 1] = 1.0f - g0; tok_rs[m] = rs;
                __hip_atomic_fetch_add(lctl + e0, 1u, __ATOMIC_RELAXED, __HIP_MEMORY_SCOPE_WORKGROUP); __hip_atomic_fetch_add(lctl + e1, 1u, __ATOMIC_RELAXED, __HIP_MEMORY_SCOPE_WORKGROUP); } }
        __syncthreads();
        if (tid < 8) atomicAdd(ctl + CW_MOECNT + tid, lctl[tid]);
        if (IN(18)) SPLIT_ARRIVE(1);
        for (int e = 2; e < NEXP; ++e) MOE_CVT13(e);
#undef MOE_CVT13
    }
    if (IN(17) && IN(18)) SPLIT_WAIT(1);

    if (IN(18)) { PHASE_PTRS
        unsigned cnt[8]; int base[8];
        { int acc = 0;
#pragma unroll
          for (int e = 0; e < 8; ++e) { cnt[e] = (unsigned)__builtin_amdgcn_readfirstlane((int)__hip_atomic_load(ctl + CW_MOECNT + e, __ATOMIC_RELAXED, __HIP_MEMORY_SCOPE_AGENT)); base[e] = acc; acc += (int)((cnt[e] + 255u) & ~255u); } }
        LAS unsigned* lcnt = lctl; LAS int* lstart = (LAS int*)(lctl + 8); LAS int* pslot = (LAS int*)(lctl + 16);
        for (int tgp = bx; tgp < T / 64; tgp += G) {
            if (tid < 8) lcnt[tid] = 0u;
            __syncthreads();
            int e0 = 0, e1 = 0, r0 = 0, r1 = 0; const int tok = tgp * 64 + tid;
            if (tid < 64) { e0 = tok_e[2 * tok]; e1 = tok_e[2 * tok + 1]; r0 = (int)__hip_atomic_fetch_add(lcnt + e0, 1u, __ATOMIC_RELAXED, __HIP_MEMORY_SCOPE_WORKGROUP); r1 = (int)__hip_atomic_fetch_add(lcnt + e1, 1u, __ATOMIC_RELAXED, __HIP_MEMORY_SCOPE_WORKGROUP); }
            __syncthreads();
            if (tid < 8) { int bsel = 0;
#pragma unroll
                for (int e = 0; e < 8; ++e) bsel = (tid == e) ? base[e] : bsel;
                lstart[tid] = bsel + (int)atomicAdd(ctl + CW_MOECUR + tid, lcnt[tid]); }
            __syncthreads();
            if (tid < 64) { const int s0 = lstart[e0] + r0, s1 = lstart[e1] + r1; pslot[2 * tid] = s0; pslot[2 * tid + 1] = s1;
                { int enc0 = s0, enc1 = s1;
#pragma unroll
                  for (int e = 0; e < 8; ++e) { const int fullr = (int)(cnt[e] & ~255u); int pi = 0;
#pragma unroll
                      for (int q = 0; q < 8; ++q) pi += (q < e && (cnt[q] & 255u)) ? 1 : 0;
                      if (e0 == e && s0 - base[e] >= fullr) enc0 = -(1 + pi * 256 + (s0 - base[e] - fullr));
                      if (e1 == e && s1 - base[e] >= fullr) enc1 = -(1 + pi * 256 + (s1 - base[e] - fullr)); }
                  tok_slot[2 * tok] = enc0; tok_slot[2 * tok + 1] = enc1; }
                const float rs = tok_rs[tok];
                row_tok[s0] = tok; row_tok[s1] = tok; row_gate[s0] = tok_g[2 * tok]; row_gate[s1] = tok_g[2 * tok + 1]; row_rs[s0] = rs; row_rs[s1] = rs; }
            __syncthreads();
            { u32x4 sv[8][2];
#pragma unroll
              for (int q = 0; q < 8; ++q) { const u32x4* src = (const u32x4*)(xb + (size_t)(tgp * 64 + wid * 8 + q) * DM) + 2 * lane; sv[q][0] = src[0]; sv[q][1] = src[1]; }
#pragma unroll
              for (int q = 0; q < 8; ++q) { const int tl = wid * 8 + q;
                f32x4 v0, v1, v2, v3; unpack8(sv[q][0], v0, v1); unpack8(sv[q][1], v2, v3); u32x4 w8; int t;
                t = 0; t = __builtin_amdgcn_cvt_pk_fp8_f32(v0[0], v0[1], t, false); t = __builtin_amdgcn_cvt_pk_fp8_f32(v0[2], v0[3], t, true); w8.x = (unsigned)t;
                t = 0; t = __builtin_amdgcn_cvt_pk_fp8_f32(v1[0], v1[1], t, false); t = __builtin_amdgcn_cvt_pk_fp8_f32(v1[2], v1[3], t, true); w8.y = (unsigned)t;
                t = 0; t = __builtin_amdgcn_cvt_pk_fp8_f32(v2[0], v2[1], t, false); t = __builtin_amdgcn_cvt_pk_fp8_f32(v2[2], v2[3], t, true); w8.z = (unsigned)t;
                t = 0; t = __builtin_amdgcn_cvt_pk_fp8_f32(v3[0], v3[1], t, false); t = __builtin_amdgcn_cvt_pk_fp8_f32(v3[2], v3[3], t, true); w8.w = (unsigned)t;
#pragma unroll
                for (int k = 0; k < 2; ++k) *((u32x4*)((unsigned char*)xg + (size_t)pslot[2 * tl + k] * DM) + lane) = w8; } }
            __syncthreads();
        }
        for (int idx = gw; idx < 8 * 256; idx += ngw) { const int e = idx >> 8, r = idx & 255; unsigned ce = 0; int be = 0;
#pragma unroll
            for (int q = 0; q < 8; ++q) { ce = (e == q) ? cnt[q] : ce; be = (e == q) ? base[q] : be; }
            const int rem = (int)(ce & 255u);
            if (rem != 0 && r >= rem) { const int slot = be + (int)(ce & ~255u) + r; u32x4 zz = {0u, 0u, 0u, 0u}; *((u32x4*)((unsigned char*)xg + (size_t)slot * DM) + lane) = zz;
                if (lane == 0) { row_tok[slot] = -1; row_gate[slot] = 0.f; row_rs[slot] = 0.f; } } }
    }
    SEAM(18);
    if (IN(19)) { PHASE_PTRS
        unsigned cnt[8];
#pragma unroll
        for (int e = 0; e < 8; ++e) cnt[e] = (unsigned)__builtin_amdgcn_readfirstlane((int)__hip_atomic_load(ctl + CW_MOECNT + e, __ATOMIC_RELAXED, __HIP_MEMORY_SCOPE_AGENT));
        pg8::Gemm g{DM / 2, DM / 2, DM / 2}; MoeOrder S; S.init(xg, DM / 2, moe_w13, DM / 2, (size_t)2 * EDIM * DM, 2 * EDIM / 256, cnt, G, bx);
        EpiSwiglu<true> E{act, EDIM, row_rs};
        pg8::gemm_phase(lds, g, S, E);
    }
    SEAM(19);
    if (IN(20)) { PHASE_PTRS
        unsigned cnt[8];
#pragma unroll
        for (int e = 0; e < 8; ++e) cnt[e] = (unsigned)__builtin_amdgcn_readfirstlane((int)__hip_atomic_load(ctl + CW_MOECNT + e, __ATOMIC_RELAXED, __HIP_MEMORY_SCOPE_AGENT));
        pg8::Gemm g{EDIM / 2, EDIM / 2, EDIM / 2}; MoeDownOrder S; S.init(act, EDIM / 2, (unsigned char*)moe_w13 + (size_t)NEXP * 2 * EDIM * DM, EDIM / 2, (size_t)DM * EDIM, cnt, G, bx);
        EpiMoeDownSplit E{ybuf, ypart, row_gate};
        pg8::gemm_phase(lds, g, S, E);
    }
    SEAM(20);
    if (IN(21)) { PHASE_PTRS
        int ns0 = 0, ns1 = 0; if (gw < T) { ns0 = tok_slot[2 * gw]; ns1 = tok_slot[2 * gw + 1]; }
        for (int m = gw; m < T; m += ngw) { const int s0 = __builtin_amdgcn_readfirstlane(ns0), s1 = __builtin_amdgcn_readfirstlane(ns1); f32x4* xr = (f32x4*)(a_out + (size_t)m * DM) + lane;
            { const int mn = (m + ngw < T) ? m + ngw : m; ns0 = tok_slot[2 * mn]; ns1 = tok_slot[2 * mn + 1]; }
            f32x4 v[4]; u32x2 ya[4], yb[4];
            const u32x2* y0 = (const u32x2*)((s0 >= 0 ? ybuf + (size_t)s0 * DM : ypart + (size_t)(-1 - s0) * DM)) + lane;
            const u32x2* y1 = (const u32x2*)((s1 >= 0 ? ybuf + (size_t)s1 * DM : ypart + (size_t)(-1 - s1) * DM)) + lane;
#pragma unroll
            for (int j = 0; j < 4; ++j) { v[j] = xr[64 * j]; ya[j] = y0[64 * j]; yb[j] = y1[64 * j]; }
#pragma unroll
            for (int j = 0; j < 4; ++j) { v[j][0] += lo2f(ya[j].x) + lo2f(yb[j].x); v[j][1] += hi2f(ya[j].x) + hi2f(yb[j].x); v[j][2] += lo2f(ya[j].y) + lo2f(yb[j].y); v[j][3] += hi2f(ya[j].y) + hi2f(yb[j].y); }
#pragma unroll
            for (int k = 0; k < 2; ++k) { const int sk = k ? s1 : s0;
                if (sk < 0) { const int pr = -1 - sk;
#pragma unroll 1
                    for (int q = 1; q < MD_KSPLIT; ++q) { const u32x2* yq = (const u32x2*)(ypart + ((size_t)q * (8 * 256) + pr) * DM) + lane;
#pragma unroll
                        for (int j = 0; j < 4; ++j) { const u32x2 p = yq[64 * j]; v[j][0] += lo2f(p.x); v[j][1] += hi2f(p.x); v[j][2] += lo2f(p.y); v[j][3] += hi2f(p.y); } } } }
#pragma unroll
            for (int j = 0; j < 4; ++j) xr[64 * j] = v[j]; }
    }
#undef IN
#undef SEAM
#undef GRID_BAR
#undef ss_mix
#undef ss_ffn
}
template <int LO, int HI> __global__ void __launch_bounds__(NTHREADS, 2) mk_fwd(Args a) { mk_body<LO, HI>(a); }

template <int PH> static void set_attr(bool& ok) { if constexpr (PH < NPH) { ok = ok && (hipFuncSetAttribute((const void*)mk_fwd<PH, PH + 1>, hipFuncAttributeMaxDynamicSharedMemorySize, LDS_TOTAL) == hipSuccess); set_attr<PH + 1>(ok); } }
template <int PH> static void launch_phases(const Args& a, int grid, hipStream_t stream) { if constexpr (PH < NPH) { hipLaunchKernelGGL((mk_fwd<PH, PH + 1>), dim3(grid), dim3(NTHREADS), LDS_TOTAL, stream, a); launch_phases<PH + 1>(a, grid, stream); } }
extern "C" void kernel_launch(void* const* d_in, const int* in_sizes, int n_in, void* d_out, int out_size, void* d_ws, size_t ws_size, hipStream_t stream) {
    static int grid = 0;
    if (!grid) {
        if (n_in != N_IN || out_size != T * DM || ws_size < WS_END) { fprintf(stderr, "kernel_launch: unexpected problem: n_in %d out %d ws %zu (need %zu)\n", n_in, out_size, ws_size, (size_t)WS_END); grid = -1; return; }
        int dev = 0, cus = 0, per_cu = 0;
        (void)hipGetDevice(&dev); (void)hipDeviceGetAttribute(&cus, hipDeviceAttributeMultiprocessorCount, dev);
#if MK_PER_PHASE
        { bool ok = true; set_attr<0>(ok); if (!ok) { fprintf(stderr, "kernel_launch: hipFuncSetAttribute failed\n"); grid = -1; return; } per_cu = 1; }
#else
        if (hipFuncSetAttribute((const void*)mk_fwd<0, NPH>, hipFuncAttributeMaxDynamicSharedMemorySize, LDS_TOTAL) != hipSuccess) { fprintf(stderr, "kernel_launch: hipFuncSetAttribute failed\n"); grid = -1; return; }
        if (hipOccupancyMaxActiveBlocksPerMultiprocessor(&per_cu, (const void*)mk_fwd<0, NPH>, NTHREADS, LDS_TOTAL) != hipSuccess || per_cu < 1) { fprintf(stderr, "kernel_launch: occupancy query failed (%d)\n", per_cu); grid = -1; return; }
#endif
        grid = cus;
    }
    if (grid <= 0) return;
    (void)hipMemsetAsync((char*)d_ws + WS_CTL, 0, 32768, stream);
    Args a{};
    for (int i = 0; i < N_IN; ++i) a.in[i] = (const float*)d_in[i];
    a.out = (float*)d_out; a.ws = (unsigned char*)d_ws;
#if MK_PER_PHASE
    launch_phases<0>(a, grid, stream);
#else
    void* args[] = {&a};
    hipError_t e = hipLaunchCooperativeKernel((const void*)mk_fwd<0, NPH>, dim3(grid), dim3(NTHREADS), args, LDS_TOTAL, stream);
    if (e != hipSuccess) fprintf(stderr, "cooperative launch failed: %s (grid %d)\n", hipGetErrorString(e), grid);
#endif
}
```

```cpp
#include <hip/hip_runtime.h>
#include <hip/hip_cooperative_groups.h>
#include <cstdio>
#include <cstdint>
namespace cg = cooperative_groups;

#ifndef FFN_FP8
#define FFN_FP8 0
#endif
#ifndef MK_PER_PHASE
#define MK_PER_PHASE 0
#endif

#define LAS __attribute__((address_space(3)))
typedef unsigned short bf16;
typedef short bf16x8 __attribute__((ext_vector_type(8)));
typedef float f32x4 __attribute__((ext_vector_type(4)));
typedef float f32x2 __attribute__((ext_vector_type(2)));
typedef unsigned u32x4 __attribute__((ext_vector_type(4)));
typedef unsigned u32x2 __attribute__((ext_vector_type(2)));

constexpr int BATCH = 8, SEQ = 2048, DM = 1024, T = BATCH * SEQ;
constexpr int CHUNK = 64, NCH = SEQ / CHUNK;
constexpr int IN_COLS = 10552, MIXC = 6456;
constexpr int ZC = 6656;
constexpr int C_RWKV = 0, C_SSM = 1824, C_ATT = 3368, C_GLA = 4904, C_HV = 6456;
constexpr int FFN = 2816, NEXP = 8, EDIM = 3584;
constexpr int MOE_ROWS = 2 * T + NEXP * 256;
constexpr float NORM_EPS = 1e-6f;

constexpr size_t MiB = 1u << 20;
constexpr size_t WS_CTL = 0;
constexpr size_t CTL_BYTES = 1 * MiB;
constexpr size_t WS_SMALL = WS_CTL + CTL_BYTES;
constexpr size_t SM_SS = 0;
constexpr size_t SM_MSSQ = SM_SS + 3 * (size_t)T * 16 * 4;
constexpr size_t SM_TOKE = SM_MSSQ + (size_t)T * 8 * 4;
constexpr size_t SM_TOKG = SM_TOKE + (size_t)T * 2 * 4;
constexpr size_t SM_TOKRS = SM_TOKG + (size_t)T * 2 * 4;
constexpr size_t SM_TOKSLOT = SM_TOKRS + (size_t)T * 4;
constexpr size_t SM_ROWTOK = SM_TOKSLOT + (size_t)T * 2 * 4;
constexpr size_t SM_ROWGATE = SM_ROWTOK + (size_t)MOE_ROWS * 4;
constexpr size_t SM_ROWRS = SM_ROWGATE + (size_t)MOE_ROWS * 4;
constexpr size_t SM_END = SM_ROWRS + (size_t)MOE_ROWS * 4;
static_assert(SM_END <= 6 * MiB, "small region");
constexpr size_t WS_XB = WS_SMALL + 6 * MiB;
constexpr size_t WS_X = WS_XB + (size_t)T * DM * 2;
constexpr size_t X_VFIRST = 0;
constexpr size_t X_MIXED = X_VFIRST + (size_t)T * 512 * 2;
constexpr size_t X_O = X_MIXED + (size_t)T * DM * 2;
constexpr size_t X_W = X_O + (size_t)T * 2048 * 2;
constexpr size_t W_IN = 0;
constexpr size_t W_G = W_IN + 2 * (size_t)ZC * DM * 2;
constexpr size_t W_B = W_G + 2 * (size_t)4096 * DM * 2;
constexpr size_t W_O = W_B + 2 * 4 * (size_t)DM * 512 * 2;
constexpr size_t W_13 = W_O + 2 * (size_t)DM * DM * 2;
constexpr size_t W_2 = W_13 + (size_t)2 * FFN * DM * 2;
constexpr size_t W_END = W_2 + (size_t)DM * FFN * 2;
constexpr size_t X_BYTES = X_W + W_END;
constexpr size_t MOE_W13 = 0;
constexpr size_t MOE_W2 = MOE_W13 + (size_t)NEXP * 2 * EDIM * DM * 2;
constexpr size_t MOE_WEND = MOE_W2 + (size_t)NEXP * DM * EDIM * 2;
static_assert(MOE_WEND <= X_BYTES, "MoE weights must fit the X region");
constexpr size_t WS_Z = WS_X + X_BYTES;
constexpr size_t Z_BYTES = (size_t)MOE_ROWS * EDIM * 2;
static_assert((size_t)T * ZC * 2 <= Z_BYTES, "z fits");
constexpr size_t WS_XG = WS_Z + Z_BYTES;
constexpr size_t XG_BYTES = (size_t)MOE_ROWS * DM * 2;
static_assert(4 * (size_t)T * 512 * 2 <= XG_BYTES, "rwkv arrays fit");
constexpr size_t WS_BCV = WS_XG + (size_t)4 * BATCH * (SEQ / 32) * 29184;
constexpr size_t WS_GEND = WS_BCV + (size_t)T * 512 * 2;
constexpr size_t WS_END = (WS_XG + XG_BYTES > WS_GEND + (size_t)BATCH * 4 * NCH * 64 * 4) ? WS_XG + XG_BYTES : WS_GEND + (size_t)BATCH * 4 * NCH * 64 * 4;

constexpr int CW_MOECNT = 64;
constexpr int CW_MOECUR = 128;
constexpr int CW_ATTQ = 192;
constexpr int CW_SPLIT = 256;
constexpr int CW_BAR = 1024;

__device__ __forceinline__ float bf2f(bf16 v) { return __builtin_bit_cast(float, (unsigned)v << 16); }
typedef __bf16 bf16x2_hw __attribute__((ext_vector_type(2)));
__device__ __forceinline__ unsigned pk2(float lo, float hi) { const f32x2 v = {lo, hi}; return __builtin_bit_cast(unsigned, __builtin_convertvector(v, bf16x2_hw)); }
__device__ __forceinline__ unsigned f2bf(float f) { return pk2(f, 0.f) & 0xffffu; }
__device__ __forceinline__ float lo2f(unsigned w) { return __builtin_bit_cast(float, w << 16); }
__device__ __forceinline__ float hi2f(unsigned w) { return __builtin_bit_cast(float, w & 0xffff0000u); }
__device__ __forceinline__ float sigmoidf_(float x) { return __builtin_amdgcn_rcpf(1.0f + __expf(-x)); }
__device__ __forceinline__ float siluf_(float x) { return x * __builtin_amdgcn_rcpf(1.0f + __expf(-x)); }
__device__ __forceinline__ float tanhf_(float x) { return 2.0f * __builtin_amdgcn_rcpf(1.0f + __expf(-2.0f * x)) - 1.0f; }
__device__ __forceinline__ float softplusf_(float x) { return x > 20.f ? x : __logf(1.0f + __expf(x)); }
template <int CTRL, int ROWMASK = 0xF, bool BOUND = true> __device__ __forceinline__ float dpp_f(float x) { return __builtin_bit_cast(float, __builtin_amdgcn_update_dpp(0, __builtin_bit_cast(int, x), CTRL, ROWMASK, 0xF, BOUND)); }
__device__ __forceinline__ float red8_sum(float x) { x += dpp_f<0xB1>(x); x += dpp_f<0x4E>(x); x += dpp_f<0x141>(x); return x; }
__device__ __forceinline__ float red16_sum(float x) { x = red8_sum(x); x += dpp_f<0x140>(x); return x; }
__device__ __forceinline__ float scan16(float x) { x += dpp_f<0x111>(x); x += dpp_f<0x112>(x); x += dpp_f<0x114>(x); x += dpp_f<0x118>(x); return x; }
__device__ __forceinline__ float scan32(float x) { x = scan16(x); x += dpp_f<0x142, 0xA, false>(x); return x; }
__device__ __forceinline__ float scan64(float x) { x = scan32(x); x += dpp_f<0x143, 0xC, false>(x); return x; }
__device__ __forceinline__ float xrows_sum(float v) { const int x = __builtin_bit_cast(int, v); const auto a = __builtin_amdgcn_permlane16_swap(x, x, false, false); v = __builtin_bit_cast(float, (int)a[0]) + __builtin_bit_cast(float, (int)a[1]);
    const int y = __builtin_bit_cast(int, v); const auto b = __builtin_amdgcn_permlane32_swap(y, y, false, false); return __builtin_bit_cast(float, (int)b[0]) + __builtin_bit_cast(float, (int)b[1]); }
__device__ __forceinline__ float xrows_max(float v) { const int x = __builtin_bit_cast(int, v); const auto a = __builtin_amdgcn_permlane16_swap(x, x, false, false); v = fmaxf(__builtin_bit_cast(float, (int)a[0]), __builtin_bit_cast(float, (int)a[1]));
    const int y = __builtin_bit_cast(int, v); const auto b = __builtin_amdgcn_permlane32_swap(y, y, false, false); return fmaxf(__builtin_bit_cast(float, (int)b[0]), __builtin_bit_cast(float, (int)b[1])); }
__device__ __forceinline__ float wave_sum(float v) { return xrows_sum(red16_sum(v)); }
__device__ __forceinline__ int opq_v(int x) { asm volatile("" : "+v"(x)); return x; }
__device__ __forceinline__ int opq_s(int x) { asm volatile("" : "+s"(x)); return x; }
__device__ __forceinline__ float rdlane(float v, int l) { return __builtin_bit_cast(float, __builtin_amdgcn_readlane(__builtin_bit_cast(int, v), l)); }

namespace pg8 {
constexpr int BM = 256, BK = 64, HALF = 128, HTB = HALF * BK * 2, STAGE_BYTES = 8 * HTB, NXCD = 8, WGM = 8;
__host__ __device__ __forceinline__ int lds_byte(int r, int c) { const int st = (r >> 4) * 2 + (c >> 5), rr = r & 15, cc = c & 31, ob = rr * 64 + cc * 2; return st * 1024 + (ob ^ (((ob >> 9) & 1) << 5)); }
__host__ __device__ __forceinline__ void stage_rc(int b, int& R, int& C) { const int st = b / 1024, sb = b % 1024, swz = sb ^ (((sb >> 9) & 1) << 5); R = (st >> 1) * 16 + swz / 64; C = (st & 1) * 32 + (swz % 64) / 2; }
__host__ __device__ __forceinline__ int perm32(int rho) { const int n = rho >> 4, i = rho & 15; return 8 * (i >> 2) + 4 * n + (i & 3); }

typedef int v4i __attribute__((ext_vector_type(4)));
typedef int v8i __attribute__((ext_vector_type(8)));
struct Unit { int pm, pn, e, kq; };
struct Gemm { int lda, ldb, K; };

struct StaticOrder {
    static constexpr bool VARNT = false;
    const char* A; const char* Bt; size_t tstepA, tstepB;
    int nM, nN, nwg, G, c;
    __device__ __forceinline__ void init(const void* A_, const void* Bt_, int lda, int ldb, int M, int N, int G_, int c_) { A = (const char*)A_; Bt = (const char*)Bt_; tstepA = (size_t)BM * lda * 2; tstepB = (size_t)BM * ldb * 2; nM = M / BM; nN = N / BM; nwg = nM * nN; G = G_; c = c_; }
    __device__ __forceinline__ bool next(int i, Unit& u) const {
        const long L = (long)i * G + c; if (L >= nwg) return false;
        int wgid = (int)L; { const int q = nwg / NXCD, r = nwg % NXCD, xcd = wgid % NXCD, off = wgid / NXCD; wgid = (xcd < r ? xcd * (q + 1) : r * (q + 1) + (xcd - r) * q) + off; }
        const int nig = WGM * nN, gid = wgid / nig, fm = gid * WGM, gsz = (nM - fm) < WGM ? (nM - fm) : WGM;
        u.pm = fm + ((wgid % nig) % gsz); u.pn = (wgid % nig) / gsz; u.e = 0; return true;
    }
    __device__ __forceinline__ const char* a_ptr(const Unit& u) const { return A + (size_t)u.pm * tstepA; }
    __device__ __forceinline__ const char* b_ptr(const Unit& u) const { return Bt + (size_t)u.pn * tstepB; }
};

typedef __bf16 bf16x2_t __attribute__((ext_vector_type(2)));
__device__ __forceinline__ unsigned cvt_pk_bf16(float lo, float hi) { const f32x2 v = {lo, hi}; return __builtin_bit_cast(unsigned, __builtin_convertvector(v, bf16x2_t)); }

template <class Epi, class Sched>
__device__ __forceinline__ void gemm_phase(LAS unsigned char* lds, const Gemm g, const Sched& S, const Epi& E) {
    const int tid = opq_v((int)threadIdx.x), wid = __builtin_amdgcn_readfirstlane(tid >> 6), lane = tid & 63, wr = wid >> 2, wc = wid & 3, fr = lane & 15, fq = lane >> 4;
    const int nt = opq_s(g.K / BK);
    unsigned voffA[2], voffB[2];
#pragma unroll
    for (int i = 0; i < 2; ++i) { int R, C; stage_rc(tid * 16 + i * 8192, R, C); const int Rb = Epi::PERM ? ((R & ~31) + perm32(R & 31)) : R;
        voffA[i] = (unsigned)(R * g.lda + C) * 2u; voffB[i] = (unsigned)(Rb * g.ldb + C) * 2u; }
    const size_t kstep = (size_t)(BK * 2);
    const size_t hstepA = (size_t)HALF * g.lda * 2, hstepB = (size_t)HALF * g.ldb * 2;
    const unsigned ldsw = (unsigned)wid * 1024u;
    const int aoff = lds_byte(wr * 64 + fr, fq * 8), boff = lds_byte(wc * 32 + fr, fq * 8);
#define PG8_SA(b, h) (((b) * 2 + (h)) * HTB)
#define PG8_SB(b, h) ((4 + (b) * 2 + (h)) * HTB)
#define PG8_STAGE(bufoff, gbase, voff) do { _Pragma("unroll") for (int _i = 0; _i < 2; ++_i) \
        __builtin_amdgcn_global_load_lds((const unsigned*)((const char*)(gbase) + (voff)[_i]), (LAS unsigned*)(lds + (bufoff) + ldsw + _i * 8192), 16, 0, 0); } while (0)
#define PG8_LDA(dst, b, h) do { _Pragma("unroll") for (int m = 0; m < 4; ++m) { if constexpr (Epi::F8) { const v4i lo_ = *(const LAS v4i*)(lds + PG8_SA(b, h) + aoff + m * 2048), hi_ = *(const LAS v4i*)(lds + PG8_SA(b, h) + aoff + m * 2048 + 1024); \
            dst##8[m] = __builtin_shufflevector(lo_, hi_, 0, 1, 2, 3, 4, 5, 6, 7); } else { _Pragma("unroll") for (int k = 0; k < 2; ++k) dst[m][k] = *(const LAS bf16x8*)(lds + PG8_SA(b, h) + aoff + m * 2048 + k * 1024); } } } while (0)
#define PG8_LDB(dst, b, h) do { _Pragma("unroll") for (int n = 0; n < 2; ++n) { if constexpr (Epi::F8) { const v4i lo_ = *(const LAS v4i*)(lds + PG8_SB(b, h) + boff + n * 2048), hi_ = *(const LAS v4i*)(lds + PG8_SB(b, h) + boff + n * 2048 + 1024); \
            dst##8[n] = __builtin_shufflevector(lo_, hi_, 0, 1, 2, 3, 4, 5, 6, 7); } else { _Pragma("unroll") for (int k = 0; k < 2; ++k) dst[n][k] = *(const LAS bf16x8*)(lds + PG8_SB(b, h) + boff + n * 2048 + k * 1024); } } } while (0)
#define PG8_MMA(ai, bj, At, Bt) do { __builtin_amdgcn_s_setprio(1); _Pragma("unroll") for (int m = 0; m < 4; ++m) _Pragma("unroll") for (int n = 0; n < 2; ++n) { \
        if constexpr (Epi::F8) asm volatile("v_mfma_scale_f32_16x16x128_f8f6f4 %0, %1, %2, %0, %3, %3 op_sel_hi:[0,0,0]" : "+v"(acc[ai][bj][m][n]) : "v"(Bt##8[n]), "v"(At##8[m]), "v"(f8scale));   \
        else { _Pragma("unroll") for (int k = 0; k < 2; ++k) acc[ai][bj][m][n] = __builtin_amdgcn_mfma_f32_16x16x32_bf16(Bt[n][k], At[m][k], acc[ai][bj][m][n], 0, 0, 0); } } \
        __builtin_amdgcn_s_setprio(0); } while (0)
#define PG8_WAIT_V(n) asm volatile("s_waitcnt vmcnt(" #n ")" ::: "memory")
#define PG8_WAIT_L(n) asm volatile("s_waitcnt lgkmcnt(" #n ")" ::: "memory")
#define PG8_BAR __builtin_amdgcn_s_barrier()
#define PG8_SCHED __builtin_amdgcn_sched_barrier(0)
    Unit cur, nxt; int ui = 0;
    if (!S.next(0, cur)) return;
    f32x4 acc[2][2][4][2];
#pragma unroll
    for (int a = 0; a < 2; ++a)
#pragma unroll
        for (int b = 0; b < 2; ++b)
#pragma unroll
            for (int m = 0; m < 4; ++m)
#pragma unroll
                for (int n = 0; n < 2; ++n) acc[a][b][m][n] = (f32x4){0.f, 0.f, 0.f, 0.f};
    const int f8scale = opq_v(0x7f7f7f7f);
    bf16x8 At[4][2], B0[2][2], B1[2][2]; v8i At8[4], B08[2], B18[2];
    const char* cA = S.a_ptr(cur); const char* cB = S.b_ptr(cur);
    PG8_STAGE(PG8_SB(0, 0), cB, voffB); PG8_STAGE(PG8_SB(0, 1), cB + hstepB, voffB); PG8_STAGE(PG8_SA(0, 0), cA, voffA); PG8_STAGE(PG8_SA(0, 1), cA + hstepA, voffA);
    if (wr == 1) PG8_BAR;
    PG8_WAIT_V(2); PG8_BAR;
    PG8_STAGE(PG8_SB(1, 0), cB + kstep, voffB); PG8_STAGE(PG8_SA(1, 0), cA + kstep, voffA); PG8_STAGE(PG8_SB(1, 1), cB + hstepB + kstep, voffB);
    PG8_WAIT_V(6); PG8_BAR;
    for (;;) {
        const bool has_next = S.next(ui + 1, nxt);
        int ntc = nt; if constexpr (Sched::VARNT) ntc = opq_s(S.nt_of(cur));
        const char* nA = has_next ? S.a_ptr(nxt) : cA; const char* nB = has_next ? S.b_ptr(nxt) : cB;
#pragma unroll 1
        for (int t = 0; t < ntc; t += 2) {
            const bool last = (t == ntc - 2);
            const char* a1 = cA + (size_t)(t + 1) * kstep;
            const char* a2 = last ? nA : cA + (size_t)(t + 2) * kstep; const char* b2 = last ? nB : cB + (size_t)(t + 2) * kstep;
            const char* a3 = a2 + kstep; const char* b3 = b2 + kstep;
            PG8_LDB(B0, 0, 0); PG8_LDB(B1, 0, 1); PG8_SCHED; PG8_LDA(At, 0, 0); PG8_STAGE(PG8_SA(1, 1), a1 + hstepA, voffA);
            PG8_WAIT_V(8); PG8_WAIT_L(0); PG8_BAR; PG8_MMA(0, 0, At, B0); PG8_MMA(0, 1, At, B1); PG8_BAR; PG8_SCHED;
            PG8_LDA(At, 0, 1); PG8_STAGE(PG8_SB(0, 0), b2, voffB); PG8_STAGE(PG8_SB(0, 1), b2 + hstepB, voffB); PG8_STAGE(PG8_SA(0, 0), a2, voffA);
            PG8_WAIT_V(8); PG8_WAIT_L(0); PG8_BAR; PG8_MMA(1, 0, At, B0); PG8_MMA(1, 1, At, B1); PG8_BAR; PG8_SCHED;
            PG8_LDB(B0, 1, 0); PG8_LDB(B1, 1, 1); PG8_SCHED; PG8_LDA(At, 1, 0); PG8_STAGE(PG8_SA(0, 1), a2 + hstepA, voffA);
            PG8_WAIT_V(8); PG8_WAIT_L(0); PG8_BAR; PG8_MMA(0, 0, At, B0); PG8_MMA(0, 1, At, B1); PG8_BAR; PG8_SCHED;
            PG8_LDA(At, 1, 1); PG8_STAGE(PG8_SB(1, 0), b3, voffB); PG8_STAGE(PG8_SB(1, 1), b3 + hstepB, voffB); PG8_STAGE(PG8_SA(1, 0), a3, voffA);
            PG8_WAIT_V(8); PG8_WAIT_L(0); PG8_BAR; PG8_MMA(1, 0, At, B0); PG8_MMA(1, 1, At, B1); PG8_BAR; PG8_SCHED;
        }
        if (wr == 0) PG8_BAR;
        if constexpr (Epi::F8) asm volatile("s_nop 15\n\ts_nop 15" ::: "memory");
        E(acc, cur, wr, wc, fr, fq);
        if (!has_next) break;
        if constexpr (!Epi::CHAIN) {
#pragma unroll
        for (int a = 0; a < 2; ++a)
#pragma unroll
            for (int b = 0; b < 2; ++b)
#pragma unroll
                for (int m = 0; m < 4; ++m)
#pragma unroll
                    for (int n = 0; n < 2; ++n) acc[a][b][m][n] = (f32x4){0.f, 0.f, 0.f, 0.f};
        }
        cur = nxt; cA = nA; cB = nB; ++ui;
        if (wr == 1) PG8_BAR;
    }
    PG8_WAIT_V(0);
    PG8_BAR;
#undef PG8_SA
#undef PG8_SB
#undef PG8_STAGE
#undef PG8_LDA
#undef PG8_LDB
#undef PG8_MMA
#undef PG8_WAIT_V
#undef PG8_WAIT_L
#undef PG8_BAR
#undef PG8_SCHED
}
}

using pg8::Unit;
__device__ __forceinline__ u32x4 pack8(f32x4 v0, f32x4 v1) { u32x4 w; w.x = pg8::cvt_pk_bf16(v0[0], v0[1]); w.y = pg8::cvt_pk_bf16(v0[2], v0[3]); w.z = pg8::cvt_pk_bf16(v1[0], v1[1]); w.w = pg8::cvt_pk_bf16(v1[2], v1[3]); return w; }
__device__ __forceinline__ f32x4 sig4(f32x4 v) { return (f32x4){sigmoidf_(v[0]), sigmoidf_(v[1]), sigmoidf_(v[2]), sigmoidf_(v[3])}; }
__device__ __forceinline__ void unpack8(u32x4 w, f32x4& a, f32x4& b) { a = (f32x4){lo2f(w.x), hi2f(w.x), lo2f(w.y), hi2f(w.y)}; b = (f32x4){lo2f(w.z), hi2f(w.z), lo2f(w.w), hi2f(w.w)}; }

__device__ __forceinline__ void rs8_from_parts(const float* ss, int row0, int fq, float (&rs)[2][4]) {
    f32x4 p[2][4];
#pragma unroll
    for (int ai = 0; ai < 2; ++ai)
#pragma unroll
        for (int m = 0; m < 4; ++m) p[ai][m] = *(const f32x4*)(ss + (size_t)(row0 + ai * 128 + m * 16) * 16 + 4 * fq);
#pragma unroll
    for (int ai = 0; ai < 2; ++ai)
#pragma unroll
        for (int m = 0; m < 4; ++m) { float t = (p[ai][m][0] + p[ai][m][1]) + (p[ai][m][2] + p[ai][m][3]); t = xrows_sum(t); rs[ai][m] = __builtin_amdgcn_rsqf(t * (1.0f / DM) + NORM_EPS); }
}
template <int ACT> struct EpiScaleBf16 {
    static constexpr bool PERM = true, CHAIN = false, F8 = false;
    bf16* O; int ldc; const float* ss;
    __device__ __forceinline__ void operator()(f32x4 (&acc)[2][2][4][2], const Unit& u, int wr, int wc, int fr, int fq) const {
        const int row0 = u.pm * 256 + wr * 64 + fr, col0 = u.pn * 256 + wc * 32 + 8 * fq;
        float rs[2][4]; rs8_from_parts(ss, row0, fq, rs);
#pragma unroll
        for (int ai = 0; ai < 2; ++ai)
#pragma unroll
            for (int m = 0; m < 4; ++m) { const int row = row0 + ai * 128 + m * 16; const float s = rs[ai][m];
                bf16* rowp = O + (size_t)row * ldc + col0;
#pragma unroll
                for (int bj = 0; bj < 2; ++bj) { f32x4 v0 = acc[ai][bj][m][0] * s, v1 = acc[ai][bj][m][1] * s;
                    if (ACT == 1) { v0 = sig4(v0); v1 = sig4(v1); }
                    *(u32x4*)(rowp + bj * 128) = pack8(v0, v1); }
                asm volatile("" ::: "memory"); }
    }
};
struct EpiGateRatio {
    static constexpr bool PERM = true, CHAIN = false, F8 = false;
    bf16* O; const float* ss;
    __device__ __forceinline__ void operator()(const f32x4 (&acc)[2][2][4][2], const Unit& u, int wr, int wc, int fr, int fq) const {
        const int row0 = u.pm * 256 + wr * 64 + fr, c0 = u.pn * 64 + wc * 16 + 4 * fq;
        float rs[2][4]; rs8_from_parts(ss, row0, fq, rs);
#pragma unroll
        for (int ai = 0; ai < 2; ++ai)
#pragma unroll
            for (int m = 0; m < 4; ++m) { const int row = row0 + ai * 128 + m * 16; const float s = rs[ai][m];
                f32x4 g[4];
#pragma unroll
                for (int i = 0; i < 4; ++i) { g[i] = sig4(acc[ai][i >> 1][m][i & 1] * s);
#pragma unroll
                    for (int j = 0; j < 4; ++j) g[i][j] = fmaxf(g[i][j], 1e-30f); }
                bf16* rowp = O + (size_t)row * 4096 + c0;
#pragma unroll
                for (int i = 0; i < 4; ++i) { f32x4 r = g[i];
                    if (i < 3) {
#pragma unroll
                        for (int j = 0; j < 4; ++j) r[j] = g[i][j] * __builtin_amdgcn_rcpf(g[i + 1][j]); }
                    u32x2 w; w.x = pg8::cvt_pk_bf16(r[0], r[1]); w.y = pg8::cvt_pk_bf16(r[2], r[3]); *(u32x2*)(rowp + i * 1024) = w; }
                asm volatile("" ::: "memory"); }
    }
};
template <bool MOE, bool F8_ = MOE> struct EpiSwiglu {
    static constexpr bool PERM = true, CHAIN = false, F8 = F8_;
    bf16* O; int ldc; const float* rsrc;
    __device__ __forceinline__ void operator()(f32x4 (&acc)[2][2][4][2], const Unit& u, int wr, int wc, int fr, int fq) const {
        const int row0 = u.pm * 256 + wr * 64 + fr, col0 = u.pn * 128 + wc * 32 + 8 * fq;
        float rs[2][4];
        if (MOE) {
#pragma unroll
            for (int ai = 0; ai < 2; ++ai)
#pragma unroll
                for (int m = 0; m < 4; ++m) rs[ai][m] = rsrc[row0 + ai * 128 + m * 16]; }
        else rs8_from_parts(rsrc, row0, fq, rs);
        if (F8) {
#pragma unroll
            for (int ai = 0; ai < 2; ++ai)
#pragma unroll
                for (int m = 0; m < 4; ++m) rs[ai][m] *= (1.0f / 32.0f); }
#pragma unroll
        for (int ai = 0; ai < 2; ++ai)
#pragma unroll
            for (int m = 0; m < 4; ++m) { const int row = row0 + ai * 128 + m * 16; const float s = rs[ai][m];
                f32x4 o[2];
#pragma unroll
                for (int n = 0; n < 2; ++n) { const f32x4 a = acc[ai][0][m][n] * s, b = acc[ai][1][m][n] * s;
                    o[n] = (f32x4){siluf_(a[0]) * b[0], siluf_(a[1]) * b[1], siluf_(a[2]) * b[2], siluf_(a[3]) * b[3]}; }
                if constexpr (F8) { u32x2 w8; int t0_ = 0, t1_ = 0; t0_ = __builtin_amdgcn_cvt_pk_fp8_f32(o[0][0], o[0][1], t0_, false); t0_ = __builtin_amdgcn_cvt_pk_fp8_f32(o[0][2], o[0][3], t0_, true);
                    t1_ = __builtin_amdgcn_cvt_pk_fp8_f32(o[1][0], o[1][1], t1_, false); t1_ = __builtin_amdgcn_cvt_pk_fp8_f32(o[1][2], o[1][3], t1_, true); w8.x = (unsigned)t0_; w8.y = (unsigned)t1_;
                    *(u32x2*)((unsigned char*)O + (size_t)row * ldc + col0) = w8; }
                else *(u32x4*)(O + (size_t)row * ldc + col0) = pack8(o[0], o[1]);
                asm volatile("" ::: "memory"); }
    }
};
template <bool F8_ = false> struct EpiResid {
    static constexpr bool PERM = false, CHAIN = false, F8 = F8_;
    const float* xin; float* out; bf16* xb; float* ss; unsigned char* xb8;
    __device__ __forceinline__ void operator()(f32x4 (&acc)[2][2][4][2], const Unit& u, int wr, int wc, int fr, int fq) const {
        const int row0 = u.pm * 256 + wr * 64 + fr, col0 = u.pn * 256 + wc * 32 + 4 * fq;
#pragma unroll
        for (int ai = 0; ai < 2; ++ai)
#pragma unroll
            for (int m = 0; m < 4; ++m) { const int row = row0 + ai * 128 + m * 16; const size_t off = (size_t)row * DM + col0; float q = 0.f;
#pragma unroll
                for (int bj = 0; bj < 2; ++bj)
#pragma unroll
                    for (int n = 0; n < 2; ++n) { const f32x4 xi = *(const f32x4*)(xin + off + bj * 128 + n * 16); const f32x4 v = F8 ? xi + acc[ai][bj][m][n] * (1.0f / 64.0f) : xi + acc[ai][bj][m][n];
                        *(f32x4*)(out + off + bj * 128 + n * 16) = v; u32x2 w; w.x = pg8::cvt_pk_bf16(v[0], v[1]); w.y = pg8::cvt_pk_bf16(v[2], v[3]);
                        *(u32x2*)(xb + off + bj * 128 + n * 16) = w;
                        if (xb8) { int t8 = 0; t8 = __builtin_amdgcn_cvt_pk_fp8_f32(v[0], v[1], t8, false); t8 = __builtin_amdgcn_cvt_pk_fp8_f32(v[2], v[3], t8, true); *(int*)(xb8 + off + bj * 128 + n * 16) = t8; }
                        q += (v[0] * v[0] + v[1] * v[1]) + (v[2] * v[2] + v[3] * v[3]); }
                q = xrows_sum(q);
                if (fq == 0 && ss) ss[(size_t)row * 16 + u.pn * 4 + wc] = q;
                if (m & 1) asm volatile("" ::: "memory"); }
    }
};
struct EpiMix {
    static constexpr bool PERM = true, CHAIN = true, F8 = false;
    const bf16* gates; bf16* mixed;
    __device__ __forceinline__ void operator()(f32x4 (&acc)[2][2][4][2], const Unit& u, int wr, int wc, int fr, int fq) const {
        const int row0 = u.pm * 256 + wr * 64 + fr, col0 = u.pn * 256 + wc * 32 + 8 * fq; const int i = u.e;
#pragma unroll
        for (int ai = 0; ai < 2; ++ai)
#pragma unroll
            for (int m = 0; m < 4; ++m) { const int row = row0 + ai * 128 + m * 16;
#pragma unroll
                for (int bj = 0; bj < 2; ++bj) { const bf16* gp = gates + (size_t)row * 4096 + i * 1024 + col0 + bj * 128;
                    f32x4 r0, r1; unpack8(*(const u32x4*)gp, r0, r1);
                    if (i < 3) { acc[ai][bj][m][0] = acc[ai][bj][m][0] * r0; acc[ai][bj][m][1] = acc[ai][bj][m][1] * r1; }
                    else {
                        *(u32x4*)(mixed + (size_t)row * DM + col0 + bj * 128) = pack8(acc[ai][bj][m][0] * r0, acc[ai][bj][m][1] * r1);
                        acc[ai][bj][m][0] = (f32x4){0.f, 0.f, 0.f, 0.f}; acc[ai][bj][m][1] = (f32x4){0.f, 0.f, 0.f, 0.f};
                    } } }
    }
};
struct MixOrder {
    static constexpr bool VARNT = false;
    const char* O; const char* Wb; int G, c;
    __device__ __forceinline__ bool next(int i, Unit& u) const {
        const int grp = (i >> 2) * G + c; if (grp >= 256) return false;
        int wgid = grp; { const int xcd = wgid % 8, off = wgid / 8; wgid = xcd * 32 + off; }
        const int nig = 8 * 4, gid = wgid / nig; u.pm = gid * 8 + ((wgid % nig) % 8); u.pn = (wgid % nig) / 8; u.e = i & 3; return true;
    }
    __device__ __forceinline__ const char* a_ptr(const Unit& u) const { return O + ((size_t)u.pm * 256 * 2048 + (size_t)u.e * 512) * 2; }
    __device__ __forceinline__ const char* b_ptr(const Unit& u) const { return Wb + ((size_t)u.e * DM * 512 + (size_t)u.pn * 256 * 512) * 2; }
};
struct MoeOrder {
    static constexpr bool VARNT = false;
    const char* A; const char* Bt; size_t tstepA, tstepB, estepB; int nN, ntiles, G, c;
    int te0, te1, te2, te3, te4, te5, te6;
    __device__ __forceinline__ void init(const void* A_, int lda, const void* Bt_, int ldb, size_t estepB_, int nN_, const unsigned* cnt, int G_, int c_) {
        A = (const char*)A_; Bt = (const char*)Bt_; tstepA = (size_t)256 * lda * 2; tstepB = (size_t)256 * ldb * 2; estepB = estepB_; nN = nN_; G = G_; c = c_;
        int acc = 0; acc += (int)((cnt[0] + 255u) >> 8); te0 = acc; acc += (int)((cnt[1] + 255u) >> 8); te1 = acc; acc += (int)((cnt[2] + 255u) >> 8); te2 = acc; acc += (int)((cnt[3] + 255u) >> 8); te3 = acc;
        acc += (int)((cnt[4] + 255u) >> 8); te4 = acc; acc += (int)((cnt[5] + 255u) >> 8); te5 = acc; acc += (int)((cnt[6] + 255u) >> 8); te6 = acc; acc += (int)((cnt[7] + 255u) >> 8); ntiles = acc;
    }
    __device__ __forceinline__ bool next(int i, Unit& u) const {
        const long L = (long)i * G + c; if (L >= (long)ntiles * nN) return false;
        const int mt = (int)(L / nN); u.pm = mt; u.pn = (int)(L % nN);
        u.e = (mt >= te0) + (mt >= te1) + (mt >= te2) + (mt >= te3) + (mt >= te4) + (mt >= te5) + (mt >= te6); return true;
    }
    __device__ __forceinline__ const char* a_ptr(const Unit& u) const { return A + (size_t)u.pm * tstepA; }
    __device__ __forceinline__ const char* b_ptr(const Unit& u) const { return Bt + (size_t)u.e * estepB + (size_t)u.pn * tstepB; }
};

constexpr int MD_KSPLIT = 7, MD_KTILES = 4;
struct MoeDownOrder {
    static constexpr bool VARNT = true;
    const char* A; const char* Bt; size_t tstepA, tstepB, estepB; int G, c, nsplit, nfull4;
    int tb[8], fe[8];
    unsigned pmask;
    __device__ __forceinline__ void init(const void* A_, int lda, const void* Bt_, int ldb, size_t estepB_, const unsigned* cnt, int G_, int c_) {
        A = (const char*)A_; Bt = (const char*)Bt_; tstepA = (size_t)256 * lda * 2; tstepB = (size_t)256 * ldb * 2; estepB = estepB_; G = G_; c = c_;
        int acc = 0, np = 0, nf = 0; pmask = 0u;
#pragma unroll
        for (int e = 0; e < 8; ++e) { tb[e] = acc; fe[e] = (int)(cnt[e] >> 8); const int p = (cnt[e] & 255u) ? 1 : 0; pmask |= (unsigned)p << e; acc += fe[e] + p; np += p; nf += fe[e]; }
        nsplit = np * 4 * MD_KSPLIT; nfull4 = nf * 4;
    }
    __device__ __forceinline__ bool next(int i, Unit& u) const {
        const long L = (long)i * G + c; if (L >= (long)nsplit + nfull4) return false;
        if (L < nsplit) { const int sidx = (int)L, pi = sidx / (4 * MD_KSPLIT), w = sidx - pi * (4 * MD_KSPLIT); u.pn = w / MD_KSPLIT; u.kq = w - u.pn * MD_KSPLIT;
            int e = 0, seen = 0;
#pragma unroll
            for (int q = 0; q < 8; ++q) { const int has = (int)((pmask >> q) & 1u); if (has && seen == pi) e = q; seen += has; }
            int tbe = 0, fee = 0;
#pragma unroll
            for (int q = 0; q < 8; ++q) { tbe = (e == q) ? tb[q] : tbe; fee = (e == q) ? fe[q] : fee; }
            u.e = e; u.pm = tbe + fee; u.kq |= pi << 8; }
        else { const int f = (int)L - nsplit, ft = f >> 2; u.pn = f & 3; u.kq = -1; int e = 0, rem = ft, pm = 0, done = 0;
#pragma unroll
            for (int q = 0; q < 8; ++q) { if (!done) { if (rem < fe[q]) { e = q; pm = tb[q] + rem; done = 1; } else rem -= fe[q]; } }
            u.e = e; u.pm = pm; }
        return true;
    }
    __device__ __forceinline__ int nt_of(const Unit& u) const { return u.kq < 0 ? MD_KSPLIT * MD_KTILES : MD_KTILES; }
    __device__ __forceinline__ const char* a_ptr(const Unit& u) const { return A + (size_t)u.pm * tstepA + (u.kq < 0 ? (size_t)0 : (size_t)(u.kq & 255) * (MD_KTILES * 128)); }
    __device__ __forceinline__ const char* b_ptr(const Unit& u) const { return Bt + (size_t)u.e * estepB + (size_t)u.pn * tstepB + (u.kq < 0 ? (size_t)0 : (size_t)(u.kq & 255) * (MD_KTILES * 128)); }
};
struct EpiMoeDownSplit {
    static constexpr bool PERM = true, CHAIN = false, F8 = true;
    bf16* Y; bf16* Yp; const float* rgate;
    __device__ __forceinline__ void operator()(f32x4 (&acc)[2][2][4][2], const Unit& u, int wr, int wc, int fr, int fq) const {
        const int rl0 = wr * 64 + fr, col0 = u.pn * 256 + wc * 32 + 8 * fq;
        bf16* dst = (u.kq < 0) ? Y + (size_t)u.pm * 256 * DM : Yp + ((size_t)(u.kq & 255) * (8 * 256) + (size_t)(u.kq >> 8) * 256) * DM;
#pragma unroll
        for (int ai = 0; ai < 2; ++ai)
#pragma unroll
            for (int m = 0; m < 4; ++m) { const int rl = rl0 + ai * 128 + m * 16; const float s = rgate[u.pm * 256 + rl] * (1.0f / 64.0f);
#pragma unroll
                for (int bj = 0; bj < 2; ++bj) *(u32x4*)(dst + (size_t)rl * DM + col0 + bj * 128) = pack8(acc[ai][bj][m][0] * s, acc[ai][bj][m][1] * s); }
    }
};

enum { I_X = 0, I_WIN, I_NORM_MIX, I_RW_MU, I_RW_DECAY_UP, I_RW_W0, I_RW_A_UP, I_RW_A0, I_RW_GATE_UP, I_RW_KK, I_RW_KA, I_RW_RK, I_RW_LNW, I_RW_LNB,
       I_VRES_DOWN, I_VRES_UP, I_VRES_V0, I_SSM_CONVW, I_SSM_CONVB, I_SSM_DTB, I_SSM_ALOG, I_SSM_D, I_SSM_NORMW, I_ATT_QG, I_ATT_KG, I_ATT_BIAS,
       I_GLA_GUP, I_GLA_GB, I_GLA_NW, I_WBRANCH, I_WOUT, I_NORM_FFN, I_FFN_W1, I_FFN_W3, I_FFN_W2, I_MOE_ROUTER, I_MOE_W1, I_MOE_W3, I_MOE_W2, N_IN };
struct Args { const float* in[N_IN]; float* out; unsigned char* ws; };
static_assert(sizeof(Args) == (N_IN + 2) * 8, "Args has no padding");

struct PT { const LAS unsigned long long* tab;
    __device__ __forceinline__ const float* operator[](int i) const { const unsigned long long v = tab[i];
        const unsigned lo = __builtin_amdgcn_readfirstlane((unsigned)v), hi = __builtin_amdgcn_readfirstlane((unsigned)(v >> 32)); return (const float*)(const __attribute__((address_space(1))) float*)(((unsigned long long)hi << 32) | lo); } };
struct ArgsD { PT in;
    __device__ __forceinline__ float* out() const { return (float*)in[N_IN]; }
    __device__ __forceinline__ unsigned char* ws() const { return (unsigned char*)in[N_IN + 1]; } };
constexpr int NWAVES = 8, NTHREADS = 512;
constexpr int LDS_MAIN = 131072;
constexpr int LDS_CTL_OFF = LDS_MAIN;
constexpr int LDS_BYTES = LDS_MAIN + 1024;

template <bool GPERM = false> __device__ __forceinline__ void cvt_item(const float* __restrict__ W, int ld, int k0, int csrc, int ncv, const float* __restrict__ gs, bf16* dst, int dstK, int drow, LAS float* scr, int lane) {
    const int lc = (lane < ncv) ? lane : ncv - 1;
    const float* wp = W + (size_t)k0 * ld + csrc + lc;
#pragma unroll
    for (int kb = 0; kb < 64; kb += 16) { float v[16];
#pragma unroll
        for (int j = 0; j < 16; ++j) v[j] = __builtin_nontemporal_load(wp + (size_t)(kb + j) * ld);
#pragma unroll
        for (int j = 0; j < 16; ++j) scr[(kb + j) * 65 + lane] = v[j]; }
    asm volatile("s_waitcnt lgkmcnt(0)" ::: "memory");
    const int kc = lane & 7;
    f32x4 g0 = {1.f, 1.f, 1.f, 1.f}, g1 = g0; if (gs) { g0 = *(const f32x4*)(gs + k0 + 8 * kc); g1 = *(const f32x4*)(gs + k0 + 8 * kc + 4); }
#pragma unroll
    for (int i = 0; i < 8; ++i) { const int nn = (lane >> 3) + 8 * i; const LAS float* sp = scr + (8 * kc) * 65 + nn;
        u32x4 o; o.x = pk2(sp[0 * 65] * g0[0], sp[1 * 65] * g0[1]); o.y = pk2(sp[2 * 65] * g0[2], sp[3 * 65] * g0[3]); o.z = pk2(sp[4 * 65] * g1[0], sp[5 * 65] * g1[1]); o.w = pk2(sp[6 * 65] * g1[2], sp[7 * 65] * g1[3]);
        const int rr = GPERM ? 32 * ((nn >> 4) & 3) + 8 * ((nn >> 2) & 3) + (nn & 3) : nn;
        if (nn < ncv) *(u32x4*)(dst + (size_t)(drow + rr) * dstK + k0 + 8 * kc) = o; }
    asm volatile("s_waitcnt lgkmcnt(0)" ::: "memory");
}
__device__ __forceinline__ void cvt_item8(const float* __restrict__ W, int ld, int k0, int csrc, int ncv, const float* __restrict__ gs, float scale, unsigned char* dst, int dstK, int drow, LAS float* scr, int lane) {
    const int lc = (lane < ncv) ? lane : ncv - 1;
    const float* wp = W + (size_t)k0 * ld + csrc + lc;
#pragma unroll
    for (int kb = 0; kb < 64; kb += 16) { float v[16];
#pragma unroll
        for (int j = 0; j < 16; ++j) v[j] = __builtin_nontemporal_load(wp + (size_t)(kb + j) * ld);
#pragma unroll
        for (int j = 0; j < 16; ++j) scr[(kb + j) * 65 + lane] = v[j]; }
    asm volatile("s_waitcnt lgkmcnt(0)" ::: "memory");
    const int kc = lane & 3; float gg[16];
#pragma unroll
    for (int j = 0; j < 16; ++j) gg[j] = gs ? gs[k0 + 16 * kc + j] * scale : scale;
#pragma unroll
    for (int i = 0; i < 4; ++i) { const int nn = (lane >> 2) + 16 * i; const LAS float* sp = scr + (16 * kc) * 65 + nn; u32x4 o;
#pragma unroll
        for (int q = 0; q < 4; ++q) { int t = 0; t = __builtin_amdgcn_cvt_pk_fp8_f32(sp[(4 * q) * 65] * gg[4 * q], sp[(4 * q + 1) * 65] * gg[4 * q + 1], t, false); t = __builtin_amdgcn_cvt_pk_fp8_f32(sp[(4 * q + 2) * 65] * gg[4 * q + 2], sp[(4 * q + 3) * 65] * gg[4 * q + 3], t, true); o[q] = (unsigned)t; }
        if (nn < ncv) *(u32x4*)(dst + (size_t)(drow + nn) * dstK + k0 + 16 * kc) = o; }
    asm volatile("s_waitcnt lgkmcnt(0)" ::: "memory");
}
struct CvtCtx { int gw, ngw, base, lane; LAS float* scr; };
__device__ __forceinline__ void cvt_job_gates(CvtCtx& cx, const float* W, int ld, int K, int csrc0, const float* gs, bf16* dst) {
    const int nnb = 64, nit = (K >> 6) * nnb;
    int first = cx.gw - (cx.base % cx.ngw); if (first < 0) first += cx.ngw;
    for (int it = first; it < nit; it += cx.ngw) { const int kb = it / nnb, nb = it - kb * nnb, i = nb >> 4, cc = (nb & 15) * 64;
        cvt_item<true>(W, ld, kb * 64, csrc0 + nb * 64, 64, gs, dst, K, 256 * (cc >> 6) + 128 * (i >> 1) + 4 * (i & 1), cx.scr, cx.lane); }
    cx.base += nit;
}
__device__ __forceinline__ void cvt_job(CvtCtx& cx, const float* W, int ld, int K, int csrc0, int ncols, const float* gs, bf16* dst, int drow_base, int rs128) {
    const int nnb = (ncols + 63) >> 6, nit = (K >> 6) * nnb;
    int first = cx.gw - (cx.base % cx.ngw); if (first < 0) first += cx.ngw;
    for (int it = first; it < nit; it += cx.ngw) { const int kb = it / nnb, nb = it - kb * nnb, c = nb * 64; const int ncv = (ncols - c) < 64 ? (ncols - c) : 64;
        cvt_item(W, ld, kb * 64, csrc0 + c, ncv, gs, dst, K, drow_base + (c >> 7) * rs128 + (c & 127), cx.scr, cx.lane); }
    cx.base += nit;
}
__device__ __forceinline__ void cvt_job8(CvtCtx& cx, const float* W, int ld, int K, int csrc0, int ncols, const float* gs, float scale, unsigned char* dst, int drow_base, int rs128) {
    const int nnb = (ncols + 63) >> 6, nit = (K >> 6) * nnb;
    int first = cx.gw - (cx.base % cx.ngw); if (first < 0) first += cx.ngw;
    for (int it = first; it < nit; it += cx.ngw) { const int kb = it / nnb, nb = it - kb * nnb, c = nb * 64; const int ncv = (ncols - c) < 64 ? (ncols - c) : 64;
        cvt_item8(W, ld, kb * 64, csrc0 + c, ncv, gs, scale, dst, K, drow_base + (c >> 7) * rs128 + (c & 127), cx.scr, cx.lane); }
    cx.base += nit;
}
__device__ __forceinline__ void zero_rows_bf16(int gtid, int nthr, bf16* dst, size_t nelem) {
    u32x4 z = {0u, 0u, 0u, 0u};
    for (size_t i = (size_t)gtid * 8; i < nelem; i += (size_t)nthr * 8) *(u32x4*)(dst + i) = z;
}


__device__ __forceinline__ int rcol(int t, int rot) { return ((((t >> 3) + rot) & 7) << 3) + (t & 7); }
__device__ __forceinline__ int rcol4(int t, int rot) { return ((((t >> 3) + rot) & 3) << 3) + (t & 7); }
constexpr int AT_ST = 72;
constexpr int AT_KS = 0, AT_VT = AT_KS + 2 * 64 * AT_ST * 2, AT_KSC = AT_VT + 2 * 64 * AT_ST * 2, AT_BUFB = AT_KSC + 2 * 64 * 4, AT_BIAS = 2 * AT_BUFB, AT_END = AT_BIAS + 8 * 264 * 4;
__device__ __forceinline__ void attn_drain(const ArgsD& a, int l, LAS unsigned char* lds, LAS unsigned* lctl, unsigned* qctr, const bf16* z, bf16* o) {
    const int tid = opq_v((int)threadIdx.x), lane = tid & 63, wid = __builtin_amdgcn_readfirstlane(tid >> 6);
    const int hs = wid >> 2, qb = wid & 3, fr = lane & 15, g = lane >> 4, ql = 16 * qb + fr, row = tid >> 3, ch = tid & 7;
    constexpr unsigned NU = BATCH * NCH * 4;
    __syncthreads();
    { const float* rb = a.in[I_ATT_BIAS]; LAS float* ball = (LAS float*)(lds + AT_BIAS); float bv[5];
#pragma unroll
      for (int j = 0; j < 5; ++j) { const int i = tid + 512 * j; bv[j] = rb[i < 8 * 257 ? i : 0]; }
#pragma unroll
      for (int j = 0; j < 5; ++j) { const int i = tid + 512 * j; if (i < 8 * 257) { const int hh = i / 257; ball[hh * 264 + (i - hh * 257)] = bv[j] * 1.44269504f; } } }
    f32x4 gq[4];
    { const float* qgp = a.in[I_ATT_QG] + l * 64; const float* kgp = a.in[I_ATT_KG] + l * 64;
      gq[0] = *(const f32x4*)(qgp + 8 * g) * *(const f32x4*)(kgp + 8 * g); gq[1] = *(const f32x4*)(qgp + 8 * g + 4) * *(const f32x4*)(kgp + 8 * g + 4);
      gq[2] = *(const f32x4*)(qgp + 32 + 8 * g) * *(const f32x4*)(kgp + 32 + 8 * g); gq[3] = *(const f32x4*)(qgp + 36 + 8 * g) * *(const f32x4*)(kgp + 36 + 8 * g); }
    if (tid == 0) lctl[32] = atomicAdd(qctr, 1u);
    __syncthreads();
    unsigned q = lctl[32], par = 0, un = 0;
    u32x4 wk[2], wv[2], wq0, wq1;
#define AT_KVPTR(q_, j_) (z + ((size_t)((int)((q_) & 7u)) * SEQ + ((31 - (int)((q_) >> 5)) - 8 + (j_)) * 64 + row) * ZC + C_ATT + 512 + (2 * (int)(((q_) >> 3) & 3u)) * 64 + 8 * ch)
#define AT_LOADKV(p_) do { wk[0] = *(const u32x4*)(p_); wv[0] = *(const u32x4*)((p_) + 512); wk[1] = *(const u32x4*)((p_) + 64); wv[1] = *(const u32x4*)((p_) + 576); } while (0)
#define AT_FETCHQ(q_) do { const int hp_ = (int)(((q_) >> 3) & 3u), c_ = 31 - (int)((q_) >> 5), b_ = (int)((q_) & 7u); const bf16* qp_ = z + ((size_t)b_ * SEQ + c_ * 64 + ql) * ZC + C_ATT + (2 * hp_ + hs) * 64 + 8 * g; \
        wq0 = *(const u32x4*)qp_; wq1 = *(const u32x4*)(qp_ + 32); } while (0)
    const bf16* kvp;
    { const unsigned q0_ = q < NU ? q : NU - 1; const int c0_ = 31 - (int)(q0_ >> 5); kvp = AT_KVPTR(q0_, (c0_ >= 8 ? 0 : 8 - c0_)); AT_LOADKV(kvp); AT_FETCHQ(q0_); }
    while (q < NU) {
        const int hp = (int)((q >> 3) & 3u), c = 31 - (int)(q >> 5), b = (int)(q & 7u), h = 2 * hp + hs;
        unsigned nq_r = NU; if (tid == 0) nq_r = atomicAdd(qctr, 1u);
        const LAS float* bias = (const LAS float*)(lds + AT_BIAS) + h * 264;
        bf16x8 qf[2];
        { f32x4 a0, a1, b0, b1; unpack8(wq0, a0, a1); unpack8(wq1, b0, b1);
          float ss = 0.f;
#pragma unroll
          for (int j = 0; j < 4; ++j) ss += a0[j] * a0[j] + a1[j] * a1[j] + b0[j] * b0[j] + b1[j] * b1[j];
          ss = xrows_sum(ss);
          const float sc = rsqrtf(ss * (1.0f / 64.0f) + NORM_EPS) * 0.125f;
          const u32x4 p0 = pack8(a0 * gq[0] * sc, a1 * gq[1] * sc), p1 = pack8(b0 * gq[2] * sc, b1 * gq[3] * sc);
          qf[0] = __builtin_bit_cast(bf16x8, p0); qf[1] = __builtin_bit_cast(bf16x8, p1); }
        f32x4 oT[4];
#pragma unroll
        for (int d = 0; d < 4; ++d) oT[d] = (f32x4){0.f, 0.f, 0.f, 0.f};
        float m = -1e30f, lsum = 0.f; unsigned nq = NU;
        for (int j = (c >= 8 ? 0 : 8 - c); j <= 8; ++j) {
            LAS unsigned char* buf = lds + par * AT_BUFB; par ^= 1u;
#pragma unroll
            for (int i = 0; i < 2; ++i) { const u32x4 wkk = wk[i], wvv = wv[i];
                *(LAS u32x4*)((LAS bf16*)(buf + AT_KS) + (i * 64 + row) * AT_ST + 8 * ch) = wkk;
                f32x4 k0, k1; unpack8(wkk, k0, k1); float q2 = 0.f;
#pragma unroll
                for (int e = 0; e < 4; ++e) q2 += k0[e] * k0[e] + k1[e] * k1[e];
                q2 = red8_sum(q2);
                if (ch == 0) ((LAS float*)(buf + AT_KSC))[i * 64 + row] = rsqrtf(q2 * (1.0f / 64.0f) + NORM_EPS) * 1.44269504f;
                LAS bf16* vt = (LAS bf16*)(buf + AT_VT) + (i * 64 + 8 * ch) * AT_ST + rcol(row, ch >> 1);
                vt[0 * AT_ST] = (bf16)(wvv.x & 0xffffu); vt[1 * AT_ST] = (bf16)(wvv.x >> 16); vt[2 * AT_ST] = (bf16)(wvv.y & 0xffffu); vt[3 * AT_ST] = (bf16)(wvv.y >> 16);
                vt[4 * AT_ST] = (bf16)(wvv.z & 0xffffu); vt[5 * AT_ST] = (bf16)(wvv.z >> 16); vt[6 * AT_ST] = (bf16)(wvv.w & 0xffffu); vt[7 * AT_ST] = (bf16)(wvv.w >> 16); }
            if (j == 8 && tid == 0) lctl[34 + (un & 1u)] = nq_r;
            __syncthreads();
            { const bf16* np = kvp + (size_t)64 * ZC;
              if (j == 8) { nq = lctl[34 + (un & 1u)]; const unsigned qn = nq < NU ? nq : NU - 1; const int cn_ = 31 - (int)(qn >> 5); np = AT_KVPTR(qn, (cn_ >= 8 ? 0 : 8 - cn_)); AT_FETCHQ(qn); }
              kvp = np; AT_LOADKV(kvp); }
            const LAS bf16* Ks = (const LAS bf16*)(buf + AT_KS) + hs * 64 * AT_ST; const LAS bf16* VT = (const LAS bf16*)(buf + AT_VT) + hs * 64 * AT_ST; const LAS float* ksc = (const LAS float*)(buf + AT_KSC) + hs * 64;
            f32x4 sT[4];
#pragma unroll
            for (int kb = 0; kb < 4; ++kb) { sT[kb] = (f32x4){0.f, 0.f, 0.f, 0.f};
#pragma unroll
                for (int ks = 0; ks < 2; ++ks) { const bf16x8 af = *(const LAS bf16x8*)(Ks + (16 * kb + fr) * AT_ST + 32 * ks + 8 * g); sT[kb] = __builtin_amdgcn_mfma_f32_16x16x32_bf16(af, qf[ks], sT[kb], 0, 0, 0); } }
            float mt = -1e30f;
            if (j <= 5) {
                const float bfar = bias[0];
#pragma unroll
                for (int kb = 0; kb < 4; ++kb) { const f32x4 kv = *(const LAS f32x4*)(ksc + 16 * kb + 4 * g);
#pragma unroll
                    for (int r = 0; r < 4; ++r) { const float sv = sT[kb][r] * kv[r] + bfar; sT[kb][r] = sv; mt = fmaxf(mt, sv); } }
            } else if (j >= 7) {
                const LAS float* bq = bias + ((j - 8) * 64 + 4 * g - ql + 128);
#pragma unroll
                for (int kb = 0; kb < 4; ++kb) { const f32x4 kv = *(const LAS f32x4*)(ksc + 16 * kb + 4 * g);
#pragma unroll
                    for (int r = 0; r < 4; ++r) { const float sv = sT[kb][r] * kv[r] + bq[16 * kb + r]; sT[kb][r] = sv; mt = fmaxf(mt, sv); } }
            } else {
#pragma unroll
                for (int kb = 0; kb < 4; ++kb) { const f32x4 kv = *(const LAS f32x4*)(ksc + 16 * kb + 4 * g);
#pragma unroll
                    for (int r = 0; r < 4; ++r) { int rel = -128 + 16 * kb + 4 * g + r - ql; rel = rel < -128 ? -128 : rel;
                        const float sv = sT[kb][r] * kv[r] + bias[rel + 128]; sT[kb][r] = sv; mt = fmaxf(mt, sv); } }
            }
            mt = xrows_max(mt);
            const float mn = fmaxf(m, mt); const float alpha = __builtin_amdgcn_exp2f(m - mn); m = mn; lsum *= alpha;
#pragma unroll
            for (int d = 0; d < 4; ++d) oT[d] = oT[d] * alpha;
#pragma unroll
            for (int kb = 0; kb < 4; ++kb)
#pragma unroll
                for (int r = 0; r < 4; ++r) { const float p = __builtin_amdgcn_exp2f(sT[kb][r] - mn); sT[kb][r] = p; lsum += p; }
#pragma unroll
            for (int ks = 0; ks < 2; ++ks) { u32x4 pw; pw.x = pg8::cvt_pk_bf16(sT[2 * ks][0], sT[2 * ks][1]); pw.y = pg8::cvt_pk_bf16(sT[2 * ks][2], sT[2 * ks][3]); pw.z = pg8::cvt_pk_bf16(sT[2 * ks + 1][0], sT[2 * ks + 1][1]); pw.w = pg8::cvt_pk_bf16(sT[2 * ks + 1][2], sT[2 * ks + 1][3]);
                const bf16x8 pf = __builtin_bit_cast(bf16x8, pw);
#pragma unroll
                for (int db = 0; db < 4; ++db) { const LAS bf16* vp = VT + (16 * db + fr) * AT_ST; const u32x2 v0 = *(const LAS u32x2*)(vp + rcol(32 * ks + 4 * g, db)), v1 = *(const LAS u32x2*)(vp + rcol(32 * ks + 4 * g + 16, db));
                    u32x4 vw; vw.x = v0.x; vw.y = v0.y; vw.z = v1.x; vw.w = v1.y;
                    oT[db] = __builtin_amdgcn_mfma_f32_16x16x32_bf16(__builtin_bit_cast(bf16x8, vw), pf, oT[db], 0, 0, 0); } }
        }
        lsum = xrows_sum(lsum);
        const float inv = 1.0f / lsum; bf16* op = o + ((size_t)b * SEQ + c * 64 + ql) * 2048 + 1024 + h * 64 + 4 * g;
#pragma unroll
        for (int db = 0; db < 4; ++db) { u32x2 w; w.x = pg8::cvt_pk_bf16(oT[db][0] * inv, oT[db][1] * inv); w.y = pg8::cvt_pk_bf16(oT[db][2] * inv, oT[db][3] * inv); *(u32x2*)(op + 16 * db) = w; }
        q = nq; ++un;
    }
#undef AT_KVPTR
#undef AT_LOADKV
#undef AT_FETCHQ
    __syncthreads();
}

typedef f32x4 acc4;
#define MFMA16(a_, b_, c_) __builtin_amdgcn_mfma_f32_16x16x32_bf16((a_), (b_), (c_), 0, 0, 0)
__device__ __forceinline__ bf16x8 frag_nat(const LAS bf16* base, int pitch, int row, int k0, int g) { return *(const LAS bf16x8*)(base + row * pitch + k0 + 8 * g); }
__device__ __forceinline__ bf16x8 frag_nat_rot(const LAS bf16* base, int row, int k0, int g) { return *(const LAS bf16x8*)(base + row * 72 + ((((k0 >> 3) + g + (row >> 4)) & 7) << 3)); }
__device__ __forceinline__ bf16x8 frag_perm(const LAS bf16* base, int pitch, int row, int k0, int g) { const LAS bf16* p = base + row * pitch + k0 + 4 * g; const u32x2 v0 = *(const LAS u32x2*)p, v1 = *(const LAS u32x2*)(p + 16);
    u32x4 w; w.x = v0.x; w.y = v0.y; w.z = v1.x; w.w = v1.y; return __builtin_bit_cast(bf16x8, w); }
__device__ __forceinline__ bf16x8 frag_acc(const acc4& lo, const acc4& hi) { u32x4 w; w.x = pg8::cvt_pk_bf16(lo[0], lo[1]); w.y = pg8::cvt_pk_bf16(lo[2], lo[3]); w.z = pg8::cvt_pk_bf16(hi[0], hi[1]); w.w = pg8::cvt_pk_bf16(hi[2], hi[3]); return __builtin_bit_cast(bf16x8, w); }
__device__ __forceinline__ float wave_incl_scan(float x, int lane) { (void)lane; return scan64(x); }

constexpr int P72 = 72, P136 = 136;
constexpr int MB_CM = 0, MB_BM = MB_CM + 64 * P136 * 2, MB_BMT = MB_BM + 64 * P136 * 2, MB_XDT = MB_BMT + 128 * P72 * 2, MB_XDTW = MB_XDT + 64 * P72 * 2, MB_P = MB_XDTW + 64 * P72 * 2,
              MB_Y = MB_P + 64 * P72 * 2, MB_ACS = MB_Y + 64 * 68 * 4, MB_DT = MB_ACS + 512, MB_END = MB_DT + 512;
static_assert(MB_END <= 159744, "mamba LDS");
__device__ __forceinline__ void mamba_bc_prepass(const ArgsD& a, int l, int gw, int ngw, int lane, const bf16* z, bf16* bcv) {
    const float* cw = a.in[I_SSM_CONVW] + (size_t)l * 4 * 1024 + 512 + 8 * lane; const float* cb = a.in[I_SSM_CONVB] + l * 1024 + 512 + 8 * lane;
    f32x4 w0[5], w1[5];
#pragma unroll
    for (int j = 0; j < 4; ++j) { w0[j] = *(const f32x4*)(cw + j * 1024); w1[j] = *(const f32x4*)(cw + j * 1024 + 4); }
    w0[4] = *(const f32x4*)cb; w1[4] = *(const f32x4*)(cb + 4);
    for (int rg = gw; rg < T / 8; rg += ngw) { const size_t t0 = (size_t)rg * 8; const bool first = ((rg * 8) & (SEQ - 1)) == 0;
        u32x4 rw[11];
#pragma unroll
        for (int i = 0; i < 11; ++i) { const size_t t = (first && i < 3) ? t0 : t0 + i - 3; rw[i] = *(const u32x4*)(z + t * ZC + C_SSM + 1024 + 8 * lane); }
        if (first) { rw[0] = (u32x4){0u, 0u, 0u, 0u}; rw[1] = rw[0]; rw[2] = rw[0]; }
#pragma unroll
        for (int i = 0; i < 8; ++i) { f32x4 o0 = w0[4], o1 = w1[4];
#pragma unroll
            for (int j = 0; j < 4; ++j) { f32x4 x0, x1; unpack8(rw[i + j], x0, x1); o0 += x0 * w0[j]; o1 += x1 * w1[j]; }
#pragma unroll
            for (int e = 0; e < 4; ++e) { o0[e] = siluf_(o0[e]); o1[e] = siluf_(o1[e]); }
            *(u32x4*)(bcv + (t0 + i) * 512 + 8 * lane) = pack8(o0, o1); } }
}
__device__ __forceinline__ void mamba_block_task(const ArgsD& a, int l, int bh, LAS unsigned char* lds, const bf16* z, const bf16* bcv, bf16* o, float* mssq) {
    const int tid = opq_v((int)threadIdx.x), lane = tid & 63, wid = __builtin_amdgcn_readfirstlane(tid >> 6), fr = lane & 15, g = lane >> 4;
    const int b = bh >> 3, hd = bh & 7, grp = hd >> 2;
    const float dtb = a.in[I_SSM_DTB][l * 8 + hd], Aneg = -__expf(a.in[I_SSM_ALOG][l * 8 + hd]), Dk = a.in[I_SSM_D][l * 8 + hd];
    LAS bf16* Cm = (LAS bf16*)(lds + MB_CM); LAS bf16* Bm = (LAS bf16*)(lds + MB_BM); LAS bf16* BmT = (LAS bf16*)(lds + MB_BMT); LAS bf16* xdtT = (LAS bf16*)(lds + MB_XDT); LAS bf16* xdtwT = (LAS bf16*)(lds + MB_XDTW);
    LAS bf16* Pm = (LAS bf16*)(lds + MB_P); LAS float* Yl = (LAS float*)(lds + MB_Y); LAS float* acs2 = (LAS float*)(lds + MB_ACS); LAS float* dts2 = (LAS float*)(lds + MB_DT);
    const int pb = wid & 3, lh = wid >> 2;
    const int row = tid >> 3, ch = tid & 7;
    f32x4 cw0[5], cw1[5];
    { const float* cw = a.in[I_SSM_CONVW] + (size_t)l * 4 * 1024 + hd * 64 + 8 * ch; const float* cb = a.in[I_SSM_CONVB] + l * 1024 + hd * 64 + 8 * ch;
#pragma unroll
      for (int j = 0; j < 4; ++j) { cw0[j] = *(const f32x4*)(cw + j * 1024); cw1[j] = *(const f32x4*)(cw + j * 1024 + 4); }
      cw0[4] = *(const f32x4*)cb; cw1[4] = *(const f32x4*)(cb + 4); }
    acc4 St[8];
#pragma unroll
    for (int nb = 0; nb < 8; ++nb) St[nb] = (acc4){0.f, 0.f, 0.f, 0.f};
    u32x4 n_gt, n_x[4], n_b0, n_b1, n_c0, n_c1; bf16 n_dt = 0;
#define MB_FETCH(cn_) do { const size_t tq_ = (size_t)b * SEQ + (cn_) * 64 + row; const bf16* zn_ = z + tq_ * ZC + C_SSM; n_gt = *(const u32x4*)(zn_ + hd * 64 + 8 * ch); \
        _Pragma("unroll") for (int k_ = 0; k_ < 4; ++k_) { const bool ok_ = ((cn_) * 64 + row - k_) >= 0; n_x[k_] = *(const u32x4*)(zn_ - (ok_ ? (size_t)k_ * ZC : (size_t)0) + 512 + hd * 64 + 8 * ch); }   \
        const bf16* bq_ = bcv + tq_ * 512 + grp * 128 + 8 * ch; n_b0 = *(const u32x4*)bq_; n_b1 = *(const u32x4*)(bq_ + 64); n_c0 = *(const u32x4*)(bq_ + 256); n_c1 = *(const u32x4*)(bq_ + 320); } while (0)
#define MB_DTSCAN(cn_) do { const float dt_ = softplusf_(bf2f(n_dt) + dtb); const float cs_ = wave_incl_scan(dt_ * Aneg, lane); dts2[((cn_) & 1) * 64 + lane] = dt_; acs2[((cn_) & 1) * 64 + lane] = cs_; } while (0)
    MB_FETCH(0);
    if (wid == 0) { n_dt = z[((size_t)b * SEQ + lane) * ZC + C_SSM + 1536 + hd]; MB_DTSCAN(0); n_dt = z[((size_t)b * SEQ + 64 + lane) * ZC + C_SSM + 1536 + hd]; }
    __syncthreads();
    for (int c = 0; c < NCH; ++c) {
        const size_t t0 = (size_t)b * SEQ + c * 64;
        const LAS float* acs = acs2 + (c & 1) * 64; const LAS float* dts = dts2 + (c & 1) * 64;
        const u32x4 c_gt = n_gt; u32x4 c_x;
        { const float dt = dts[row], wl = __expf(acs[63] - acs[row]);
          f32x4 x0 = cw0[4], x1 = cw1[4];
#pragma unroll
          for (int j = 0; j < 4; ++j) { f32x4 r0, r1; unpack8(n_x[3 - j], r0, r1); const float mk = (c * 64 + row - (3 - j) >= 0) ? 1.0f : 0.0f; x0 += r0 * (cw0[j] * mk); x1 += r1 * (cw1[j] * mk); }
#pragma unroll
          for (int e = 0; e < 4; ++e) { x0[e] = siluf_(x0[e]); x1[e] = siluf_(x1[e]); }
          c_x = pack8(x0, x1);
#pragma unroll
          for (int e = 0; e < 4; ++e) { const float v0 = x0[e] * dt, v1 = x1[e] * dt; xdtT[(8 * ch + e) * P72 + rcol(row, ch >> 1)] = (bf16)f2bf(v0); xdtT[(8 * ch + 4 + e) * P72 + rcol(row, ch >> 1)] = (bf16)f2bf(v1);
              xdtwT[(8 * ch + e) * P72 + rcol(row, ch >> 1)] = (bf16)f2bf(v0 * wl); xdtwT[(8 * ch + 4 + e) * P72 + rcol(row, ch >> 1)] = (bf16)f2bf(v1 * wl); }
#pragma unroll
          for (int i = 0; i < 2; ++i) { const int cc = ch + 8 * i; const u32x4 wb = i ? n_b1 : n_b0, wc = i ? n_c1 : n_c0;
              *(LAS u32x4*)(Bm + row * P136 + 8 * cc) = wb; *(LAS u32x4*)(Cm + row * P136 + 8 * cc) = wc;
              LAS bf16* bt = BmT + (8 * cc) * P72 + rcol(row, cc >> 1);
              bt[0 * P72] = (bf16)(wb.x & 0xffffu); bt[1 * P72] = (bf16)(wb.x >> 16); bt[2 * P72] = (bf16)(wb.y & 0xffffu); bt[3 * P72] = (bf16)(wb.y >> 16);
              bt[4 * P72] = (bf16)(wb.z & 0xffffu); bt[5 * P72] = (bf16)(wb.z >> 16); bt[6 * P72] = (bf16)(wb.w & 0xffffu); bt[7 * P72] = (bf16)(wb.w >> 16); } }
        __syncthreads();
        if (wid == 0 && c + 1 < NCH) MB_DTSCAN(c + 1);
        { const int lb = wid >> 1;
#pragma unroll
          for (int q = 0; q < 2; ++q) { const int sb = 2 * (wid & 1) + q; acc4 cb = (acc4){0.f, 0.f, 0.f, 0.f};
#pragma unroll
              for (int ks = 0; ks < 4; ++ks) cb = MFMA16(frag_nat(Cm, P136, 16 * lb + fr, 32 * ks, g), frag_nat(Bm, P136, 16 * sb + fr, 32 * ks, g), cb);
              const int sidx = 16 * sb + fr; const float as = acs[sidx];
#pragma unroll
              for (int r = 0; r < 4; ++r) { const int lidx = 16 * lb + 4 * g + r; const float v = (sidx <= lidx) ? cb[r] * __expf(acs[lidx] - as) : 0.f; Pm[lidx * P72 + sidx] = (bf16)f2bf(v); } } }
        __syncthreads();
        { const int cn = (c + 1 < NCH) ? c + 1 : c; MB_FETCH(cn); const int cd = (c + 2 < NCH) ? c + 2 : c; if (wid == 0) n_dt = z[((size_t)b * SEQ + cd * 64 + lane) * ZC + C_SSM + 1536 + hd]; }
#pragma unroll
        for (int q = 0; q < 2; ++q) { const int lb = 2 * lh + q; acc4 y = (acc4){0.f, 0.f, 0.f, 0.f};
#pragma unroll
            for (int kk = 0; kk < 4; ++kk) y = MFMA16(frag_perm(Cm, P136, 16 * lb + fr, 32 * kk, g), frag_acc(St[2 * kk], St[2 * kk + 1]), y);
#pragma unroll
            for (int r = 0; r < 4; ++r) y[r] *= __expf(acs[16 * lb + 4 * g + r]);
#pragma unroll
            for (int ks = 0; ks < 2; ++ks) y = MFMA16(frag_nat(Pm, P72, 16 * lb + fr, 32 * ks, g), frag_nat_rot(xdtT, 16 * pb + fr, 32 * ks, g), y);
#pragma unroll
            for (int r = 0; r < 4; ++r) Yl[(16 * lb + 4 * g + r) * 68 + 16 * pb + fr] = y[r]; }
        { const float dec = __expf(acs[63]);
#pragma unroll
          for (int nb = 0; nb < 8; ++nb) { St[nb] = St[nb] * dec;
#pragma unroll
              for (int ks = 0; ks < 2; ++ks) St[nb] = MFMA16(frag_nat_rot(BmT, 16 * nb + fr, 32 * ks, g), frag_nat_rot(xdtwT, 16 * pb + fr, 32 * ks, g), St[nb]); } }
        __syncthreads();
        { const size_t t = t0 + row;
          f32x4 x0, x1, g0, g1; unpack8(c_x, x0, x1); unpack8(c_gt, g0, g1);
          const f32x4 y0 = *(const LAS f32x4*)(Yl + row * 68 + 8 * ch), y1 = *(const LAS f32x4*)(Yl + row * 68 + 8 * ch + 4); f32x4 o0, o1; float q2 = 0.f;
#pragma unroll
          for (int e = 0; e < 4; ++e) { o0[e] = (y0[e] + x0[e] * Dk) * siluf_(g0[e]); o1[e] = (y1[e] + x1[e] * Dk) * siluf_(g1[e]); q2 += o0[e] * o0[e] + o1[e] * o1[e]; }
          *(u32x4*)(o + t * 2048 + 512 + hd * 64 + 8 * ch) = pack8(o0, o1);
          q2 = red8_sum(q2);
          if (ch == 0) mssq[t * 8 + hd] = q2; }
    }
#undef MB_FETCH
#undef MB_DTSCAN
    __syncthreads();
}

constexpr int P132 = 132;
constexpr int GL_BC = 0, GL_QG = GL_BC + 64 * 68 * 4, GL_KG = GL_QG + 64 * P72 * 2, GL_KDT = GL_KG + 64 * P72 * 2, GL_VT = GL_KDT + 64 * P72 * 2, GL_ATT = GL_VT + 128 * P72 * 2,
              GL_O = GL_ATT + 64 * P72 * 2, GL_GU = GL_O + 64 * P132 * 4, GL_END = GL_GU + 17 * 64 * 4;
static_assert(GL_END <= LDS_MAIN, "gla LDS");
constexpr int GP_GU = 0, GP_BC = GP_GU + 17 * 64 * 4, GP_END = GP_BC + 2 * 64 * 68 * 4;
__device__ __forceinline__ void gla_prepass(const ArgsD& a, int l, int bx, int G, LAS unsigned char* lds, bf16* z, float* gend) {
    const int tid = opq_v((int)threadIdx.x), lane = tid & 63, wid = __builtin_amdgcn_readfirstlane(tid >> 6), row = tid >> 3, ch = tid & 7;
    LAS float* gu = (LAS float*)(lds + GP_GU);
    constexpr int NUN = BATCH * 4 * NCH;
    int gu_h = -1; unsigned par = 0;
    u32x4 wx0, wx1, wq, wk;
#define GP_FETCH(u_) do { const int c_ = (u_) & 31, h_ = ((u_) >> 5) & 3, b_ = (u_) >> 7; const bf16* zn_ = z + ((size_t)b_ * SEQ + c_ * 64 + row) * ZC + C_GLA; \
        wx0 = *(const u32x4*)(zn_ + 1024); wx1 = *(const u32x4*)(zn_ + 1032); wq = *(const u32x4*)(zn_ + h_ * 64 + 8 * ch); wk = *(const u32x4*)(zn_ + 256 + h_ * 64 + 8 * ch); } while (0)
    { const int u0 = bx < NUN ? bx : NUN - 1; GP_FETCH(u0); }
    for (int u = bx; u < NUN; u += G) {
        const int c = u & 31, h = (u >> 5) & 3, b = u >> 7;
        if (gu_h != h) { gu_h = h; __syncthreads();
            const float* gup = a.in[I_GLA_GUP] + (size_t)l * 16 * 256 + h * 64; const float* gbp = a.in[I_GLA_GB] + l * 256 + h * 64; float gv[3];
#pragma unroll
            for (int j = 0; j < 3; ++j) { const int i = tid + 512 * j, ic = i < 17 * 64 ? i : 0, r = ic >> 6, k = ic & 63; gv[j] = (r < 16) ? gup[r * 256 + k] : gbp[k]; }
#pragma unroll
            for (int j = 0; j < 3; ++j) { const int i = tid + 512 * j; if (i < 17 * 64) gu[i] = gv[j]; }
            __syncthreads(); }
        LAS float* bc = (LAS float*)(lds + GP_BC) + par * (64 * 68); par ^= 1u;
        const u32x4 c_q = wq, c_k = wk; f32x4 xa, xb_, xc, xd; unpack8(wx0, xa, xb_); unpack8(wx1, xc, xd);
        { const int un = (u + G < NUN) ? u + G : u; GP_FETCH(un); }
        { f32x4 la0 = *(const LAS f32x4*)(gu + 16 * 64 + 8 * ch), la1 = *(const LAS f32x4*)(gu + 16 * 64 + 8 * ch + 4);
#pragma unroll
          for (int r = 0; r < 16; ++r) { const float xv = (r < 4) ? xa[r & 3] : (r < 8) ? xb_[r & 3] : (r < 12) ? xc[r & 3] : xd[r & 3];
              la0 += *(const LAS f32x4*)(gu + r * 64 + 8 * ch) * xv; la1 += *(const LAS f32x4*)(gu + r * 64 + 8 * ch + 4) * xv; }
#pragma unroll
          for (int e = 0; e < 4; ++e) { la0[e] = (fminf(la0[e], 0.f) - __logf(1.0f + __expf(-fabsf(la0[e])))) * (1.0f / 16.0f); la1[e] = (fminf(la1[e], 0.f) - __logf(1.0f + __expf(-fabsf(la1[e])))) * (1.0f / 16.0f); }
          *(LAS f32x4*)(bc + row * 68 + 8 * ch) = la0; *(LAS f32x4*)(bc + row * 68 + 8 * ch + 4) = la1; }
        __syncthreads();
#pragma unroll
        for (int q = 0; q < 8; ++q) { const int k = 8 * wid + q; const float v = scan64(bc[lane * 68 + k]); bc[lane * 68 + k] = v; }
        __syncthreads();
        { const f32x4 b0 = *(const LAS f32x4*)(bc + row * 68 + 8 * ch), b1 = *(const LAS f32x4*)(bc + row * 68 + 8 * ch + 4);
          f32x4 q0, q1, k0, k1, qa, qb_, ka, kb_; unpack8(c_q, q0, q1); unpack8(c_k, k0, k1);
#pragma unroll
          for (int e = 0; e < 4; ++e) { qa[e] = q0[e] * __expf(b0[e]) * 0.125f; qb_[e] = q1[e] * __expf(b1[e]) * 0.125f; ka[e] = k0[e] * __expf(-b0[e]); kb_[e] = k1[e] * __expf(-b1[e]); }
          bf16* zn = z + ((size_t)b * SEQ + c * 64 + row) * ZC + C_GLA; *(u32x4*)(zn + h * 64 + 8 * ch) = pack8(qa, qb_); *(u32x4*)(zn + 256 + h * 64 + 8 * ch) = pack8(ka, kb_);
          if (tid < 64) gend[(size_t)u * 64 + tid] = bc[63 * 68 + tid]; }
    }
#undef GP_FETCH
    __syncthreads();
}
__device__ __forceinline__ void gla_block_task(const ArgsD& a, int l, int bh, LAS unsigned char* lds, const bf16* z, const float* gend, bf16* o) {
    const int tid = opq_v((int)threadIdx.x), lane = tid & 63, wid = __builtin_amdgcn_readfirstlane(tid >> 6), fr = lane & 15, g = lane >> 4;
    const int b = bh >> 2, h = bh & 3;
    LAS float* endl = (LAS float*)(lds + GL_BC); LAS bf16* qg = (LAS bf16*)(lds + GL_QG); LAS bf16* kg = (LAS bf16*)(lds + GL_KG); LAS bf16* kgT = (LAS bf16*)(lds + GL_KDT); LAS bf16* vT = (LAS bf16*)(lds + GL_VT);
    LAS bf16* att = (LAS bf16*)(lds + GL_ATT); LAS float* Ol = (LAS float*)(lds + GL_O);
    const float* nwp = a.in[I_GLA_NW] + l * 128;
    acc4 St[4];
#pragma unroll
    for (int kb = 0; kb < 4; ++kb) St[kb] = (acc4){0.f, 0.f, 0.f, 0.f};
    const int row = tid >> 3, ch = tid & 7;
    const f32x4 nw0 = *(const f32x4*)(nwp + 16 * ch), nw1 = *(const f32x4*)(nwp + 16 * ch + 4), nw2 = *(const f32x4*)(nwp + 16 * ch + 8), nw3 = *(const f32x4*)(nwp + 16 * ch + 12);
    u32x4 n_q, n_k, n_v0, n_v1, n_g0, n_g1; float n_end = 0.f;
#define GL_FETCH(cn_) do { const bf16* zn_ = z + ((size_t)b * SEQ + (cn_) * 64 + row) * ZC + C_GLA; n_q = *(const u32x4*)(zn_ + h * 64 + 8 * ch); n_k = *(const u32x4*)(zn_ + 256 + h * 64 + 8 * ch); \
        n_v0 = *(const u32x4*)(zn_ + 512 + h * 128 + 8 * ch); n_v1 = *(const u32x4*)(zn_ + 512 + h * 128 + 8 * (ch + 8)); n_g0 = *(const u32x4*)(zn_ + 1040 + h * 128 + 16 * ch); n_g1 = *(const u32x4*)(zn_ + 1040 + h * 128 + 16 * ch + 8); \
        if (tid < 64) n_end = gend[((size_t)(b * 4 + h) * NCH + (cn_)) * 64 + tid]; } while (0)
    GL_FETCH(0);
    __syncthreads();
    for (int c = 0; c < NCH; ++c) {
        const size_t t0 = (size_t)b * SEQ + c * 64;
        const u32x4 c_g0 = n_g0, c_g1 = n_g1;
        { *(LAS u32x4*)(qg + row * P72 + 8 * ch) = n_q; *(LAS u32x4*)(kg + row * P72 + 8 * ch) = n_k;
          if (tid < 64) endl[tid] = n_end;
          { LAS bf16* kt = kgT + (8 * ch) * P72 + rcol(row, ch >> 1); const u32x4 wv = n_k;
            kt[0 * P72] = (bf16)(wv.x & 0xffffu); kt[1 * P72] = (bf16)(wv.x >> 16); kt[2 * P72] = (bf16)(wv.y & 0xffffu); kt[3 * P72] = (bf16)(wv.y >> 16);
            kt[4 * P72] = (bf16)(wv.z & 0xffffu); kt[5 * P72] = (bf16)(wv.z >> 16); kt[6 * P72] = (bf16)(wv.w & 0xffffu); kt[7 * P72] = (bf16)(wv.w >> 16); }
#pragma unroll
          for (int i = 0; i < 2; ++i) { const int cc = ch + 8 * i; const u32x4 wv = i ? n_v1 : n_v0; LAS bf16* vt = vT + (8 * cc) * P72 + rcol(row, cc >> 1);
              vt[0 * P72] = (bf16)(wv.x & 0xffffu); vt[1 * P72] = (bf16)(wv.x >> 16); vt[2 * P72] = (bf16)(wv.y & 0xffffu); vt[3 * P72] = (bf16)(wv.y >> 16);
              vt[4 * P72] = (bf16)(wv.z & 0xffffu); vt[5 * P72] = (bf16)(wv.z >> 16); vt[6 * P72] = (bf16)(wv.w & 0xffffu); vt[7 * P72] = (bf16)(wv.w >> 16); } }
        __syncthreads();
        { const int lb = wid >> 1;
#pragma unroll
          for (int q = 0; q < 2; ++q) { const int sb = 2 * (wid & 1) + q; acc4 at = (acc4){0.f, 0.f, 0.f, 0.f};
#pragma unroll
              for (int ks = 0; ks < 2; ++ks) at = MFMA16(frag_nat(qg, P72, 16 * lb + fr, 32 * ks, g), frag_nat(kg, P72, 16 * sb + fr, 32 * ks, g), at);
              const int sidx = 16 * sb + fr;
#pragma unroll
              for (int r = 0; r < 4; ++r) { const int lidx = 16 * lb + 4 * g + r; att[lidx * P72 + sidx] = (bf16)f2bf((sidx <= lidx) ? at[r] : 0.f); } } }
        __syncthreads();
        { const int cn = (c + 1 < NCH) ? c + 1 : c; GL_FETCH(cn); }
#pragma unroll
        for (int lb = 0; lb < 4; ++lb) { acc4 ov = (acc4){0.f, 0.f, 0.f, 0.f};
#pragma unroll
            for (int kk = 0; kk < 2; ++kk) ov = MFMA16(frag_perm(qg, P72, 16 * lb + fr, 32 * kk, g), frag_acc(St[2 * kk], St[2 * kk + 1]), ov);
#pragma unroll
            for (int ks = 0; ks < 2; ++ks) ov = MFMA16(frag_nat(att, P72, 16 * lb + fr, 32 * ks, g), frag_nat_rot(vT, 16 * wid + fr, 32 * ks, g), ov);
#pragma unroll
            for (int r = 0; r < 4; ++r) Ol[(16 * lb + 4 * g + r) * P132 + 16 * wid + fr] = ov[r]; }
#pragma unroll
        for (int kb = 0; kb < 4; ++kb) { const f32x4 bl = *(const LAS f32x4*)(endl + 16 * kb + 4 * g);
#pragma unroll
            for (int ks = 0; ks < 2; ++ks) St[kb] = MFMA16(frag_nat_rot(kgT, 16 * kb + fr, 32 * ks, g), frag_nat_rot(vT, 16 * wid + fr, 32 * ks, g), St[kb]);
#pragma unroll
            for (int r = 0; r < 4; ++r) St[kb][r] *= __expf(bl[r]); }
        __syncthreads();
        { const size_t t = t0 + row; float q2 = 0.f; f32x4 ov[4];
#pragma unroll
          for (int i = 0; i < 4; ++i) { ov[i] = *(const LAS f32x4*)(Ol + row * P132 + 16 * ch + 4 * i); q2 += ov[i][0] * ov[i][0] + ov[i][1] * ov[i][1] + ov[i][2] * ov[i][2] + ov[i][3] * ov[i][3]; }
          q2 = red8_sum(q2);
          const float sc = rsqrtf(q2 * (1.0f / 128.0f) + NORM_EPS);
#pragma unroll
          for (int i = 0; i < 2; ++i) { const u32x4 wg = i ? c_g1 : c_g0; f32x4 g0, g1; unpack8(wg, g0, g1);
              const f32x4 n0 = i ? nw2 : nw0, n1 = i ? nw3 : nw1; f32x4 r0, r1;
#pragma unroll
              for (int e = 0; e < 4; ++e) { r0[e] = ov[2 * i][e] * sc * n0[e] * siluf_(g0[e]); r1[e] = ov[2 * i + 1][e] * sc * n1[e] * siluf_(g1[e]); }
              *(u32x4*)(o + t * 2048 + 1536 + h * 128 + 16 * ch + 8 * i) = pack8(r0, r1); } }
    }
#undef GL_FETCH
    __syncthreads();
}

constexpr int RT = 32, P40 = 40, P328 = 328, P168 = 168;
constexpr int RW_REC = 29184;
constexpr int IM_AT = 0, IM_RT = IM_AT + RT * P72 * 2, IM_KPT = IM_RT + RT * P72 * 2, IM_BPT = IM_KPT + 64 * P40 * 2, IM_VT = IM_BPT + 64 * P40 * 2, IM_MAK = IM_VT + 64 * P40 * 2, IM_ARK = IM_MAK + RT * P40 * 2,
              IM_ARB = IM_ARK + RT * P40 * 2, IM_T1 = IM_ARB + RT * P40 * 2, IM_T2 = IM_T1 + 16 * P40 * 2, IM_GAM = IM_T2 + 16 * P40 * 2, IM_BON = IM_GAM + 256, IM_END = IM_BON + 128;
__device__ __forceinline__ int rw_piece_off(int p) {
    if (p < 512) { const int m = p >> 8, q = p & 255; return (m ? IM_RT : IM_AT) + (q >> 3) * (P72 * 2) + (q & 7) * 16; }
    p -= 512; if (p < 768) { const int m = p >> 8, q = p & 255; return IM_KPT + m * (64 * P40 * 2) + (q >> 2) * (P40 * 2) + (q & 3) * 16; }
    p -= 768; if (p < 384) { const int m = p >> 7, q = p & 127; return IM_MAK + m * (RT * P40 * 2) + (q >> 2) * (P40 * 2) + (q & 3) * 16; }
    p -= 384; if (p < 128) { const int m = p >> 6, q = p & 63; return IM_T1 + m * (16 * P40 * 2) + (q >> 2) * (P40 * 2) + (q & 3) * 16; }
    p -= 128; return IM_GAM + p * 16;
}
constexpr int RW_NPIECE = 1816;
__device__ __forceinline__ unsigned char* rw_rec_ptr(unsigned char* ws, int h, int b, int c) {
    unsigned char* base = (h < 4) ? ws + WS_XG : (h < 6) ? ws + WS_X + X_MIXED : ws + WS_Z + (size_t)T * ZC * 2;
    const int hl = (h < 4) ? h : (h < 6) ? h - 4 : h - 6;
    return base + ((size_t)(hl * BATCH + b) * (SEQ / RT) + c) * RW_REC;
}
static_assert((size_t)4 * BATCH * (SEQ / RT) * RW_REC <= XG_BYTES && (size_t)2 * BATCH * (SEQ / RT) * RW_REC <= (size_t)T * DM * 2 && (size_t)2 * BATCH * (SEQ / RT) * RW_REC <= Z_BYTES - (size_t)T * ZC * 2, "rwkv record regions");

constexpr int RW_WD = 0, RW_WA = RW_WD + 64 * P72 * 2, RW_WG = RW_WA + 64 * P72 * 2, RW_WV = RW_WG + 64 * P168 * 2, RW_HALF0 = RW_WV + 64 * P40 * 2;
constexpr int RH_XLR = 0, RH_LC = 0, RH_KH = RH_LC + RT * 68 * 4, RH_BH = RH_KH + RT * P72 * 2, RH_MAB = RH_BH + RT * P72 * 2, RH_R1_END = RH_MAB + RT * 33 * 4, RH_IMG = 22272, RH_PROJ = RH_IMG, RH_BYTES = RH_IMG + IM_END;
constexpr int RW_PAR = RW_HALF0 + 2 * RH_BYTES;
constexpr int RW_END = RW_PAR + 9 * 64 * 4;
static_assert(RH_R1_END <= RH_IMG && RT * P328 * 2 <= RH_IMG && 4 * RT * P72 * 2 <= IM_GAM && RW_END <= NWAVES * 20352 && (RH_IMG % 16) == 0 && (RH_BYTES % 16) == 0 && (RW_HALF0 % 16) == 0, "rwkv prep LDS");
constexpr int XLR_OFF = 512;
__device__ __forceinline__ void rwkv_xlr_prepass(const ArgsD& a, int l, int bx, int G, const bf16* z, bf16* o) {
    const int tid = opq_v((int)threadIdx.x);
    const float* mu = a.in[I_RW_MU] + l * 1824;
    for (int rb = bx; rb < T / 64; rb += G) {
        u32x4 wc_[5], wp_[5]; f32x4 m0_[5], m1_[5];
#pragma unroll
        for (int i = 0; i < 5; ++i) { const int it = tid + 512 * i, tk = it / 40, q = it - tk * 40; const size_t row = (size_t)rb * 64 + tk;
            const int col = (q < 36) ? 1536 + 8 * q : C_HV + 8 * (q - 36);
            const size_t prow = ((row & (SEQ - 1)) == 0) ? row : row - 1;
            wc_[i] = *(const u32x4*)(z + row * ZC + col); wp_[i] = *(const u32x4*)(z + prow * ZC + col);
            const int mcol = (q < 36) ? col : 1536;
            m0_[i] = *(const f32x4*)(mu + mcol); m1_[i] = *(const f32x4*)(mu + mcol + 4); }
#pragma unroll
        for (int i = 0; i < 5; ++i) { const int it = tid + 512 * i, tk = it / 40, q = it - tk * 40; const size_t row = (size_t)rb * 64 + tk; f32x4 c0v, c1v, p0v, p1v; unpack8(wc_[i], c0v, c1v); unpack8(wp_[i], p0v, p1v);
            if ((row & (SEQ - 1)) == 0) { p0v = (f32x4){0.f, 0.f, 0.f, 0.f}; p1v = p0v; }
            const f32x4 x0 = c0v + (p0v - c0v) * m0_[i], x1 = c1v + (p1v - c1v) * m1_[i];
            const float kk2 = (q < 8) ? 2.0f : 1.0f; f32x4 v0, v1;
#pragma unroll
            for (int e = 0; e < 4; ++e) { const float s0 = sigmoidf_(kk2 * x0[e]), s1 = sigmoidf_(kk2 * x1[e]);
                v0[e] = (q < 8) ? 2.0f * s0 - 1.0f : (q < 16) ? x0[e] : (q < 36) ? s0 : c0v[e]; v1[e] = (q < 8) ? 2.0f * s1 - 1.0f : (q < 16) ? x1[e] : (q < 36) ? s1 : c1v[e]; }
            *(u32x4*)(o + row * 2048 + XLR_OFF + 8 * q) = pack8(v0, v1); }
    }
}
struct PrepPf { u32x4 wzr, wzk, wzv, wpr, wpk, wpv, wvf, xl[5]; };
__device__ __forceinline__ void rwkv_prep_fetch(PrepPf& pf, int l, int h, int b, int cpair, const bf16* z, const bf16* vfirst, const bf16* o) {
    const int tid = opq_v((int)threadIdx.x), lt = tid & 255, c = cpair + (tid >> 8), tok = lt >> 3, C0 = h * 64 + 8 * (lt & 7);
    const size_t t0 = (size_t)b * SEQ + c * RT;
    const bf16* zp = z + (t0 + tok) * ZC + C0; pf.wzr = *(const u32x4*)zp; pf.wzk = *(const u32x4*)(zp + 512); pf.wzv = *(const u32x4*)(zp + 1024);
    const bf16* zq = (c == 0 && tok == 0) ? zp : zp - ZC; pf.wpr = *(const u32x4*)zq; pf.wpk = *(const u32x4*)(zq + 512); pf.wpv = *(const u32x4*)(zq + 1024);
    if (l == 1) pf.wvf = *(const u32x4*)(vfirst + (t0 + tok) * 512 + C0); else pf.wvf = (u32x4){0u, 0u, 0u, 0u};
#pragma unroll
    for (int i = 0; i < 5; ++i) { const int it = lt + 256 * i, tk = it / 40, q = it - tk * 40; pf.xl[i] = *(const u32x4*)(o + (t0 + tk) * 2048 + XLR_OFF + 8 * q); }
}
__device__ __forceinline__ void rwkv_prep_pair(const ArgsD& a, int l, int h, int b, int cpair, int nh, int nb, int ncpair, PrepPf& pf, int& wts_h, LAS unsigned char* lds, const bf16* z, bf16* vfirst, bf16* o, unsigned char* ws) {
    const int tid = opq_v((int)threadIdx.x), lane = tid & 63, wid = __builtin_amdgcn_readfirstlane(tid >> 6), fr = lane & 15, g = lane >> 4;
    const int hf = wid >> 2, lw = wid & 3, lt = tid & 255, c = cpair + hf;
    LAS bf16* Wd = (LAS bf16*)(lds + RW_WD); LAS bf16* Wa = (LAS bf16*)(lds + RW_WA); LAS bf16* Wg = (LAS bf16*)(lds + RW_WG); LAS bf16* Wv = (LAS bf16*)(lds + RW_WV);
    LAS unsigned char* hb_ = lds + RW_HALF0 + hf * RH_BYTES;
    LAS bf16* Xlr = (LAS bf16*)(hb_ + RH_XLR); LAS bf16* Proj = (LAS bf16*)(hb_ + RH_PROJ); LAS float* Lc = (LAS float*)(hb_ + RH_LC);
    LAS bf16* Kh = (LAS bf16*)(hb_ + RH_KH); LAS bf16* Bh = (LAS bf16*)(hb_ + RH_BH); LAS float* Mab = (LAS float*)(hb_ + RH_MAB); LAS unsigned char* img = hb_ + RH_IMG;
    LAS bf16* At = (LAS bf16*)(img + IM_AT); LAS bf16* Rt = (LAS bf16*)(img + IM_RT); LAS bf16* KpT = (LAS bf16*)(img + IM_KPT); LAS bf16* BpT = (LAS bf16*)(img + IM_BPT); LAS bf16* VT = (LAS bf16*)(img + IM_VT);
    LAS bf16* Mak = (LAS bf16*)(img + IM_MAK); LAS bf16* Ark = (LAS bf16*)(img + IM_ARK); LAS bf16* Arb = (LAS bf16*)(img + IM_ARB); LAS bf16* T1 = (LAS bf16*)(img + IM_T1); LAS bf16* T2 = (LAS bf16*)(img + IM_T2);
    LAS float* gam = (LAS float*)(img + IM_GAM); LAS float* bon = (LAS float*)(img + IM_BON);
    if (wts_h != h) { wts_h = h;
        const float* dup = a.in[I_RW_DECAY_UP] + (size_t)l * 64 * 512 + h * 64; const float* aup = a.in[I_RW_A_UP] + (size_t)l * 64 * 512 + h * 64; const float* gup = a.in[I_RW_GATE_UP] + (size_t)l * 160 * 512 + h * 64; const float* vup = a.in[I_VRES_UP] + h * 64;
        { const int k0 = tid >> 6, ch = tid & 63;
          float dv[8], av_[8], gv[20], vv_[4];
#pragma unroll
          for (int j = 0; j < 8; ++j) { dv[j] = dup[(k0 + 8 * j) * 512 + ch]; av_[j] = aup[(k0 + 8 * j) * 512 + ch]; }
#pragma unroll
          for (int j = 0; j < 4; ++j) vv_[j] = vup[(k0 + 8 * j) * 512 + ch];
#pragma unroll
          for (int j = 0; j < 20; ++j) gv[j] = gup[(k0 + 8 * j) * 512 + ch];
#pragma unroll
          for (int j = 0; j < 8; ++j) { Wd[ch * P72 + k0 + 8 * j] = (bf16)f2bf(dv[j]); Wa[ch * P72 + k0 + 8 * j] = (bf16)f2bf(av_[j]); }
#pragma unroll
          for (int j = 0; j < 4; ++j) Wv[ch * P40 + k0 + 8 * j] = (bf16)f2bf(vv_[j]);
#pragma unroll
          for (int j = 0; j < 20; ++j) Wg[ch * P168 + k0 + 8 * j] = (bf16)f2bf(gv[j]); }
        { const int p = tid >> 6, cc = h * 64 + (tid & 63); const float* mu_ = a.in[I_RW_MU] + l * 1824;
          float pv0 = 0.f, pv1 = 0.f;
          pv0 = (p == 0) ? mu_[cc] : (p == 1) ? mu_[512 + cc] : (p == 2) ? mu_[1024 + cc] : (p == 3) ? a.in[I_RW_W0][l * 512 + cc] : (p == 4) ? a.in[I_RW_A0][l * 512 + cc] : (p == 5) ? a.in[I_VRES_V0][cc] : (p == 6) ? a.in[I_RW_KK][l * 512 + cc] : a.in[I_RW_KA][l * 512 + cc];
          if (tid < 64) pv1 = a.in[I_RW_RK][l * 512 + cc];
          LAS float* par_ = (LAS float*)(lds + RW_PAR); par_[tid] = pv0; if (tid < 64) par_[512 + tid] = pv1; } }
    const float* mu = a.in[I_RW_MU] + l * 1824;
    const int tok = lt >> 3, c0 = 8 * (lt & 7), C0 = h * 64 + c0;
    const size_t t0 = (size_t)b * SEQ + c * RT;
    const u32x4 zz4 = {0u, 0u, 0u, 0u}; const bool ftok = (c == 0 && tok == 0);
    const u32x4 wzr = pf.wzr, wzk = pf.wzk, wzv = pf.wzv, wpr = ftok ? zz4 : pf.wpr, wpk = ftok ? zz4 : pf.wpk, wpv = ftok ? zz4 : pf.wpv, wvf = pf.wvf;
#pragma unroll
    for (int i = 0; i < 5; ++i) { const int it = lt + 256 * i, tk = it / 40, q = it - tk * 40; *(LAS u32x4*)(Xlr + tk * P328 + 8 * q) = pf.xl[i]; }
    __syncthreads();
    { const int cb = lw;
#pragma unroll
      for (int p = 0; p < 4; ++p) { const LAS bf16* Wp = (p == 0) ? Wd : (p == 1) ? Wa : (p == 2) ? Wg : Wv; const int wp = (p == 2) ? P168 : (p == 3) ? P40 : P72; const int kb0 = (p == 0) ? 0 : (p == 1) ? 64 : (p == 2) ? 128 : 288;
          const int nks = (p == 2) ? 5 : (p == 3) ? 1 : 2;
#pragma unroll
          for (int rb = 0; rb < 2; ++rb) { acc4 ac = (acc4){0.f, 0.f, 0.f, 0.f};
#pragma unroll
              for (int ks = 0; ks < nks; ++ks) ac = MFMA16(frag_nat(Xlr, P328, 16 * rb + fr, kb0 + 32 * ks, g), frag_nat(Wp, wp, 16 * cb + fr, 32 * ks, g), ac);
#pragma unroll
              for (int r = 0; r < 4; ++r) Proj[(p * RT + 16 * rb + 4 * g + r) * P72 + 16 * cb + fr] = (bf16)f2bf(ac[r]); } } }
    __syncthreads();
    f32x4 rr[2], kk_[2], vv[2], ap[2], bp[2];
    { const size_t row = t0 + tok; f32x4 zr[2], zk[2], zv[2], pr[2], pk[2], pv[2], dw[2], da[2], gg[2], vm[2], vf[2];
      unpack8(wzr, zr[0], zr[1]); unpack8(wzk, zk[0], zk[1]); unpack8(wzv, zv[0], zv[1]); unpack8(wpr, pr[0], pr[1]); unpack8(wpk, pk[0], pk[1]); unpack8(wpv, pv[0], pv[1]); unpack8(wvf, vf[0], vf[1]);
      unpack8(*(const LAS u32x4*)(Proj + (0 * RT + tok) * P72 + c0), dw[0], dw[1]); unpack8(*(const LAS u32x4*)(Proj + (1 * RT + tok) * P72 + c0), da[0], da[1]);
      unpack8(*(const LAS u32x4*)(Proj + (2 * RT + tok) * P72 + c0), gg[0], gg[1]); unpack8(*(const LAS u32x4*)(Proj + (3 * RT + tok) * P72 + c0), vm[0], vm[1]);
      f32x4 ee[2], av[2], vraw[2], kraw[2]; float n2 = 0.f;
#pragma unroll
      for (int hq = 0; hq < 2; ++hq) { const int Cq = C0 + 4 * hq;
          const LAS float* pq = (const LAS float*)(lds + RW_PAR) + c0 + 4 * hq; (void)Cq;
          const f32x4 mur = *(const LAS f32x4*)(pq), muk = *(const LAS f32x4*)(pq + 64), muv = *(const LAS f32x4*)(pq + 128);
          const f32x4 w0c = *(const LAS f32x4*)(pq + 192), a0c = *(const LAS f32x4*)(pq + 256), v0c = *(const LAS f32x4*)(pq + 320), kkc = *(const LAS f32x4*)(pq + 384);
          rr[hq] = zr[hq] + (pr[hq] - zr[hq]) * mur; kraw[hq] = zk[hq] + (pk[hq] - zk[hq]) * muk; vraw[hq] = zv[hq] + (pv[hq] - zv[hq]) * muv;
#pragma unroll
          for (int e = 0; e < 4; ++e) { ee[hq][e] = 0.60653066f * sigmoidf_(w0c[e] + dw[hq][e]); av[hq][e] = sigmoidf_(a0c[e] + da[hq][e]); const float kq = kraw[hq][e] * kkc[e]; n2 += kq * kq;
              vv[hq][e] = (l == 1) ? vraw[hq][e] + (vf[hq][e] - vraw[hq][e]) * sigmoidf_(v0c[e] + vm[hq][e]) : vraw[hq][e]; } }
      if (l == 0) *(u32x4*)(vfirst + row * 512 + C0) = pack8(vraw[0], vraw[1]);
      n2 = red8_sum(n2);
      const float inn = 1.0f / fmaxf(sqrtf(n2), 1e-12f); float bq = 0.f;
#pragma unroll
      for (int hq = 0; hq < 2; ++hq) { const LAS float* pq = (const LAS float*)(lds + RW_PAR) + c0 + 4 * hq; const f32x4 kkc = *(const LAS f32x4*)(pq + 384), kac = *(const LAS f32x4*)(pq + 448), rkc = *(const LAS f32x4*)(pq + 512);
#pragma unroll
          for (int e = 0; e < 4; ++e) { const float kkn = kraw[hq][e] * kkc[e] * inn; kk_[hq][e] = kraw[hq][e] * (1.0f + (av[hq][e] - 1.0f) * kac[e]); ap[hq][e] = -kkn; bp[hq][e] = kkn * av[hq][e]; bq += rr[hq][e] * kk_[hq][e] * rkc[e]; } }
      bq = red8_sum(bq);
      if ((lt & 7) == 0) bon[tok] = bq;
      *(LAS f32x4*)(Lc + tok * 68 + c0) = -ee[0]; *(LAS f32x4*)(Lc + tok * 68 + c0 + 4) = -ee[1];
      *(u32x4*)(o + row * 2048 + C0) = pack8(gg[0], gg[1]); }
    __syncthreads();
#pragma unroll
    for (int q = 0; q < 8; ++q) { const int ch = 16 * lw + 2 * q + (lane >> 5), tk = lane & 31; float x = Lc[tk * 68 + ch];
        x = scan32(x);
        Lc[tk * 68 + ch] = x; }
    __syncthreads();
#pragma unroll
    for (int hq = 0; hq < 2; ++hq) { const int cq = c0 + 4 * hq;
      const f32x4 Lt = *(const LAS f32x4*)(Lc + tok * 68 + cq), Ll = *(const LAS f32x4*)(Lc + (RT - 1) * 68 + cq); f32x4 Lp = (f32x4){0.f, 0.f, 0.f, 0.f}; if (tok > 0) Lp = *(const LAS f32x4*)(Lc + (tok - 1) * 68 + cq);
      f32x4 at_, rt_, kh_, bh_;
#pragma unroll
      for (int e = 0; e < 4; ++e) { const float ep = __expf(Lt[e]), em = __expf(-Lt[e]), el = __expf(Ll[e] - Lt[e]); at_[e] = ap[hq][e] * __expf(Lp[e]); rt_[e] = rr[hq][e] * ep; kh_[e] = kk_[hq][e] * em; bh_[e] = bp[hq][e] * em;
          const int tr_ = (cq + e) * P40 + rcol4(tok, cq >> 4);
          KpT[tr_] = (bf16)f2bf(kk_[hq][e] * el); BpT[tr_] = (bf16)f2bf(bp[hq][e] * el); VT[tr_] = (bf16)f2bf(vv[hq][e]); }
      u32x2 w; w.x = pk2(at_[0], at_[1]); w.y = pk2(at_[2], at_[3]); *(LAS u32x2*)(At + tok * P72 + cq) = w; w.x = pk2(rt_[0], rt_[1]); w.y = pk2(rt_[2], rt_[3]); *(LAS u32x2*)(Rt + tok * P72 + cq) = w;
      w.x = pk2(kh_[0], kh_[1]); w.y = pk2(kh_[2], kh_[3]); *(LAS u32x2*)(Kh + tok * P72 + cq) = w; w.x = pk2(bh_[0], bh_[1]); w.y = pk2(bh_[2], bh_[3]); *(LAS u32x2*)(Bh + tok * P72 + cq) = w;
      if (tok == 0) { f32x4 gv;
#pragma unroll
          for (int e = 0; e < 4; ++e) gv[e] = __expf(Ll[e]);
          *(LAS f32x4*)(gam + cq) = gv; } }
    __syncthreads();
    { const int rb = lw; const LAS bf16* Am = (rb < 2) ? At : Rt;
#pragma unroll
      for (int cb = 0; cb < 4; ++cb) { const LAS bf16* Bm_ = (cb < 2) ? Kh : Bh; acc4 gm = (acc4){0.f, 0.f, 0.f, 0.f};
#pragma unroll
          for (int ks = 0; ks < 2; ++ks) gm = MFMA16(frag_nat(Am, P72, 16 * (rb & 1) + fr, 32 * ks, g), frag_nat(Bm_, P72, 16 * (cb & 1) + fr, 32 * ks, g), gm);
          const int sidx = 16 * (cb & 1) + fr;
#pragma unroll
          for (int r = 0; r < 4; ++r) { const int tidx = 16 * (rb & 1) + 4 * g + r;
              if (rb < 2) { const float v = (sidx < tidx) ? gm[r] : 0.f; if (cb < 2) Mak[tidx * P40 + sidx] = (bf16)f2bf(v); else Mab[tidx * 33 + sidx] = v; }
              else { const float v = (sidx <= tidx) ? gm[r] : 0.f; if (cb < 2) Ark[tidx * P40 + sidx] = (bf16)f2bf(v); else Arb[tidx * P40 + sidx] = (bf16)f2bf(v); } } } }
    __syncthreads();
    rwkv_prep_fetch(pf, l, nh, nb, ncpair, z, vfirst, o);
    if (lw != 0) { unsigned char* rec = rw_rec_ptr(ws, h, b, c);
        for (int p = lt - 64; p < RW_NPIECE - 128; p += 192) { const int pp = (p < 1664) ? p : p + 128; *(u32x4*)(rec + 16 * pp) = *(const LAS u32x4*)(img + rw_piece_off(pp)); } }
    else {
        if (lane < 32) { const int blk = lane >> 4, cc = lane & 15; float x[16]; unsigned moff = (unsigned)((16 * blk) * 33 + 16 * blk) * 4u;
#pragma unroll
            for (int t = 0; t < 16; ++t) { float sacc = (t == cc) ? 1.0f : 0.f;
                if (t > 0) asm volatile("" : "+v"(moff) : "v"(x[t - 1]));
                const LAS float* mp = (const LAS float*)((LAS unsigned char*)Mab + moff) + t * 33;
#pragma unroll
                for (int s2 = 0; s2 < t; ++s2) sacc += mp[s2] * x[s2];
                x[t] = sacc; }
#pragma unroll
            for (int t = 0; t < 16; ++t) { if (blk == 0) { T1[t * P40 + cc] = (bf16)f2bf(x[t]); T1[t * P40 + 16 + cc] = 0; T2[t * P40 + cc] = (bf16)f2bf(Mab[(16 + t) * 33 + cc]); } else T2[t * P40 + 16 + cc] = (bf16)f2bf(x[t]); } }
        { unsigned char* rec = rw_rec_ptr(ws, h, b, c);
#pragma unroll
          for (int k = 0; k < 2; ++k) { const int p = 1664 + lane + 64 * k; *(u32x4*)(rec + 16 * p) = *(const LAS u32x4*)(img + rw_piece_off(p)); } }
    }
    __syncthreads();
}

constexpr int RC_IMG0 = 0, RC_IMG1 = ((IM_END + 255) / 256) * 256, RC_STAT = 2 * RC_IMG1, RC_DUMMY = RC_STAT + RT * 4 * 8, RC_END = RC_DUMMY + 256 * 16;
__device__ __forceinline__ void rwkv_chain_task(const ArgsD& a, int l, int bh, LAS unsigned char* lds, bf16* o, unsigned char* ws) {
    const int tid = opq_v((int)threadIdx.x), lane = tid & 63, wid = __builtin_amdgcn_readfirstlane(tid >> 6), fr = lane & 15, g = lane >> 4;
    const int b = bh >> 3, h = bh & 7;
    LAS f32x2* stat = (LAS f32x2*)(lds + RC_STAT);
    const int ib = wid & 3, Ci = h * 64 + 16 * ib + fr;
    const float lnw = a.in[I_RW_LNW][l * 512 + Ci], lnb = a.in[I_RW_LNB][l * 512 + Ci];
    acc4 St[4];
#pragma unroll
    for (int jb = 0; jb < 4; ++jb) St[jb] = (acc4){0.f, 0.f, 0.f, 0.f};
    u32x4 pv[8]; int poff[8];
#pragma unroll
    for (int i = 0; i < 8; ++i) { const int p = tid - 256 + 256 * i; poff[i] = (p >= 0 && p < RW_NPIECE) ? rw_piece_off(p) : RC_DUMMY + 16 * (tid & 255); pv[i] = (u32x4){0u, 0u, 0u, 0u}; }
#define RC_FETCH(rec_) do { _Pragma("unroll") for (int i_ = 0; i_ < 8; ++i_) { const int p_ = tid - 256 + 256 * i_; pv[i_] = *(const u32x4*)((rec_) + 16 * (p_ < RW_NPIECE ? p_ : 0)); } } while (0)
#define RC_PUT(dst_) do { _Pragma("unroll") for (int i_ = 0; i_ < 8; ++i_) { *(LAS u32x4*)(((i_ < 7 || tid < 256 + RW_NPIECE - 7 * 256) ? (dst_) : lds) + poff[i_]) = pv[i_]; } } while (0)
    if (wid >= 4) { RC_FETCH(rw_rec_ptr(ws, h, b, 0)); RC_PUT(lds + RC_IMG0); RC_FETCH(rw_rec_ptr(ws, h, b, 1)); }
    __syncthreads();
    for (int c = 0; c < SEQ / RT; ++c) {
        LAS unsigned char* img = lds + ((c & 1) ? RC_IMG1 : RC_IMG0);
        acc4 Y0 = (acc4){0.f, 0.f, 0.f, 0.f}, Y1 = Y0; unsigned gpk[2][4] = {{0, 0, 0, 0}, {0, 0, 0, 0}};
        if (wid >= 4) { RC_PUT(lds + ((c & 1) ? RC_IMG0 : RC_IMG1)); const int cf = (c + 2 < SEQ / RT) ? c + 2 : c; RC_FETCH(rw_rec_ptr(ws, h, b, cf)); }
        else {
            { const size_t tq = (size_t)b * SEQ + c * RT;
#pragma unroll
              for (int hb = 0; hb < 2; ++hb)
#pragma unroll
                  for (int r = 0; r < 4; ++r) gpk[hb][r] = o[(tq + 16 * hb + 4 * g + r) * 2048 + Ci]; }
            const LAS bf16* At = (const LAS bf16*)(img + IM_AT); const LAS bf16* Rt = (const LAS bf16*)(img + IM_RT); const LAS bf16* KpT = (const LAS bf16*)(img + IM_KPT); const LAS bf16* BpT = (const LAS bf16*)(img + IM_BPT); const LAS bf16* VT = (const LAS bf16*)(img + IM_VT);
            const LAS bf16* Mak = (const LAS bf16*)(img + IM_MAK); const LAS bf16* Ark = (const LAS bf16*)(img + IM_ARK); const LAS bf16* Arb = (const LAS bf16*)(img + IM_ARB); const LAS bf16* T1 = (const LAS bf16*)(img + IM_T1); const LAS bf16* T2 = (const LAS bf16*)(img + IM_T2);
            const LAS float* gam = (const LAS float*)(img + IM_GAM);
            const bf16x8 Sb0 = frag_acc(St[0], St[1]), Sb1 = frag_acc(St[2], St[3]); const bf16x8 vtf = *(const LAS bf16x8*)(VT + (16 * ib + fr) * P40 + rcol4(8 * g, ib));
            acc4 X0 = (acc4){0.f, 0.f, 0.f, 0.f}, X1 = X0;
            X0 = MFMA16(frag_perm(At, P72, fr, 0, g), Sb0, X0); X0 = MFMA16(frag_perm(At, P72, fr, 32, g), Sb1, X0); X0 = MFMA16(frag_nat(Mak, P40, fr, 0, g), vtf, X0);
            X1 = MFMA16(frag_perm(At, P72, 16 + fr, 0, g), Sb0, X1); X1 = MFMA16(frag_perm(At, P72, 16 + fr, 32, g), Sb1, X1); X1 = MFMA16(frag_nat(Mak, P40, 16 + fr, 0, g), vtf, X1);
            Y0 = MFMA16(frag_perm(Rt, P72, fr, 0, g), Sb0, Y0); Y0 = MFMA16(frag_perm(Rt, P72, fr, 32, g), Sb1, Y0); Y0 = MFMA16(frag_nat(Ark, P40, fr, 0, g), vtf, Y0);
            Y1 = MFMA16(frag_perm(Rt, P72, 16 + fr, 0, g), Sb0, Y1); Y1 = MFMA16(frag_perm(Rt, P72, 16 + fr, 32, g), Sb1, Y1); Y1 = MFMA16(frag_nat(Ark, P40, 16 + fr, 0, g), vtf, Y1);
            const acc4 zero4 = (acc4){0.f, 0.f, 0.f, 0.f};
            const acc4 U0 = MFMA16(frag_perm(T1, P40, fr, 0, g), frag_acc(X0, zero4), zero4);
            const bf16x8 t2f = frag_perm(T2, P40, fr, 0, g);
            const acc4 W1 = MFMA16(t2f, frag_acc(U0, zero4), X1);
            const acc4 U1 = MFMA16(t2f, frag_acc(zero4, W1), zero4);
            const bf16x8 Ub = frag_acc(U0, U1);
            Y0 = MFMA16(frag_perm(Arb, P40, fr, 0, g), Ub, Y0); Y1 = MFMA16(frag_perm(Arb, P40, 16 + fr, 0, g), Ub, Y1);
#pragma unroll
            for (int jb = 0; jb < 4; ++jb) { const f32x4 gm = *(const LAS f32x4*)(gam + 16 * jb + 4 * g); St[jb] = St[jb] * gm;
                const bf16x8 kpf = *(const LAS bf16x8*)(KpT + (16 * jb + fr) * P40 + rcol4(8 * g, jb));
                const LAS bf16* bpp = BpT + (16 * jb + fr) * P40; const u32x2 bv0 = *(const LAS u32x2*)(bpp + rcol4(4 * g, jb)), bv1 = *(const LAS u32x2*)(bpp + rcol4(4 * g + 16, jb)); u32x4 bw; bw.x = bv0.x; bw.y = bv0.y; bw.z = bv1.x; bw.w = bv1.y;
                St[jb] = MFMA16(kpf, vtf, St[jb]); St[jb] = MFMA16(__builtin_bit_cast(bf16x8, bw), Ub, St[jb]); }
#pragma unroll
            for (int r = 0; r < 4; ++r) { float s0 = Y0[r], q0 = Y0[r] * Y0[r], s1 = Y1[r], q1 = Y1[r] * Y1[r];
                s0 = red16_sum(s0); q0 = red16_sum(q0); s1 = red16_sum(s1); q1 = red16_sum(q1);
                if (fr == 0) { stat[(4 * g + r) * 4 + ib] = (f32x2){s0, q0}; stat[(16 + 4 * g + r) * 4 + ib] = (f32x2){s1, q1}; } }
        }
        __syncthreads();
        if (wid < 4) {
            const LAS bf16* VT = (const LAS bf16*)(img + IM_VT); const LAS float* bon = (const LAS float*)(img + IM_BON);
            const size_t t0 = (size_t)b * SEQ + c * RT;
#pragma unroll
            for (int hb = 0; hb < 2; ++hb) { const u32x2 vw = *(const LAS u32x2*)(VT + (16 * ib + fr) * P40 + rcol4(16 * hb + 4 * g, ib)); const f32x4 vv = (f32x4){lo2f(vw.x), hi2f(vw.x), lo2f(vw.y), hi2f(vw.y)};
#pragma unroll
                for (int r = 0; r < 4; ++r) { const int t = 16 * hb + 4 * g + r; const f32x2 s0 = stat[t * 4 + 0], s1 = stat[t * 4 + 1], s2 = stat[t * 4 + 2], s3 = stat[t * 4 + 3];
                    const float mean = ((s0.x + s1.x) + (s2.x + s3.x)) * (1.0f / 64.0f); const float ex2 = ((s0.y + s1.y) + (s2.y + s3.y)) * (1.0f / 64.0f);
                    const float rstd = rsqrtf(fmaxf(ex2 - mean * mean, 0.f) + 64e-5f); const float y = hb ? Y1[r] : Y0[r];
                    bf16* op = o + (t0 + t) * 2048 + Ci; const float gg = bf2f((bf16)gpk[hb][r]);
                    *op = (bf16)f2bf((((y - mean) * rstd * lnw + lnb) + bon[t] * vv[r]) * gg); } }
        }
        __syncthreads();
    }
}

#define XB_TMO      128
#define XB_XCNT(j)  (256  + 64 * (j))
#define XB_XSUB(j)  (1280 + 64 * (j))
#define XB_XGEN(j)  (2304 + 64 * (j))
#define XB_TOP      3328
#define XB_TOPGEN   3392
#define XCD_BAR_WORDS 3456
#define XB_SPIN_CAP (1u << 20)
__device__ __forceinline__ unsigned xb_ld(unsigned* p)              { return __hip_atomic_load(p, __ATOMIC_RELAXED, __HIP_MEMORY_SCOPE_AGENT); }
__device__ __forceinline__ unsigned xb_add(unsigned* p, unsigned v) { return __hip_atomic_fetch_add(p, v, __ATOMIC_RELAXED, __HIP_MEMORY_SCOPE_AGENT); }
__device__ __forceinline__ unsigned xb_xcc_id() { return (unsigned)__builtin_amdgcn_s_getreg((3 << 11) | 20) & 0xFu; }
#define XB_SPIN(cond, bar) do { unsigned _sp = 0; while (cond) { __builtin_amdgcn_s_sleep(1); \
    if ((++_sp & 255u) == 0u) { if (xb_ld(&(bar)[XB_TMO])) break; if (_sp > XB_SPIN_CAP) { atomicAdd(&(bar)[XB_TMO], 1u); break; } } } } while (0)
__device__ __forceinline__ void xcd_barrier_complete(unsigned* bar, unsigned x, unsigned& nloc, unsigned& nx) {
    const unsigned G = gridDim.x * gridDim.y * gridDim.z;
    unsigned sum, cnt, mine, sp = 0u;
    for (;;) {
        sum = 0u; cnt = 0u; mine = 0u;
#pragma unroll
        for (unsigned j = 0; j < 16; ++j) { const unsigned c = xb_ld(&bar[XB_XCNT(j)]); sum += c; cnt += (c > 0u) ? 1u : 0u; mine = (j == x) ? c : mine; }
        if (sum == G) break;
        __builtin_amdgcn_s_sleep(1);
        if ((++sp & 255u) == 0u) { if (xb_ld(&bar[XB_TMO])) break; if (sp > XB_SPIN_CAP) { atomicAdd(&bar[XB_TMO], 1u); break; } }
    }
    nloc = mine > 0u ? mine : 1u; nx = cnt > 0u ? cnt : 1u;
}
__device__ __forceinline__ void xcd_barrier(unsigned* bar, volatile LAS unsigned* st) {
    asm volatile("s_waitcnt vmcnt(0)" ::: "memory");
    __syncthreads();
    if (threadIdx.x == 0) {
        __builtin_amdgcn_s_waitcnt(0);
        unsigned nloc = st[0], nx = st[1]; const unsigned x = st[2];
        if (nloc == 0u) { xcd_barrier_complete(bar, x, nloc, nx); st[0] = nloc; st[1] = nx; }
        const unsigned old = xb_add(&bar[XB_XSUB(x)], 1u);
        const unsigned gen = old / nloc;
        if (old + 1u == (gen + 1u) * nloc) {
            __builtin_amdgcn_fence(__ATOMIC_RELEASE, "agent");
            asm volatile("s_waitcnt vmcnt(0)" ::: "memory");
            const unsigned og = xb_add(&bar[XB_TOP], 1u);
            const unsigned tg = og / nx;
            if (og + 1u == (tg + 1u) * nx) xb_add(&bar[XB_TOPGEN], 1u);
            else XB_SPIN(xb_ld(&bar[XB_TOPGEN]) == tg, bar);
            __builtin_amdgcn_fence(__ATOMIC_ACQUIRE, "agent");
            xb_add(&bar[XB_XGEN(x)], 1u);
            asm volatile("s_waitcnt vmcnt(0)" ::: "memory");
        } else {
            XB_SPIN(xb_ld(&bar[XB_XGEN(x)]) == gen, bar);
            __builtin_amdgcn_fence(__ATOMIC_ACQUIRE, "agent");
            asm volatile("s_waitcnt vmcnt(0)" ::: "memory");
        }
    }
    __syncthreads();
}

constexpr int LDS_WSCR = 20352;
constexpr int LDS_TOTAL = NWAVES * LDS_WSCR + 1024;
static_assert(LDS_TOTAL <= 163840 && NWAVES * LDS_WSCR >= LDS_MAIN, "LDS map");
constexpr int NPH = 22;
#ifndef MIXMASK
#define MIXMASK 15
#endif
#define MIX_T(bit, call) do { if ((MIXMASK) & (bit)) { call; } } while (0)

#define PHASE_PTRS \
    const int tid = opq_v((int)threadIdx.x), lane = tid & 63, wid = __builtin_amdgcn_readfirstlane(tid >> 6); (void)lane; (void)wid; \
    const int G = opq_s((int)gridDim.x), bx = opq_s((int)blockIdx.x); const int gw = bx * NWAVES + wid, ngw = G * NWAVES; (void)gw; (void)ngw; \
    LAS unsigned char* lds = (LAS unsigned char*)lds_raw; LAS unsigned* lctl = (LAS unsigned*)(lds + NWAVES * LDS_WSCR); (void)lctl; \
    ArgsD a; a.in.tab = (LAS unsigned long long*)(lds + NWAVES * LDS_WSCR + 640); \
    unsigned char* ws = a.ws(); float* a_out = a.out(); (void)a_out; \
    unsigned* ctl = (unsigned*)(ws + WS_CTL); (void)ctl; \
    float* ssb = (float*)(ws + WS_SMALL + SM_SS); (void)ssb; \
    float* mssq = (float*)(ws + WS_SMALL + SM_MSSQ); (void)mssq; \
    int* tok_e = (int*)(ws + WS_SMALL + SM_TOKE); float* tok_g = (float*)(ws + WS_SMALL + SM_TOKG); float* tok_rs = (float*)(ws + WS_SMALL + SM_TOKRS); (void)tok_e; (void)tok_g; (void)tok_rs; \
    int* tok_slot = (int*)(ws + WS_SMALL + SM_TOKSLOT); int* row_tok = (int*)(ws + WS_SMALL + SM_ROWTOK); float* row_gate = (float*)(ws + WS_SMALL + SM_ROWGATE); float* row_rs = (float*)(ws + WS_SMALL + SM_ROWRS); (void)tok_slot; (void)row_tok; (void)row_gate; (void)row_rs; \
    bf16* xb = (bf16*)(ws + WS_XB); (void)xb; \
    bf16* vfirst = (bf16*)(ws + WS_X + X_VFIRST); bf16* mixed = (bf16*)(ws + WS_X + X_MIXED); bf16* obuf = (bf16*)(ws + WS_X + X_O); (void)vfirst; (void)mixed; (void)obuf; \
    unsigned char* wreg = ws + WS_X + X_W; (void)wreg; \
    bf16* zbuf = (bf16*)(ws + WS_Z); bf16* gates = zbuf; bf16* hidden = zbuf; bf16* act = zbuf; (void)gates; (void)hidden; (void)act; \
    bf16* xg = (bf16*)(ws + WS_XG); bf16* ybuf = xg; bf16* rwarr = xg; (void)ybuf; (void)rwarr; bf16* ypart = (bf16*)(ws + WS_Z + (size_t)128 * MiB); (void)ypart; bf16* bcv = (bf16*)(ws + WS_BCV); (void)bcv; float* gend = (float*)(ws + WS_GEND); (void)gend; \
    bf16* moe_w13 = (bf16*)(ws + WS_X + MOE_W13); bf16* moe_w2 = (bf16*)(ws + WS_X + MOE_W2); (void)moe_w13; (void)moe_w2;

#define IDLE_CVT_BEGIN(nwg_) { const int p0_ = (nwg_) % G; if (bx >= p0_) { CvtCtx cx; cx.gw = (bx - p0_) * NWAVES + wid; cx.ngw = (G - p0_) * NWAVES; cx.base = 0; cx.lane = lane; cx.scr = (LAS float*)(lds + wid * LDS_WSCR); \
        const int zt_ = (bx - p0_) * NTHREADS + tid, zn_ = (G - p0_) * NTHREADS; (void)zt_; (void)zn_;
#define IDLE_CVT_END } }
#define CVT_LAYER_REST(l_) do { const float* win_ = a.in[I_WIN] + (size_t)(l_) * DM * IN_COLS; const float* nm_ = a.in[I_NORM_MIX] + (l_) * DM; \
        cvt_job_gates(cx, win_, IN_COLS, DM, MIXC, nm_, (bf16*)(wreg + W_G) + (size_t)(l_) * 4096 * DM); \
        for (int i_ = 0; i_ < 4; ++i_) cvt_job(cx, a.in[I_WBRANCH] + ((size_t)(l_) * 4 + i_) * 512 * DM, DM, 512, 0, DM, nullptr, (bf16*)(wreg + W_B) + ((size_t)(l_) * 4 + i_) * DM * 512, 0, 128); \
        cvt_job(cx, a.in[I_WOUT] + (size_t)(l_) * DM * DM, DM, DM, 0, DM, nullptr, (bf16*)(wreg + W_O) + (size_t)(l_) * DM * DM, 0, 128); } while (0)
template <int LO, int HI>
__device__ __forceinline__ void mk_body(const Args& ka) {
    extern __shared__ __attribute__((aligned(16))) unsigned char lds_raw[];
    { LAS unsigned long long* ptab = (LAS unsigned long long*)((LAS unsigned char*)lds_raw + NWAVES * LDS_WSCR + 640);
      const int t0 = threadIdx.x;
      if (t0 < N_IN) ptab[t0] = (unsigned long long)ka.in[t0];
      if (t0 == N_IN) ptab[t0] = (unsigned long long)ka.out;
      if (t0 == N_IN + 1) ptab[t0] = (unsigned long long)ka.ws;
#if !MK_PER_PHASE
      if (t0 == 64) { LAS unsigned* st = (LAS unsigned*)((LAS unsigned char*)lds_raw + NWAVES * LDS_WSCR + 992); st[0] = 0u; st[1] = 0u; const unsigned x = xb_xcc_id(); st[2] = x;
          (void)xb_add((unsigned*)(ka.ws + WS_CTL) + CW_BAR + XB_XCNT(x), 1u); }
#endif
      __syncthreads(); }
#if MK_PER_PHASE
#define GRID_BAR() do { } while (0)
#else
#define GRID_BAR() do { unsigned char* ws_ = ArgsD{PT{(LAS unsigned long long*)((LAS unsigned char*)lds_raw + NWAVES * LDS_WSCR + 640)}}.ws(); \
    xcd_barrier((unsigned*)(ws_ + WS_CTL) + CW_BAR, (volatile LAS unsigned*)((LAS unsigned char*)lds_raw + NWAVES * LDS_WSCR + 992)); } while (0)
#endif
#define IN(k) (LO <= (k) && (k) < HI)
#if MK_PER_PHASE
#define SPLIT_ARRIVE(w) do { } while (0)
#define SPLIT_WAIT(w) do { } while (0)
#else
#define SPLIT_ARRIVE(w) do { asm volatile("s_waitcnt vmcnt(0)" ::: "memory"); __syncthreads(); if (threadIdx.x == 0) { unsigned* c_ = (unsigned*)(ArgsD{PT{(LAS unsigned long long*)((LAS unsigned char*)lds_raw + NWAVES * LDS_WSCR + 640)}}.ws() + WS_CTL); \
        __builtin_amdgcn_fence(__ATOMIC_RELEASE, "agent"); asm volatile("s_waitcnt vmcnt(0)" ::: "memory"); xb_add(c_ + CW_SPLIT + 64 * (w), 1u); } } while (0)
#define SPLIT_WAIT(w) do { if (threadIdx.x == 0) { unsigned* c_ = (unsigned*)(ArgsD{PT{(LAS unsigned long long*)((LAS unsigned char*)lds_raw + NWAVES * LDS_WSCR + 640)}}.ws() + WS_CTL); \
        XB_SPIN(xb_ld(c_ + CW_SPLIT + 64 * (w)) < gridDim.x, c_ + CW_BAR); __builtin_amdgcn_fence(__ATOMIC_ACQUIRE, "agent"); asm volatile("s_waitcnt vmcnt(0)" ::: "memory"); } __syncthreads(); } while (0)
#endif
#define SEAM(k) do { if (IN(k) && IN((k) + 1)) GRID_BAR(); } while (0)

    if (IN(0)) { PHASE_PTRS
        CvtCtx cx; cx.gw = gw; cx.ngw = ngw; cx.base = 0; cx.lane = lane; cx.scr = (LAS float*)(lds + wid * LDS_WSCR);
        { const float* win = a.in[I_WIN]; const float* nm = a.in[I_NORM_MIX]; bf16* winT = (bf16*)(wreg + W_IN);
          cvt_job(cx, win, IN_COLS, DM, 0, MIXC, nm, winT, 0, 128);
          zero_rows_bf16(bx * NTHREADS + tid, G * NTHREADS, winT + (size_t)C_HV * DM, (size_t)(ZC - C_HV) * DM); }
        const float* x = a.in[I_X];
        for (int m = gw; m < T; m += ngw) { const f32x4* xr = (const f32x4*)(x + (size_t)m * DM) + lane; float s = 0.f;
#pragma unroll
            for (int j = 0; j < 4; ++j) { const f32x4 v = xr[64 * j]; s += (v[0] * v[0] + v[1] * v[1]) + (v[2] * v[2] + v[3] * v[3]); u32x2 w; w.x = pk2(v[0], v[1]); w.y = pk2(v[2], v[3]); *((u32x2*)(xb + (size_t)m * DM) + lane + 64 * j) = w; }
            s = wave_sum(s); if (lane < 16) ssb[(size_t)m * 16 + lane] = (lane == 0) ? s : 0.f; }
    }
#if MK_PER_PHASE
    SEAM(0);
#else
    if (IN(0) && IN(1)) { cg::this_grid().sync(); }
#endif

#pragma unroll
    for (int l = 0; l < 2; ++l) {
        const int pb = 1 + 9 * l;
#define ss_mix (ssb + (size_t)(l == 0 ? 0 : 2) * T * 16)
#define ss_ffn (l == 0 ? ssb + (size_t)T * 16 : (float*)nullptr)
        if (IN(pb + 0)) { PHASE_PTRS
            pg8::Gemm g{DM, DM, DM}; pg8::StaticOrder S; S.init(xb, (bf16*)(wreg + W_IN) + (size_t)l * ZC * DM, DM, DM, T, ZC, G, bx);
            EpiScaleBf16<0> E{zbuf, ZC, ss_mix};
            pg8::gemm_phase(lds, g, S, E);
            IDLE_CVT_BEGIN((T / 256) * (ZC / 256))
                CVT_LAYER_REST(l);
                if (l == 0) {
#if FFN_FP8
                    cvt_job8(cx, a.in[I_FFN_W1], FFN, DM, 0, FFN, a.in[I_NORM_FFN], 32.0f, wreg + W_13, 0, 256);
                    cvt_job8(cx, a.in[I_FFN_W3], FFN, DM, 0, FFN, a.in[I_NORM_FFN], 32.0f, wreg + W_13, 128, 256);
                    cvt_job8(cx, a.in[I_FFN_W2], DM, FFN, 0, DM, nullptr, 64.0f, wreg + W_2, 0, 128);
#else
                    cvt_job(cx, a.in[I_FFN_W1], FFN, DM, 0, FFN, a.in[I_NORM_FFN], (bf16*)(wreg + W_13), 0, 256);
                    cvt_job(cx, a.in[I_FFN_W3], FFN, DM, 0, FFN, a.in[I_NORM_FFN], (bf16*)(wreg + W_13), 128, 256);
                    cvt_job(cx, a.in[I_FFN_W2], DM, FFN, 0, DM, nullptr, (bf16*)(wreg + W_2), 0, 128);
#endif
                }
            IDLE_CVT_END
        }
        SEAM(pb + 0);
        if (IN(pb + 1)) { PHASE_PTRS
            rwkv_xlr_prepass(a, l, bx, G, zbuf, obuf);
            if (IN(pb + 2)) SPLIT_ARRIVE(2 + l);
            mamba_bc_prepass(a, l, gw, ngw, lane, zbuf, bcv);
            gla_prepass(a, l, bx, G, lds, zbuf, gend);
        }
        if (IN(pb + 1) && IN(pb + 2)) SPLIT_WAIT(2 + l);
        if (IN(pb + 2)) { PHASE_PTRS
            const int npair = 8 * BATCH * (SEQ / RT) / 2, ppb = (npair + G - 1) / G; int wts_h = -1;
            const int u0 = bx * ppb, u1 = ((bx + 1) * ppb < npair) ? (bx + 1) * ppb : npair;
            if (u0 < u1) { PrepPf pf; rwkv_prep_fetch(pf, l, u0 >> 8, (u0 >> 5) & 7, 2 * (u0 & 31), zbuf, vfirst, obuf);
                for (int u = u0; u < u1; ++u) { const int un = (u + 1 < u1) ? u + 1 : u;
                    rwkv_prep_pair(a, l, u >> 8, (u >> 5) & 7, 2 * (u & 31), un >> 8, (un >> 5) & 7, 2 * (un & 31), pf, wts_h, lds, zbuf, vfirst, obuf, ws); } } }
        SEAM(pb + 2);
        if (IN(pb + 3)) { PHASE_PTRS
            if (bx < 64) { MIX_T(1, rwkv_chain_task(a, l, bx, lds, obuf, ws)); }
            else if (bx < 128) { MIX_T(2, mamba_block_task(a, l, bx - 64, lds, zbuf, bcv, obuf, mssq)); }
            else if (bx < 160) { MIX_T(4, gla_block_task(a, l, bx - 128, lds, zbuf, gend, obuf)); }
            MIX_T(8, attn_drain(a, l, lds, lctl, ctl + CW_ATTQ + l, zbuf, obuf));
        }
        SEAM(pb + 3);
        if (IN(pb + 4)) { PHASE_PTRS
            const float* nw = a.in[I_SSM_NORMW] + l * 512;
            for (int m = gw; m < T; m += ngw) { const int g = lane >> 5; const float* q = mssq + (size_t)m * 8 + g * 4; const float sc = rsqrtf((q[0] + q[1] + q[2] + q[3]) * (1.0f / 256.0f) + NORM_EPS);
                bf16* p = obuf + (size_t)m * 2048 + 512 + lane * 8; const u32x4 w = *(const u32x4*)p; f32x4 v0, v1; unpack8(w, v0, v1);
                const f32x4 n0 = *(const f32x4*)(nw + lane * 8), n1 = *(const f32x4*)(nw + lane * 8 + 4);
                *(u32x4*)p = pack8(v0 * n0 * sc, v1 * n1 * sc); }
            pg8::Gemm g{DM, DM, DM}; pg8::StaticOrder S; S.init(xb, (bf16*)(wreg + W_G) + (size_t)l * 4096 * DM, DM, DM, T, 4096, G, bx);
            EpiGateRatio E{gates, ss_mix};
            pg8::gemm_phase(lds, g, S, E);
        }
        SEAM(pb + 4);
        if (IN(pb + 5)) { PHASE_PTRS
            pg8::Gemm g{2048, 512, 512}; MixOrder S{(const char*)obuf, (const char*)((bf16*)(wreg + W_B) + (size_t)l * 4 * DM * 512), G, bx};
            EpiMix E{gates, mixed};
            pg8::gemm_phase(lds, g, S, E);
        }
        SEAM(pb + 5);
        if (IN(pb + 6)) { PHASE_PTRS
            pg8::Gemm g{DM, DM, DM}; pg8::StaticOrder S; S.init(mixed, (bf16*)(wreg + W_O) + (size_t)l * DM * DM, DM, DM, T, DM, G, bx);
            EpiResid<false> E{l == 0 ? a.in[I_X] : a_out, a_out, xb, ss_ffn, (FFN_FP8 && l == 0) ? (unsigned char*)xg : (unsigned char*)nullptr};
            pg8::gemm_phase(lds, g, S, E);
        }
        if (l == 0) SEAM(pb + 6); else if (IN(pb + 6) && IN(pb + 7)) SPLIT_ARRIVE(0);
        if (l == 0) {
            if (IN(pb + 7)) { PHASE_PTRS
#if FFN_FP8
                pg8::Gemm g{DM / 2, DM / 2, DM / 2}; pg8::StaticOrder S; S.init(xg, (bf16*)(wreg + W_13), DM / 2, DM / 2, T, 2 * FFN, G, bx);
                EpiSwiglu<false, true> E{hidden, FFN, ss_ffn};
#else
                pg8::Gemm g{DM, DM, DM}; pg8::StaticOrder S; S.init(xb, (bf16*)(wreg + W_13), DM, DM, T, 2 * FFN, G, bx);
                EpiSwiglu<false, false> E{hidden, FFN, ss_ffn};
#endif
                pg8::gemm_phase(lds, g, S, E);
                IDLE_CVT_BEGIN((T / 256) * (2 * FFN / 256))
                    const float* win = a.in[I_WIN] + (size_t)DM * IN_COLS; const float* nm = a.in[I_NORM_MIX] + DM; bf16* winT = (bf16*)(wreg + W_IN) + (size_t)ZC * DM;
                    cvt_job(cx, win, IN_COLS, DM, 0, MIXC, nm, winT, 0, 128);
                    cvt_job(cx, a.in[I_VRES_DOWN], 32, DM, 0, 32, nm, winT, C_HV, 128);
                    zero_rows_bf16(zt_, zn_, winT + (size_t)(C_HV + 32) * DM, (size_t)(ZC - C_HV - 32) * DM);
                IDLE_CVT_END
            }
            SEAM(pb + 7);
            if (IN(pb + 8)) { PHASE_PTRS
#if FFN_FP8
                pg8::Gemm g{FFN / 2, FFN / 2, FFN / 2}; pg8::StaticOrder S; S.init(hidden, (bf16*)(wreg + W_2), FFN / 2, FFN / 2, T, DM, G, bx);
                EpiResid<true> E{a_out, a_out, xb, ssb + (size_t)2 * T * 16, nullptr};
#else
                pg8::Gemm g{FFN, FFN, FFN}; pg8::StaticOrder S; S.init(hidden, (bf16*)(wreg + W_2), FFN, FFN, T, DM, G, bx);
                EpiResid<false> E{a_out, a_out, xb, ssb + (size_t)2 * T * 16, nullptr};
#endif
                pg8::gemm_phase(lds, g, S, E);
            }
            SEAM(pb + 8);
        }
    }
    if (IN(17)) { PHASE_PTRS
        if (tid < 8) lctl[tid] = 0u;
        __syncthreads();
        const float* nf_ = a.in[I_NORM_FFN] + DM;
        CvtCtx cx; cx.gw = gw; cx.ngw = ngw; cx.base = 0; cx.lane = lane; cx.scr = (LAS float*)(lds + wid * LDS_WSCR);
#define MOE_CVT13(e_) do { unsigned char* w13_8 = (unsigned char*)moe_w13 + (size_t)(e_) * 2 * EDIM * DM; \
            cvt_job8(cx, a.in[I_MOE_W1] + (size_t)(e_) * DM * EDIM, EDIM, DM, 0, EDIM, nf_, 32.0f, w13_8, 0, 256); cvt_job8(cx, a.in[I_MOE_W3] + (size_t)(e_) * DM * EDIM, EDIM, DM, 0, EDIM, nf_, 32.0f, w13_8, 128, 256); } while (0)
        for (int e = 0; e < NEXP; ++e) { unsigned char* w2_8 = (unsigned char*)moe_w13 + (size_t)NEXP * 2 * EDIM * DM + (size_t)e * DM * EDIM;
            cvt_job8(cx, a.in[I_MOE_W2] + (size_t)e * EDIM * DM, DM, EDIM, 0, DM, nullptr, 64.0f, w2_8, 0, 128); }
        for (int e = 0; e < 2; ++e) MOE_CVT13(e);
        if (IN(16)) SPLIT_WAIT(0);
        const float* nf = a.in[I_NORM_FFN] + DM; const float* wr = a.in[I_MOE_ROUTER];
        for (int m = gw; m < T; m += ngw) { const f32x4* xr = (const f32x4*)(a_out + (size_t)m * DM) + lane; f32x4 v[4]; float s = 0.f;
#pragma unroll
            for (int j = 0; j < 4; ++j) { v[j] = xr[64 * j]; s += (v[j][0] * v[j][0] + v[j][1] * v[j][1]) + (v[j][2] * v[j][2] + v[j][3] * v[j][3]); }
            const float rs = rsqrtf(wave_sum(s) * (1.0f / DM) + NORM_EPS);
            float lg[8];
#pragma unroll
            for (int e = 0; e < 8; ++e) lg[e] = 0.f;
#pragma unroll
            for (int j = 0; j < 4; ++j) { const int k0 = 4 * (lane + 64 * j); const f32x4 gn = *(const f32x4*)(nf + k0);
#pragma unroll
                for (int q = 0; q < 4; ++q) { const float hf = v[j][q] * rs * gn[q]; const f32x4 w0 = *(const f32x4*)(wr + (size_t)(k0 + q) * 8), w1 = *(const f32x4*)(wr + (size_t)(k0 + q) * 8 + 4);
                    lg[0] += hf * w0[0]; lg[1] += hf * w0[1]; lg[2] += hf * w0[2]; lg[3] += hf * w0[3]; lg[4] += hf * w1[0]; lg[5] += hf * w1[1]; lg[6] += hf * w1[2]; lg[7] += hf * w1[3]; } }
#pragma unroll
            for (int e = 0; e < 8; ++e) lg[e] = wave_sum(lg[e]);
            int e0 = 0; float v0 = lg[0];
#pragma unroll
            for (int e = 1; e < 8; ++e) if (lg[e] > v0) { v0 = lg[e]; e0 = e; }
            int e1 = -1; float v1 = -3.0e38f;
#pragma unroll
            for (int e = 0; e < 8; ++e) if (e != e0 && lg[e] > v1) { v1 = lg[e]; e1 = e; }
            if (e1 < 0) { e1 = (e0 == 0) ? 1 : 0; v1 = v0; }
            const float g0 = 1.0f / (1.0f + __expf(v1 - v0));
            if (lane == 0) { tok_e[2 * m] = e0; tok_e[2 * m + 1] = e1; tok_g[2 * m] = g0; tok_g[2 * m + 1] = 1.0f - g0; tok_rs[m] = rs;
                __hip_atomic_fetch_add(lctl + e0, 1u, __ATOMIC_RELAXED, __HIP_MEMORY_SCOPE_WORKGROUP); __hip_atomic_fetch_add(lctl + e1, 1u, __ATOMIC_RELAXED, __HIP_MEMORY_SCOPE_WORKGROUP); } }
        __syncthreads();
        if (tid < 8) atomicAdd(ctl + CW_MOECNT + tid, lctl[tid]);
        if (IN(18)) SPLIT_ARRIVE(1);
        for (int e = 2; e < NEXP; ++e) MOE_CVT13(e);
#undef MOE_CVT13
    }
    if (IN(17) && IN(18)) SPLIT_WAIT(1);

    if (IN(18)) { PHASE_PTRS
        unsigned cnt[8]; int base[8];
        { int acc = 0;
#pragma unroll
          for (int e = 0; e < 8; ++e) { cnt[e] = (unsigned)__builtin_amdgcn_readfirstlane((int)__hip_atomic_load(ctl + CW_MOECNT + e, __ATOMIC_RELAXED, __HIP_MEMORY_SCOPE_AGENT)); base[e] = acc; acc += (int)((cnt[e] + 255u) & ~255u); } }
        LAS unsigned* lcnt = lctl; LAS int* lstart = (LAS int*)(lctl + 8); LAS int* pslot = (LAS int*)(lctl + 16);
        for (int tgp = bx; tgp < T / 64; tgp += G) {
            if (tid < 8) lcnt[tid] = 0u;
            __syncthreads();
            int e0 = 0, e1 = 0, r0 = 0, r1 = 0; const int tok = tgp * 64 + tid;
            if (tid < 64) { e0 = tok_e[2 * tok]; e1 = tok_e[2 * tok + 1]; r0 = (int)__hip_atomic_fetch_add(lcnt + e0, 1u, __ATOMIC_RELAXED, __HIP_MEMORY_SCOPE_WORKGROUP); r1 = (int)__hip_atomic_fetch_add(lcnt + e1, 1u, __ATOMIC_RELAXED, __HIP_MEMORY_SCOPE_WORKGROUP); }
            __syncthreads();
            if (tid < 8) { int bsel = 0;
#pragma unroll
                for (int e = 0; e < 8; ++e) bsel = (tid == e) ? base[e] : bsel;
                lstart[tid] = bsel + (int)atomicAdd(ctl + CW_MOECUR + tid, lcnt[tid]); }
            __syncthreads();
            if (tid < 64) { const int s0 = lstart[e0] + r0, s1 = lstart[e1] + r1; pslot[2 * tid] = s0; pslot[2 * tid + 1] = s1;
                { int enc0 = s0, enc1 = s1;
#pragma unroll
                  for (int e = 0; e < 8; ++e) { const int fullr = (int)(cnt[e] & ~255u); int pi = 0;
#pragma unroll
                      for (int q = 0; q < 8; ++q) pi += (q < e && (cnt[q] & 255u)) ? 1 : 0;
                      if (e0 == e && s0 - base[e] >= fullr) enc0 = -(1 + pi * 256 + (s0 - base[e] - fullr));
                      if (e1 == e && s1 - base[e] >= fullr) enc1 = -(1 + pi * 256 + (s1 - base[e] - fullr)); }
                  tok_slot[2 * tok] = enc0; tok_slot[2 * tok + 1] = enc1; }
                const float rs = tok_rs[tok];
                row_tok[s0] = tok; row_tok[s1] = tok; row_gate[s0] = tok_g[2 * tok]; row_gate[s1] = tok_g[2 * tok + 1]; row_rs[s0] = rs; row_rs[s1] = rs; }
            __syncthreads();
            { u32x4 sv[8][2];
#pragma unroll
              for (int q = 0; q < 8; ++q) { const u32x4* src = (const u32x4*)(xb + (size_t)(tgp * 64 + wid * 8 + q) * DM) + 2 * lane; sv[q][0] = src[0]; sv[q][1] = src[1]; }
#pragma unroll
              for (int q = 0; q < 8; ++q) { const int tl = wid * 8 + q;
                f32x4 v0, v1, v2, v3; unpack8(sv[q][0], v0, v1); unpack8(sv[q][1], v2, v3); u32x4 w8; int t;
                t = 0; t = __builtin_amdgcn_cvt_pk_fp8_f32(v0[0], v0[1], t, false); t = __builtin_amdgcn_cvt_pk_fp8_f32(v0[2], v0[3], t, true); w8.x = (unsigned)t;
                t = 0; t = __builtin_amdgcn_cvt_pk_fp8_f32(v1[0], v1[1], t, false); t = __builtin_amdgcn_cvt_pk_fp8_f32(v1[2], v1[3], t, true); w8.y = (unsigned)t;
                t = 0; t = __builtin_amdgcn_cvt_pk_fp8_f32(v2[0], v2[1], t, false); t = __builtin_amdgcn_cvt_pk_fp8_f32(v2[2], v2[3], t, true); w8.z = (unsigned)t;
                t = 0; t = __builtin_amdgcn_cvt_pk_fp8_f32(v3[0], v3[1], t, false); t = __builtin_amdgcn_cvt_pk_fp8_f32(v3[2], v3[3], t, true); w8.w = (unsigned)t;
#pragma unroll
                for (int k = 0; k < 2; ++k) *((u32x4*)((unsigned char*)xg + (size_t)pslot[2 * tl + k] * DM) + lane) = w8; } }
            __syncthreads();
        }
        for (int idx = gw; idx < 8 * 256; idx += ngw) { const int e = idx >> 8, r = idx & 255; unsigned ce = 0; int be = 0;
#pragma unroll
            for (int q = 0; q < 8; ++q) { ce = (e == q) ? cnt[q] : ce; be = (e == q) ? base[q] : be; }
            const int rem = (int)(ce & 255u);
            if (rem != 0 && r >= rem) { const int slot = be + (int)(ce & ~255u) + r; u32x4 zz = {0u, 0u, 0u, 0u}; *((u32x4*)((unsigned char*)xg + (size_t)slot * DM) + lane) = zz;
                if (lane == 0) { row_tok[slot] = -1; row_gate[slot] = 0.f; row_rs[slot] = 0.f; } } }
    }
    SEAM(18);
    if (IN(19)) { PHASE_PTRS
        unsigned cnt[8];
#pragma unroll
        for (int e = 0; e < 8; ++e) cnt[e] = (unsigned)__builtin_amdgcn_readfirstlane((int)__hip_atomic_load(ctl + CW_MOECNT + e, __ATOMIC_RELAXED, __HIP_MEMORY_SCOPE_AGENT));
        pg8::Gemm g{DM / 2, DM / 2, DM / 2}; MoeOrder S; S.init(xg, DM / 2, moe_w13, DM / 2, (size_t)2 * EDIM * DM, 2 * EDIM / 256, cnt, G, bx);
        EpiSwiglu<true> E{act, EDIM, row_rs};
        pg8::gemm_phase(lds, g, S, E);
    }
    SEAM(19);
    if (IN(20)) { PHASE_PTRS
        unsigned cnt[8];
#pragma unroll
        for (int e = 0; e < 8; ++e) cnt[e] = (unsigned)__builtin_amdgcn_readfirstlane((int)__hip_atomic_load(ctl + CW_MOECNT + e, __ATOMIC_RELAXED, __HIP_MEMORY_SCOPE_AGENT));
        pg8::Gemm g{EDIM / 2, EDIM / 2, EDIM / 2}; MoeDownOrder S; S.init(act, EDIM / 2, (unsigned char*)moe_w13 + (size_t)NEXP * 2 * EDIM * DM, EDIM / 2, (size_t)DM * EDIM, cnt, G, bx);
        EpiMoeDownSplit E{ybuf, ypart, row_gate};
        pg8::gemm_phase(lds, g, S, E);
    }
    SEAM(20);
    if (IN(21)) { PHASE_PTRS
        int ns0 = 0, ns1 = 0; if (gw < T) { ns0 = tok_slot[2 * gw]; ns1 = tok_slot[2 * gw + 1]; }
        for (int m = gw; m < T; m += ngw) { const int s0 = __builtin_amdgcn_readfirstlane(ns0), s1 = __builtin_amdgcn_readfirstlane(ns1); f32x4* xr = (f32x4*)(a_out + (size_t)m * DM) + lane;
            { const int mn = (m + ngw < T) ? m + ngw : m; ns0 = tok_slot[2 * mn]; ns1 = tok_slot[2 * mn + 1]; }
            f32x4 v[4]; u32x2 ya[4], yb[4];
            const u32x2* y0 = (const u32x2*)((s0 >= 0 ? ybuf + (size_t)s0 * DM : ypart + (size_t)(-1 - s0) * DM)) + lane;
            const u32x2* y1 = (const u32x2*)((s1 >= 0 ? ybuf + (size_t)s1 * DM : ypart + (size_t)(-1 - s1) * DM)) + lane;
#pragma unroll
            for (int j = 0; j < 4; ++j) { v[j] = xr[64 * j]; ya[j] = y0[64 * j]; yb[j] = y1[64 * j]; }
#pragma unroll
            for (int j = 0; j < 4; ++j) { v[j][0] += lo2f(ya[j].x) + lo2f(yb[j].x); v[j][1] += hi2f(ya[j].x) + hi2f(yb[j].x); v[j][2] += lo2f(ya[j].y) + lo2f(yb[j].y); v[j][3] += hi2f(ya[j].y) + hi2f(yb[j].y); }
#pragma unroll
            for (int k = 0; k < 2; ++k) { const int sk = k ? s1 : s0;
                if (sk < 0) { const int pr = -1 - sk;
#pragma unroll 1
                    for (int q = 1; q < MD_KSPLIT; ++q) { const u32x2* yq = (const u32x2*)(ypart + ((size_t)q * (8 * 256) + pr) * DM) + lane;
#pragma unroll
                        for (int j = 0; j < 4; ++j) { const u32x2 p = yq[64 * j]; v[j][0] += lo2f(p.x); v[j][1] += hi2f(p.x); v[j][2] += lo2f(p.y); v[j][3] += hi2f(p.y); } } } }
#pragma unroll
            for (int j = 0; j < 4; ++j) xr[64 * j] = v[j]; }
    }
#undef IN
#undef SEAM
#undef GRID_BAR
#undef ss_mix
#undef ss_ffn
}
template <int LO, int HI> __global__ void __launch_bounds__(NTHREADS, 2) mk_fwd(Args a) { mk_body<LO, HI>(a); }

template <int PH> static void set_attr(bool& ok) { if constexpr (PH < NPH) { ok = ok && (hipFuncSetAttribute((const void*)mk_fwd<PH, PH + 1>, hipFuncAttributeMaxDynamicSharedMemorySize, LDS_TOTAL) == hipSuccess); set_attr<PH + 1>(ok); } }
template <int PH> static void launch_phases(const Args& a, int grid, hipStream_t stream) { if constexpr (PH < NPH) { hipLaunchKernelGGL((mk_fwd<PH, PH + 1>), dim3(grid), dim3(NTHREADS), LDS_TOTAL, stream, a); launch_phases<PH + 1>(a, grid, stream); } }
extern "C" void kernel_launch(void* const* d_in, const int* in_sizes, int n_in, void* d_out, int out_size, void* d_ws, size_t ws_size, hipStream_t stream) {
    static int grid = 0;
    if (!grid) {
        if (n_in != N_IN || out_size != T * DM || ws_size < WS_END) { fprintf(stderr, "kernel_launch: unexpected problem: n_in %d out %d ws %zu (need %zu)\n", n_in, out_size, ws_size, (size_t)WS_END); grid = -1; return; }
        int dev = 0, cus = 0, per_cu = 0;
        (void)hipGetDevice(&dev); (void)hipDeviceGetAttribute(&cus, hipDeviceAttributeMultiprocessorCount, dev);
#if MK_PER_PHASE
        { bool ok = true; set_attr<0>(ok); if (!ok) { fprintf(stderr, "kernel_launch: hipFuncSetAttribute failed\n"); grid = -1; return; } per_cu = 1; }
#else
        if (hipFuncSetAttribute((const void*)mk_fwd<0, NPH>, hipFuncAttributeMaxDynamicSharedMemorySize, LDS_TOTAL) != hipSuccess) { fprintf(stderr, "kernel_launch: hipFuncSetAttribute failed\n"); grid = -1; return; }
        if (hipOccupancyMaxActiveBlocksPerMultiprocessor(&per_cu, (const void*)mk_fwd<0, NPH>, NTHREADS, LDS_TOTAL) != hipSuccess || per_cu < 1) { fprintf(stderr, "kernel_launch: occupancy query failed (%d)\n", per_cu); grid = -1; return; }
#endif
        grid = cus;
    }
    if (grid <= 0) return;
    (void)hipMemsetAsync((char*)d_ws + WS_CTL, 0, 32768, stream);
    Args a{};
    for (int i = 0; i < N_IN; ++i) a.in[i] = (const float*)d_in[i];
    a.out = (float*)d_out; a.ws = (unsigned char*)d_ws;
#if MK_PER_PHASE
    launch_phases<0>(a, grid, stream);
#else
    void* args[] = {&a};
    hipError_t e = hipLaunchCooperativeKernel((const void*)mk_fwd<0, NPH>, dim3(grid), dim3(NTHREADS), args, LDS_TOTAL, stream);
    if (e != hipSuccess) fprintf(stderr, "cooperative launch failed: %s (grid %d)\n", hipGetErrorString(e), grid);
#endif
}
```

```cpp
#include <hip/hip_runtime.h>
#include <hip/hip_cooperative_groups.h>
#include <cstdio>
#include <cstdint>
namespace cg = cooperative_groups;

#ifndef FFN_FP8
#define FFN_FP8 0
#endif
#ifndef MK_PER_PHASE
#define MK_PER_PHASE 0
#endif

#define LAS __attribute__((address_space(3)))
typedef unsigned short bf16;
typedef short bf16x8 __attribute__((ext_vector_type(8)));
typedef float f32x4 __attribute__((ext_vector_type(4)));
typedef float f32x2 __attribute__((ext_vector_type(2)));
typedef unsigned u32x4 __attribute__((ext_vector_type(4)));
typedef unsigned u32x2 __attribute__((ext_vector_type(2)));

constexpr int BATCH = 8, SEQ = 2048, DM = 1024, T = BATCH * SEQ;
constexpr int CHUNK = 64, NCH = SEQ / CHUNK;
constexpr int IN_COLS = 10552, MIXC = 6456;
constexpr int ZC = 6656;
constexpr int C_RWKV = 0, C_SSM = 1824, C_ATT = 3368, C_GLA = 4904, C_HV = 6456;
constexpr int FFN = 2816, NEXP = 8, EDIM = 3584;
constexpr int MOE_ROWS = 2 * T + NEXP * 256;
constexpr float NORM_EPS = 1e-6f;

constexpr size_t MiB = 1u << 20;
constexpr size_t WS_CTL = 0;
constexpr size_t CTL_BYTES = 1 * MiB;
constexpr size_t WS_SMALL = WS_CTL + CTL_BYTES;
constexpr size_t SM_SS = 0;
constexpr size_t SM_MSSQ = SM_SS + 3 * (size_t)T * 16 * 4;
constexpr size_t SM_TOKE = SM_MSSQ + (size_t)T * 8 * 4;
constexpr size_t SM_TOKG = SM_TOKE + (size_t)T * 2 * 4;
constexpr size_t SM_TOKRS = SM_TOKG + (size_t)T * 2 * 4;
constexpr size_t SM_TOKSLOT = SM_TOKRS + (size_t)T * 4;
constexpr size_t SM_ROWTOK = SM_TOKSLOT + (size_t)T * 2 * 4;
constexpr size_t SM_ROWGATE = SM_ROWTOK + (size_t)MOE_ROWS * 4;
constexpr size_t SM_ROWRS = SM_ROWGATE + (size_t)MOE_ROWS * 4;
constexpr size_t SM_END = SM_ROWRS + (size_t)MOE_ROWS * 4;
static_assert(SM_END <= 6 * MiB, "small region");
constexpr size_t WS_XB = WS_SMALL + 6 * MiB;
constexpr size_t WS_X = WS_XB + (size_t)T * DM * 2;
constexpr size_t X_VFIRST = 0;
constexpr size_t X_MIXED = X_VFIRST + (size_t)T * 512 * 2;
constexpr size_t X_O = X_MIXED + (size_t)T * DM * 2;
constexpr size_t X_W = X_O + (size_t)T * 2048 * 2;
constexpr size_t W_IN = 0;
constexpr size_t W_G = W_IN + 2 * (size_t)ZC * DM * 2;
constexpr size_t W_B = W_G + 2 * (size_t)4096 * DM * 2;
constexpr size_t W_O = W_B + 2 * 4 * (size_t)DM * 512 * 2;
constexpr size_t W_13 = W_O + 2 * (size_t)DM * DM * 2;
constexpr size_t W_2 = W_13 + (size_t)2 * FFN * DM * 2;
constexpr size_t W_END = W_2 + (size_t)DM * FFN * 2;
constexpr size_t X_BYTES = X_W + W_END;
constexpr size_t MOE_W13 = 0;
constexpr size_t MOE_W2 = MOE_W13 + (size_t)NEXP * 2 * EDIM * DM * 2;
constexpr size_t MOE_WEND = MOE_W2 + (size_t)NEXP * DM * EDIM * 2;
static_assert(MOE_WEND <= X_BYTES, "MoE weights must fit the X region");
constexpr size_t WS_Z = WS_X + X_BYTES;
constexpr size_t Z_BYTES = (size_t)MOE_ROWS * EDIM * 2;
static_assert((size_t)T * ZC * 2 <= Z_BYTES, "z fits");
constexpr size_t WS_XG = WS_Z + Z_BYTES;
constexpr size_t XG_BYTES = (size_t)MOE_ROWS * DM * 2;
static_assert(4 * (size_t)T * 512 * 2 <= XG_BYTES, "rwkv arrays fit");
constexpr size_t WS_BCV = WS_XG + (size_t)4 * BATCH * (SEQ / 32) * 29184;
constexpr size_t WS_GEND = WS_BCV + (size_t)T * 512 * 2;
constexpr size_t WS_END = (WS_XG + XG_BYTES > WS_GEND + (size_t)BATCH * 4 * NCH * 64 * 4) ? WS_XG + XG_BYTES : WS_GEND + (size_t)BATCH * 4 * NCH * 64 * 4;

constexpr int CW_MOECNT = 64;
constexpr int CW_MOECUR = 128;
constexpr int CW_ATTQ = 192;
constexpr int CW_SPLIT = 256;
constexpr int CW_BAR = 1024;

__device__ __forceinline__ float bf2f(bf16 v) { return __builtin_bit_cast(float, (unsigned)v << 16); }
typedef __bf16 bf16x2_hw __attribute__((ext_vector_type(2)));
__device__ __forceinline__ unsigned pk2(float lo, float hi) { const f32x2 v = {lo, hi}; return __builtin_bit_cast(unsigned, __builtin_convertvector(v, bf16x2_hw)); }
__device__ __forceinline__ unsigned f2bf(float f) { return pk2(f, 0.f) & 0xffffu; }
__device__ __forceinline__ float lo2f(unsigned w) { return __builtin_bit_cast(float, w << 16); }
__device__ __forceinline__ float hi2f(unsigned w) { return __builtin_bit_cast(float, w & 0xffff0000u); }
__device__ __forceinline__ float sigmoidf_(float x) { return __builtin_amdgcn_rcpf(1.0f + __expf(-x)); }
__device__ __forceinline__ float siluf_(float x) { return x * __builtin_amdgcn_rcpf(1.0f + __expf(-x)); }
__device__ __forceinline__ float tanhf_(float x) { return 2.0f * __builtin_amdgcn_rcpf(1.0f + __expf(-2.0f * x)) - 1.0f; }
__device__ __forceinline__ float softplusf_(float x) { return x > 20.f ? x : __logf(1.0f + __expf(x)); }
template <int CTRL, int ROWMASK = 0xF, bool BOUND = true> __device__ __forceinline__ float dpp_f(float x) { return __builtin_bit_cast(float, __builtin_amdgcn_update_dpp(0, __builtin_bit_cast(int, x), CTRL, ROWMASK, 0xF, BOUND)); }
__device__ __forceinline__ float red8_sum(float x) { x += dpp_f<0xB1>(x); x += dpp_f<0x4E>(x); x += dpp_f<0x141>(x); return x; }
__device__ __forceinline__ float red16_sum(float x) { x = red8_sum(x); x += dpp_f<0x140>(x); return x; }
__device__ __forceinline__ float scan16(float x) { x += dpp_f<0x111>(x); x += dpp_f<0x112>(x); x += dpp_f<0x114>(x); x += dpp_f<0x118>(x); return x; }
__device__ __forceinline__ float scan32(float x) { x = scan16(x); x += dpp_f<0x142, 0xA, false>(x); return x; }
__device__ __forceinline__ float scan64(float x) { x = scan32(x); x += dpp_f<0x143, 0xC, false>(x); return x; }
__device__ __forceinline__ float xrows_sum(float v) { const int x = __builtin_bit_cast(int, v); const auto a = __builtin_amdgcn_permlane16_swap(x, x, false, false); v = __builtin_bit_cast(float, (int)a[0]) + __builtin_bit_cast(float, (int)a[1]);
    const int y = __builtin_bit_cast(int, v); const auto b = __builtin_amdgcn_permlane32_swap(y, y, false, false); return __builtin_bit_cast(float, (int)b[0]) + __builtin_bit_cast(float, (int)b[1]); }
__device__ __forceinline__ float xrows_max(float v) { const int x = __builtin_bit_cast(int, v); const auto a = __builtin_amdgcn_permlane16_swap(x, x, false, false); v = fmaxf(__builtin_bit_cast(float, (int)a[0]), __builtin_bit_cast(float, (int)a[1]));
    const int y = __builtin_bit_cast(int, v); const auto b = __builtin_amdgcn_permlane32_swap(y, y, false, false); return fmaxf(__builtin_bit_cast(float, (int)b[0]), __builtin_bit_cast(float, (int)b[1])); }
__device__ __forceinline__ float wave_sum(float v) { return xrows_sum(red16_sum(v)); }
__device__ __forceinline__ int opq_v(int x) { asm volatile("" : "+v"(x)); return x; }
__device__ __forceinline__ int opq_s(int x) { asm volatile("" : "+s"(x)); return x; }
__device__ __forceinline__ float rdlane(float v, int l) { return __builtin_bit_cast(float, __builtin_amdgcn_readlane(__builtin_bit_cast(int, v), l)); }

namespace pg8 {
constexpr int BM = 256, BK = 64, HALF = 128, HTB = HALF * BK * 2, STAGE_BYTES = 8 * HTB, NXCD = 8, WGM = 8;
__host__ __device__ __forceinline__ int lds_byte(int r, int c) { const int st = (r >> 4) * 2 + (c >> 5), rr = r & 15, cc = c & 31, ob = rr * 64 + cc * 2; return st * 1024 + (ob ^ (((ob >> 9) & 1) << 5)); }
__host__ __device__ __forceinline__ void stage_rc(int b, int& R, int& C) { const int st = b / 1024, sb = b % 1024, swz = sb ^ (((sb >> 9) & 1) << 5); R = (st >> 1) * 16 + swz / 64; C = (st & 1) * 32 + (swz % 64) / 2; }
__host__ __device__ __forceinline__ int perm32(int rho) { const int n = rho >> 4, i = rho & 15; return 8 * (i >> 2) + 4 * n + (i & 3); }

typedef int v4i __attribute__((ext_vector_type(4)));
typedef int v8i __attribute__((ext_vector_type(8)));
struct Unit { int pm, pn, e, kq; };
struct Gemm { int lda, ldb, K; };

struct StaticOrder {
    static constexpr bool VARNT = false;
    const char* A; const char* Bt; size_t tstepA, tstepB;
    int nM, nN, nwg, G, c;
    __device__ __forceinline__ void init(const void* A_, const void* Bt_, int lda, int ldb, int M, int N, int G_, int c_) { A = (const char*)A_; Bt = (const char*)Bt_; tstepA = (size_t)BM * lda * 2; tstepB = (size_t)BM * ldb * 2; nM = M / BM; nN = N / BM; nwg = nM * nN; G = G_; c = c_; }
    __device__ __forceinline__ bool next(int i, Unit& u) const {
        const long L = (long)i * G + c; if (L >= nwg) return false;
        int wgid = (int)L; { const int q = nwg / NXCD, r = nwg % NXCD, xcd = wgid % NXCD, off = wgid / NXCD; wgid = (xcd < r ? xcd * (q + 1) : r * (q + 1) + (xcd - r) * q) + off; }
        const int nig = WGM * nN, gid = wgid / nig, fm = gid * WGM, gsz = (nM - fm) < WGM ? (nM - fm) : WGM;
        u.pm = fm + ((wgid % nig) % gsz); u.pn = (wgid % nig) / gsz; u.e = 0; return true;
    }
    __device__ __forceinline__ const char* a_ptr(const Unit& u) const { return A + (size_t)u.pm * tstepA; }
    __device__ __forceinline__ const char* b_ptr(const Unit& u) const { return Bt + (size_t)u.pn * tstepB; }
};

typedef __bf16 bf16x2_t __attribute__((ext_vector_type(2)));
__device__ __forceinline__ unsigned cvt_pk_bf16(float lo, float hi) { const f32x2 v = {lo, hi}; return __builtin_bit_cast(unsigned, __builtin_convertvector(v, bf16x2_t)); }

template <class Epi, class Sched>
__device__ __forceinline__ void gemm_phase(LAS unsigned char* lds, const Gemm g, const Sched& S, const Epi& E) {
    const int tid = opq_v((int)threadIdx.x), wid = __builtin_amdgcn_readfirstlane(tid >> 6), lane = tid & 63, wr = wid >> 2, wc = wid & 3, fr = lane & 15, fq = lane >> 4;
    const int nt = opq_s(g.K / BK);
    unsigned voffA[2], voffB[2];
#pragma unroll
    for (int i = 0; i < 2; ++i) { int R, C; stage_rc(tid * 16 + i * 8192, R, C); const int Rb = Epi::PERM ? ((R & ~31) + perm32(R & 31)) : R;
        voffA[i] = (unsigned)(R * g.lda + C) * 2u; voffB[i] = (unsigned)(Rb * g.ldb + C) * 2u; }
    const size_t kstep = (size_t)(BK * 2);
    const size_t hstepA = (size_t)HALF * g.lda * 2, hstepB = (size_t)HALF * g.ldb * 2;
    const unsigned ldsw = (unsigned)wid * 1024u;
    const int aoff = lds_byte(wr * 64 + fr, fq * 8), boff = lds_byte(wc * 32 + fr, fq * 8);
#define PG8_SA(b, h) (((b) * 2 + (h)) * HTB)
#define PG8_SB(b, h) ((4 + (b) * 2 + (h)) * HTB)
#define PG8_STAGE(bufoff, gbase, voff) do { _Pragma("unroll") for (int _i = 0; _i < 2; ++_i) \
        __builtin_amdgcn_global_load_lds((const unsigned*)((const char*)(gbase) + (voff)[_i]), (LAS unsigned*)(lds + (bufoff) + ldsw + _i * 8192), 16, 0, 0); } while (0)
#define PG8_LDA(dst, b, h) do { _Pragma("unroll") for (int m = 0; m < 4; ++m) { if constexpr (Epi::F8) { const v4i lo_ = *(const LAS v4i*)(lds + PG8_SA(b, h) + aoff + m * 2048), hi_ = *(const LAS v4i*)(lds + PG8_SA(b, h) + aoff + m * 2048 + 1024); \
            dst##8[m] = __builtin_shufflevector(lo_, hi_, 0, 1, 2, 3, 4, 5, 6, 7); } else { _Pragma("unroll") for (int k = 0; k < 2; ++k) dst[m][k] = *(const LAS bf16x8*)(lds + PG8_SA(b, h) + aoff + m * 2048 + k * 1024); } } } while (0)
#define PG8_LDB(dst, b, h) do { _Pragma("unroll") for (int n = 0; n < 2; ++n) { if constexpr (Epi::F8) { const v4i lo_ = *(const LAS v4i*)(lds + PG8_SB(b, h) + boff + n * 2048), hi_ = *(const LAS v4i*)(lds + PG8_SB(b, h) + boff + n * 2048 + 1024); \
            dst##8[n] = __builtin_shufflevector(lo_, hi_, 0, 1, 2, 3, 4, 5, 6, 7); } else { _Pragma("unroll") for (int k = 0; k < 2; ++k) dst[n][k] = *(const LAS bf16x8*)(lds + PG8_SB(b, h) + boff + n * 2048 + k * 1024); } } } while (0)
#define PG8_MMA(ai, bj, At, Bt) do { __builtin_amdgcn_s_setprio(1); _Pragma("unroll") for (int m = 0; m < 4; ++m) _Pragma("unroll") for (int n = 0; n < 2; ++n) { \
        if constexpr (Epi::F8) asm volatile("v_mfma_scale_f32_16x16x128_f8f6f4 %0, %1, %2, %0, %3, %3 op_sel_hi:[0,0,0]" : "+v"(acc[ai][bj][m][n]) : "v"(Bt##8[n]), "v"(At##8[m]), "v"(f8scale));   \
        else { _Pragma("unroll") for (int k = 0; k < 2; ++k) acc[ai][bj][m][n] = __builtin_amdgcn_mfma_f32_16x16x32_bf16(Bt[n][k], At[m][k], acc[ai][bj][m][n], 0, 0, 0); } } \
        __builtin_amdgcn_s_setprio(0); } while (0)
#define PG8_WAIT_V(n) asm volatile("s_waitcnt vmcnt(" #n ")" ::: "memory")
#define PG8_WAIT_L(n) asm volatile("s_waitcnt lgkmcnt(" #n ")" ::: "memory")
#define PG8_BAR __builtin_amdgcn_s_barrier()
#define PG8_SCHED __builtin_amdgcn_sched_barrier(0)
    Unit cur, nxt; int ui = 0;
    if (!S.next(0, cur)) return;
    f32x4 acc[2][2][4][2];
#pragma unroll
    for (int a = 0; a < 2; ++a)
#pragma unroll
        for (int b = 0; b < 2; ++b)
#pragma unroll
            for (int m = 0; m < 4; ++m)
#pragma unroll
                for (int n = 0; n < 2; ++n) acc[a][b][m][n] = (f32x4){0.f, 0.f, 0.f, 0.f};
    const int f8scale = opq_v(0x7f7f7f7f);
    bf16x8 At[4][2], B0[2][2], B1[2][2]; v8i At8[4], B08[2], B18[2];
    const char* cA = S.a_ptr(cur); const char* cB = S.b_ptr(cur);
    PG8_STAGE(PG8_SB(0, 0), cB, voffB); PG8_STAGE(PG8_SB(0, 1), cB + hstepB, voffB); PG8_STAGE(PG8_SA(0, 0), cA, voffA); PG8_STAGE(PG8_SA(0, 1), cA + hstepA, voffA);
    if (wr == 1) PG8_BAR;
    PG8_WAIT_V(2); PG8_BAR;
    PG8_STAGE(PG8_SB(1, 0), cB + kstep, voffB); PG8_STAGE(PG8_SA(1, 0), cA + kstep, voffA); PG8_STAGE(PG8_SB(1, 1), cB + hstepB + kstep, voffB);
    PG8_WAIT_V(6); PG8_BAR;
    for (;;) {
        const bool has_next = S.next(ui + 1, nxt);
        int ntc = nt; if constexpr (Sched::VARNT) ntc = opq_s(S.nt_of(cur));
        const char* nA = has_next ? S.a_ptr(nxt) : cA; const char* nB = has_next ? S.b_ptr(nxt) : cB;
#pragma unroll 1
        for (int t = 0; t < ntc; t += 2) {
            const bool last = (t == ntc - 2);
            const char* a1 = cA + (size_t)(t + 1) * kstep;
            const char* a2 = last ? nA : cA + (size_t)(t + 2) * kstep; const char* b2 = last ? nB : cB + (size_t)(t + 2) * kstep;
            const char* a3 = a2 + kstep; const char* b3 = b2 + kstep;
            PG8_LDB(B0, 0, 0); PG8_LDB(B1, 0, 1); PG8_SCHED; PG8_LDA(At, 0, 0); PG8_STAGE(PG8_SA(1, 1), a1 + hstepA, voffA);
            PG8_WAIT_V(8); PG8_WAIT_L(0); PG8_BAR; PG8_MMA(0, 0, At, B0); PG8_MMA(0, 1, At, B1); PG8_BAR; PG8_SCHED;
            PG8_LDA(At, 0, 1); PG8_STAGE(PG8_SB(0, 0), b2, voffB); PG8_STAGE(PG8_SB(0, 1), b2 + hstepB, voffB); PG8_STAGE(PG8_SA(0, 0), a2, voffA);
            PG8_WAIT_V(8); PG8_WAIT_L(0); PG8_BAR; PG8_MMA(1, 0, At, B0); PG8_MMA(1, 1, At, B1); PG8_BAR; PG8_SCHED;
            PG8_LDB(B0, 1, 0); PG8_LDB(B1, 1, 1); PG8_SCHED; PG8_LDA(At, 1, 0); PG8_STAGE(PG8_SA(0, 1), a2 + hstepA, voffA);
            PG8_WAIT_V(8); PG8_WAIT_L(0); PG8_BAR; PG8_MMA(0, 0, At, B0); PG8_MMA(0, 1, At, B1); PG8_BAR; PG8_SCHED;
            PG8_LDA(At, 1, 1); PG8_STAGE(PG8_SB(1, 0), b3, voffB); PG8_STAGE(PG8_SB(1, 1), b3 + hstepB, voffB); PG8_STAGE(PG8_SA(1, 0), a3, voffA);
            PG8_WAIT_V(8); PG8_WAIT_L(0); PG8_BAR; PG8_MMA(1, 0, At, B0); PG8_MMA(1, 1, At, B1); PG8_BAR; PG8_SCHED;
        }
        if (wr == 0) PG8_BAR;
        if constexpr (Epi::F8) asm volatile("s_nop 15\n\ts_nop 15" ::: "memory");
        E(acc, cur, wr, wc, fr, fq);
        if (!has_next) break;
        if constexpr (!Epi::CHAIN) {
#pragma unroll
        for (int a = 0; a < 2; ++a)
#pragma unroll
            for (int b = 0; b < 2; ++b)
#pragma unroll
                for (int m = 0; m < 4; ++m)
#pragma unroll
                    for (int n = 0; n < 2; ++n) acc[a][b][m][n] = (f32x4){0.f, 0.f, 0.f, 0.f};
        }
        cur = nxt; cA = nA; cB = nB; ++ui;
        if (wr == 1) PG8_BAR;
    }
    PG8_WAIT_V(0);
    PG8_BAR;
#undef PG8_SA
#undef PG8_SB
#undef PG8_STAGE
#undef PG8_LDA
#undef PG8_LDB
#undef PG8_MMA
#undef PG8_WAIT_V
#undef PG8_WAIT_L
#undef PG8_BAR
#undef PG8_SCHED
}
}

using pg8::Unit;
__device__ __forceinline__ u32x4 pack8(f32x4 v0, f32x4 v1) { u32x4 w; w.x = pg8::cvt_pk_bf16(v0[0], v0[1]); w.y = pg8::cvt_pk_bf16(v0[2], v0[3]); w.z = pg8::cvt_pk_bf16(v1[0], v1[1]); w.w = pg8::cvt_pk_bf16(v1[2], v1[3]); return w; }
__device__ __forceinline__ f32x4 sig4(f32x4 v) { return (f32x4){sigmoidf_(v[0]), sigmoidf_(v[1]), sigmoidf_(v[2]), sigmoidf_(v[3])}; }
__device__ __forceinline__ void unpack8(u32x4 w, f32x4& a, f32x4& b) { a = (f32x4){lo2f(w.x), hi2f(w.x), lo2f(w.y), hi2f(w.y)}; b = (f32x4){lo2f(w.z), hi2f(w.z), lo2f(w.w), hi2f(w.w)}; }

__device__ __forceinline__ void rs8_from_parts(const float* ss, int row0, int fq, float (&rs)[2][4]) {
    f32x4 p[2][4];
#pragma unroll
    for (int ai = 0; ai < 2; ++ai)
#pragma unroll
        for (int m = 0; m < 4; ++m) p[ai][m] = *(const f32x4*)(ss + (size_t)(row0 + ai * 128 + m * 16) * 16 + 4 * fq);
#pragma unroll
    for (int ai = 0; ai < 2; ++ai)
#pragma unroll
        for (int m = 0; m < 4; ++m) { float t = (p[ai][m][0] + p[ai][m][1]) + (p[ai][m][2] + p[ai][m][3]); t = xrows_sum(t); rs[ai][m] = __builtin_amdgcn_rsqf(t * (1.0f / DM) + NORM_EPS); }
}
template <int ACT> struct EpiScaleBf16 {
    static constexpr bool PERM = true, CHAIN = false, F8 = false;
    bf16* O; int ldc; const float* ss;
    __device__ __forceinline__ void operator()(f32x4 (&acc)[2][2][4][2], const Unit& u, int wr, int wc, int fr, int fq) const {
        const int row0 = u.pm * 256 + wr * 64 + fr, col0 = u.pn * 256 + wc * 32 + 8 * fq;
        float rs[2][4]; rs8_from_parts(ss, row0, fq, rs);
#pragma unroll
        for (int ai = 0; ai < 2; ++ai)
#pragma unroll
            for (int m = 0; m < 4; ++m) { const int row = row0 + ai * 128 + m * 16; const float s = rs[ai][m];
                bf16* rowp = O + (size_t)row * ldc + col0;
#pragma unroll
                for (int bj = 0; bj < 2; ++bj) { f32x4 v0 = acc[ai][bj][m][0] * s, v1 = acc[ai][bj][m][1] * s;
                    if (ACT == 1) { v0 = sig4(v0); v1 = sig4(v1); }
                    *(u32x4*)(rowp + bj * 128) = pack8(v0, v1); }
                asm volatile("" ::: "memory"); }
    }
};
struct EpiGateRatio {
    static constexpr bool PERM = true, CHAIN = false, F8 = false;
    bf16* O; const float* ss;
    __device__ __forceinline__ void operator()(const f32x4 (&acc)[2][2][4][2], const Unit& u, int wr, int wc, int fr, int fq) const {
        const int row0 = u.pm * 256 + wr * 64 + fr, c0 = u.pn * 64 + wc * 16 + 4 * fq;
        float rs[2][4]; rs8_from_parts(ss, row0, fq, rs);
#pragma unroll
        for (int ai = 0; ai < 2; ++ai)
#pragma unroll
            for (int m = 0; m < 4; ++m) { const int row = row0 + ai * 128 + m * 16; const float s = rs[ai][m];
                f32x4 g[4];
#pragma unroll
                for (int i = 0; i < 4; ++i) { g[i] = sig4(acc[ai][i >> 1][m][i & 1] * s);
#pragma unroll
                    for (int j = 0; j < 4; ++j) g[i][j] = fmaxf(g[i][j], 1e-30f); }
                bf16* rowp = O + (size_t)row * 4096 + c0;
#pragma unroll
                for (int i = 0; i < 4; ++i) { f32x4 r = g[i];
                    if (i < 3) {
#pragma unroll
                        for (int j = 0; j < 4; ++j) r[j] = g[i][j] * __builtin_amdgcn_rcpf(g[i + 1][j]); }
                    u32x2 w; w.x = pg8::cvt_pk_bf16(r[0], r[1]); w.y = pg8::cvt_pk_bf16(r[2], r[3]); *(u32x2*)(rowp + i * 1024) = w; }
                asm volatile("" ::: "memory"); }
    }
};
template <bool MOE, bool F8_ = MOE> struct EpiSwiglu {
    static constexpr bool PERM = true, CHAIN = false, F8 = F8_;
    bf16* O; int ldc; const float* rsrc;
    __device__ __forceinline__ void operator()(f32x4 (&acc)[2][2][4][2], const Unit& u, int wr, int wc, int fr, int fq) const {
        const int row0 = u.pm * 256 + wr * 64 + fr, col0 = u.pn * 128 + wc * 32 + 8 * fq;
        float rs[2][4];
        if (MOE) {
#pragma unroll
            for (int ai = 0; ai < 2; ++ai)
#pragma unroll
                for (int m = 0; m < 4; ++m) rs[ai][m] = rsrc[row0 + ai * 128 + m * 16]; }
        else rs8_from_parts(rsrc, row0, fq, rs);
        if (F8) {
#pragma unroll
            for (int ai = 0; ai < 2; ++ai)
#pragma unroll
                for (int m = 0; m < 4; ++m) rs[ai][m] *= (1.0f / 32.0f); }
#pragma unroll
        for (int ai = 0; ai < 2; ++ai)
#pragma unroll
            for (int m = 0; m < 4; ++m) { const int row = row0 + ai * 128 + m * 16; const float s = rs[ai][m];
                f32x4 o[2];
#pragma unroll
                for (int n = 0; n < 2; ++n) { const f32x4 a = acc[ai][0][m][n] * s, b = acc[ai][1][m][n] * s;
                    o[n] = (f32x4){siluf_(a[0]) * b[0], siluf_(a[1]) * b[1], siluf_(a[2]) * b[2], siluf_(a[3]) * b[3]}; }
                if constexpr (F8) { u32x2 w8; int t0_ = 0, t1_ = 0; t0_ = __builtin_amdgcn_cvt_pk_fp8_f32(o[0][0], o[0][1], t0_, false); t0_ = __builtin_amdgcn_cvt_pk_fp8_f32(o[0][2], o[0][3], t0_, true);
                    t1_ = __builtin_amdgcn_cvt_pk_fp8_f32(o[1][0], o[1][1], t1_, false); t1_ = __builtin_amdgcn_cvt_pk_fp8_f32(o[1][2], o[1][3], t1_, true); w8.x = (unsigned)t0_; w8.y = (unsigned)t1_;
                    *(u32x2*)((unsigned char*)O + (size_t)row * ldc + col0) = w8; }
                else *(u32x4*)(O + (size_t)row * ldc + col0) = pack8(o[0], o[1]);
                asm volatile("" ::: "memory"); }
    }
};
template <bool F8_ = false> struct EpiResid {
    static constexpr bool PERM = false, CHAIN = false, F8 = F8_;
    const float* xin; float* out; bf16* xb; float* ss; unsigned char* xb8;
    __device__ __forceinline__ void operator()(f32x4 (&acc)[2][2][4][2], const Unit& u, int wr, int wc, int fr, int fq) const {
        const int row0 = u.pm * 256 + wr * 64 + fr, col0 = u.pn * 256 + wc * 32 + 4 * fq;
#pragma unroll
        for (int ai = 0; ai < 2; ++ai)
#pragma unroll
            for (int m = 0; m < 4; ++m) { const int row = row0 + ai * 128 + m * 16; const size_t off = (size_t)row * DM + col0; float q = 0.f;
#pragma unroll
                for (int bj = 0; bj < 2; ++bj)
#pragma unroll
                    for (int n = 0; n < 2; ++n) { const f32x4 xi = *(const f32x4*)(xin + off + bj * 128 + n * 16); const f32x4 v = F8 ? xi + acc[ai][bj][m][n] * (1.0f / 64.0f) : xi + acc[ai][bj][m][n];
                        *(f32x4*)(out + off + bj * 128 + n * 16) = v; u32x2 w; w.x = pg8::cvt_pk_bf16(v[0], v[1]); w.y = pg8::cvt_pk_bf16(v[2], v[3]);
                        *(u32x2*)(xb + off + bj * 128 + n * 16) = w;
                        if (xb8) { int t8 = 0; t8 = __builtin_amdgcn_cvt_pk_fp8_f32(v[0], v[1], t8, false); t8 = __builtin_amdgcn_cvt_pk_fp8_f32(v[2], v[3], t8, true); *(int*)(xb8 + off + bj * 128 + n * 16) = t8; }
                        q += (v[0] * v[0] + v[1] * v[1]) + (v[2] * v[2] + v[3] * v[3]); }
                q = xrows_sum(q);
                if (fq == 0 && ss) ss[(size_t)row * 16 + u.pn * 4 + wc] = q;
                if (m & 1) asm volatile("" ::: "memory"); }
    }
};
struct EpiMix {
    static constexpr bool PERM = true, CHAIN = true, F8 = false;
    const bf16* gates; bf16* mixed;
    __device__ __forceinline__ void operator()(f32x4 (&acc)[2][2][4][2], const Unit& u, int wr, int wc, int fr, int fq) const {
        const int row0 = u.pm * 256 + wr * 64 + fr, col0 = u.pn * 256 + wc * 32 + 8 * fq; const int i = u.e;
#pragma unroll
        for (int ai = 0; ai < 2; ++ai)
#pragma unroll
            for (int m = 0; m < 4; ++m) { const int row = row0 + ai * 128 + m * 16;
#pragma unroll
                for (int bj = 0; bj < 2; ++bj) { const bf16* gp = gates + (size_t)row * 4096 + i * 1024 + col0 + bj * 128;
                    f32x4 r0, r1; unpack8(*(const u32x4*)gp, r0, r1);
                    if (i < 3) { acc[ai][bj][m][0] = acc[ai][bj][m][0] * r0; acc[ai][bj][m][1] = acc[ai][bj][m][1] * r1; }
                    else {
                        *(u32x4*)(mixed + (size_t)row * DM + col0 + bj * 128) = pack8(acc[ai][bj][m][0] * r0, acc[ai][bj][m][1] * r1);
                        acc[ai][bj][m][0] = (f32x4){0.f, 0.f, 0.f, 0.f}; acc[ai][bj][m][1] = (f32x4){0.f, 0.f, 0.f, 0.f};
                    } } }
    }
};
struct MixOrder {
    static constexpr bool VARNT = false;
    const char* O; const char* Wb; int G, c;
    __device__ __forceinline__ bool next(int i, Unit& u) const {
        const int grp = (i >> 2) * G + c; if (grp >= 256) return false;
        int wgid = grp; { const int xcd = wgid % 8, off = wgid / 8; wgid = xcd * 32 + off; }
        const int nig = 8 * 4, gid = wgid / nig; u.pm = gid * 8 + ((wgid % nig) % 8); u.pn = (wgid % nig) / 8; u.e = i & 3; return true;
    }
    __device__ __forceinline__ const char* a_ptr(const Unit& u) const { return O + ((size_t)u.pm * 256 * 2048 + (size_t)u.e * 512) * 2; }
    __device__ __forceinline__ const char* b_ptr(const Unit& u) const { return Wb + ((size_t)u.e * DM * 512 + (size_t)u.pn * 256 * 512) * 2; }
};
struct MoeOrder {
    static constexpr bool VARNT = false;
    const char* A; const char* Bt; size_t tstepA, tstepB, estepB; int nN, ntiles, G, c;
    int te0, te1, te2, te3, te4, te5, te6;
    __device__ __forceinline__ void init(const void* A_, int lda, const void* Bt_, int ldb, size_t estepB_, int nN_, const unsigned* cnt, int G_, int c_) {
        A = (const char*)A_; Bt = (const char*)Bt_; tstepA = (size_t)256 * lda * 2; tstepB = (size_t)256 * ldb * 2; estepB = estepB_; nN = nN_; G = G_; c = c_;
        int acc = 0; acc += (int)((cnt[0] + 255u) >> 8); te0 = acc; acc += (int)((cnt[1] + 255u) >> 8); te1 = acc; acc += (int)((cnt[2] + 255u) >> 8); te2 = acc; acc += (int)((cnt[3] + 255u) >> 8); te3 = acc;
        acc += (int)((cnt[4] + 255u) >> 8); te4 = acc; acc += (int)((cnt[5] + 255u) >> 8); te5 = acc; acc += (int)((cnt[6] + 255u) >> 8); te6 = acc; acc += (int)((cnt[7] + 255u) >> 8); ntiles = acc;
    }
    __device__ __forceinline__ bool next(int i, Unit& u) const {
        const long L = (long)i * G + c; if (L >= (long)ntiles * nN) return false;
        const int mt = (int)(L / nN); u.pm = mt; u.pn = (int)(L % nN);
        u.e = (mt >= te0) + (mt >= te1) + (mt >= te2) + (mt >= te3) + (mt >= te4) + (mt >= te5) + (mt >= te6); return true;
    }
    __device__ __forceinline__ const char* a_ptr(const Unit& u) const { return A + (size_t)u.pm * tstepA; }
    __device__ __forceinline__ const char* b_ptr(const Unit& u) const { return Bt + (size_t)u.e * estepB + (size_t)u.pn * tstepB; }
};

constexpr int MD_KSPLIT = 7, MD_KTILES = 4;
struct MoeDownOrder {
    static constexpr bool VARNT = true;
    const char* A; const char* Bt; size_t tstepA, tstepB, estepB; int G, c, nsplit, nfull4;
    int tb[8], fe[8];
    unsigned pmask;
    __device__ __forceinline__ void init(const void* A_, int lda, const void* Bt_, int ldb, size_t estepB_, const unsigned* cnt, int G_, int c_) {
        A = (const char*)A_; Bt = (const char*)Bt_; tstepA = (size_t)256 * lda * 2; tstepB = (size_t)256 * ldb * 2; estepB = estepB_; G = G_; c = c_;
        int acc = 0, np = 0, nf = 0; pmask = 0u;
#pragma unroll
        for (int e = 0; e < 8; ++e) { tb[e] = acc; fe[e] = (int)(cnt[e] >> 8); const int p = (cnt[e] & 255u) ? 1 : 0; pmask |= (unsigned)p << e; acc += fe[e] + p; np += p; nf += fe[e]; }
        nsplit = np * 4 * MD_KSPLIT; nfull4 = nf * 4;
    }
    __device__ __forceinline__ bool next(int i, Unit& u) const {
        const long L = (long)i * G + c; if (L >= (long)nsplit + nfull4) return false;
        if (L < nsplit) { const int sidx = (int)L, pi = sidx / (4 * MD_KSPLIT), w = sidx - pi * (4 * MD_KSPLIT); u.pn = w / MD_KSPLIT; u.kq = w - u.pn * MD_KSPLIT;
            int e = 0, seen = 0;
#pragma unroll
            for (int q = 0; q < 8; ++q) { const int has = (int)((pmask >> q) & 1u); if (has && seen == pi) e = q; seen += has; }
            int tbe = 0, fee = 0;
#pragma unroll
            for (int q = 0; q < 8; ++q) { tbe = (e == q) ? tb[q] : tbe; fee = (e == q) ? fe[q] : fee; }
            u.e = e; u.pm = tbe + fee; u.kq |= pi << 8; }
        else { const int f = (int)L - nsplit, ft = f >> 2; u.pn = f & 3; u.kq = -1; int e = 0, rem = ft, pm = 0, done = 0;
#pragma unroll
            for (int q = 0; q < 8; ++q) { if (!done) { if (rem < fe[q]) { e = q; pm = tb[q] + rem; done = 1; } else rem -= fe[q]; } }
            u.e = e; u.pm = pm; }
        return true;
    }
    __device__ __forceinline__ int nt_of(const Unit& u) const { return u.kq < 0 ? MD_KSPLIT * MD_KTILES : MD_KTILES; }
    __device__ __forceinline__ const char* a_ptr(const Unit& u) const { return A + (size_t)u.pm * tstepA + (u.kq < 0 ? (size_t)0 : (size_t)(u.kq & 255) * (MD_KTILES * 128)); }
    __device__ __forceinline__ const char* b_ptr(const Unit& u) const { return Bt + (size_t)u.e * estepB + (size_t)u.pn * tstepB + (u.kq < 0 ? (size_t)0 : (size_t)(u.kq & 255) * (MD_KTILES * 128)); }
};
struct EpiMoeDownSplit {
    static constexpr bool PERM = true, CHAIN = false, F8 = true;
    bf16* Y; bf16* Yp; const float* rgate;
    __device__ __forceinline__ void operator()(f32x4 (&acc)[2][2][4][2], const Unit& u, int wr, int wc, int fr, int fq) const {
        const int rl0 = wr * 64 + fr, col0 = u.pn * 256 + wc * 32 + 8 * fq;
        bf16* dst = (u.kq < 0) ? Y + (size_t)u.pm * 256 * DM : Yp + ((size_t)(u.kq & 255) * (8 * 256) + (size_t)(u.kq >> 8) * 256) * DM;
#pragma unroll
        for (int ai = 0; ai < 2; ++ai)
#pragma unroll
            for (int m = 0; m < 4; ++m) { const int rl = rl0 + ai * 128 + m * 16; const float s = rgate[u.pm * 256 + rl] * (1.0f / 64.0f);
#pragma unroll
                for (int bj = 0; bj < 2; ++bj) *(u32x4*)(dst + (size_t)rl * DM + col0 + bj * 128) = pack8(acc[ai][bj][m][0] * s, acc[ai][bj][m][1] * s); }
    }
};

enum { I_X = 0, I_WIN, I_NORM_MIX, I_RW_MU, I_RW_DECAY_UP, I_RW_W0, I_RW_A_UP, I_RW_A0, I_RW_GATE_UP, I_RW_KK, I_RW_KA, I_RW_RK, I_RW_LNW, I_RW_LNB,
       I_VRES_DOWN, I_VRES_UP, I_VRES_V0, I_SSM_CONVW, I_SSM_CONVB, I_SSM_DTB, I_SSM_ALOG, I_SSM_D, I_SSM_NORMW, I_ATT_QG, I_ATT_KG, I_ATT_BIAS,
       I_GLA_GUP, I_GLA_GB, I_GLA_NW, I_WBRANCH, I_WOUT, I_NORM_FFN, I_FFN_W1, I_FFN_W3, I_FFN_W2, I_MOE_ROUTER, I_MOE_W1, I_MOE_W3, I_MOE_W2, N_IN };
struct Args { const float* in[N_IN]; float* out; unsigned char* ws; };
static_assert(sizeof(Args) == (N_IN + 2) * 8, "Args has no padding");

struct PT { const LAS unsigned long long* tab;
    __device__ __forceinline__ const float* operator[](int i) const { const unsigned long long v = tab[i];
        const unsigned lo = __builtin_amdgcn_readfirstlane((unsigned)v), hi = __builtin_amdgcn_readfirstlane((unsigned)(v >> 32)); return (const float*)(const __attribute__((address_space(1))) float*)(((unsigned long long)hi << 32) | lo); } };
struct ArgsD { PT in;
    __device__ __forceinline__ float* out() const { return (float*)in[N_IN]; }
    __device__ __forceinline__ unsigned char* ws() const { return (unsigned char*)in[N_IN + 1]; } };
constexpr int NWAVES = 8, NTHREADS = 512;
constexpr int LDS_MAIN = 131072;
constexpr int LDS_CTL_OFF = LDS_MAIN;
constexpr int LDS_BYTES = LDS_MAIN + 1024;

template <bool GPERM = false> __device__ __forceinline__ void cvt_item(const float* __restrict__ W, int ld, int k0, int csrc, int ncv, const float* __restrict__ gs, bf16* dst, int dstK, int drow, LAS float* scr, int lane) {
    const int lc = (lane < ncv) ? lane : ncv - 1;
    const float* wp = W + (size_t)k0 * ld + csrc + lc;
#pragma unroll
    for (int kb = 0; kb < 64; kb += 16) { float v[16];
#pragma unroll
        for (int j = 0; j < 16; ++j) v[j] = __builtin_nontemporal_load(wp + (size_t)(kb + j) * ld);
#pragma unroll
        for (int j = 0; j < 16; ++j) scr[(kb + j) * 65 + lane] = v[j]; }
    asm volatile("s_waitcnt lgkmcnt(0)" ::: "memory");
    const int kc = lane & 7;
    f32x4 g0 = {1.f, 1.f, 1.f, 1.f}, g1 = g0; if (gs) { g0 = *(const f32x4*)(gs + k0 + 8 * kc); g1 = *(const f32x4*)(gs + k0 + 8 * kc + 4); }
#pragma unroll
    for (int i = 0; i < 8; ++i) { const int nn = (lane >> 3) + 8 * i; const LAS float* sp = scr + (8 * kc) * 65 + nn;
        u32x4 o; o.x = pk2(sp[0 * 65] * g0[0], sp[1 * 65] * g0[1]); o.y = pk2(sp[2 * 65] * g0[2], sp[3 * 65] * g0[3]); o.z = pk2(sp[4 * 65] * g1[0], sp[5 * 65] * g1[1]); o.w = pk2(sp[6 * 65] * g1[2], sp[7 * 65] * g1[3]);
        const int rr = GPERM ? 32 * ((nn >> 4) & 3) + 8 * ((nn >> 2) & 3) + (nn & 3) : nn;
        if (nn < ncv) *(u32x4*)(dst + (size_t)(drow + rr) * dstK + k0 + 8 * kc) = o; }
    asm volatile("s_waitcnt lgkmcnt(0)" ::: "memory");
}
__device__ __forceinline__ void cvt_item8(const float* __restrict__ W, int ld, int k0, int csrc, int ncv, const float* __restrict__ gs, float scale, unsigned char* dst, int dstK, int drow, LAS float* scr, int lane) {
    const int lc = (lane < ncv) ? lane : ncv - 1;
    const float* wp = W + (size_t)k0 * ld + csrc + lc;
#pragma unroll
    for (int kb = 0; kb < 64; kb += 16) { float v[16];
#pragma unroll
        for (int j = 0; j < 16; ++j) v[j] = __builtin_nontemporal_load(wp + (size_t)(kb + j) * ld);
#pragma unroll
        for (int j = 0; j < 16; ++j) scr[(kb + j) * 65 + lane] = v[j]; }
    asm volatile("s_waitcnt lgkmcnt(0)" ::: "memory");
    const int kc = lane & 3; float gg[16];
#pragma unroll
    for (int j = 0; j < 16; ++j) gg[j] = gs ? gs[k0 + 16 * kc + j] * scale : scale;
#pragma unroll
    for (int i = 0; i < 4; ++i) { const int nn = (lane >> 2) + 16 * i; const LAS float* sp = scr + (16 * kc) * 65 + nn; u32x4 o;
#pragma unroll
        for (int q = 0; q < 4; ++q) { int t = 0; t = __builtin_amdgcn_cvt_pk_fp8_f32(sp[(4 * q) * 65] * gg[4 * q], sp[(4 * q + 1) * 65] * gg[4 * q + 1], t, false); t = __builtin_amdgcn_cvt_pk_fp8_f32(sp[(4 * q + 2) * 65] * gg[4 * q + 2], sp[(4 * q + 3) * 65] * gg[4 * q + 3], t, true); o[q] = (unsigned)t; }
        if (nn < ncv) *(u32x4*)(dst + (size_t)(drow + nn) * dstK + k0 + 16 * kc) = o; }
    asm volatile("s_waitcnt lgkmcnt(0)" ::: "memory");
}
struct CvtCtx { int gw, ngw, base, lane; LAS float* scr; };
__device__ __forceinline__ void cvt_job_gates(CvtCtx& cx, const float* W, int ld, int K, int csrc0, const float* gs, bf16* dst) {
    const int nnb = 64, nit = (K >> 6) * nnb;
    int first = cx.gw - (cx.base % cx.ngw); if (first < 0) first += cx.ngw;
    for (int it = first; it < nit; it += cx.ngw) { const int kb = it / nnb, nb = it - kb * nnb, i = nb >> 4, cc = (nb & 15) * 64;
        cvt_item<true>(W, ld, kb * 64, csrc0 + nb * 64, 64, gs, dst, K, 256 * (cc >> 6) + 128 * (i >> 1) + 4 * (i & 1), cx.scr, cx.lane); }
    cx.base += nit;
}
__device__ __forceinline__ void cvt_job(CvtCtx& cx, const float* W, int ld, int K, int csrc0, int ncols, const float* gs, bf16* dst, int drow_base, int rs128) {
    const int nnb = (ncols + 63) >> 6, nit = (K >> 6) * nnb;
    int first = cx.gw - (cx.base % cx.ngw); if (first < 0) first += cx.ngw;
    for (int it = first; it < nit; it += cx.ngw) { const int kb = it / nnb, nb = it - kb * nnb, c = nb * 64; const int ncv = (ncols - c) < 64 ? (ncols - c) : 64;
        cvt_item(W, ld, kb * 64, csrc0 + c, ncv, gs, dst, K, drow_base + (c >> 7) * rs128 + (c & 127), cx.scr, cx.lane); }
    cx.base += nit;
}
__device__ __forceinline__ void cvt_job8(CvtCtx& cx, const float* W, int ld, int K, int csrc0, int ncols, const float* gs, float scale, unsigned char* dst, int drow_base, int rs128) {
    const int nnb = (ncols + 63) >> 6, nit = (K >> 6) * nnb;
    int first = cx.gw - (cx.base % cx.ngw); if (first < 0) first += cx.ngw;
    for (int it = first; it < nit; it += cx.ngw) { const int kb = it / nnb, nb = it - kb * nnb, c = nb * 64; const int ncv = (ncols - c) < 64 ? (ncols - c) : 64;
        cvt_item8(W, ld, kb * 64, csrc0 + c, ncv, gs, scale, dst, K, drow_base + (c >> 7) * rs128 + (c & 127), cx.scr, cx.lane); }
    cx.base += nit;
}
__device__ __forceinline__ void zero_rows_bf16(int gtid, int nthr, bf16* dst, size_t nelem) {
    u32x4 z = {0u, 0u, 0u, 0u};
    for (size_t i = (size_t)gtid * 8; i < nelem; i += (size_t)nthr * 8) *(u32x4*)(dst + i) = z;
}


__device__ __forceinline__ int rcol(int t, int rot) { return ((((t >> 3) + rot) & 7) << 3) + (t & 7); }
__device__ __forceinline__ int rcol4(int t, int rot) { return ((((t >> 3) + rot) & 3) << 3) + (t & 7); }
constexpr int AT_ST = 72;
constexpr int AT_KS = 0, AT_VT = AT_KS + 2 * 64 * AT_ST * 2, AT_KSC = AT_VT + 2 * 64 * AT_ST * 2, AT_BUFB = AT_KSC + 2 * 64 * 4, AT_BIAS = 2 * AT_BUFB, AT_END = AT_BIAS + 8 * 264 * 4;
__device__ __forceinline__ void attn_drain(const ArgsD& a, int l, LAS unsigned char* lds, LAS unsigned* lctl, unsigned* qctr, const bf16* z, bf16* o) {
    const int tid = opq_v((int)threadIdx.x), lane = tid & 63, wid = __builtin_amdgcn_readfirstlane(tid >> 6);
    const int hs = wid >> 2, qb = wid & 3, fr = lane & 15, g = lane >> 4, ql = 16 * qb + fr, row = tid >> 3, ch = tid & 7;
    constexpr unsigned NU = BATCH * NCH * 4;
    __syncthreads();
    { const float* rb = a.in[I_ATT_BIAS]; LAS float* ball = (LAS float*)(lds + AT_BIAS); float bv[5];
#pragma unroll
      for (int j = 0; j < 5; ++j) { const int i = tid + 512 * j; bv[j] = rb[i < 8 * 257 ? i : 0]; }
#pragma unroll
      for (int j = 0; j < 5; ++j) { const int i = tid + 512 * j; if (i < 8 * 257) { const int hh = i / 257; ball[hh * 264 + (i - hh * 257)] = bv[j] * 1.44269504f; } } }
    f32x4 gq[4];
    { const float* qgp = a.in[I_ATT_QG] + l * 64; const float* kgp = a.in[I_ATT_KG] + l * 64;
      gq[0] = *(const f32x4*)(qgp + 8 * g) * *(const f32x4*)(kgp + 8 * g); gq[1] = *(const f32x4*)(qgp + 8 * g + 4) * *(const f32x4*)(kgp + 8 * g + 4);
      gq[2] = *(const f32x4*)(qgp + 32 + 8 * g) * *(const f32x4*)(kgp + 32 + 8 * g); gq[3] = *(const f32x4*)(qgp + 36 + 8 * g) * *(const f32x4*)(kgp + 36 + 8 * g); }
    if (tid == 0) lctl[32] = atomicAdd(qctr, 1u);
    __syncthreads();
    unsigned q = lctl[32], par = 0, un = 0;
    u32x4 wk[2], wv[2], wq0, wq1;
#define AT_KVPTR(q_, j_) (z + ((size_t)((int)((q_) & 7u)) * SEQ + ((31 - (int)((q_) >> 5)) - 8 + (j_)) * 64 + row) * ZC + C_ATT + 512 + (2 * (int)(((q_) >> 3) & 3u)) * 64 + 8 * ch)
#define AT_LOADKV(p_) do { wk[0] = *(const u32x4*)(p_); wv[0] = *(const u32x4*)((p_) + 512); wk[1] = *(const u32x4*)((p_) + 64); wv[1] = *(const u32x4*)((p_) + 576); } while (0)
#define AT_FETCHQ(q_) do { const int hp_ = (int)(((q_) >> 3) & 3u), c_ = 31 - (int)((q_) >> 5), b_ = (int)((q_) & 7u); const bf16* qp_ = z + ((size_t)b_ * SEQ + c_ * 64 + ql) * ZC + C_ATT + (2 * hp_ + hs) * 64 + 8 * g; \
        wq0 = *(const u32x4*)qp_; wq1 = *(const u32x4*)(qp_ + 32); } while (0)
    const bf16* kvp;
    { const unsigned q0_ = q < NU ? q : NU - 1; const int c0_ = 31 - (int)(q0_ >> 5); kvp = AT_KVPTR(q0_, (c0_ >= 8 ? 0 : 8 - c0_)); AT_LOADKV(kvp); AT_FETCHQ(q0_); }
    while (q < NU) {
        const int hp = (int)((q >> 3) & 3u), c = 31 - (int)(q >> 5), b = (int)(q & 7u), h = 2 * hp + hs;
        unsigned nq_r = NU; if (tid == 0) nq_r = atomicAdd(qctr, 1u);
        const LAS float* bias = (const LAS float*)(lds + AT_BIAS) + h * 264;
        bf16x8 qf[2];
        { f32x4 a0, a1, b0, b1; unpack8(wq0, a0, a1); unpack8(wq1, b0, b1);
          float ss = 0.f;
#pragma unroll
          for (int j = 0; j < 4; ++j) ss += a0[j] * a0[j] + a1[j] * a1[j] + b0[j] * b0[j] + b1[j] * b1[j];
          ss = xrows_sum(ss);
          const float sc = rsqrtf(ss * (1.0f / 64.0f) + NORM_EPS) * 0.125f;
          const u32x4 p0 = pack8(a0 * gq[0] * sc, a1 * gq[1] * sc), p1 = pack8(b0 * gq[2] * sc, b1 * gq[3] * sc);
          qf[0] = __builtin_bit_cast(bf16x8, p0); qf[1] = __builtin_bit_cast(bf16x8, p1); }
        f32x4 oT[4];
#pragma unroll
        for (int d = 0; d < 4; ++d) oT[d] = (f32x4){0.f, 0.f, 0.f, 0.f};
        float m = -1e30f, lsum = 0.f; unsigned nq = NU;
        for (int j = (c >= 8 ? 0 : 8 - c); j <= 8; ++j) {
            LAS unsigned char* buf = lds + par * AT_BUFB; par ^= 1u;
#pragma unroll
            for (int i = 0; i < 2; ++i) { const u32x4 wkk = wk[i], wvv = wv[i];
                *(LAS u32x4*)((LAS bf16*)(buf + AT_KS) + (i * 64 + row) * AT_ST + 8 * ch) = wkk;
                f32x4 k0, k1; unpack8(wkk, k0, k1); float q2 = 0.f;
#pragma unroll
                for (int e = 0; e < 4; ++e) q2 += k0[e] * k0[e] + k1[e] * k1[e];
                q2 = red8_sum(q2);
                if (ch == 0) ((LAS float*)(buf + AT_KSC))[i * 64 + row] = rsqrtf(q2 * (1.0f / 64.0f) + NORM_EPS) * 1.44269504f;
                LAS bf16* vt = (LAS bf16*)(buf + AT_VT) + (i * 64 + 8 * ch) * AT_ST + rcol(row, ch >> 1);
                vt[0 * AT_ST] = (bf16)(wvv.x & 0xffffu); vt[1 * AT_ST] = (bf16)(wvv.x >> 16); vt[2 * AT_ST] = (bf16)(wvv.y & 0xffffu); vt[3 * AT_ST] = (bf16)(wvv.y >> 16);
                vt[4 * AT_ST] = (bf16)(wvv.z & 0xffffu); vt[5 * AT_ST] = (bf16)(wvv.z >> 16); vt[6 * AT_ST] = (bf16)(wvv.w & 0xffffu); vt[7 * AT_ST] = (bf16)(wvv.w >> 16); }
            if (j == 8 && tid == 0) lctl[34 + (un & 1u)] = nq_r;
            __syncthreads();
            { const bf16* np = kvp + (size_t)64 * ZC;
              if (j == 8) { nq = lctl[34 + (un & 1u)]; const unsigned qn = nq < NU ? nq : NU - 1; const int cn_ = 31 - (int)(qn >> 5); np = AT_KVPTR(qn, (cn_ >= 8 ? 0 : 8 - cn_)); AT_FETCHQ(qn); }
              kvp = np; AT_LOADKV(kvp); }
            const LAS bf16* Ks = (const LAS bf16*)(buf + AT_KS) + hs * 64 * AT_ST; const LAS bf16* VT = (const LAS bf16*)(buf + AT_VT) + hs * 64 * AT_ST; const LAS float* ksc = (const LAS float*)(buf + AT_KSC) + hs * 64;
            f32x4 sT[4];
#pragma unroll
            for (int kb = 0; kb < 4; ++kb) { sT[kb] = (f32x4){0.f, 0.f, 0.f, 0.f};
#pragma unroll
                for (int ks = 0; ks < 2; ++ks) { const bf16x8 af = *(const LAS bf16x8*)(Ks + (16 * kb + fr) * AT_ST + 32 * ks + 8 * g); sT[kb] = __builtin_amdgcn_mfma_f32_16x16x32_bf16(af, qf[ks], sT[kb], 0, 0, 0); } }
            float mt = -1e30f;
            if (j <= 5) {
                const float bfar = bias[0];
#pragma unroll
                for (int kb = 0; kb < 4; ++kb) { const f32x4 kv = *(const LAS f32x4*)(ksc + 16 * kb + 4 * g);
#pragma unroll
                    for (int r = 0; r < 4; ++r) { const float sv = sT[kb][r] * kv[r] + bfar; sT[kb][r] = sv; mt = fmaxf(mt, sv); } }
            } else if (j >= 7) {
                const LAS float* bq = bias + ((j - 8) * 64 + 4 * g - ql + 128);
#pragma unroll
                for (int kb = 0; kb < 4; ++kb) { const f32x4 kv = *(const LAS f32x4*)(ksc + 16 * kb + 4 * g);
#pragma unroll
                    for (int r = 0; r < 4; ++r) { const float sv = sT[kb][r] * kv[r] + bq[16 * kb + r]; sT[kb][r] = sv; mt = fmaxf(mt, sv); } }
            } else {
#pragma unroll
                for (int kb = 0; kb < 4; ++kb) { const f32x4 kv = *(const LAS f32x4*)(ksc + 16 * kb + 4 * g);
#pragma unroll
                    for (int r = 0; r < 4; ++r) { int rel = -128 + 16 * kb + 4 * g + r - ql; rel = rel < -128 ? -128 : rel;
                        const float sv = sT[kb][r] * kv[r] + bias[rel + 128]; sT[kb][r] = sv; mt = fmaxf(mt, sv); } }
            }
            mt = xrows_max(mt);
            const float mn = fmaxf(m, mt); const float alpha = __builtin_amdgcn_exp2f(m - mn); m = mn; lsum *= alpha;
#pragma unroll
            for (int d = 0; d < 4; ++d) oT[d] = oT[d] * alpha;
#pragma unroll
            for (int kb = 0; kb < 4; ++kb)
#pragma unroll
                for (int r = 0; r < 4; ++r) { const float p = __builtin_amdgcn_exp2f(sT[kb][r] - mn); sT[kb][r] = p; lsum += p; }
#pragma unroll
            for (int ks = 0; ks < 2; ++ks) { u32x4 pw; pw.x = pg8::cvt_pk_bf16(sT[2 * ks][0], sT[2 * ks][1]); pw.y = pg8::cvt_pk_bf16(sT[2 * ks][2], sT[2 * ks][3]); pw.z = pg8::cvt_pk_bf16(sT[2 * ks + 1][0], sT[2 * ks + 1][1]); pw.w = pg8::cvt_pk_bf16(sT[2 * ks + 1][2], sT[2 * ks + 1][3]);
                const bf16x8 pf = __builtin_bit_cast(bf16x8, pw);
#pragma unroll
                for (int db = 0; db < 4; ++db) { const LAS bf16* vp = VT + (16 * db + fr) * AT_ST; const u32x2 v0 = *(const LAS u32x2*)(vp + rcol(32 * ks + 4 * g, db)), v1 = *(const LAS u32x2*)(vp + rcol(32 * ks + 4 * g + 16, db));
                    u32x4 vw; vw.x = v0.x; vw.y = v0.y; vw.z = v1.x; vw.w = v1.y;
                    oT[db] = __builtin_amdgcn_mfma_f32_16x16x32_bf16(__builtin_bit_cast(bf16x8, vw), pf, oT[db], 0, 0, 0); } }
        }
        lsum = xrows_sum(lsum);
        const float inv = 1.0f / lsum; bf16* op = o + ((size_t)b * SEQ + c * 64 + ql) * 2048 + 1024 + h * 64 + 4 * g;
#pragma unroll
        for (int db = 0; db < 4; ++db) { u32x2 w; w.x = pg8::cvt_pk_bf16(oT[db][0] * inv, oT[db][1] * inv); w.y = pg8::cvt_pk_bf16(oT[db][2] * inv, oT[db][3] * inv); *(u32x2*)(op + 16 * db) = w; }
        q = nq; ++un;
    }
#undef AT_KVPTR
#undef AT_LOADKV
#undef AT_FETCHQ
    __syncthreads();
}

typedef f32x4 acc4;
#define MFMA16(a_, b_, c_) __builtin_amdgcn_mfma_f32_16x16x32_bf16((a_), (b_), (c_), 0, 0, 0)
__device__ __forceinline__ bf16x8 frag_nat(const LAS bf16* base, int pitch, int row, int k0, int g) { return *(const LAS bf16x8*)(base + row * pitch + k0 + 8 * g); }
__device__ __forceinline__ bf16x8 frag_nat_rot(const LAS bf16* base, int row, int k0, int g) { return *(const LAS bf16x8*)(base + row * 72 + ((((k0 >> 3) + g + (row >> 4)) & 7) << 3)); }
__device__ __forceinline__ bf16x8 frag_perm(const LAS bf16* base, int pitch, int row, int k0, int g) { const LAS bf16* p = base + row * pitch + k0 + 4 * g; const u32x2 v0 = *(const LAS u32x2*)p, v1 = *(const LAS u32x2*)(p + 16);
    u32x4 w; w.x = v0.x; w.y = v0.y; w.z = v1.x; w.w = v1.y; return __builtin_bit_cast(bf16x8, w); }
__device__ __forceinline__ bf16x8 frag_acc(const acc4& lo, const acc4& hi) { u32x4 w; w.x = pg8::cvt_pk_bf16(lo[0], lo[1]); w.y = pg8::cvt_pk_bf16(lo[2], lo[3]); w.z = pg8::cvt_pk_bf16(hi[0], hi[1]); w.w = pg8::cvt_pk_bf16(hi[2], hi[3]); return __builtin_bit_cast(bf16x8, w); }
__device__ __forceinline__ float wave_incl_scan(float x, int lane) { (void)lane; return scan64(x); }

constexpr int P72 = 72, P136 = 136;
constexpr int MB_CM = 0, MB_BM = MB_CM + 64 * P136 * 2, MB_BMT = MB_BM + 64 * P136 * 2, MB_XDT = MB_BMT + 128 * P72 * 2, MB_XDTW = MB_XDT + 64 * P72 * 2, MB_P = MB_XDTW + 64 * P72 * 2,
              MB_Y = MB_P + 64 * P72 * 2, MB_ACS = MB_Y + 64 * 68 * 4, MB_DT = MB_ACS + 512, MB_END = MB_DT + 512;
static_assert(MB_END <= 159744, "mamba LDS");
__device__ __forceinline__ void mamba_bc_prepass(const ArgsD& a, int l, int gw, int ngw, int lane, const bf16* z, bf16* bcv) {
    const float* cw = a.in[I_SSM_CONVW] + (size_t)l * 4 * 1024 + 512 + 8 * lane; const float* cb = a.in[I_SSM_CONVB] + l * 1024 + 512 + 8 * lane;
    f32x4 w0[5], w1[5];
#pragma unroll
    for (int j = 0; j < 4; ++j) { w0[j] = *(const f32x4*)(cw + j * 1024); w1[j] = *(const f32x4*)(cw + j * 1024 + 4); }
    w0[4] = *(const f32x4*)cb; w1[4] = *(const f32x4*)(cb + 4);
    for (int rg = gw; rg < T / 8; rg += ngw) { const size_t t0 = (size_t)rg * 8; const bool first = ((rg * 8) & (SEQ - 1)) == 0;
        u32x4 rw[11];
#pragma unroll
        for (int i = 0; i < 11; ++i) { const size_t t = (first && i < 3) ? t0 : t0 + i - 3; rw[i] = *(const u32x4*)(z + t * ZC + C_SSM + 1024 + 8 * lane); }
        if (first) { rw[0] = (u32x4){0u, 0u, 0u, 0u}; rw[1] = rw[0]; rw[2] = rw[0]; }
#pragma unroll
        for (int i = 0; i < 8; ++i) { f32x4 o0 = w0[4], o1 = w1[4];
#pragma unroll
            for (int j = 0; j < 4; ++j) { f32x4 x0, x1; unpack8(rw[i + j], x0, x1); o0 += x0 * w0[j]; o1 += x1 * w1[j]; }
#pragma unroll
            for (int e = 0; e < 4; ++e) { o0[e] = siluf_(o0[e]); o1[e] = siluf_(o1[e]); }
            *(u32x4*)(bcv + (t0 + i) * 512 + 8 * lane) = pack8(o0, o1); } }
}
__device__ __forceinline__ void mamba_block_task(const ArgsD& a, int l, int bh, LAS unsigned char* lds, const bf16* z, const bf16* bcv, bf16* o, float* mssq) {
    const int tid = opq_v((int)threadIdx.x), lane = tid & 63, wid = __builtin_amdgcn_readfirstlane(tid >> 6), fr = lane & 15, g = lane >> 4;
    const int b = bh >> 3, hd = bh & 7, grp = hd >> 2;
    const float dtb = a.in[I_SSM_DTB][l * 8 + hd], Aneg = -__expf(a.in[I_SSM_ALOG][l * 8 + hd]), Dk = a.in[I_SSM_D][l * 8 + hd];
    LAS bf16* Cm = (LAS bf16*)(lds + MB_CM); LAS bf16* Bm = (LAS bf16*)(lds + MB_BM); LAS bf16* BmT = (LAS bf16*)(lds + MB_BMT); LAS bf16* xdtT = (LAS bf16*)(lds + MB_XDT); LAS bf16* xdtwT = (LAS bf16*)(lds + MB_XDTW);
    LAS bf16* Pm = (LAS bf16*)(lds + MB_P); LAS float* Yl = (LAS float*)(lds + MB_Y); LAS float* acs2 = (LAS float*)(lds + MB_ACS); LAS float* dts2 = (LAS float*)(lds + MB_DT);
    const int pb = wid & 3, lh = wid >> 2;
    const int row = tid >> 3, ch = tid & 7;
    f32x4 cw0[5], cw1[5];
    { const float* cw = a.in[I_SSM_CONVW] + (size_t)l * 4 * 1024 + hd * 64 + 8 * ch; const float* cb = a.in[I_SSM_CONVB] + l * 1024 + hd * 64 + 8 * ch;
#pragma unroll
      for (int j = 0; j < 4; ++j) { cw0[j] = *(const f32x4*)(cw + j * 1024); cw1[j] = *(const f32x4*)(cw + j * 1024 + 4); }
      cw0[4] = *(const f32x4*)cb; cw1[4] = *(const f32x4*)(cb + 4); }
    acc4 St[8];
#pragma unroll
    for (int nb = 0; nb < 8; ++nb) St[nb] = (acc4){0.f, 0.f, 0.f, 0.f};
    u32x4 n_gt, n_x[4], n_b0, n_b1, n_c0, n_c1; bf16 n_dt = 0;
#define MB_FETCH(cn_) do { const size_t tq_ = (size_t)b * SEQ + (cn_) * 64 + row; const bf16* zn_ = z + tq_ * ZC + C_SSM; n_gt = *(const u32x4*)(zn_ + hd * 64 + 8 * ch); \
        _Pragma("unroll") for (int k_ = 0; k_ < 4; ++k_) { const bool ok_ = ((cn_) * 64 + row - k_) >= 0; n_x[k_] = *(const u32x4*)(zn_ - (ok_ ? (size_t)k_ * ZC : (size_t)0) + 512 + hd * 64 + 8 * ch); }   \
        const bf16* bq_ = bcv + tq_ * 512 + grp * 128 + 8 * ch; n_b0 = *(const u32x4*)bq_; n_b1 = *(const u32x4*)(bq_ + 64); n_c0 = *(const u32x4*)(bq_ + 256); n_c1 = *(const u32x4*)(bq_ + 320); } while (0)
#define MB_DTSCAN(cn_) do { const float dt_ = softplusf_(bf2f(n_dt) + dtb); const float cs_ = wave_incl_scan(dt_ * Aneg, lane); dts2[((cn_) & 1) * 64 + lane] = dt_; acs2[((cn_) & 1) * 64 + lane] = cs_; } while (0)
    MB_FETCH(0);
    if (wid == 0) { n_dt = z[((size_t)b * SEQ + lane) * ZC + C_SSM + 1536 + hd]; MB_DTSCAN(0); n_dt = z[((size_t)b * SEQ + 64 + lane) * ZC + C_SSM + 1536 + hd]; }
    __syncthreads();
    for (int c = 0; c < NCH; ++c) {
        const size_t t0 = (size_t)b * SEQ + c * 64;
        const LAS float* acs = acs2 + (c & 1) * 64; const LAS float* dts = dts2 + (c & 1) * 64;
        const u32x4 c_gt = n_gt; u32x4 c_x;
        { const float dt = dts[row], wl = __expf(acs[63] - acs[row]);
          f32x4 x0 = cw0[4], x1 = cw1[4];
#pragma unroll
          for (int j = 0; j < 4; ++j) { f32x4 r0, r1; unpack8(n_x[3 - j], r0, r1); const float mk = (c * 64 + row - (3 - j) >= 0) ? 1.0f : 0.0f; x0 += r0 * (cw0[j] * mk); x1 += r1 * (cw1[j] * mk); }
#pragma unroll
          for (int e = 0; e < 4; ++e) { x0[e] = siluf_(x0[e]); x1[e] = siluf_(x1[e]); }
          c_x = pack8(x0, x1);
#pragma unroll
          for (int e = 0; e < 4; ++e) { const float v0 = x0[e] * dt, v1 = x1[e] * dt; xdtT[(8 * ch + e) * P72 + rcol(row, ch >> 1)] = (bf16)f2bf(v0); xdtT[(8 * ch + 4 + e) * P72 + rcol(row, ch >> 1)] = (bf16)f2bf(v1);
              xdtwT[(8 * ch + e) * P72 + rcol(row, ch >> 1)] = (bf16)f2bf(v0 * wl); xdtwT[(8 * ch + 4 + e) * P72 + rcol(row, ch >> 1)] = (bf16)f2bf(v1 * wl); }
#pragma unroll
          for (int i = 0; i < 2; ++i) { const int cc = ch + 8 * i; const u32x4 wb = i ? n_b1 : n_b0, wc = i ? n_c1 : n_c0;
              *(LAS u32x4*)(Bm + row * P136 + 8 * cc) = wb; *(LAS u32x4*)(Cm + row * P136 + 8 * cc) = wc;
              LAS bf16* bt = BmT + (8 * cc) * P72 + rcol(row, cc >> 1);
              bt[0 * P72] = (bf16)(wb.x & 0xffffu); bt[1 * P72] = (bf16)(wb.x >> 16); bt[2 * P72] = (bf16)(wb.y & 0xffffu); bt[3 * P72] = (bf16)(wb.y >> 16);
              bt[4 * P72] = (bf16)(wb.z & 0xffffu); bt[5 * P72] = (bf16)(wb.z >> 16); bt[6 * P72] = (bf16)(wb.w & 0xffffu); bt[7 * P72] = (bf16)(wb.w >> 16); } }
        __syncthreads();
        if (wid == 0 && c + 1 < NCH) MB_DTSCAN(c + 1);
        { const int lb = wid >> 1;
#pragma unroll
          for (int q = 0; q < 2; ++q) { const int sb = 2 * (wid & 1) + q; acc4 cb = (acc4){0.f, 0.f, 0.f, 0.f};
#pragma unroll
              for (int ks = 0; ks < 4; ++ks) cb = MFMA16(frag_nat(Cm, P136, 16 * lb + fr, 32 * ks, g), frag_nat(Bm, P136, 16 * sb + fr, 32 * ks, g), cb);
              const int sidx = 16 * sb + fr; const float as = acs[sidx];
#pragma unroll
              for (int r = 0; r < 4; ++r) { const int lidx = 16 * lb + 4 * g + r; const float v = (sidx <= lidx) ? cb[r] * __expf(acs[lidx] - as) : 0.f; Pm[lidx * P72 + sidx] = (bf16)f2bf(v); } } }
        __syncthreads();
        { const int cn = (c + 1 < NCH) ? c + 1 : c; MB_FETCH(cn); const int cd = (c + 2 < NCH) ? c + 2 : c; if (wid == 0) n_dt = z[((size_t)b * SEQ + cd * 64 + lane) * ZC + C_SSM + 1536 + hd]; }
#pragma unroll
        for (int q = 0; q < 2; ++q) { const int lb = 2 * lh + q; acc4 y = (acc4){0.f, 0.f, 0.f, 0.f};
#pragma unroll
            for (int kk = 0; kk < 4; ++kk) y = MFMA16(frag_perm(Cm, P136, 16 * lb + fr, 32 * kk, g), frag_acc(St[2 * kk], St[2 * kk + 1]), y);
#pragma unroll
            for (int r = 0; r < 4; ++r) y[r] *= __expf(acs[16 * lb + 4 * g + r]);
#pragma unroll
            for (int ks = 0; ks < 2; ++ks) y = MFMA16(frag_nat(Pm, P72, 16 * lb + fr, 32 * ks, g), frag_nat_rot(xdtT, 16 * pb + fr, 32 * ks, g), y);
#pragma unroll
            for (int r = 0; r < 4; ++r) Yl[(16 * lb + 4 * g + r) * 68 + 16 * pb + fr] = y[r]; }
        { const float dec = __expf(acs[63]);
#pragma unroll
          for (int nb = 0; nb < 8; ++nb) { St[nb] = St[nb] * dec;
#pragma unroll
              for (int ks = 0; ks < 2; ++ks) St[nb] = MFMA16(frag_nat_rot(BmT, 16 * nb + fr, 32 * ks, g), frag_nat_rot(xdtwT, 16 * pb + fr, 32 * ks, g), St[nb]); } }
        __syncthreads();
        { const size_t t = t0 + row;
          f32x4 x0, x1, g0, g1; unpack8(c_x, x0, x1); unpack8(c_gt, g0, g1);
          const f32x4 y0 = *(const LAS f32x4*)(Yl + row * 68 + 8 * ch), y1 = *(const LAS f32x4*)(Yl + row * 68 + 8 * ch + 4); f32x4 o0, o1; float q2 = 0.f;
#pragma unroll
          for (int e = 0; e < 4; ++e) { o0[e] = (y0[e] + x0[e] * Dk) * siluf_(g0[e]); o1[e] = (y1[e] + x1[e] * Dk) * siluf_(g1[e]); q2 += o0[e] * o0[e] + o1[e] * o1[e]; }
          *(u32x4*)(o + t * 2048 + 512 + hd * 64 + 8 * ch) = pack8(o0, o1);
          q2 = red8_sum(q2);
          if (ch == 0) mssq[t * 8 + hd] = q2; }
    }
#undef MB_FETCH
#undef MB_DTSCAN
    __syncthreads();
}

constexpr int P132 = 132;
constexpr int GL_BC = 0, GL_QG = GL_BC + 64 * 68 * 4, GL_KG = GL_QG + 64 * P72 * 2, GL_KDT = GL_KG + 64 * P72 * 2, GL_VT = GL_KDT + 64 * P72 * 2, GL_ATT = GL_VT + 128 * P72 * 2,
              GL_O = GL_ATT + 64 * P72 * 2, GL_GU = GL_O + 64 * P132 * 4, GL_END = GL_GU + 17 * 64 * 4;
static_assert(GL_END <= LDS_MAIN, "gla LDS");
constexpr int GP_GU = 0, GP_BC = GP_GU + 17 * 64 * 4, GP_END = GP_BC + 2 * 64 * 68 * 4;
__device__ __forceinline__ void gla_prepass(const ArgsD& a, int l, int bx, int G, LAS unsigned char* lds, bf16* z, float* gend) {
    const int tid = opq_v((int)threadIdx.x), lane = tid & 63, wid = __builtin_amdgcn_readfirstlane(tid >> 6), row = tid >> 3, ch = tid & 7;
    LAS float* gu = (LAS float*)(lds + GP_GU);
    constexpr int NUN = BATCH * 4 * NCH;
    int gu_h = -1; unsigned par = 0;
    u32x4 wx0, wx1, wq, wk;
#define GP_FETCH(u_) do { const int c_ = (u_) & 31, h_ = ((u_) >> 5) & 3, b_ = (u_) >> 7; const bf16* zn_ = z + ((size_t)b_ * SEQ + c_ * 64 + row) * ZC + C_GLA; \
        wx0 = *(const u32x4*)(zn_ + 1024); wx1 = *(const u32x4*)(zn_ + 1032); wq = *(const u32x4*)(zn_ + h_ * 64 + 8 * ch); wk = *(const u32x4*)(zn_ + 256 + h_ * 64 + 8 * ch); } while (0)
    { const int u0 = bx < NUN ? bx : NUN - 1; GP_FETCH(u0); }
    for (int u = bx; u < NUN; u += G) {
        const int c = u & 31, h = (u >> 5) & 3, b = u >> 7;
        if (gu_h != h) { gu_h = h; __syncthreads();
            const float* gup = a.in[I_GLA_GUP] + (size_t)l * 16 * 256 + h * 64; const float* gbp = a.in[I_GLA_GB] + l * 256 + h * 64; float gv[3];
#pragma unroll
            for (int j = 0; j < 3; ++j) { const int i = tid + 512 * j, ic = i < 17 * 64 ? i : 0, r = ic >> 6, k = ic & 63; gv[j] = (r < 16) ? gup[r * 256 + k] : gbp[k]; }
#pragma unroll
            for (int j = 0; j < 3; ++j) { const int i = tid + 512 * j; if (i < 17 * 64) gu[i] = gv[j]; }
            __syncthreads(); }
        LAS float* bc = (LAS float*)(lds + GP_BC) + par * (64 * 68); par ^= 1u;
        const u32x4 c_q = wq, c_k = wk; f32x4 xa, xb_, xc, xd; unpack8(wx0, xa, xb_); unpack8(wx1, xc, xd);
        { const int un = (u + G < NUN) ? u + G : u; GP_FETCH(un); }
        { f32x4 la0 = *(const LAS f32x4*)(gu + 16 * 64 + 8 * ch), la1 = *(const LAS f32x4*)(gu + 16 * 64 + 8 * ch + 4);
#pragma unroll
          for (int r = 0; r < 16; ++r) { const float xv = (r < 4) ? xa[r & 3] : (r < 8) ? xb_[r & 3] : (r < 12) ? xc[r & 3] : xd[r & 3];
              la0 += *(const LAS f32x4*)(gu + r * 64 + 8 * ch) * xv; la1 += *(const LAS f32x4*)(gu + r * 64 + 8 * ch + 4) * xv; }
#pragma unroll
          for (int e = 0; e < 4; ++e) { la0[e] = (fminf(la0[e], 0.f) - __logf(1.0f + __expf(-fabsf(la0[e])))) * (1.0f / 16.0f); la1[e] = (fminf(la1[e], 0.f) - __logf(1.0f + __expf(-fabsf(la1[e])))) * (1.0f / 16.0f); }
          *(LAS f32x4*)(bc + row * 68 + 8 * ch) = la0; *(LAS f32x4*)(bc + row * 68 + 8 * ch + 4) = la1; }
        __syncthreads();
#pragma unroll
        for (int q = 0; q < 8; ++q) { const int k = 8 * wid + q; const float v = scan64(bc[lane * 68 + k]); bc[lane * 68 + k] = v; }
        __syncthreads();
        { const f32x4 b0 = *(const LAS f32x4*)(bc + row * 68 + 8 * ch), b1 = *(const LAS f32x4*)(bc + row * 68 + 8 * ch + 4);
          f32x4 q0, q1, k0, k1, qa, qb_, ka, kb_; unpack8(c_q, q0, q1); unpack8(c_k, k0, k1);
#pragma unroll
          for (int e = 0; e < 4; ++e) { qa[e] = q0[e] * __expf(b0[e]) * 0.125f; qb_[e] = q1[e] * __expf(b1[e]) * 0.125f; ka[e] = k0[e] * __expf(-b0[e]); kb_[e] = k1[e] * __expf(-b1[e]); }
          bf16* zn = z + ((size_t)b * SEQ + c * 64 + row) * ZC + C_GLA; *(u32x4*)(zn + h * 64 + 8 * ch) = pack8(qa, qb_); *(u32x4*)(zn + 256 + h * 64 + 8 * ch) = pack8(ka, kb_);
          if (tid < 64) gend[(size_t)u * 64 + tid] = bc[63 * 68 + tid]; }
    }
#undef GP_FETCH
    __syncthreads();
}
__device__ __forceinline__ void gla_block_task(const ArgsD& a, int l, int bh, LAS unsigned char* lds, const bf16* z, const float* gend, bf16* o) {
    const int tid = opq_v((int)threadIdx.x), lane = tid & 63, wid = __builtin_amdgcn_readfirstlane(tid >> 6), fr = lane & 15, g = lane >> 4;
    const int b = bh >> 2, h = bh & 3;
    LAS float* endl = (LAS float*)(lds + GL_BC); LAS bf16* qg = (LAS bf16*)(lds + GL_QG); LAS bf16* kg = (LAS bf16*)(lds + GL_KG); LAS bf16* kgT = (LAS bf16*)(lds + GL_KDT); LAS bf16* vT = (LAS bf16*)(lds + GL_VT);
    LAS bf16* att = (LAS bf16*)(lds + GL_ATT); LAS float* Ol = (LAS float*)(lds + GL_O);
    const float* nwp = a.in[I_GLA_NW] + l * 128;
    acc4 St[4];
#pragma unroll
    for (int kb = 0; kb < 4; ++kb) St[kb] = (acc4){0.f, 0.f, 0.f, 0.f};
    const int row = tid >> 3, ch = tid & 7;
    const f32x4 nw0 = *(const f32x4*)(nwp + 16 * ch), nw1 = *(const f32x4*)(nwp + 16 * ch + 4), nw2 = *(const f32x4*)(nwp + 16 * ch + 8), nw3 = *(const f32x4*)(nwp + 16 * ch + 12);
    u32x4 n_q, n_k, n_v0, n_v1, n_g0, n_g1; float n_end = 0.f;
#define GL_FETCH(cn_) do { const bf16* zn_ = z + ((size_t)b * SEQ + (cn_) * 64 + row) * ZC + C_GLA; n_q = *(const u32x4*)(zn_ + h * 64 + 8 * ch); n_k = *(const u32x4*)(zn_ + 256 + h * 64 + 8 * ch); \
        n_v0 = *(const u32x4*)(zn_ + 512 + h * 128 + 8 * ch); n_v1 = *(const u32x4*)(zn_ + 512 + h * 128 + 8 * (ch + 8)); n_g0 = *(const u32x4*)(zn_ + 1040 + h * 128 + 16 * ch); n_g1 = *(const u32x4*)(zn_ + 1040 + h * 128 + 16 * ch + 8); \
        if (tid < 64) n_end = gend[((size_t)(b * 4 + h) * NCH + (cn_)) * 64 + tid]; } while (0)
    GL_FETCH(0);
    __syncthreads();
    for (int c = 0; c < NCH; ++c) {
        const size_t t0 = (size_t)b * SEQ + c * 64;
        const u32x4 c_g0 = n_g0, c_g1 = n_g1;
        { *(LAS u32x4*)(qg + row * P72 + 8 * ch) = n_q; *(LAS u32x4*)(kg + row * P72 + 8 * ch) = n_k;
          if (tid < 64) endl[tid] = n_end;
          { LAS bf16* kt = kgT + (8 * ch) * P72 + rcol(row, ch >> 1); const u32x4 wv = n_k;
            kt[0 * P72] = (bf16)(wv.x & 0xffffu); kt[1 * P72] = (bf16)(wv.x >> 16); kt[2 * P72] = (bf16)(wv.y & 0xffffu); kt[3 * P72] = (bf16)(wv.y >> 16);
            kt[4 * P72] = (bf16)(wv.z & 0xffffu); kt[5 * P72] = (bf16)(wv.z >> 16); kt[6 * P72] = (bf16)(wv.w & 0xffffu); kt[7 * P72] = (bf16)(wv.w >> 16); }
#pragma unroll
          for (int i = 0; i < 2; ++i) { const int cc = ch + 8 * i; const u32x4 wv = i ? n_v1 : n_v0; LAS bf16* vt = vT + (8 * cc) * P72 + rcol(row, cc >> 1);
              vt[0 * P72] = (bf16)(wv.x & 0xffffu); vt[1 * P72] = (bf16)(wv.x >> 16); vt[2 * P72] = (bf16)(wv.y & 0xffffu); vt[3 * P72] = (bf16)(wv.y >> 16);
              vt[4 * P72] = (bf16)(wv.z & 0xffffu); vt[5 * P72] = (bf16)(wv.z >> 16); vt[6 * P72] = (bf16)(wv.w & 0xffffu); vt[7 * P72] = (bf16)(wv.w >> 16); } }
        __syncthreads();
        { const int lb = wid >> 1;
#pragma unroll
          for (int q = 0; q < 2; ++q) { const int sb = 2 * (wid & 1) + q; acc4 at = (acc4){0.f, 0.f, 0.f, 0.f};
#pragma unroll
              for (int ks = 0; ks < 2; ++ks) at = MFMA16(frag_nat(qg, P72, 16 * lb + fr, 32 * ks, g), frag_nat(kg, P72, 16 * sb + fr, 32 * ks, g), at);
              const int sidx = 16 * sb + fr;
#pragma unroll
              for (int r = 0; r < 4; ++r) { const int lidx = 16 * lb + 4 * g + r; att[lidx * P72 + sidx] = (bf16)f2bf((sidx <= lidx) ? at[r] : 0.f); } } }
        __syncthreads();
        { const int cn = (c + 1 < NCH) ? c + 1 : c; GL_FETCH(cn); }
#pragma unroll
        for (int lb = 0; lb < 4; ++lb) { acc4 ov = (acc4){0.f, 0.f, 0.f, 0.f};
#pragma unroll
            for (int kk = 0; kk < 2; ++kk) ov = MFMA16(frag_perm(qg, P72, 16 * lb + fr, 32 * kk, g), frag_acc(St[2 * kk], St[2 * kk + 1]), ov);
#pragma unroll
            for (int ks = 0; ks < 2; ++ks) ov = MFMA16(frag_nat(att, P72, 16 * lb + fr, 32 * ks, g), frag_nat_rot(vT, 16 * wid + fr, 32 * ks, g), ov);
#pragma unroll
            for (int r = 0; r < 4; ++r) Ol[(16 * lb + 4 * g + r) * P132 + 16 * wid + fr] = ov[r]; }
#pragma unroll
        for (int kb = 0; kb < 4; ++kb) { const f32x4 bl = *(const LAS f32x4*)(endl + 16 * kb + 4 * g);
#pragma unroll
            for (int ks = 0; ks < 2; ++ks) St[kb] = MFMA16(frag_nat_rot(kgT, 16 * kb + fr, 32 * ks, g), frag_nat_rot(vT, 16 * wid + fr, 32 * ks, g), St[kb]);
#pragma unroll
            for (int r = 0; r < 4; ++r) St[kb][r] *= __expf(bl[r]); }
        __syncthreads();
        { const size_t t = t0 + row; float q2 = 0.f; f32x4 ov[4];
#pragma unroll
          for (int i = 0; i < 4; ++i) { ov[i] = *(const LAS f32x4*)(Ol + row * P132 + 16 * ch + 4 * i); q2 += ov[i][0] * ov[i][0] + ov[i][1] * ov[i][1] + ov[i][2] * ov[i][2] + ov[i][3] * ov[i][3]; }
          q2 = red8_sum(q2);
          const float sc = rsqrtf(q2 * (1.0f / 128.0f) + NORM_EPS);
#pragma unroll
          for (int i = 0; i < 2; ++i) { const u32x4 wg = i ? c_g1 : c_g0; f32x4 g0, g1; unpack8(wg, g0, g1);
              const f32x4 n0 = i ? nw2 : nw0, n1 = i ? nw3 : nw1; f32x4 r0, r1;
#pragma unroll
              for (int e = 0; e < 4; ++e) { r0[e] = ov[2 * i][e] * sc * n0[e] * siluf_(g0[e]); r1[e] = ov[2 * i + 1][e] * sc * n1[e] * siluf_(g1[e]); }
              *(u32x4*)(o + t * 2048 + 1536 + h * 128 + 16 * ch + 8 * i) = pack8(r0, r1); } }
    }
#undef GL_FETCH
    __syncthreads();
}

constexpr int RT = 32, P40 = 40, P328 = 328, P168 = 168;
constexpr int RW_REC = 29184;
constexpr int IM_AT = 0, IM_RT = IM_AT + RT * P72 * 2, IM_KPT = IM_RT + RT * P72 * 2, IM_BPT = IM_KPT + 64 * P40 * 2, IM_VT = IM_BPT + 64 * P40 * 2, IM_MAK = IM_VT + 64 * P40 * 2, IM_ARK = IM_MAK + RT * P40 * 2,
              IM_ARB = IM_ARK + RT * P40 * 2, IM_T1 = IM_ARB + RT * P40 * 2, IM_T2 = IM_T1 + 16 * P40 * 2, IM_GAM = IM_T2 + 16 * P40 * 2, IM_BON = IM_GAM + 256, IM_END = IM_BON + 128;
__device__ __forceinline__ int rw_piece_off(int p) {
    if (p < 512) { const int m = p >> 8, q = p & 255; return (m ? IM_RT : IM_AT) + (q >> 3) * (P72 * 2) + (q & 7) * 16; }
    p -= 512; if (p < 768) { const int m = p >> 8, q = p & 255; return IM_KPT + m * (64 * P40 * 2) + (q >> 2) * (P40 * 2) + (q & 3) * 16; }
    p -= 768; if (p < 384) { const int m = p >> 7, q = p & 127; return IM_MAK + m * (RT * P40 * 2) + (q >> 2) * (P40 * 2) + (q & 3) * 16; }
    p -= 384; if (p < 128) { const int m = p >> 6, q = p & 63; return IM_T1 + m * (16 * P40 * 2) + (q >> 2) * (P40 * 2) + (q & 3) * 16; }
    p -= 128; return IM_GAM + p * 16;
}
constexpr int RW_NPIECE = 1816;
__device__ __forceinline__ unsigned char* rw_rec_ptr(unsigned char* ws, int h, int b, int c) {
    unsigned char* base = (h < 4) ? ws + WS_XG : (h < 6) ? ws + WS_X + X_MIXED : ws + WS_Z + (size_t)T * ZC * 2;
    const int hl = (h < 4) ? h : (h < 6) ? h - 4 : h - 6;
    return base + ((size_t)(hl * BATCH + b) * (SEQ / RT) + c) * RW_REC;
}
static_assert((size_t)4 * BATCH * (SEQ / RT) * RW_REC <= XG_BYTES && (size_t)2 * BATCH * (SEQ / RT) * RW_REC <= (size_t)T * DM * 2 && (size_t)2 * BATCH * (SEQ / RT) * RW_REC <= Z_BYTES - (size_t)T * ZC * 2, "rwkv record regions");

constexpr int RW_WD = 0, RW_WA = RW_WD + 64 * P72 * 2, RW_WG = RW_WA + 64 * P72 * 2, RW_WV = RW_WG + 64 * P168 * 2, RW_HALF0 = RW_WV + 64 * P40 * 2;
constexpr int RH_XLR = 0, RH_LC = 0, RH_KH = RH_LC + RT * 68 * 4, RH_BH = RH_KH + RT * P72 * 2, RH_MAB = RH_BH + RT * P72 * 2, RH_R1_END = RH_MAB + RT * 33 * 4, RH_IMG = 22272, RH_PROJ = RH_IMG, RH_BYTES = RH_IMG + IM_END;
constexpr int RW_PAR = RW_HALF0 + 2 * RH_BYTES;
constexpr int RW_END = RW_PAR + 9 * 64 * 4;
static_assert(RH_R1_END <= RH_IMG && RT * P328 * 2 <= RH_IMG && 4 * RT * P72 * 2 <= IM_GAM && RW_END <= NWAVES * 20352 && (RH_IMG % 16) == 0 && (RH_BYTES % 16) == 0 && (RW_HALF0 % 16) == 0, "rwkv prep LDS");
constexpr int XLR_OFF = 512;
__device__ __forceinline__ void rwkv_xlr_prepass(const ArgsD& a, int l, int bx, int G, const bf16* z, bf16* o) {
    const int tid = opq_v((int)threadIdx.x);
    const float* mu = a.in[I_RW_MU] + l * 1824;
    for (int rb = bx; rb < T / 64; rb += G) {
        u32x4 wc_[5], wp_[5]; f32x4 m0_[5], m1_[5];
#pragma unroll
        for (int i = 0; i < 5; ++i) { const int it = tid + 512 * i, tk = it / 40, q = it - tk * 40; const size_t row = (size_t)rb * 64 + tk;
            const int col = (q < 36) ? 1536 + 8 * q : C_HV + 8 * (q - 36);
            const size_t prow = ((row & (SEQ - 1)) == 0) ? row : row - 1;
            wc_[i] = *(const u32x4*)(z + row * ZC + col); wp_[i] = *(const u32x4*)(z + prow * ZC + col);
            const int mcol = (q < 36) ? col : 1536;
            m0_[i] = *(const f32x4*)(mu + mcol); m1_[i] = *(const f32x4*)(mu + mcol + 4); }
#pragma unroll
        for (int i = 0; i < 5; ++i) { const int it = tid + 512 * i, tk = it / 40, q = it - tk * 40; const size_t row = (size_t)rb * 64 + tk; f32x4 c0v, c1v, p0v, p1v; unpack8(wc_[i], c0v, c1v); unpack8(wp_[i], p0v, p1v);
            if ((row & (SEQ - 1)) == 0) { p0v = (f32x4){0.f, 0.f, 0.f, 0.f}; p1v = p0v; }
            const f32x4 x0 = c0v + (p0v - c0v) * m0_[i], x1 = c1v + (p1v - c1v) * m1_[i];
            const float kk2 = (q < 8) ? 2.0f : 1.0f; f32x4 v0, v1;
#pragma unroll
            for (int e = 0; e < 4; ++e) { const float s0 = sigmoidf_(kk2 * x0[e]), s1 = sigmoidf_(kk2 * x1[e]);
                v0[e] = (q < 8) ? 2.0f * s0 - 1.0f : (q < 16) ? x0[e] : (q < 36) ? s0 : c0v[e]; v1[e] = (q < 8) ? 2.0f * s1 - 1.0f : (q < 16) ? x1[e] : (q < 36) ? s1 : c1v[e]; }
            *(u32x4*)(o + row * 2048 + XLR_OFF + 8 * q) = pack8(v0, v1); }
    }
}
struct PrepPf { u32x4 wzr, wzk, wzv, wpr, wpk, wpv, wvf, xl[5]; };
__device__ __forceinline__ void rwkv_prep_fetch(PrepPf& pf, int l, int h, int b, int cpair, const bf16* z, const bf16* vfirst, const bf16* o) {
    const int tid = opq_v((int)threadIdx.x), lt = tid & 255, c = cpair + (tid >> 8), tok = lt >> 3, C0 = h * 64 + 8 * (lt & 7);
    const size_t t0 = (size_t)b * SEQ + c * RT;
    const bf16* zp = z + (t0 + tok) * ZC + C0; pf.wzr = *(const u32x4*)zp; pf.wzk = *(const u32x4*)(zp + 512); pf.wzv = *(const u32x4*)(zp + 1024);
    const bf16* zq = (c == 0 && tok == 0) ? zp : zp - ZC; pf.wpr = *(const u32x4*)zq; pf.wpk = *(const u32x4*)(zq + 512); pf.wpv = *(const u32x4*)(zq + 1024);
    if (l == 1) pf.wvf = *(const u32x4*)(vfirst + (t0 + tok) * 512 + C0); else pf.wvf = (u32x4){0u, 0u, 0u, 0u};
#pragma unroll
    for (int i = 0; i < 5; ++i) { const int it = lt + 256 * i, tk = it / 40, q = it - tk * 40; pf.xl[i] = *(const u32x4*)(o + (t0 + tk) * 2048 + XLR_OFF + 8 * q); }
}
__device__ __forceinline__ void rwkv_prep_pair(const ArgsD& a, int l, int h, int b, int cpair, int nh, int nb, int ncpair, PrepPf& pf, int& wts_h, LAS unsigned char* lds, const bf16* z, bf16* vfirst, bf16* o, unsigned char* ws) {
    const int tid = opq_v((int)threadIdx.x), lane = tid & 63, wid = __builtin_amdgcn_readfirstlane(tid >> 6), fr = lane & 15, g = lane >> 4;
    const int hf = wid >> 2, lw = wid & 3, lt = tid & 255, c = cpair + hf;
    LAS bf16* Wd = (LAS bf16*)(lds + RW_WD); LAS bf16* Wa = (LAS bf16*)(lds + RW_WA); LAS bf16* Wg = (LAS bf16*)(lds + RW_WG); LAS bf16* Wv = (LAS bf16*)(lds + RW_WV);
    LAS unsigned char* hb_ = lds + RW_HALF0 + hf * RH_BYTES;
    LAS bf16* Xlr = (LAS bf16*)(hb_ + RH_XLR); LAS bf16* Proj = (LAS bf16*)(hb_ + RH_PROJ); LAS float* Lc = (LAS float*)(hb_ + RH_LC);
    LAS bf16* Kh = (LAS bf16*)(hb_ + RH_KH); LAS bf16* Bh = (LAS bf16*)(hb_ + RH_BH); LAS float* Mab = (LAS float*)(hb_ + RH_MAB); LAS unsigned char* img = hb_ + RH_IMG;
    LAS bf16* At = (LAS bf16*)(img + IM_AT); LAS bf16* Rt = (LAS bf16*)(img + IM_RT); LAS bf16* KpT = (LAS bf16*)(img + IM_KPT); LAS bf16* BpT = (LAS bf16*)(img + IM_BPT); LAS bf16* VT = (LAS bf16*)(img + IM_VT);
    LAS bf16* Mak = (LAS bf16*)(img + IM_MAK); LAS bf16* Ark = (LAS bf16*)(img + IM_ARK); LAS bf16* Arb = (LAS bf16*)(img + IM_ARB); LAS bf16* T1 = (LAS bf16*)(img + IM_T1); LAS bf16* T2 = (LAS bf16*)(img + IM_T2);
    LAS float* gam = (LAS float*)(img + IM_GAM); LAS float* bon = (LAS float*)(img + IM_BON);
    if (wts_h != h) { wts_h = h;
        const float* dup = a.in[I_RW_DECAY_UP] + (size_t)l * 64 * 512 + h * 64; const float* aup = a.in[I_RW_A_UP] + (size_t)l * 64 * 512 + h * 64; const float* gup = a.in[I_RW_GATE_UP] + (size_t)l * 160 * 512 + h * 64; const float* vup = a.in[I_VRES_UP] + h * 64;
        { const int k0 = tid >> 6, ch = tid & 63;
          float dv[8], av_[8], gv[20], vv_[4];
#pragma unroll
          for (int j = 0; j < 8; ++j) { dv[j] = dup[(k0 + 8 * j) * 512 + ch]; av_[j] = aup[(k0 + 8 * j) * 512 + ch]; }
#pragma unroll
          for (int j = 0; j < 4; ++j) vv_[j] = vup[(k0 + 8 * j) * 512 + ch];
#pragma unroll
          for (int j = 0; j < 20; ++j) gv[j] = gup[(k0 + 8 * j) * 512 + ch];
#pragma unroll
          for (int j = 0; j < 8; ++j) { Wd[ch * P72 + k0 + 8 * j] = (bf16)f2bf(dv[j]); Wa[ch * P72 + k0 + 8 * j] = (bf16)f2bf(av_[j]); }
#pragma unroll
          for (int j = 0; j < 4; ++j) Wv[ch * P40 + k0 + 8 * j] = (bf16)f2bf(vv_[j]);
#pragma unroll
          for (int j = 0; j < 20; ++j) Wg[ch * P168 + k0 + 8 * j] = (bf16)f2bf(gv[j]); }
        { const int p = tid >> 6, cc = h * 64 + (tid & 63); const float* mu_ = a.in[I_RW_MU] + l * 1824;
          float pv0 = 0.f, pv1 = 0.f;
          pv0 = (p == 0) ? mu_[cc] : (p == 1) ? mu_[512 + cc] : (p == 2) ? mu_[1024 + cc] : (p == 3) ? a.in[I_RW_W0][l * 512 + cc] : (p == 4) ? a.in[I_RW_A0][l * 512 + cc] : (p == 5) ? a.in[I_VRES_V0][cc] : (p == 6) ? a.in[I_RW_KK][l * 512 + cc] : a.in[I_RW_KA][l * 512 + cc];
          if (tid < 64) pv1 = a.in[I_RW_RK][l * 512 + cc];
          LAS float* par_ = (LAS float*)(lds + RW_PAR); par_[tid] = pv0; if (tid < 64) par_[512 + tid] = pv1; } }
    const float* mu = a.in[I_RW_MU] + l * 1824;
    const int tok = lt >> 3, c0 = 8 * (lt & 7), C0 = h * 64 + c0;
    const size_t t0 = (size_t)b * SEQ + c * RT;
    const u32x4 zz4 = {0u, 0u, 0u, 0u}; const bool ftok = (c == 0 && tok == 0);
    const u32x4 wzr = pf.wzr, wzk = pf.wzk, wzv = pf.wzv, wpr = ftok ? zz4 : pf.wpr, wpk = ftok ? zz4 : pf.wpk, wpv = ftok ? zz4 : pf.wpv, wvf = pf.wvf;
#pragma unroll
    for (int i = 0; i < 5; ++i) { const int it = lt + 256 * i, tk = it / 40, q = it - tk * 40; *(LAS u32x4*)(Xlr + tk * P328 + 8 * q) = pf.xl[i]; }
    __syncthreads();
    { const int cb = lw;
#pragma unroll
      for (int p = 0; p < 4; ++p) { const LAS bf16* Wp = (p == 0) ? Wd : (p == 1) ? Wa : (p == 2) ? Wg : Wv; const int wp = (p == 2) ? P168 : (p == 3) ? P40 : P72; const int kb0 = (p == 0) ? 0 : (p == 1) ? 64 : (p == 2) ? 128 : 288;
          const int nks = (p == 2) ? 5 : (p == 3) ? 1 : 2;
#pragma unroll
          for (int rb = 0; rb < 2; ++rb) { acc4 ac = (acc4){0.f, 0.f, 0.f, 0.f};
#pragma unroll
              for (int ks = 0; ks < nks; ++ks) ac = MFMA16(frag_nat(Xlr, P328, 16 * rb + fr, kb0 + 32 * ks, g), frag_nat(Wp, wp, 16 * cb + fr, 32 * ks, g), ac);
#pragma unroll
              for (int r = 0; r < 4; ++r) Proj[(p * RT + 16 * rb + 4 * g + r) * P72 + 16 * cb + fr] = (bf16)f2bf(ac[r]); } } }
    __syncthreads();
    f32x4 rr[2], kk_[2], vv[2], ap[2], bp[2];
    { const size_t row = t0 + tok; f32x4 zr[2], zk[2], zv[2], pr[2], pk[2], pv[2], dw[2], da[2], gg[2], vm[2], vf[2];
      unpack8(wzr, zr[0], zr[1]); unpack8(wzk, zk[0], zk[1]); unpack8(wzv, zv[0], zv[1]); unpack8(wpr, pr[0], pr[1]); unpack8(wpk, pk[0], pk[1]); unpack8(wpv, pv[0], pv[1]); unpack8(wvf, vf[0], vf[1]);
      unpack8(*(const LAS u32x4*)(Proj + (0 * RT + tok) * P72 + c0), dw[0], dw[1]); unpack8(*(const LAS u32x4*)(Proj + (1 * RT + tok) * P72 + c0), da[0], da[1]);
      unpack8(*(const LAS u32x4*)(Proj + (2 * RT + tok) * P72 + c0), gg[0], gg[1]); unpack8(*(const LAS u32x4*)(Proj + (3 * RT + tok) * P72 + c0), vm[0], vm[1]);
      f32x4 ee[2], av[2], vraw[2], kraw[2]; float n2 = 0.f;
#pragma unroll
      for (int hq = 0; hq < 2; ++hq) { const int Cq = C0 + 4 * hq;
          const LAS float* pq = (const LAS float*)(lds + RW_PAR) + c0 + 4 * hq; (void)Cq;
          const f32x4 mur = *(const LAS f32x4*)(pq), muk = *(const LAS f32x4*)(pq + 64), muv = *(const LAS f32x4*)(pq + 128);
          const f32x4 w0c = *(const LAS f32x4*)(pq + 192), a0c = *(const LAS f32x4*)(pq + 256), v0c = *(const LAS f32x4*)(pq + 320), kkc = *(const LAS f32x4*)(pq + 384);
          rr[hq] = zr[hq] + (pr[hq] - zr[hq]) * mur; kraw[hq] = zk[hq] + (pk[hq] - zk[hq]) * muk; vraw[hq] = zv[hq] + (pv[hq] - zv[hq]) * muv;
#pragma unroll
          for (int e = 0; e < 4; ++e) { ee[hq][e] = 0.60653066f * sigmoidf_(w0c[e] + dw[hq][e]); av[hq][e] = sigmoidf_(a0c[e] + da[hq][e]); const float kq = kraw[hq][e] * kkc[e]; n2 += kq * kq;
              vv[hq][e] = (l == 1) ? vraw[hq][e] + (vf[hq][e] - vraw[hq][e]) * sigmoidf_(v0c[e] + vm[hq][e]) : vraw[hq][e]; } }
      if (l == 0) *(u32x4*)(vfirst + row * 512 + C0) = pack8(vraw[0], vraw[1]);
      n2 = red8_sum(n2);
      const float inn = 1.0f / fmaxf(sqrtf(n2), 1e-12f); float bq = 0.f;
#pragma unroll
      for (int hq = 0; hq < 2; ++hq) { const LAS float* pq = (const LAS float*)(lds + RW_PAR) + c0 + 4 * hq; const f32x4 kkc = *(const LAS f32x4*)(pq + 384), kac = *(const LAS f32x4*)(pq + 448), rkc = *(const LAS f32x4*)(pq + 512);
#pragma unroll
          for (int e = 0; e < 4; ++e) { const float kkn = kraw[hq][e] * kkc[e] * inn; kk_[hq][e] = kraw[hq][e] * (1.0f + (av[hq][e] - 1.0f) * kac[e]); ap[hq][e] = -kkn; bp[hq][e] = kkn * av[hq][e]; bq += rr[hq][e] * kk_[hq][e] * rkc[e]; } }
      bq = red8_sum(bq);
      if ((lt & 7) == 0) bon[tok] = bq;
      *(LAS f32x4*)(Lc + tok * 68 + c0) = -ee[0]; *(LAS f32x4*)(Lc + tok * 68 + c0 + 4) = -ee[1];
      *(u32x4*)(o + row * 2048 + C0) = pack8(gg[0], gg[1]); }
    __syncthreads();
#pragma unroll
    for (int q = 0; q < 8; ++q) { const int ch = 16 * lw + 2 * q + (lane >> 5), tk = lane & 31; float x = Lc[tk * 68 + ch];
        x = scan32(x);
        Lc[tk * 68 + ch] = x; }
    __syncthreads();
#pragma unroll
    for (int hq = 0; hq < 2; ++hq) { const int cq = c0 + 4 * hq;
      const f32x4 Lt = *(const LAS f32x4*)(Lc + tok * 68 + cq), Ll = *(const LAS f32x4*)(Lc + (RT - 1) * 68 + cq); f32x4 Lp = (f32x4){0.f, 0.f, 0.f, 0.f}; if (tok > 0) Lp = *(const LAS f32x4*)(Lc + (tok - 1) * 68 + cq);
      f32x4 at_, rt_, kh_, bh_;
#pragma unroll
      for (int e = 0; e < 4; ++e) { const float ep = __expf(Lt[e]), em = __expf(-Lt[e]), el = __expf(Ll[e] - Lt[e]); at_[e] = ap[hq][e] * __expf(Lp[e]); rt_[e] = rr[hq][e] * ep; kh_[e] = kk_[hq][e] * em; bh_[e] = bp[hq][e] * em;
          const int tr_ = (cq + e) * P40 + rcol4(tok, cq >> 4);
          KpT[tr_] = (bf16)f2bf(kk_[hq][e] * el); BpT[tr_] = (bf16)f2bf(bp[hq][e] * el); VT[tr_] = (bf16)f2bf(vv[hq][e]); }
      u32x2 w; w.x = pk2(at_[0], at_[1]); w.y = pk2(at_[2], at_[3]); *(LAS u32x2*)(At + tok * P72 + cq) = w; w.x = pk2(rt_[0], rt_[1]); w.y = pk2(rt_[2], rt_[3]); *(LAS u32x2*)(Rt + tok * P72 + cq) = w;
      w.x = pk2(kh_[0], kh_[1]); w.y = pk2(kh_[2], kh_[3]); *(LAS u32x2*)(Kh + tok * P72 + cq) = w; w.x = pk2(bh_[0], bh_[1]); w.y = pk2(bh_[2], bh_[3]); *(LAS u32x2*)(Bh + tok * P72 + cq) = w;
      if (tok == 0) { f32x4 gv;
#pragma unroll
          for (int e = 0; e < 4; ++e) gv[e] = __expf(Ll[e]);
          *(LAS f32x4*)(gam + cq) = gv; } }
    __syncthreads();
    { const int rb = lw; const LAS bf16* Am = (rb < 2) ? At : Rt;
#pragma unroll
      for (int cb = 0; cb < 4; ++cb) { const LAS bf16* Bm_ = (cb < 2) ? Kh : Bh; acc4 gm = (acc4){0.f, 0.f, 0.f, 0.f};
#pragma unroll
          for (int ks = 0; ks < 2; ++ks) gm = MFMA16(frag_nat(Am, P72, 16 * (rb & 1) + fr, 32 * ks, g), frag_nat(Bm_, P72, 16 * (cb & 1) + fr, 32 * ks, g), gm);
          const int sidx = 16 * (cb & 1) + fr;
#pragma unroll
          for (int r = 0; r < 4; ++r) { const int tidx = 16 * (rb & 1) + 4 * g + r;
              if (rb < 2) { const float v = (sidx < tidx) ? gm[r] : 0.f; if (cb < 2) Mak[tidx * P40 + sidx] = (bf16)f2bf(v); else Mab[tidx * 33 + sidx] = v; }
              else { const float v = (sidx <= tidx) ? gm[r] : 0.f; if (cb < 2) Ark[tidx * P40 + sidx] = (bf16)f2bf(v); else Arb[tidx * P40 + sidx] = (bf16)f2bf(v); } } } }
    __syncthreads();
    rwkv_prep_fetch(pf, l, nh, nb, ncpair, z, vfirst, o);
    if (lw != 0) { unsigned char* rec = rw_rec_ptr(ws, h, b, c);
        for (int p = lt - 64; p < RW_NPIECE - 128; p += 192) { const int pp = (p < 1664) ? p : p + 128; *(u32x4*)(rec + 16 * pp) = *(const LAS u32x4*)(img + rw_piece_off(pp)); } }
    else {
        if (lane < 32) { const int blk = lane >> 4, cc = lane & 15; float x[16]; unsigned moff = (unsigned)((16 * blk) * 33 + 16 * blk) * 4u;
#pragma unroll
            for (int t = 0; t < 16; ++t) { float sacc = (t == cc) ? 1.0f : 0.f;
                if (t > 0) asm volatile("" : "+v"(moff) : "v"(x[t - 1]));
                const LAS float* mp = (const LAS float*)((LAS unsigned char*)Mab + moff) + t * 33;
#pragma unroll
                for (int s2 = 0; s2 < t; ++s2) sacc += mp[s2] * x[s2];
                x[t] = sacc; }
#pragma unroll
            for (int t = 0; t < 16; ++t) { if (blk == 0) { T1[t * P40 + cc] = (bf16)f2bf(x[t]); T1[t * P40 + 16 + cc] = 0; T2[t * P40 + cc] = (bf16)f2bf(Mab[(16 + t) * 33 + cc]); } else T2[t * P40 + 16 + cc] = (bf16)f2bf(x[t]); } }
        { unsigned char* rec = rw_rec_ptr(ws, h, b, c);
#pragma unroll
          for (int k = 0; k < 2; ++k) { const int p = 1664 + lane + 64 * k; *(u32x4*)(rec + 16 * p) = *(const LAS u32x4*)(img + rw_piece_off(p)); } }
    }
    __syncthreads();
}

constexpr int RC_IMG0 = 0, RC_IMG1 = ((IM_END + 255) / 256) * 256, RC_STAT = 2 * RC_IMG1, RC_DUMMY = RC_STAT + RT * 4 * 8, RC_END = RC_DUMMY + 256 * 16;
__device__ __forceinline__ void rwkv_chain_task(const ArgsD& a, int l, int bh, LAS unsigned char* lds, bf16* o, unsigned char* ws) {
    const int tid = opq_v((int)threadIdx.x), lane = tid & 63, wid = __builtin_amdgcn_readfirstlane(tid >> 6), fr = lane & 15, g = lane >> 4;
    const int b = bh >> 3, h = bh & 7;
    LAS f32x2* stat = (LAS f32x2*)(lds + RC_STAT);
    const int ib = wid & 3, Ci = h * 64 + 16 * ib + fr;
    const float lnw = a.in[I_RW_LNW][l * 512 + Ci], lnb = a.in[I_RW_LNB][l * 512 + Ci];
    acc4 St[4];
#pragma unroll
    for (int jb = 0; jb < 4; ++jb) St[jb] = (acc4){0.f, 0.f, 0.f, 0.f};
    u32x4 pv[8]; int poff[8];
#pragma unroll
    for (int i = 0; i < 8; ++i) { const int p = tid - 256 + 256 * i; poff[i] = (p >= 0 && p < RW_NPIECE) ? rw_piece_off(p) : RC_DUMMY + 16 * (tid & 255); pv[i] = (u32x4){0u, 0u, 0u, 0u}; }
#define RC_FETCH(rec_) do { _Pragma("unroll") for (int i_ = 0; i_ < 8; ++i_) { const int p_ = tid - 256 + 256 * i_; pv[i_] = *(const u32x4*)((rec_) + 16 * (p_ < RW_NPIECE ? p_ : 0)); } } while (0)
#define RC_PUT(dst_) do { _Pragma("unroll") for (int i_ = 0; i_ < 8; ++i_) { *(LAS u32x4*)(((i_ < 7 || tid < 256 + RW_NPIECE - 7 * 256) ? (dst_) : lds) + poff[i_]) = pv[i_]; } } while (0)
    if (wid >= 4) { RC_FETCH(rw_rec_ptr(ws, h, b, 0)); RC_PUT(lds + RC_IMG0); RC_FETCH(rw_rec_ptr(ws, h, b, 1)); }
    __syncthreads();
    for (int c = 0; c < SEQ / RT; ++c) {
        LAS unsigned char* img = lds + ((c & 1) ? RC_IMG1 : RC_IMG0);
        acc4 Y0 = (acc4){0.f, 0.f, 0.f, 0.f}, Y1 = Y0; unsigned gpk[2][4] = {{0, 0, 0, 0}, {0, 0, 0, 0}};
        if (wid >= 4) { RC_PUT(lds + ((c & 1) ? RC_IMG0 : RC_IMG1)); const int cf = (c + 2 < SEQ / RT) ? c + 2 : c; RC_FETCH(rw_rec_ptr(ws, h, b, cf)); }
        else {
            { const size_t tq = (size_t)b * SEQ + c * RT;
#pragma unroll
              for (int hb = 0; hb < 2; ++hb)
#pragma unroll
                  for (int r = 0; r < 4; ++r) gpk[hb][r] = o[(tq + 16 * hb + 4 * g + r) * 2048 + Ci]; }
            const LAS bf16* At = (const LAS bf16*)(img + IM_AT); const LAS bf16* Rt = (const LAS bf16*)(img + IM_RT); const LAS bf16* KpT = (const LAS bf16*)(img + IM_KPT); const LAS bf16* BpT = (const LAS bf16*)(img + IM_BPT); const LAS bf16* VT = (const LAS bf16*)(img + IM_VT);
            const LAS bf16* Mak = (const LAS bf16*)(img + IM_MAK); const LAS bf16* Ark = (const LAS bf16*)(img + IM_ARK); const LAS bf16* Arb = (const LAS bf16*)(img + IM_ARB); const LAS bf16* T1 = (const LAS bf16*)(img + IM_T1); const LAS bf16* T2 = (const LAS bf16*)(img + IM_T2);
            const LAS float* gam = (const LAS float*)(img + IM_GAM);
            const bf16x8 Sb0 = frag_acc(St[0], St[1]), Sb1 = frag_acc(St[2], St[3]); const bf16x8 vtf = *(const LAS bf16x8*)(VT + (16 * ib + fr) * P40 + rcol4(8 * g, ib));
            acc4 X0 = (acc4){0.f, 0.f, 0.f, 0.f}, X1 = X0;
            X0 = MFMA16(frag_perm(At, P72, fr, 0, g), Sb0, X0); X0 = MFMA16(frag_perm(At, P72, fr, 32, g), Sb1, X0); X0 = MFMA16(frag_nat(Mak, P40, fr, 0, g), vtf, X0);
            X1 = MFMA16(frag_perm(At, P72, 16 + fr, 0, g), Sb0, X1); X1 = MFMA16(frag_perm(At, P72, 16 + fr, 32, g), Sb1, X1); X1 = MFMA16(frag_nat(Mak, P40, 16 + fr, 0, g), vtf, X1);
            Y0 = MFMA16(frag_perm(Rt, P72, fr, 0, g), Sb0, Y0); Y0 = MFMA16(frag_perm(Rt, P72, fr, 32, g), Sb1, Y0); Y0 = MFMA16(frag_nat(Ark, P40, fr, 0, g), vtf, Y0);
            Y1 = MFMA16(frag_perm(Rt, P72, 16 + fr, 0, g), Sb0, Y1); Y1 = MFMA16(frag_perm(Rt, P72, 16 + fr, 32, g), Sb1, Y1); Y1 = MFMA16(frag_nat(Ark, P40, 16 + fr, 0, g), vtf, Y1);
            const acc4 zero4 = (acc4){0.f, 0.f, 0.f, 0.f};
            const acc4 U0 = MFMA16(frag_perm(T1, P40, fr, 0, g), frag_acc(X0, zero4), zero4);
            const bf16x8 t2f = frag_perm(T2, P40, fr, 0, g);
            const acc4 W1 = MFMA16(t2f, frag_acc(U0, zero4), X1);
            const acc4 U1 = MFMA16(t2f, frag_acc(zero4, W1), zero4);
            const bf16x8 Ub = frag_acc(U0, U1);
            Y0 = MFMA16(frag_perm(Arb, P40, fr, 0, g), Ub, Y0); Y1 = MFMA16(frag_perm(Arb, P40, 16 + fr, 0, g), Ub, Y1);
#pragma unroll
            for (int jb = 0; jb < 4; ++jb) { const f32x4 gm = *(const LAS f32x4*)(gam + 16 * jb + 4 * g); St[jb] = St[jb] * gm;
                const bf16x8 kpf = *(const LAS bf16x8*)(KpT + (16 * jb + fr) * P40 + rcol4(8 * g, jb));
                const LAS bf16* bpp = BpT + (16 * jb + fr) * P40; const u32x2 bv0 = *(const LAS u32x2*)(bpp + rcol4(4 * g, jb)), bv1 = *(const LAS u32x2*)(bpp + rcol4(4 * g + 16, jb)); u32x4 bw; bw.x = bv0.x; bw.y = bv0.y; bw.z = bv1.x; bw.w = bv1.y;
                St[jb] = MFMA16(kpf, vtf, St[jb]); St[jb] = MFMA16(__builtin_bit_cast(bf16x8, bw), Ub, St[jb]); }
#pragma unroll
            for (int r = 0; r < 4; ++r) { float s0 = Y0[r], q0 = Y0[r] * Y0[r], s1 = Y1[r], q1 = Y1[r] * Y1[r];
                s0 = red16_sum(s0); q0 = red16_sum(q0); s1 = red16_sum(s1); q1 = red16_sum(q1);
                if (fr == 0) { stat[(4 * g + r) * 4 + ib] = (f32x2){s0, q0}; stat[(16 + 4 * g + r) * 4 + ib] = (f32x2){s1, q1}; } }
        }
        __syncthreads();
        if (wid < 4) {
            const LAS bf16* VT = (const LAS bf16*)(img + IM_VT); const LAS float* bon = (const LAS float*)(img + IM_BON);
            const size_t t0 = (size_t)b * SEQ + c * RT;
#pragma unroll
            for (int hb = 0; hb < 2; ++hb) { const u32x2 vw = *(const LAS u32x2*)(VT + (16 * ib + fr) * P40 + rcol4(16 * hb + 4 * g, ib)); const f32x4 vv = (f32x4){lo2f(vw.x), hi2f(vw.x), lo2f(vw.y), hi2f(vw.y)};
#pragma unroll
                for (int r = 0; r < 4; ++r) { const int t = 16 * hb + 4 * g + r; const f32x2 s0 = stat[t * 4 + 0], s1 = stat[t * 4 + 1], s2 = stat[t * 4 + 2], s3 = stat[t * 4 + 3];
                    const float mean = ((s0.x + s1.x) + (s2.x + s3.x)) * (1.0f / 64.0f); const float ex2 = ((s0.y + s1.y) + (s2.y + s3.y)) * (1.0f / 64.0f);
                    const float rstd = rsqrtf(fmaxf(ex2 - mean * mean, 0.f) + 64e-5f); const float y = hb ? Y1[r] : Y0[r];
                    bf16* op = o + (t0 + t) * 2048 + Ci; const float gg = bf2f((bf16)gpk[hb][r]);
                    *op = (bf16)f2bf((((y - mean) * rstd * lnw + lnb) + bon[t] * vv[r]) * gg); } }
        }
        __syncthreads();
    }
}

#define XB_TMO      128
#define XB_XCNT(j)  (256  + 64 * (j))
#define XB_XSUB(j)  (1280 + 64 * (j))
#define XB_XGEN(j)  (2304 + 64 * (j))
#define XB_TOP      3328
#define XB_TOPGEN   3392
#define XCD_BAR_WORDS 3456
#define XB_SPIN_CAP (1u << 20)
__device__ __forceinline__ unsigned xb_ld(unsigned* p)              { return __hip_atomic_load(p, __ATOMIC_RELAXED, __HIP_MEMORY_SCOPE_AGENT); }
__device__ __forceinline__ unsigned xb_add(unsigned* p, unsigned v) { return __hip_atomic_fetch_add(p, v, __ATOMIC_RELAXED, __HIP_MEMORY_SCOPE_AGENT); }
__device__ __forceinline__ unsigned xb_xcc_id() { return (unsigned)__builtin_amdgcn_s_getreg((3 << 11) | 20) & 0xFu; }
#define XB_SPIN(cond, bar) do { unsigned _sp = 0; while (cond) { __builtin_amdgcn_s_sleep(1); \
    if ((++_sp & 255u) == 0u) { if (xb_ld(&(bar)[XB_TMO])) break; if (_sp > XB_SPIN_CAP) { atomicAdd(&(bar)[XB_TMO], 1u); break; } } } } while (0)
__device__ __forceinline__ void xcd_barrier_complete(unsigned* bar, unsigned x, unsigned& nloc, unsigned& nx) {
    const unsigned G = gridDim.x * gridDim.y * gridDim.z;
    unsigned sum, cnt, mine, sp = 0u;
    for (;;) {
        sum = 0u; cnt = 0u; mine = 0u;
#pragma unroll
        for (unsigned j = 0; j < 16; ++j) { const unsigned c = xb_ld(&bar[XB_XCNT(j)]); sum += c; cnt += (c > 0u) ? 1u : 0u; mine = (j == x) ? c : mine; }
        if (sum == G) break;
        __builtin_amdgcn_s_sleep(1);
        if ((++sp & 255u) == 0u) { if (xb_ld(&bar[XB_TMO])) break; if (sp > XB_SPIN_CAP) { atomicAdd(&bar[XB_TMO], 1u); break; } }
    }
    nloc = mine > 0u ? mine : 1u; nx = cnt > 0u ? cnt : 1u;
}
__device__ __forceinline__ void xcd_barrier(unsigned* bar, volatile LAS unsigned* st) {
    asm volatile("s_waitcnt vmcnt(0)" ::: "memory");
    __syncthreads();
    if (threadIdx.x == 0) {
        __builtin_amdgcn_s_waitcnt(0);
        unsigned nloc = st[0], nx = st[1]; const unsigned x = st[2];
        if (nloc == 0u) { xcd_barrier_complete(bar, x, nloc, nx); st[0] = nloc; st[1] = nx; }
        const unsigned old = xb_add(&bar[XB_XSUB(x)], 1u);
        const unsigned gen = old / nloc;
        if (old + 1u == (gen + 1u) * nloc) {
            __builtin_amdgcn_fence(__ATOMIC_RELEASE, "agent");
            asm volatile("s_waitcnt vmcnt(0)" ::: "memory");
            const unsigned og = xb_add(&bar[XB_TOP], 1u);
            const unsigned tg = og / nx;
            if (og + 1u == (tg + 1u) * nx) xb_add(&bar[XB_TOPGEN], 1u);
            else XB_SPIN(xb_ld(&bar[XB_TOPGEN]) == tg, bar);
            __builtin_amdgcn_fence(__ATOMIC_ACQUIRE, "agent");
            xb_add(&bar[XB_XGEN(x)], 1u);
            asm volatile("s_waitcnt vmcnt(0)" ::: "memory");
        } else {
            XB_SPIN(xb_ld(&bar[XB_XGEN(x)]) == gen, bar);
            __builtin_amdgcn_fence(__ATOMIC_ACQUIRE, "agent");
            asm volatile("s_waitcnt vmcnt(0)" ::: "memory");
        }
    }
    __syncthreads();
}

constexpr int LDS_WSCR = 20352;
constexpr int LDS_TOTAL = NWAVES * LDS_WSCR + 1024;
static_assert(LDS_TOTAL <= 163840 && NWAVES * LDS_WSCR >= LDS_MAIN, "LDS map");
constexpr int NPH = 22;
#ifndef MIXMASK
#define MIXMASK 15
#endif
#define MIX_T(bit, call) do { if ((MIXMASK) & (bit)) { call; } } while (0)

#define PHASE_PTRS \
    const int tid = opq_v((int)threadIdx.x), lane = tid & 63, wid = __builtin_amdgcn_readfirstlane(tid >> 6); (void)lane; (void)wid; \
    const int G = opq_s((int)gridDim.x), bx = opq_s((int)blockIdx.x); const int gw = bx * NWAVES + wid, ngw = G * NWAVES; (void)gw; (void)ngw; \
    LAS unsigned char* lds = (LAS unsigned char*)lds_raw; LAS unsigned* lctl = (LAS unsigned*)(lds + NWAVES * LDS_WSCR); (void)lctl; \
    ArgsD a; a.in.tab = (LAS unsigned long long*)(lds + NWAVES * LDS_WSCR + 640); \
    unsigned char* ws = a.ws(); float* a_out = a.out(); (void)a_out; \
    unsigned* ctl = (unsigned*)(ws + WS_CTL); (void)ctl; \
    float* ssb = (float*)(ws + WS_SMALL + SM_SS); (void)ssb; \
    float* mssq = (float*)(ws + WS_SMALL + SM_MSSQ); (void)mssq; \
    int* tok_e = (int*)(ws + WS_SMALL + SM_TOKE); float* tok_g = (float*)(ws + WS_SMALL + SM_TOKG); float* tok_rs = (float*)(ws + WS_SMALL + SM_TOKRS); (void)tok_e; (void)tok_g; (void)tok_rs; \
    int* tok_slot = (int*)(ws + WS_SMALL + SM_TOKSLOT); int* row_tok = (int*)(ws + WS_SMALL + SM_ROWTOK); float* row_gate = (float*)(ws + WS_SMALL + SM_ROWGATE); float* row_rs = (float*)(ws + WS_SMALL + SM_ROWRS); (void)tok_slot; (void)row_tok; (void)row_gate; (void)row_rs; \
    bf16* xb = (bf16*)(ws + WS_XB); (void)xb; \
    bf16* vfirst = (bf16*)(ws + WS_X + X_VFIRST); bf16* mixed = (bf16*)(ws + WS_X + X_MIXED); bf16* obuf = (bf16*)(ws + WS_X + X_O); (void)vfirst; (void)mixed; (void)obuf; \
    unsigned char* wreg = ws + WS_X + X_W; (void)wreg; \
    bf16* zbuf = (bf16*)(ws + WS_Z); bf16* gates = zbuf; bf16* hidden = zbuf; bf16* act = zbuf; (void)gates; (void)hidden; (void)act; \
    bf16* xg = (bf16*)(ws + WS_XG); bf16* ybuf = xg; bf16* rwarr = xg; (void)ybuf; (void)rwarr; bf16* ypart = (bf16*)(ws + WS_Z + (size_t)128 * MiB); (void)ypart; bf16* bcv = (bf16*)(ws + WS_BCV); (void)bcv; float* gend = (float*)(ws + WS_GEND); (void)gend; \
    bf16* moe_w13 = (bf16*)(ws + WS_X + MOE_W13); bf16* moe_w2 = (bf16*)(ws + WS_X + MOE_W2); (void)moe_w13; (void)moe_w2;

#define IDLE_CVT_BEGIN(nwg_) { const int p0_ = (nwg_) % G; if (bx >= p0_) { CvtCtx cx; cx.gw = (bx - p0_) * NWAVES + wid; cx.ngw = (G - p0_) * NWAVES; cx.base = 0; cx.lane = lane; cx.scr = (LAS float*)(lds + wid * LDS_WSCR); \
        const int zt_ = (bx - p0_) * NTHREADS + tid, zn_ = (G - p0_) * NTHREADS; (void)zt_; (void)zn_;
#define IDLE_CVT_END } }
#define CVT_LAYER_REST(l_) do { const float* win_ = a.in[I_WIN] + (size_t)(l_) * DM * IN_COLS; const float* nm_ = a.in[I_NORM_MIX] + (l_) * DM; \
        cvt_job_gates(cx, win_, IN_COLS, DM, MIXC, nm_, (bf16*)(wreg + W_G) + (size_t)(l_) * 4096 * DM); \
        for (int i_ = 0; i_ < 4; ++i_) cvt_job(cx, a.in[I_WBRANCH] + ((size_t)(l_) * 4 + i_) * 512 * DM, DM, 512, 0, DM, nullptr, (bf16*)(wreg + W_B) + ((size_t)(l_) * 4 + i_) * DM * 512, 0, 128); \
        cvt_job(cx, a.in[I_WOUT] + (size_t)(l_) * DM * DM, DM, DM, 0, DM, nullptr, (bf16*)(wreg + W_O) + (size_t)(l_) * DM * DM, 0, 128); } while (0)
template <int LO, int HI>
__device__ __forceinline__ void mk_body(const Args& ka) {
    extern __shared__ __attribute__((aligned(16))) unsigned char lds_raw[];
    { LAS unsigned long long* ptab = (LAS unsigned long long*)((LAS unsigned char*)lds_raw + NWAVES * LDS_WSCR + 640);
      const int t0 = threadIdx.x;
      if (t0 < N_IN) ptab[t0] = (unsigned long long)ka.in[t0];
      if (t0 == N_IN) ptab[t0] = (unsigned long long)ka.out;
      if (t0 == N_IN + 1) ptab[t0] = (unsigned long long)ka.ws;
#if !MK_PER_PHASE
      if (t0 == 64) { LAS unsigned* st = (LAS unsigned*)((LAS unsigned char*)lds_raw + NWAVES * LDS_WSCR + 992); st[0] = 0u; st[1] = 0u; const unsigned x = xb_xcc_id(); st[2] = x;
          (void)xb_add((unsigned*)(ka.ws + WS_CTL) + CW_BAR + XB_XCNT(x), 1u); }
#endif
      __syncthreads(); }
#if MK_PER_PHASE
#define GRID_BAR() do { } while (0)
#else
#define GRID_BAR() do { unsigned char* ws_ = ArgsD{PT{(LAS unsigned long long*)((LAS unsigned char*)lds_raw + NWAVES * LDS_WSCR + 640)}}.ws(); \
    xcd_barrier((unsigned*)(ws_ + WS_CTL) + CW_BAR, (volatile LAS unsigned*)((LAS unsigned char*)lds_raw + NWAVES * LDS_WSCR + 992)); } while (0)
#endif
#define IN(k) (LO <= (k) && (k) < HI)
#if MK_PER_PHASE
#define SPLIT_ARRIVE(w) do { } while (0)
#define SPLIT_WAIT(w) do { } while (0)
#else
#define SPLIT_ARRIVE(w) do { asm volatile("s_waitcnt vmcnt(0)" ::: "memory"); __syncthreads(); if (threadIdx.x == 0) { unsigned* c_ = (unsigned*)(ArgsD{PT{(LAS unsigned long long*)((LAS unsigned char*)lds_raw + NWAVES * LDS_WSCR + 640)}}.ws() + WS_CTL); \
        __builtin_amdgcn_fence(__ATOMIC_RELEASE, "agent"); asm volatile("s_waitcnt vmcnt(0)" ::: "memory"); xb_add(c_ + CW_SPLIT + 64 * (w), 1u); } } while (0)
#define SPLIT_WAIT(w) do { if (threadIdx.x == 0) { unsigned* c_ = (unsigned*)(ArgsD{PT{(LAS unsigned long long*)((LAS unsigned char*)lds_raw + NWAVES * LDS_WSCR + 640)}}.ws() + WS_CTL); \
        XB_SPIN(xb_ld(c_ + CW_SPLIT + 64 * (w)) < gridDim.x, c_ + CW_BAR); __builtin_amdgcn_fence(__ATOMIC_ACQUIRE, "agent"); asm volatile("s_waitcnt vmcnt(0)" ::: "memory"); } __syncthreads(); } while (0)
#endif
#define SEAM(k) do { if (IN(k) && IN((k) + 1)) GRID_BAR(); } while (0)

    if (IN(0)) { PHASE_PTRS
        CvtCtx cx; cx.gw = gw; cx.ngw = ngw; cx.base = 0; cx.lane = lane; cx.scr = (LAS float*)(lds + wid * LDS_WSCR);
        { const float* win = a.in[I_WIN]; const float* nm = a.in[I_NORM_MIX]; bf16* winT = (bf16*)(wreg + W_IN);
          cvt_job(cx, win, IN_COLS, DM, 0, MIXC, nm, winT, 0, 128);
          zero_rows_bf16(bx * NTHREADS + tid, G * NTHREADS, winT + (size_t)C_HV * DM, (size_t)(ZC - C_HV) * DM); }
        const float* x = a.in[I_X];
        for (int m = gw; m < T; m += ngw) { const f32x4* xr = (const f32x4*)(x + (size_t)m * DM) + lane; float s = 0.f;
#pragma unroll
            for (int j = 0; j < 4; ++j) { const f32x4 v = xr[64 * j]; s += (v[0] * v[0] + v[1] * v[1]) + (v[2] * v[2] + v[3] * v[3]); u32x2 w; w.x = pk2(v[0], v[1]); w.y = pk2(v[2], v[3]); *((u32x2*)(xb + (size_t)m * DM) + lane + 64 * j) = w; }
            s = wave_sum(s); if (lane < 16) ssb[(size_t)m * 16 + lane] = (lane == 0) ? s : 0.f; }
    }
#if MK_PER_PHASE
    SEAM(0);
#else
    if (IN(0) && IN(1)) { cg::this_grid().sync(); }
#endif

#pragma unroll
    for (int l = 0; l < 2; ++l) {
        const int pb = 1 + 9 * l;
#define ss_mix (ssb + (size_t)(l == 0 ? 0 : 2) * T * 16)
#define ss_ffn (l == 0 ? ssb + (size_t)T * 16 : (float*)nullptr)
        if (IN(pb + 0)) { PHASE_PTRS
            pg8::Gemm g{DM, DM, DM}; pg8::StaticOrder S; S.init(xb, (bf16*)(wreg + W_IN) + (size_t)l * ZC * DM, DM, DM, T, ZC, G, bx);
            EpiScaleBf16<0> E{zbuf, ZC, ss_mix};
            pg8::gemm_phase(lds, g, S, E);
            IDLE_CVT_BEGIN((T / 256) * (ZC / 256))
                CVT_LAYER_REST(l);
                if (l == 0) {
#if FFN_FP8
                    cvt_job8(cx, a.in[I_FFN_W1], FFN, DM, 0, FFN, a.in[I_NORM_FFN], 32.0f, wreg + W_13, 0, 256);
                    cvt_job8(cx, a.in[I_FFN_W3], FFN, DM, 0, FFN, a.in[I_NORM_FFN], 32.0f, wreg + W_13, 128, 256);
                    cvt_job8(cx, a.in[I_FFN_W2], DM, FFN, 0, DM, nullptr, 64.0f, wreg + W_2, 0, 128);
#else
                    cvt_job(cx, a.in[I_FFN_W1], FFN, DM, 0, FFN, a.in[I_NORM_FFN], (bf16*)(wreg + W_13), 0, 256);
                    cvt_job(cx, a.in[I_FFN_W3], FFN, DM, 0, FFN, a.in[I_NORM_FFN], (bf16*)(wreg + W_13), 128, 256);
                    cvt_job(cx, a.in[I_FFN_W2], DM, FFN, 0, DM, nullptr, (bf16*)(wreg + W_2), 0, 128);
#endif
                }
            IDLE_CVT_END
        }
        SEAM(pb + 0);
        if (IN(pb + 1)) { PHASE_PTRS
            rwkv_xlr_prepass(a, l, bx, G, zbuf, obuf);
            if (IN(pb + 2)) SPLIT_ARRIVE(2 + l);
            mamba_bc_prepass(a, l, gw, ngw, lane, zbuf, bcv);
            gla_prepass(a, l, bx, G, lds, zbuf, gend);
        }
        if (IN(pb + 1) && IN(pb + 2)) SPLIT_WAIT(2 + l);
        if (IN(pb + 2)) { PHASE_PTRS
            const int npair = 8 * BATCH * (SEQ / RT) / 2, ppb = (npair + G - 1) / G; int wts_h = -1;
            const int u0 = bx * ppb, u1 = ((bx + 1) * ppb < npair) ? (bx + 1) * ppb : npair;
            if (u0 < u1) { PrepPf pf; rwkv_prep_fetch(pf, l, u0 >> 8, (u0 >> 5) & 7, 2 * (u0 & 31), zbuf, vfirst, obuf);
                for (int u = u0; u < u1; ++u) { const int un = (u + 1 < u1) ? u + 1 : u;
                    rwkv_prep_pair(a, l, u >> 8, (u >> 5) & 7, 2 * (u & 31), un >> 8, (un >> 5) & 7, 2 * (un & 31), pf, wts_h, lds, zbuf, vfirst, obuf, ws); } } }
        SEAM(pb + 2);
        if (IN(pb + 3)) { PHASE_PTRS
            if (bx < 64) { MIX_T(1, rwkv_chain_task(a, l, bx, lds, obuf, ws)); }
            else if (bx < 128) { MIX_T(2, mamba_block_task(a, l, bx - 64, lds, zbuf, bcv, obuf, mssq)); }
            else if (bx < 160) { MIX_T(4, gla_block_task(a, l, bx - 128, lds, zbuf, gend, obuf)); }
            MIX_T(8, attn_drain(a, l, lds, lctl, ctl + CW_ATTQ + l, zbuf, obuf));
        }
        SEAM(pb + 3);
        if (IN(pb + 4)) { PHASE_PTRS
            const float* nw = a.in[I_SSM_NORMW] + l * 512;
            for (int m = gw; m < T; m += ngw) { const int g = lane >> 5; const float* q = mssq + (size_t)m * 8 + g * 4; const float sc = rsqrtf((q[0] + q[1] + q[2] + q[3]) * (1.0f / 256.0f) + NORM_EPS);
                bf16* p = obuf + (size_t)m * 2048 + 512 + lane * 8; const u32x4 w = *(const u32x4*)p; f32x4 v0, v1; unpack8(w, v0, v1);
                const f32x4 n0 = *(const f32x4*)(nw + lane * 8), n1 = *(const f32x4*)(nw + lane * 8 + 4);
                *(u32x4*)p = pack8(v0 * n0 * sc, v1 * n1 * sc); }
            pg8::Gemm g{DM, DM, DM}; pg8::StaticOrder S; S.init(xb, (bf16*)(wreg + W_G) + (size_t)l * 4096 * DM, DM, DM, T, 4096, G, bx);
            EpiGateRatio E{gates, ss_mix};
            pg8::gemm_phase(lds, g, S, E);
        }
        SEAM(pb + 4);
        if (IN(pb + 5)) { PHASE_PTRS
            pg8::Gemm g{2048, 512, 512}; MixOrder S{(const char*)obuf, (const char*)((bf16*)(wreg + W_B) + (size_t)l * 4 * DM * 512), G, bx};
            EpiMix E{gates, mixed};
            pg8::gemm_phase(lds, g, S, E);
        }
        SEAM(pb + 5);
        if (IN(pb + 6)) { PHASE_PTRS
            pg8::Gemm g{DM, DM, DM}; pg8::StaticOrder S; S.init(mixed, (bf16*)(wreg + W_O) + (size_t)l * DM * DM, DM, DM, T, DM, G, bx);
            EpiResid<false> E{l == 0 ? a.in[I_X] : a_out, a_out, xb, ss_ffn, (FFN_FP8 && l == 0) ? (unsigned char*)xg : (unsigned char*)nullptr};
            pg8::gemm_phase(lds, g, S, E);
        }
        if (l == 0) SEAM(pb + 6); else if (IN(pb + 6) && IN(pb + 7)) SPLIT_ARRIVE(0);
        if (l == 0) {
            if (IN(pb + 7)) { PHASE_PTRS
#if FFN_FP8
                pg8::Gemm g{DM / 2, DM / 2, DM / 2}; pg8::StaticOrder S; S.init(xg, (bf16*)(wreg + W_13), DM / 2, DM / 2, T, 2 * FFN, G, bx);
                EpiSwiglu<false, true> E{hidden, FFN, ss_ffn};
#else
                pg8::Gemm g{DM, DM, DM}; pg8::StaticOrder S; S.init(xb, (bf16*)(wreg + W_13), DM, DM, T, 2 * FFN, G, bx);
                EpiSwiglu<false, false> E{hidden, FFN, ss_ffn};
#endif
                pg8::gemm_phase(lds, g, S, E);
                IDLE_CVT_BEGIN((T / 256) * (2 * FFN / 256))
                    const float* win = a.in[I_WIN] + (size_t)DM * IN_COLS; const float* nm = a.in[I_NORM_MIX] + DM; bf16* winT = (bf16*)(wreg + W_IN) + (size_t)ZC * DM;
                    cvt_job(cx, win, IN_COLS, DM, 0, MIXC, nm, winT, 0, 128);
                    cvt_job(cx, a.in[I_VRES_DOWN], 32, DM, 0, 32, nm, winT, C_HV, 128);
                    zero_rows_bf16(zt_, zn_, winT + (size_t)(C_HV + 32) * DM, (size_t)(ZC - C_HV - 32) * DM);
                IDLE_CVT_END
            }
            SEAM(pb + 7);
            if (IN(pb + 8)) { PHASE_PTRS
#if FFN_FP8
                pg8::Gemm g{FFN / 2, FFN / 2, FFN / 2}; pg8::StaticOrder S; S.init(hidden, (bf16*)(wreg + W_2), FFN / 2, FFN / 2, T, DM, G, bx);
                EpiResid<true> E{a_out, a_out, xb, ssb + (size_t)2 * T * 16, nullptr};
#else
                pg8::Gemm g{FFN, FFN, FFN}; pg8::StaticOrder S; S.init(hidden, (bf16*)(wreg + W_2), FFN, FFN, T, DM, G, bx);
                EpiResid<false> E{a_out, a_out, xb, ssb + (size_t)2 * T * 16, nullptr};
#endif
                pg8::gemm_phase(lds, g, S, E);
            }
            SEAM(pb + 8);
        }
    }
    if (IN(17)) { PHASE_PTRS
        if (tid < 8) lctl[tid] = 0u;
        __syncthreads();
        const float* nf_ = a.in[I_NORM_FFN] + DM;
        CvtCtx cx; cx.gw = gw; cx.ngw = ngw; cx.base = 0; cx.lane = lane; cx.scr = (LAS float*)(lds + wid * LDS_WSCR);
#define MOE_CVT13(e_) do { unsigned char* w13_8 = (unsigned char*)moe_w13 + (size_t)(e_) * 2 * EDIM * DM; \
            cvt_job8(cx, a.in[I_MOE_W1] + (size_t)(e_) * DM * EDIM, EDIM, DM, 0, EDIM, nf_, 32.0f, w13_8, 0, 256); cvt_job8(cx, a.in[I_MOE_W3] + (size_t)(e_) * DM * EDIM, EDIM, DM, 0, EDIM, nf_, 32.0f, w13_8, 128, 256); } while (0)
        for (int e = 0; e < NEXP; ++e) { unsigned char* w2_8 = (unsigned char*)moe_w13 + (size_t)NEXP * 2 * EDIM * DM + (size_t)e * DM * EDIM;
            cvt_job8(cx, a.in[I_MOE_W2] + (size_t)e * EDIM * DM, DM, EDIM, 0, DM, nullptr, 64.0f, w2_8, 0, 128); }
        for (int e = 0; e < 2; ++e) MOE_CVT13(e);
        if (IN(16)) SPLIT_WAIT(0);
        const float* nf = a.in[I_NORM_FFN] + DM; const float* wr = a.in[I_MOE_ROUTER];
        f32x4 nv[4];
        { const int m0 = gw < T ? gw : 0; const f32x4* xr = (const f32x4*)(a_out + (size_t)m0 * DM) + lane;
#pragma unroll
          for (int j = 0; j < 4; ++j) nv[j] = xr[64 * j]; }
        for (int m = gw; m < T; m += ngw) { f32x4 v[4]; float s = 0.f;
#pragma unroll
            for (int j = 0; j < 4; ++j) { v[j] = nv[j]; s += (v[j][0] * v[j][0] + v[j][1] * v[j][1]) + (v[j][2] * v[j][2] + v[j][3] * v[j][3]); }
            { const int mn = (m + ngw < T) ? m + ngw : m; const f32x4* xr = (const f32x4*)(a_out + (size_t)mn * DM) + lane;
#pragma unroll
              for (int j = 0; j < 4; ++j) nv[j] = xr[64 * j]; }
            const float rs = rsqrtf(wave_sum(s) * (1.0f / DM) + NORM_EPS);
            float lg[8];
#pragma unroll
            for (int e = 0; e < 8; ++e) lg[e] = 0.f;
#pragma unroll
            for (int j = 0; j < 4; ++j) { const int k0 = 4 * (lane + 64 * j); const f32x4 gn = *(const f32x4*)(nf + k0);
#pragma unroll
                for (int q = 0; q < 4; ++q) { const float hf = v[j][q] * rs * gn[q]; const f32x4 w0 = *(const f32x4*)(wr + (size_t)(k0 + q) * 8), w1 = *(const f32x4*)(wr + (size_t)(k0 + q) * 8 + 4);
                    lg[0] += hf * w0[0]; lg[1] += hf * w0[1]; lg[2] += hf * w0[2]; lg[3] += hf * w0[3]; lg[4] += hf * w1[0]; lg[5] += hf * w1[1]; lg[6] += hf * w1[2]; lg[7] += hf * w1[3]; } }
#pragma unroll
            for (int e = 0; e < 8; ++e) lg[e] = wave_sum(lg[e]);
            int e0 = 0; float v0 = lg[0];
#pragma unroll
            for (int e = 1; e < 8; ++e) if (lg[e] > v0) { v0 = lg[e]; e0 = e; }
            int e1 = -1; float v1 = -3.0e38f;
#pragma unroll
            for (int e = 0; e < 8; ++e) if (e != e0 && lg[e] > v1) { v1 = lg[e]; e1 = e; }
            if (e1 < 0) { e1 = (e0 == 0) ? 1 : 0; v1 = v0; }
            const float g0 = 1.0f / (1.0f + __expf(v1 - v0));
            if (lane == 0) { tok_e[2 * m] = e0; tok_e[2 * m + 1] = e1; tok_g[2 * m] = g0; tok_g[2 * m + 1] = 1.0f - g0; tok_rs[m] = rs;
                __hip_atomic_fetch_add(lctl + e0, 1u, __ATOMIC_RELAXED, __HIP_MEMORY_SCOPE_WORKGROUP); __hip_atomic_fetch_add(lctl + e1, 1u, __ATOMIC_RELAXED, __HIP_MEMORY_SCOPE_WORKGROUP); } }
        __syncthreads();
        if (tid < 8) atomicAdd(ctl + CW_MOECNT + tid, lctl[tid]);
        if (IN(18)) SPLIT_ARRIVE(1);
        for (int e = 2; e < NEXP; ++e) MOE_CVT13(e);
#undef MOE_CVT13
    }
    if (IN(17) && IN(18)) SPLIT_WAIT(1);

    if (IN(18)) { PHASE_PTRS
        unsigned cnt[8]; int base[8];
        { int acc = 0;
#pragma unroll
          for (int e = 0; e < 8; ++e) { cnt[e] = (unsigned)__builtin_amdgcn_readfirstlane((int)__hip_atomic_load(ctl + CW_MOECNT + e, __ATOMIC_RELAXED, __HIP_MEMORY_SCOPE_AGENT)); base[e] = acc; acc += (int)((cnt[e] + 255u) & ~255u); } }
        LAS unsigned* lcnt = lctl; LAS int* lstart = (LAS int*)(lctl + 8); LAS int* pslot = (LAS int*)(lctl + 16);
        for (int tgp = bx; tgp < T / 64; tgp += G) {
            if (tid < 8) lcnt[tid] = 0u;
            __syncthreads();
            int e0 = 0, e1 = 0, r0 = 0, r1 = 0; const int tok = tgp * 64 + tid;
            if (tid < 64) { e0 = tok_e[2 * tok]; e1 = tok_e[2 * tok + 1]; r0 = (int)__hip_atomic_fetch_add(lcnt + e0, 1u, __ATOMIC_RELAXED, __HIP_MEMORY_SCOPE_WORKGROUP); r1 = (int)__hip_atomic_fetch_add(lcnt + e1, 1u, __ATOMIC_RELAXED, __HIP_MEMORY_SCOPE_WORKGROUP); }
            __syncthreads();
            if (tid < 8) { int bsel = 0;
#pragma unroll
                for (int e = 0; e < 8; ++e) bsel = (tid == e) ? base[e] : bsel;
                lstart[tid] = bsel + (int)atomicAdd(ctl + CW_MOECUR + tid, lcnt[tid]); }
            __syncthreads();
            if (tid < 64) { const int s0 = lstart[e0] + r0, s1 = lstart[e1] + r1; pslot[2 * tid] = s0; pslot[2 * tid + 1] = s1;
                { int enc0 = s0, enc1 = s1;
#pragma unroll
                  for (int e = 0; e < 8; ++e) { const int fullr = (int)(cnt[e] & ~255u); int pi = 0;
#pragma unroll
                      for (int q = 0; q < 8; ++q) pi += (q < e && (cnt[q] & 255u)) ? 1 : 0;
                      if (e0 == e && s0 - base[e] >= fullr) enc0 = -(1 + pi * 256 + (s0 - base[e] - fullr));
                      if (e1 == e && s1 - base[e] >= fullr) enc1 = -(1 + pi * 256 + (s1 - base[e] - fullr)); }
                  tok_slot[2 * tok] = enc0; tok_slot[2 * tok + 1] = enc1; }
                const float rs = tok_rs[tok];
                row_tok[s0] = tok; row_tok[s1] = tok; row_gate[s0] = tok_g[2 * tok]; row_gate[s1] = tok_g[2 * tok + 1]; row_rs[s0] = rs; row_rs[s1] = rs; }
            __syncthreads();
            { u32x4 sv[8][2];
#pragma unroll
              for (int q = 0; q < 8; ++q) { const u32x4* src = (const u32x4*)(xb + (size_t)(tgp * 64 + wid * 8 + q) * DM) + 2 * lane; sv[q][0] = src[0]; sv[q][1] = src[1]; }
#pragma unroll
              for (int q = 0; q < 8; ++q) { const int tl = wid * 8 + q;
                f32x4 v0, v1, v2, v3; unpack8(sv[q][0], v0, v1); unpack8(sv[q][1], v2, v3); u32x4 w8; int t;
                t = 0; t = __builtin_amdgcn_cvt_pk_fp8_f32(v0[0], v0[1], t, false); t = __builtin_amdgcn_cvt_pk_fp8_f32(v0[2], v0[3], t, true); w8.x = (unsigned)t;
                t = 0; t = __builtin_amdgcn_cvt_pk_fp8_f32(v1[0], v1[1], t, false); t = __builtin_amdgcn_cvt_pk_fp8_f32(v1[2], v1[3], t, true); w8.y = (unsigned)t;
                t = 0; t = __builtin_amdgcn_cvt_pk_fp8_f32(v2[0], v2[1], t, false); t = __builtin_amdgcn_cvt_pk_fp8_f32(v2[2], v2[3], t, true); w8.z = (unsigned)t;
                t = 0; t = __builtin_amdgcn_cvt_pk_fp8_f32(v3[0], v3[1], t, false); t = __builtin_amdgcn_cvt_pk_fp8_f32(v3[2], v3[3], t, true); w8.w = (unsigned)t;
#pragma unroll
                for (int k = 0; k < 2; ++k) *((u32x4*)((unsigned char*)xg + (size_t)pslot[2 * tl + k] * DM) + lane) = w8; } }
            __syncthreads();
        }
        for (int idx = gw; idx < 8 * 256; idx += ngw) { const int e = idx >> 8, r = idx & 255; unsigned ce = 0; int be = 0;
#pragma unroll
            for (int q = 0; q < 8; ++q) { ce = (e == q) ? cnt[q] : ce; be = (e == q) ? base[q] : be; }
            const int rem = (int)(ce & 255u);
            if (rem != 0 && r >= rem) { const int slot = be + (int)(ce & ~255u) + r; u32x4 zz = {0u, 0u, 0u, 0u}; *((u32x4*)((unsigned char*)xg + (size_t)slot * DM) + lane) = zz;
                if (lane == 0) { row_tok[slot] = -1; row_gate[slot] = 0.f; row_rs[slot] = 0.f; } } }
    }
    SEAM(18);
    if (IN(19)) { PHASE_PTRS
        unsigned cnt[8];
#pragma unroll
        for (int e = 0; e < 8; ++e) cnt[e] = (unsigned)__builtin_amdgcn_readfirstlane((int)__hip_atomic_load(ctl + CW_MOECNT + e, __ATOMIC_RELAXED, __HIP_MEMORY_SCOPE_AGENT));
        pg8::Gemm g{DM / 2, DM / 2, DM / 2}; MoeOrder S; S.init(xg, DM / 2, moe_w13, DM / 2, (size_t)2 * EDIM * DM, 2 * EDIM / 256, cnt, G, bx);
        EpiSwiglu<true> E{act, EDIM, row_rs};
        pg8::gemm_phase(lds, g, S, E);
    }
    SEAM(19);
    if (IN(20)) { PHASE_PTRS
        unsigned cnt[8];
#pragma unroll
        for (int e = 0; e < 8; ++e) cnt[e] = (unsigned)__builtin_amdgcn_readfirstlane((int)__hip_atomic_load(ctl + CW_MOECNT + e, __ATOMIC_RELAXED, __HIP_MEMORY_SCOPE_AGENT));
        pg8::Gemm g{EDIM / 2, EDIM / 2, EDIM / 2}; MoeDownOrder S; S.init(act, EDIM / 2, (unsigned char*)moe_w13 + (size_t)NEXP * 2 * EDIM * DM, EDIM / 2, (size_t)DM * EDIM, cnt, G, bx);
        EpiMoeDownSplit E{ybuf, ypart, row_gate};
        pg8::gemm_phase(lds, g, S, E);
    }
    SEAM(20);
    if (IN(21)) { PHASE_PTRS
        int ns0 = 0, ns1 = 0; if (gw < T) { ns0 = tok_slot[2 * gw]; ns1 = tok_slot[2 * gw + 1]; }
        for (int m = gw; m < T; m += ngw) { const int s0 = __builtin_amdgcn_readfirstlane(ns0), s1 = __builtin_amdgcn_readfirstlane(ns1); f32x4* xr = (f32x4*)(a_out + (size_t)m * DM) + lane;
            { const int mn = (m + ngw < T) ? m + ngw : m; ns0 = tok_slot[2 * mn]; ns1 = tok_slot[2 * mn + 1]; }
            f32x4 v[4]; u32x2 ya[4], yb[4];
            const u32x2* y0 = (const u32x2*)((s0 >= 0 ? ybuf + (size_t)s0 * DM : ypart + (size_t)(-1 - s0) * DM)) + lane;
            const u32x2* y1 = (const u32x2*)((s1 >= 0 ? ybuf + (size_t)s1 * DM : ypart + (size_t)(-1 - s1) * DM)) + lane;
#pragma unroll
            for (int j = 0; j < 4; ++j) { v[j] = xr[64 * j]; ya[j] = y0[64 * j]; yb[j] = y1[64 * j]; }
#pragma unroll
            for (int j = 0; j < 4; ++j) { v[j][0] += lo2f(ya[j].x) + lo2f(yb[j].x); v[j][1] += hi2f(ya[j].x) + hi2f(yb[j].x); v[j][2] += lo2f(ya[j].y) + lo2f(yb[j].y); v[j][3] += hi2f(ya[j].y) + hi2f(yb[j].y); }
#pragma unroll
            for (int k = 0; k < 2; ++k) { const int sk = k ? s1 : s0;
                if (sk < 0) { const int pr = -1 - sk;
#pragma unroll 1
                    for (int q = 1; q < MD_KSPLIT; ++q) { const u32x2* yq = (const u32x2*)(ypart + ((size_t)q * (8 * 256) + pr) * DM) + lane;
#pragma unroll
                        for (int j = 0; j < 4; ++j) { const u32x2 p = yq[64 * j]; v[j][0] += lo2f(p.x); v[j][1] += hi2f(p.x); v[j][2] += lo2f(p.y); v[j][3] += hi2f(p.y); } } } }
#pragma unroll
            for (int j = 0; j < 4; ++j) xr[64 * j] = v[j]; }
    }
#undef IN
#undef SEAM
#undef GRID_BAR
#undef ss_mix
#undef ss_ffn
}
template <int LO, int HI> __global__ void __launch_bounds__(NTHREADS, 2) mk_fwd(Args a) { mk_body<LO, HI>(a); }

template <int PH> static void set_attr(bool& ok) { if constexpr (PH < NPH) { ok = ok && (hipFuncSetAttribute((const void*)mk_fwd<PH, PH + 1>, hipFuncAttributeMaxDynamicSharedMemorySize, LDS_TOTAL) == hipSuccess); set_attr<PH + 1>(ok); } }
template <int PH> static void launch_phases(const Args& a, int grid, hipStream_t stream) { if constexpr (PH < NPH) { hipLaunchKernelGGL((mk_fwd<PH, PH + 1>), dim3(grid), dim3(NTHREADS), LDS_TOTAL, stream, a); launch_phases<PH + 1>(a, grid, stream); } }
extern "C" void kernel_launch(void* const* d_in, const int* in_sizes, int n_in, void* d_out, int out_size, void* d_ws, size_t ws_size, hipStream_t stream) {
    static int grid = 0;
    if (!grid) {
        if (n_in != N_IN || out_size != T * DM || ws_size < WS_END) { fprintf(stderr, "kernel_launch: unexpected problem: n_in %d out %d ws %zu (need %zu)\n", n_in, out_size, ws_size, (size_t)WS_END); grid = -1; return; }
        int dev = 0, cus = 0, per_cu = 0;
        (void)hipGetDevice(&dev); (void)hipDeviceGetAttribute(&cus, hipDeviceAttributeMultiprocessorCount, dev);
#if MK_PER_PHASE
        { bool ok = true; set_attr<0>(ok); if (!ok) { fprintf(stderr, "kernel_launch: hipFuncSetAttribute failed\n"); grid = -1; return; } per_cu = 1; }
#else
        if (hipFuncSetAttribute((const void*)mk_fwd<0, NPH>, hipFuncAttributeMaxDynamicSharedMemorySize, LDS_TOTAL) != hipSuccess) { fprintf(stderr, "kernel_launch: hipFuncSetAttribute failed\n"); grid = -1; return; }
        if (hipOccupancyMaxActiveBlocksPerMultiprocessor(&per_cu, (const void*)mk_fwd<0, NPH>, NTHREADS, LDS_TOTAL) != hipSuccess || per_cu < 1) { fprintf(stderr, "kernel_launch: occupancy query failed (%d)\n", per_cu); grid = -1; return; }
#endif
        grid = cus;
    }
    if (grid <= 0) return;
    (void)hipMemsetAsync((char*)d_ws + WS_CTL, 0, 32768, stream);
    Args a{};
    for (int i = 0; i < N_IN; ++i) a.in[i] = (const float*)d_in[i];
    a.out = (float*)d_out; a.ws = (unsigned char*)d_ws;
#if MK_PER_PHASE
    launch_phases<0>(a, grid, stream);
#else
    void* args[] = {&a};
    hipError_t e = hipLaunchCooperativeKernel((const void*)mk_fwd<0, NPH>, dim3(grid), dim3(NTHREADS), args, LDS_TOTAL, stream);
    if (e != hipSuccess) fprintf(stderr, "cooperative launch failed: %s (grid %d)\n", hipGetErrorString(e), grid);
#endif
}
```

```cpp
#include <hip/hip_runtime.h>
#include <hip/hip_cooperative_groups.h>
#include <cstdio>
#include <cstdint>
namespace cg = cooperative_groups;

#ifndef FFN_FP8
#define FFN_FP8 0
#endif
#ifndef MK_PER_PHASE
#define MK_PER_PHASE 0
#endif

#define LAS __attribute__((address_space(3)))
typedef unsigned short bf16;
typedef short bf16x8 __attribute__((ext_vector_type(8)));
typedef float f32x4 __attribute__((ext_vector_type(4)));
typedef float f32x2 __attribute__((ext_vector_type(2)));
typedef unsigned u32x4 __attribute__((ext_vector_type(4)));
typedef unsigned u32x2 __attribute__((ext_vector_type(2)));

constexpr int BATCH = 8, SEQ = 2048, DM = 1024, T = BATCH * SEQ;
constexpr int CHUNK = 64, NCH = SEQ / CHUNK;
constexpr int IN_COLS = 10552, MIXC = 6456;
constexpr int ZC = 6656;
constexpr int C_RWKV = 0, C_SSM = 1824, C_ATT = 3368, C_GLA = 4904, C_HV = 6456;
constexpr int FFN = 2816, NEXP = 8, EDIM = 3584;
constexpr int MOE_ROWS = 2 * T + NEXP * 256;
constexpr float NORM_EPS = 1e-6f;

constexpr size_t MiB = 1u << 20;
constexpr size_t WS_CTL = 0;
constexpr size_t CTL_BYTES = 1 * MiB;
constexpr size_t WS_SMALL = WS_CTL + CTL_BYTES;
constexpr size_t SM_SS = 0;
constexpr size_t SM_MSSQ = SM_SS + 3 * (size_t)T * 16 * 4;
constexpr size_t SM_TOKE = SM_MSSQ + (size_t)T * 8 * 4;
constexpr size_t SM_TOKG = SM_TOKE + (size_t)T * 2 * 4;
constexpr size_t SM_TOKRS = SM_TOKG + (size_t)T * 2 * 4;
constexpr size_t SM_TOKSLOT = SM_TOKRS + (size_t)T * 4;
constexpr size_t SM_ROWTOK = SM_TOKSLOT + (size_t)T * 2 * 4;
constexpr size_t SM_ROWGATE = SM_ROWTOK + (size_t)MOE_ROWS * 4;
constexpr size_t SM_ROWRS = SM_ROWGATE + (size_t)MOE_ROWS * 4;
constexpr size_t SM_END = SM_ROWRS + (size_t)MOE_ROWS * 4;
static_assert(SM_END <= 6 * MiB, "small region");
constexpr size_t WS_XB = WS_SMALL + 6 * MiB;
constexpr size_t WS_X = WS_XB + (size_t)T * DM * 2;
constexpr size_t X_VFIRST = 0;
constexpr size_t X_MIXED = X_VFIRST + (size_t)T * 512 * 2;
constexpr size_t X_O = X_MIXED + (size_t)T * DM * 2;
constexpr size_t X_W = X_O + (size_t)T * 2048 * 2;
constexpr size_t W_IN = 0;
constexpr size_t W_G = W_IN + 2 * (size_t)ZC * DM * 2;
constexpr size_t W_B = W_G + 2 * (size_t)4096 * DM * 2;
constexpr size_t W_O = W_B + 2 * 4 * (size_t)DM * 512 * 2;
constexpr size_t W_13 = W_O + 2 * (size_t)DM * DM * 2;
constexpr size_t W_2 = W_13 + (size_t)2 * FFN * DM * 2;
constexpr size_t W_END = W_2 + (size_t)DM * FFN * 2;
constexpr size_t X_BYTES = X_W + W_END;
constexpr size_t MOE_W13 = 0;
constexpr size_t MOE_W2 = MOE_W13 + (size_t)NEXP * 2 * EDIM * DM * 2;
constexpr size_t MOE_WEND = MOE_W2 + (size_t)NEXP * DM * EDIM * 2;
static_assert(MOE_WEND <= X_BYTES, "MoE weights must fit the X region");
constexpr size_t WS_Z = WS_X + X_BYTES;
constexpr size_t Z_BYTES = (size_t)MOE_ROWS * EDIM * 2;
static_assert((size_t)T * ZC * 2 <= Z_BYTES, "z fits");
constexpr size_t WS_XG = WS_Z + Z_BYTES;
constexpr size_t XG_BYTES = (size_t)MOE_ROWS * DM * 2;
static_assert(4 * (size_t)T * 512 * 2 <= XG_BYTES, "rwkv arrays fit");
constexpr size_t WS_BCV = WS_XG + (size_t)4 * BATCH * (SEQ / 32) * 29184;
constexpr size_t WS_GEND = WS_BCV + (size_t)T * 512 * 2;
constexpr size_t WS_END = (WS_XG + XG_BYTES > WS_GEND + (size_t)BATCH * 4 * NCH * 64 * 4) ? WS_XG + XG_BYTES : WS_GEND + (size_t)BATCH * 4 * NCH * 64 * 4;

constexpr int CW_MOECNT = 64;
constexpr int CW_MOECUR = 128;
constexpr int CW_ATTQ = 192;
constexpr int CW_SPLIT = 256;
constexpr int CW_BAR = 1024;

__device__ __forceinline__ float bf2f(bf16 v) { return __builtin_bit_cast(float, (unsigned)v << 16); }
typedef __bf16 bf16x2_hw __attribute__((ext_vector_type(2)));
__device__ __forceinline__ unsigned pk2(float lo, float hi) { const f32x2 v = {lo, hi}; return __builtin_bit_cast(unsigned, __builtin_convertvector(v, bf16x2_hw)); }
__device__ __forceinline__ unsigned f2bf(float f) { return pk2(f, 0.f) & 0xffffu; }
__device__ __forceinline__ float lo2f(unsigned w) { return __builtin_bit_cast(float, w << 16); }
__device__ __forceinline__ float hi2f(unsigned w) { return __builtin_bit_cast(float, w & 0xffff0000u); }
__device__ __forceinline__ float sigmoidf_(float x) { return __builtin_amdgcn_rcpf(1.0f + __expf(-x)); }
__device__ __forceinline__ float siluf_(float x) { return x * __builtin_amdgcn_rcpf(1.0f + __expf(-x)); }
__device__ __forceinline__ float tanhf_(float x) { return 2.0f * __builtin_amdgcn_rcpf(1.0f + __expf(-2.0f * x)) - 1.0f; }
__device__ __forceinline__ float softplusf_(float x) { return x > 20.f ? x : __logf(1.0f + __expf(x)); }
template <int CTRL, int ROWMASK = 0xF, bool BOUND = true> __device__ __forceinline__ float dpp_f(float x) { return __builtin_bit_cast(float, __builtin_amdgcn_update_dpp(0, __builtin_bit_cast(int, x), CTRL, ROWMASK, 0xF, BOUND)); }
__device__ __forceinline__ float red8_sum(float x) { x += dpp_f<0xB1>(x); x += dpp_f<0x4E>(x); x += dpp_f<0x141>(x); return x; }
__device__ __forceinline__ float red16_sum(float x) { x = red8_sum(x); x += dpp_f<0x140>(x); return x; }
__device__ __forceinline__ float scan16(float x) { x += dpp_f<0x111>(x); x += dpp_f<0x112>(x); x += dpp_f<0x114>(x); x += dpp_f<0x118>(x); return x; }
__device__ __forceinline__ float scan32(float x) { x = scan16(x); x += dpp_f<0x142, 0xA, false>(x); return x; }
__device__ __forceinline__ float scan64(float x) { x = scan32(x); x += dpp_f<0x143, 0xC, false>(x); return x; }
__device__ __forceinline__ float xrows_sum(float v) { const int x = __builtin_bit_cast(int, v); const auto a = __builtin_amdgcn_permlane16_swap(x, x, false, false); v = __builtin_bit_cast(float, (int)a[0]) + __builtin_bit_cast(float, (int)a[1]);
    const int y = __builtin_bit_cast(int, v); const auto b = __builtin_amdgcn_permlane32_swap(y, y, false, false); return __builtin_bit_cast(float, (int)b[0]) + __builtin_bit_cast(float, (int)b[1]); }
__device__ __forceinline__ float xrows_max(float v) { const int x = __builtin_bit_cast(int, v); const auto a = __builtin_amdgcn_permlane16_swap(x, x, false, false); v = fmaxf(__builtin_bit_cast(float, (int)a[0]), __builtin_bit_cast(float, (int)a[1]));
    const int y = __builtin_bit_cast(int, v); const auto b = __builtin_amdgcn_permlane32_swap(y, y, false, false); return fmaxf(__builtin_bit_cast(float, (int)b[0]), __builtin_bit_cast(float, (int)b[1])); }
__device__ __forceinline__ float wave_sum(float v) { return xrows_sum(red16_sum(v)); }
__device__ __forceinline__ int opq_v(int x) { asm volatile("" : "+v"(x)); return x; }
__device__ __forceinline__ int opq_s(int x) { asm volatile("" : "+s"(x)); return x; }
__device__ __forceinline__ float rdlane(float v, int l) { return __builtin_bit_cast(float, __builtin_amdgcn_readlane(__builtin_bit_cast(int, v), l)); }

namespace pg8 {
constexpr int BM = 256, BK = 64, HALF = 128, HTB = HALF * BK * 2, STAGE_BYTES = 8 * HTB, NXCD = 8, WGM = 8;
__host__ __device__ __forceinline__ int lds_byte(int r, int c) { const int st = (r >> 4) * 2 + (c >> 5), rr = r & 15, cc = c & 31, ob = rr * 64 + cc * 2; return st * 1024 + (ob ^ (((ob >> 9) & 1) << 5)); }
__host__ __device__ __forceinline__ void stage_rc(int b, int& R, int& C) { const int st = b / 1024, sb = b % 1024, swz = sb ^ (((sb >> 9) & 1) << 5); R = (st >> 1) * 16 + swz / 64; C = (st & 1) * 32 + (swz % 64) / 2; }
__host__ __device__ __forceinline__ int perm32(int rho) { const int n = rho >> 4, i = rho & 15; return 8 * (i >> 2) + 4 * n + (i & 3); }

typedef int v4i __attribute__((ext_vector_type(4)));
typedef int v8i __attribute__((ext_vector_type(8)));
struct Unit { int pm, pn, e, kq; };
struct Gemm { int lda, ldb, K; };

struct StaticOrder {
    static constexpr bool VARNT = false;
    const char* A; const char* Bt; size_t tstepA, tstepB;
    int nM, nN, nwg, G, c;
    __device__ __forceinline__ void init(const void* A_, const void* Bt_, int lda, int ldb, int M, int N, int G_, int c_) { A = (const char*)A_; Bt = (const char*)Bt_; tstepA = (size_t)BM * lda * 2; tstepB = (size_t)BM * ldb * 2; nM = M / BM; nN = N / BM; nwg = nM * nN; G = G_; c = c_; }
    __device__ __forceinline__ bool next(int i, Unit& u) const {
        const long L = (long)i * G + c; if (L >= nwg) return false;
        int wgid = (int)L; { const int q = nwg / NXCD, r = nwg % NXCD, xcd = wgid % NXCD, off = wgid / NXCD; wgid = (xcd < r ? xcd * (q + 1) : r * (q + 1) + (xcd - r) * q) + off; }
        const int nig = WGM * nN, gid = wgid / nig, fm = gid * WGM, gsz = (nM - fm) < WGM ? (nM - fm) : WGM;
        u.pm = fm + ((wgid % nig) % gsz); u.pn = (wgid % nig) / gsz; u.e = 0; return true;
    }
    __device__ __forceinline__ const char* a_ptr(const Unit& u) const { return A + (size_t)u.pm * tstepA; }
    __device__ __forceinline__ const char* b_ptr(const Unit& u) const { return Bt + (size_t)u.pn * tstepB; }
};

typedef __bf16 bf16x2_t __attribute__((ext_vector_type(2)));
__device__ __forceinline__ unsigned cvt_pk_bf16(float lo, float hi) { const f32x2 v = {lo, hi}; return __builtin_bit_cast(unsigned, __builtin_convertvector(v, bf16x2_t)); }

template <class Epi, class Sched>
__device__ __forceinline__ void gemm_phase(LAS unsigned char* lds, const Gemm g, const Sched& S, const Epi& E) {
    const int tid = opq_v((int)threadIdx.x), wid = __builtin_amdgcn_readfirstlane(tid >> 6), lane = tid & 63, wr = wid >> 2, wc = wid & 3, fr = lane & 15, fq = lane >> 4;
    const int nt = opq_s(g.K / BK);
    unsigned voffA[2], voffB[2];
#pragma unroll
    for (int i = 0; i < 2; ++i) { int R, C; stage_rc(tid * 16 + i * 8192, R, C); const int Rb = Epi::PERM ? ((R & ~31) + perm32(R & 31)) : R;
        voffA[i] = (unsigned)(R * g.lda + C) * 2u; voffB[i] = (unsigned)(Rb * g.ldb + C) * 2u; }
    const size_t kstep = (size_t)(BK * 2);
    const size_t hstepA = (size_t)HALF * g.lda * 2, hstepB = (size_t)HALF * g.ldb * 2;
    const unsigned ldsw = (unsigned)wid * 1024u;
    const int aoff = lds_byte(wr * 64 + fr, fq * 8), boff = lds_byte(wc * 32 + fr, fq * 8);
#define PG8_SA(b, h) (((b) * 2 + (h)) * HTB)
#define PG8_SB(b, h) ((4 + (b) * 2 + (h)) * HTB)
#define PG8_STAGE(bufoff, gbase, voff) do { _Pragma("unroll") for (int _i = 0; _i < 2; ++_i) \
        __builtin_amdgcn_global_load_lds((const unsigned*)((const char*)(gbase) + (voff)[_i]), (LAS unsigned*)(lds + (bufoff) + ldsw + _i * 8192), 16, 0, 0); } while (0)
#define PG8_LDA(dst, b, h) do { _Pragma("unroll") for (int m = 0; m < 4; ++m) { if constexpr (Epi::F8) { const v4i lo_ = *(const LAS v4i*)(lds + PG8_SA(b, h) + aoff + m * 2048), hi_ = *(const LAS v4i*)(lds + PG8_SA(b, h) + aoff + m * 2048 + 1024); \
            dst##8[m] = __builtin_shufflevector(lo_, hi_, 0, 1, 2, 3, 4, 5, 6, 7); } else { _Pragma("unroll") for (int k = 0; k < 2; ++k) dst[m][k] = *(const LAS bf16x8*)(lds + PG8_SA(b, h) + aoff + m * 2048 + k * 1024); } } } while (0)
#define PG8_LDB(dst, b, h) do { _Pragma("unroll") for (int n = 0; n < 2; ++n) { if constexpr (Epi::F8) { const v4i lo_ = *(const LAS v4i*)(lds + PG8_SB(b, h) + boff + n * 2048), hi_ = *(const LAS v4i*)(lds + PG8_SB(b, h) + boff + n * 2048 + 1024); \
            dst##8[n] = __builtin_shufflevector(lo_, hi_, 0, 1, 2, 3, 4, 5, 6, 7); } else { _Pragma("unroll") for (int k = 0; k < 2; ++k) dst[n][k] = *(const LAS bf16x8*)(lds + PG8_SB(b, h) + boff + n * 2048 + k * 1024); } } } while (0)
#define PG8_MMA(ai, bj, At, Bt) do { __builtin_amdgcn_s_setprio(1); _Pragma("unroll") for (int m = 0; m < 4; ++m) _Pragma("unroll") for (int n = 0; n < 2; ++n) { \
        if constexpr (Epi::F8) asm volatile("v_mfma_scale_f32_16x16x128_f8f6f4 %0, %1, %2, %0, %3, %3 op_sel_hi:[0,0,0]" : "+v"(acc[ai][bj][m][n]) : "v"(Bt##8[n]), "v"(At##8[m]), "v"(f8scale));   \
        else { _Pragma("unroll") for (int k = 0; k < 2; ++k) acc[ai][bj][m][n] = __builtin_amdgcn_mfma_f32_16x16x32_bf16(Bt[n][k], At[m][k], acc[ai][bj][m][n], 0, 0, 0); } } \
        __builtin_amdgcn_s_setprio(0); } while (0)
#define PG8_WAIT_V(n) asm volatile("s_waitcnt vmcnt(" #n ")" ::: "memory")
#define PG8_WAIT_L(n) asm volatile("s_waitcnt lgkmcnt(" #n ")" ::: "memory")
#define PG8_BAR __builtin_amdgcn_s_barrier()
#define PG8_SCHED __builtin_amdgcn_sched_barrier(0)
    Unit cur, nxt; int ui = 0;
    if (!S.next(0, cur)) return;
    f32x4 acc[2][2][4][2];
#pragma unroll
    for (int a = 0; a < 2; ++a)
#pragma unroll
        for (int b = 0; b < 2; ++b)
#pragma unroll
            for (int m = 0; m < 4; ++m)
#pragma unroll
                for (int n = 0; n < 2; ++n) acc[a][b][m][n] = (f32x4){0.f, 0.f, 0.f, 0.f};
    const int f8scale = opq_v(0x7f7f7f7f);
    bf16x8 At[4][2], B0[2][2], B1[2][2]; v8i At8[4], B08[2], B18[2];
    const char* cA = S.a_ptr(cur); const char* cB = S.b_ptr(cur);
    PG8_STAGE(PG8_SB(0, 0), cB, voffB); PG8_STAGE(PG8_SB(0, 1), cB + hstepB, voffB); PG8_STAGE(PG8_SA(0, 0), cA, voffA); PG8_STAGE(PG8_SA(0, 1), cA + hstepA, voffA);
    if (wr == 1) PG8_BAR;
    PG8_WAIT_V(2); PG8_BAR;
    PG8_STAGE(PG8_SB(1, 0), cB + kstep, voffB); PG8_STAGE(PG8_SA(1, 0), cA + kstep, voffA); PG8_STAGE(PG8_SB(1, 1), cB + hstepB + kstep, voffB);
    PG8_WAIT_V(6); PG8_BAR;
    for (;;) {
        const bool has_next = S.next(ui + 1, nxt);
        int ntc = nt; if constexpr (Sched::VARNT) ntc = opq_s(S.nt_of(cur));
        const char* nA = has_next ? S.a_ptr(nxt) : cA; const char* nB = has_next ? S.b_ptr(nxt) : cB;
#pragma unroll 1
        for (int t = 0; t < ntc; t += 2) {
            const bool last = (t == ntc - 2);
            const char* a1 = cA + (size_t)(t + 1) * kstep;
            const char* a2 = last ? nA : cA + (size_t)(t + 2) * kstep; const char* b2 = last ? nB : cB + (size_t)(t + 2) * kstep;
            const char* a3 = a2 + kstep; const char* b3 = b2 + kstep;
            PG8_LDB(B0, 0, 0); PG8_LDB(B1, 0, 1); PG8_SCHED; PG8_LDA(At, 0, 0); PG8_STAGE(PG8_SA(1, 1), a1 + hstepA, voffA);
            PG8_WAIT_V(8); PG8_WAIT_L(0); PG8_BAR; PG8_MMA(0, 0, At, B0); PG8_MMA(0, 1, At, B1); PG8_BAR; PG8_SCHED;
            PG8_LDA(At, 0, 1); PG8_STAGE(PG8_SB(0, 0), b2, voffB); PG8_STAGE(PG8_SB(0, 1), b2 + hstepB, voffB); PG8_STAGE(PG8_SA(0, 0), a2, voffA);
            PG8_WAIT_V(8); PG8_WAIT_L(0); PG8_BAR; PG8_MMA(1, 0, At, B0); PG8_MMA(1, 1, At, B1); PG8_BAR; PG8_SCHED;
            PG8_LDB(B0, 1, 0); PG8_LDB(B1, 1, 1); PG8_SCHED; PG8_LDA(At, 1, 0); PG8_STAGE(PG8_SA(0, 1), a2 + hstepA, voffA);
            PG8_WAIT_V(8); PG8_WAIT_L(0); PG8_BAR; PG8_MMA(0, 0, At, B0); PG8_MMA(0, 1, At, B1); PG8_BAR; PG8_SCHED;
            PG8_LDA(At, 1, 1); PG8_STAGE(PG8_SB(1, 0), b3, voffB); PG8_STAGE(PG8_SB(1, 1), b3 + hstepB, voffB); PG8_STAGE(PG8_SA(1, 0), a3, voffA);
            PG8_WAIT_V(8); PG8_WAIT_L(0); PG8_BAR; PG8_MMA(1, 0, At, B0); PG8_MMA(1, 1, At, B1); PG8_BAR; PG8_SCHED;
        }
        if (wr == 0) PG8_BAR;
        if constexpr (Epi::F8) asm volatile("s_nop 15\n\ts_nop 15" ::: "memory");
        E(acc, cur, wr, wc, fr, fq);
        if (!has_next) break;
        if constexpr (!Epi::CHAIN) {
#pragma unroll
        for (int a = 0; a < 2; ++a)
#pragma unroll
            for (int b = 0; b < 2; ++b)
#pragma unroll
                for (int m = 0; m < 4; ++m)
#pragma unroll
                    for (int n = 0; n < 2; ++n) acc[a][b][m][n] = (f32x4){0.f, 0.f, 0.f, 0.f};
        }
        cur = nxt; cA = nA; cB = nB; ++ui;
        if (wr == 1) PG8_BAR;
    }
    PG8_WAIT_V(0);
    PG8_BAR;
#undef PG8_SA
#undef PG8_SB
#undef PG8_STAGE
#undef PG8_LDA
#undef PG8_LDB
#undef PG8_MMA
#undef PG8_WAIT_V
#undef PG8_WAIT_L
#undef PG8_BAR
#undef PG8_SCHED
}
}

using pg8::Unit;
__device__ __forceinline__ u32x4 pack8(f32x4 v0, f32x4 v1) { u32x4 w; w.x = pg8::cvt_pk_bf16(v0[0], v0[1]); w.y = pg8::cvt_pk_bf16(v0[2], v0[3]); w.z = pg8::cvt_pk_bf16(v1[0], v1[1]); w.w = pg8::cvt_pk_bf16(v1[2], v1[3]); return w; }
__device__ __forceinline__ f32x4 sig4(f32x4 v) { return (f32x4){sigmoidf_(v[0]), sigmoidf_(v[1]), sigmoidf_(v[2]), sigmoidf_(v[3])}; }
__device__ __forceinline__ void unpack8(u32x4 w, f32x4& a, f32x4& b) { a = (f32x4){lo2f(w.x), hi2f(w.x), lo2f(w.y), hi2f(w.y)}; b = (f32x4){lo2f(w.z), hi2f(w.z), lo2f(w.w), hi2f(w.w)}; }

__device__ __forceinline__ void rs8_from_parts(const float* ss, int row0, int fq, float (&rs)[2][4]) {
    f32x4 p[2][4];
#pragma unroll
    for (int ai = 0; ai < 2; ++ai)
#pragma unroll
        for (int m = 0; m < 4; ++m) p[ai][m] = *(const f32x4*)(ss + (size_t)(row0 + ai * 128 + m * 16) * 16 + 4 * fq);
#pragma unroll
    for (int ai = 0; ai < 2; ++ai)
#pragma unroll
        for (int m = 0; m < 4; ++m) { float t = (p[ai][m][0] + p[ai][m][1]) + (p[ai][m][2] + p[ai][m][3]); t = xrows_sum(t); rs[ai][m] = __builtin_amdgcn_rsqf(t * (1.0f / DM) + NORM_EPS); }
}
template <int ACT> struct EpiScaleBf16 {
    static constexpr bool PERM = true, CHAIN = false, F8 = false;
    bf16* O; int ldc; const float* ss;
    __device__ __forceinline__ void operator()(f32x4 (&acc)[2][2][4][2], const Unit& u, int wr, int wc, int fr, int fq) const {
        const int row0 = u.pm * 256 + wr * 64 + fr, col0 = u.pn * 256 + wc * 32 + 8 * fq;
        float rs[2][4]; rs8_from_parts(ss, row0, fq, rs);
#pragma unroll
        for (int ai = 0; ai < 2; ++ai)
#pragma unroll
            for (int m = 0; m < 4; ++m) { const int row = row0 + ai * 128 + m * 16; const float s = rs[ai][m];
                bf16* rowp = O + (size_t)row * ldc + col0;
#pragma unroll
                for (int bj = 0; bj < 2; ++bj) { f32x4 v0 = acc[ai][bj][m][0] * s, v1 = acc[ai][bj][m][1] * s;
                    if (ACT == 1) { v0 = sig4(v0); v1 = sig4(v1); }
                    *(u32x4*)(rowp + bj * 128) = pack8(v0, v1); }
                asm volatile("" ::: "memory"); }
    }
};
struct EpiGateRatio {
    static constexpr bool PERM = true, CHAIN = false, F8 = false;
    bf16* O; const float* ss;
    __device__ __forceinline__ void operator()(const f32x4 (&acc)[2][2][4][2], const Unit& u, int wr, int wc, int fr, int fq) const {
        const int row0 = u.pm * 256 + wr * 64 + fr, c0 = u.pn * 64 + wc * 16 + 4 * fq;
        float rs[2][4]; rs8_from_parts(ss, row0, fq, rs);
#pragma unroll
        for (int ai = 0; ai < 2; ++ai)
#pragma unroll
            for (int m = 0; m < 4; ++m) { const int row = row0 + ai * 128 + m * 16; const float s = rs[ai][m];
                f32x4 g[4];
#pragma unroll
                for (int i = 0; i < 4; ++i) { g[i] = sig4(acc[ai][i >> 1][m][i & 1] * s);
#pragma unroll
                    for (int j = 0; j < 4; ++j) g[i][j] = fmaxf(g[i][j], 1e-30f); }
                bf16* rowp = O + (size_t)row * 4096 + c0;
#pragma unroll
                for (int i = 0; i < 4; ++i) { f32x4 r = g[i];
                    if (i < 3) {
#pragma unroll
                        for (int j = 0; j < 4; ++j) r[j] = g[i][j] * __builtin_amdgcn_rcpf(g[i + 1][j]); }
                    u32x2 w; w.x = pg8::cvt_pk_bf16(r[0], r[1]); w.y = pg8::cvt_pk_bf16(r[2], r[3]); *(u32x2*)(rowp + i * 1024) = w; }
                asm volatile("" ::: "memory"); }
    }
};
template <bool MOE, bool F8_ = MOE> struct EpiSwiglu {
    static constexpr bool PERM = true, CHAIN = false, F8 = F8_;
    bf16* O; int ldc; const float* rsrc;
    __device__ __forceinline__ void operator()(f32x4 (&acc)[2][2][4][2], const Unit& u, int wr, int wc, int fr, int fq) const {
        const int row0 = u.pm * 256 + wr * 64 + fr, col0 = u.pn * 128 + wc * 32 + 8 * fq;
        float rs[2][4];
        if (MOE) {
#pragma unroll
            for (int ai = 0; ai < 2; ++ai)
#pragma unroll
                for (int m = 0; m < 4; ++m) rs[ai][m] = rsrc[row0 + ai * 128 + m * 16]; }
        else rs8_from_parts(rsrc, row0, fq, rs);
        if (F8) {
#pragma unroll
            for (int ai = 0; ai < 2; ++ai)
#pragma unroll
                for (int m = 0; m < 4; ++m) rs[ai][m] *= (1.0f / 32.0f); }
#pragma unroll
        for (int ai = 0; ai < 2; ++ai)
#pragma unroll
            for (int m = 0; m < 4; ++m) { const int row = row0 + ai * 128 + m * 16; const float s = rs[ai][m];
                f32x4 o[2];
#pragma unroll
                for (int n = 0; n < 2; ++n) { const f32x4 a = acc[ai][0][m][n] * s, b = acc[ai][1][m][n] * s;
                    o[n] = (f32x4){siluf_(a[0]) * b[0], siluf_(a[1]) * b[1], siluf_(a[2]) * b[2], siluf_(a[3]) * b[3]}; }
                if constexpr (F8) { u32x2 w8; int t0_ = 0, t1_ = 0; t0_ = __builtin_amdgcn_cvt_pk_fp8_f32(o[0][0], o[0][1], t0_, false); t0_ = __builtin_amdgcn_cvt_pk_fp8_f32(o[0][2], o[0][3], t0_, true);
                    t1_ = __builtin_amdgcn_cvt_pk_fp8_f32(o[1][0], o[1][1], t1_, false); t1_ = __builtin_amdgcn_cvt_pk_fp8_f32(o[1][2], o[1][3], t1_, true); w8.x = (unsigned)t0_; w8.y = (unsigned)t1_;
                    *(u32x2*)((unsigned char*)O + (size_t)row * ldc + col0) = w8; }
                else *(u32x4*)(O + (size_t)row * ldc + col0) = pack8(o[0], o[1]);
                asm volatile("" ::: "memory"); }
    }
};
template <bool F8_ = false> struct EpiResid {
    static constexpr bool PERM = false, CHAIN = false, F8 = F8_;
    const float* xin; float* out; bf16* xb; float* ss; unsigned char* xb8;
    __device__ __forceinline__ void operator()(f32x4 (&acc)[2][2][4][2], const Unit& u, int wr, int wc, int fr, int fq) const {
        const int row0 = u.pm * 256 + wr * 64 + fr, col0 = u.pn * 256 + wc * 32 + 4 * fq;
#pragma unroll
        for (int ai = 0; ai < 2; ++ai)
#pragma unroll
            for (int m = 0; m < 4; ++m) { const int row = row0 + ai * 128 + m * 16; const size_t off = (size_t)row * DM + col0; float q = 0.f;
#pragma unroll
                for (int bj = 0; bj < 2; ++bj)
#pragma unroll
                    for (int n = 0; n < 2; ++n) { const f32x4 xi = *(const f32x4*)(xin + off + bj * 128 + n * 16); const f32x4 v = F8 ? xi + acc[ai][bj][m][n] * (1.0f / 64.0f) : xi + acc[ai][bj][m][n];
                        *(f32x4*)(out + off + bj * 128 + n * 16) = v; u32x2 w; w.x = pg8::cvt_pk_bf16(v[0], v[1]); w.y = pg8::cvt_pk_bf16(v[2], v[3]);
                        *(u32x2*)(xb + off + bj * 128 + n * 16) = w;
                        if (xb8) { int t8 = 0; t8 = __builtin_amdgcn_cvt_pk_fp8_f32(v[0], v[1], t8, false); t8 = __builtin_amdgcn_cvt_pk_fp8_f32(v[2], v[3], t8, true); *(int*)(xb8 + off + bj * 128 + n * 16) = t8; }
                        q += (v[0] * v[0] + v[1] * v[1]) + (v[2] * v[2] + v[3] * v[3]); }
                q = xrows_sum(q);
                if (fq == 0 && ss) ss[(size_t)row * 16 + u.pn * 4 + wc] = q;
                if (m & 1) asm volatile("" ::: "memory"); }
    }
};
struct EpiMix {
    static constexpr bool PERM = true, CHAIN = true, F8 = false;
    const bf16* gates; bf16* mixed;
    __device__ __forceinline__ void operator()(f32x4 (&acc)[2][2][4][2], const Unit& u, int wr, int wc, int fr, int fq) const {
        const int row0 = u.pm * 256 + wr * 64 + fr, col0 = u.pn * 256 + wc * 32 + 8 * fq; const int i = u.e;
#pragma unroll
        for (int ai = 0; ai < 2; ++ai)
#pragma unroll
            for (int m = 0; m < 4; ++m) { const int row = row0 + ai * 128 + m * 16;
#pragma unroll
                for (int bj = 0; bj < 2; ++bj) { const bf16* gp = gates + (size_t)row * 4096 + i * 1024 + col0 + bj * 128;
                    f32x4 r0, r1; unpack8(*(const u32x4*)gp, r0, r1);
                    if (i < 3) { acc[ai][bj][m][0] = acc[ai][bj][m][0] * r0; acc[ai][bj][m][1] = acc[ai][bj][m][1] * r1; }
                    else {
                        *(u32x4*)(mixed + (size_t)row * DM + col0 + bj * 128) = pack8(acc[ai][bj][m][0] * r0, acc[ai][bj][m][1] * r1);
                        acc[ai][bj][m][0] = (f32x4){0.f, 0.f, 0.f, 0.f}; acc[ai][bj][m][1] = (f32x4){0.f, 0.f, 0.f, 0.f};
                    } } }
    }
};
struct MixOrder {
    static constexpr bool VARNT = false;
    const char* O; const char* Wb; int G, c;
    __device__ __forceinline__ bool next(int i, Unit& u) const {
        const int grp = (i >> 2) * G + c; if (grp >= 256) return false;
        int wgid = grp; { const int xcd = wgid % 8, off = wgid / 8; wgid = xcd * 32 + off; }
        const int nig = 8 * 4, gid = wgid / nig; u.pm = gid * 8 + ((wgid % nig) % 8); u.pn = (wgid % nig) / 8; u.e = i & 3; return true;
    }
    __device__ __forceinline__ const char* a_ptr(const Unit& u) const { return O + ((size_t)u.pm * 256 * 2048 + (size_t)u.e * 512) * 2; }
    __device__ __forceinline__ const char* b_ptr(const Unit& u) const { return Wb + ((size_t)u.e * DM * 512 + (size_t)u.pn * 256 * 512) * 2; }
};
struct MoeOrder {
    static constexpr bool VARNT = false;
    const char* A; const char* Bt; size_t tstepA, tstepB, estepB; int nN, ntiles, G, c;
    int te0, te1, te2, te3, te4, te5, te6;
    __device__ __forceinline__ void init(const void* A_, int lda, const void* Bt_, int ldb, size_t estepB_, int nN_, const unsigned* cnt, int G_, int c_) {
        A = (const char*)A_; Bt = (const char*)Bt_; tstepA = (size_t)256 * lda * 2; tstepB = (size_t)256 * ldb * 2; estepB = estepB_; nN = nN_; G = G_; c = c_;
        int acc = 0; acc += (int)((cnt[0] + 255u) >> 8); te0 = acc; acc += (int)((cnt[1] + 255u) >> 8); te1 = acc; acc += (int)((cnt[2] + 255u) >> 8); te2 = acc; acc += (int)((cnt[3] + 255u) >> 8); te3 = acc;
        acc += (int)((cnt[4] + 255u) >> 8); te4 = acc; acc += (int)((cnt[5] + 255u) >> 8); te5 = acc; acc += (int)((cnt[6] + 255u) >> 8); te6 = acc; acc += (int)((cnt[7] + 255u) >> 8); ntiles = acc;
    }
    __device__ __forceinline__ bool next(int i, Unit& u) const {
        const long L = (long)i * G + c; if (L >= (long)ntiles * nN) return false;
        const int mt = (int)(L / nN); u.pm = mt; u.pn = (int)(L % nN);
        u.e = (mt >= te0) + (mt >= te1) + (mt >= te2) + (mt >= te3) + (mt >= te4) + (mt >= te5) + (mt >= te6); return true;
    }
    __device__ __forceinline__ const char* a_ptr(const Unit& u) const { return A + (size_t)u.pm * tstepA; }
    __device__ __forceinline__ const char* b_ptr(const Unit& u) const { return Bt + (size_t)u.e * estepB + (size_t)u.pn * tstepB; }
};

constexpr int MD_KSPLIT = 7, MD_KTILES = 4;
struct MoeDownOrder {
    static constexpr bool VARNT = true;
    const char* A; const char* Bt; size_t tstepA, tstepB, estepB; int G, c, nsplit, nfull4;
    int tb[8], fe[8];
    unsigned pmask;
    __device__ __forceinline__ void init(const void* A_, int lda, const void* Bt_, int ldb, size_t estepB_, const unsigned* cnt, int G_, int c_) {
        A = (const char*)A_; Bt = (const char*)Bt_; tstepA = (size_t)256 * lda * 2; tstepB = (size_t)256 * ldb * 2; estepB = estepB_; G = G_; c = c_;
        int acc = 0, np = 0, nf = 0; pmask = 0u;
#pragma unroll
        for (int e = 0; e < 8; ++e) { tb[e] = acc; fe[e] = (int)(cnt[e] >> 8); const int p = (cnt[e] & 255u) ? 1 : 0; pmask |= (unsigned)p << e; acc += fe[e] + p; np += p; nf += fe[e]; }
        nsplit = np * 4 * MD_KSPLIT; nfull4 = nf * 4;
    }
    __device__ __forceinline__ bool next(int i, Unit& u) const {
        const long L = (long)i * G + c; if (L >= (long)nsplit + nfull4) return false;
        if (L < nsplit) { const int sidx = (int)L, pi = sidx / (4 * MD_KSPLIT), w = sidx - pi * (4 * MD_KSPLIT); u.pn = w / MD_KSPLIT; u.kq = w - u.pn * MD_KSPLIT;
            int e = 0, seen = 0;
#pragma unroll
            for (int q = 0; q < 8; ++q) { const int has = (int)((pmask >> q) & 1u); if (has && seen == pi) e = q; seen += has; }
            int tbe = 0, fee = 0;
#pragma unroll
            for (int q = 0; q < 8; ++q) { tbe = (e == q) ? tb[q] : tbe; fee = (e == q) ? fe[q] : fee; }
            u.e = e; u.pm = tbe + fee; u.kq |= pi << 8; }
        else { const int f = (int)L - nsplit, ft = f >> 2; u.pn = f & 3; u.kq = -1; int e = 0, rem = ft, pm = 0, done = 0;
#pragma unroll
            for (int q = 0; q < 8; ++q) { if (!done) { if (rem < fe[q]) { e = q; pm = tb[q] + rem; done = 1; } else rem -= fe[q]; } }
            u.e = e; u.pm = pm; }
        return true;
    }
    __device__ __forceinline__ int nt_of(const Unit& u) const { return u.kq < 0 ? MD_KSPLIT * MD_KTILES : MD_KTILES; }
    __device__ __forceinline__ const char* a_ptr(const Unit& u) const { return A + (size_t)u.pm * tstepA + (u.kq < 0 ? (size_t)0 : (size_t)(u.kq & 255) * (MD_KTILES * 128)); }
    __device__ __forceinline__ const char* b_ptr(const Unit& u) const { return Bt + (size_t)u.e * estepB + (size_t)u.pn * tstepB + (u.kq < 0 ? (size_t)0 : (size_t)(u.kq & 255) * (MD_KTILES * 128)); }
};
struct EpiMoeDownSplit {
    static constexpr bool PERM = true, CHAIN = false, F8 = true;
    bf16* Y; bf16* Yp; const float* rgate;
    __device__ __forceinline__ void operator()(f32x4 (&acc)[2][2][4][2], const Unit& u, int wr, int wc, int fr, int fq) const {
        const int rl0 = wr * 64 + fr, col0 = u.pn * 256 + wc * 32 + 8 * fq;
        bf16* dst = (u.kq < 0) ? Y + (size_t)u.pm * 256 * DM : Yp + ((size_t)(u.kq & 255) * (8 * 256) + (size_t)(u.kq >> 8) * 256) * DM;
#pragma unroll
        for (int ai = 0; ai < 2; ++ai)
#pragma unroll
            for (int m = 0; m < 4; ++m) { const int rl = rl0 + ai * 128 + m * 16; const float s = rgate[u.pm * 256 + rl] * (1.0f / 64.0f);
#pragma unroll
                for (int bj = 0; bj < 2; ++bj) *(u32x4*)(dst + (size_t)rl * DM + col0 + bj * 128) = pack8(acc[ai][bj][m][0] * s, acc[ai][bj][m][1] * s); }
    }
};

enum { I_X = 0, I_WIN, I_NORM_MIX, I_RW_MU, I_RW_DECAY_UP, I_RW_W0, I_RW_A_UP, I_RW_A0, I_RW_GATE_UP, I_RW_KK, I_RW_KA, I_RW_RK, I_RW_LNW, I_RW_LNB,
       I_VRES_DOWN, I_VRES_UP, I_VRES_V0, I_SSM_CONVW, I_SSM_CONVB, I_SSM_DTB, I_SSM_ALOG, I_SSM_D, I_SSM_NORMW, I_ATT_QG, I_ATT_KG, I_ATT_BIAS,
       I_GLA_GUP, I_GLA_GB, I_GLA_NW, I_WBRANCH, I_WOUT, I_NORM_FFN, I_FFN_W1, I_FFN_W3, I_FFN_W2, I_MOE_ROUTER, I_MOE_W1, I_MOE_W3, I_MOE_W2, N_IN };
struct Args { const float* in[N_IN]; float* out; unsigned char* ws; };
static_assert(sizeof(Args) == (N_IN + 2) * 8, "Args has no padding");

struct PT { const LAS unsigned long long* tab;
    __device__ __forceinline__ const float* operator[](int i) const { const unsigned long long v = tab[i];
        const unsigned lo = __builtin_amdgcn_readfirstlane((unsigned)v), hi = __builtin_amdgcn_readfirstlane((unsigned)(v >> 32)); return (const float*)(const __attribute__((address_space(1))) float*)(((unsigned long long)hi << 32) | lo); } };
struct ArgsD { PT in;
    __device__ __forceinline__ float* out() const { return (float*)in[N_IN]; }
    __device__ __forceinline__ unsigned char* ws() const { return (unsigned char*)in[N_IN + 1]; } };
constexpr int NWAVES = 8, NTHREADS = 512;
constexpr int LDS_MAIN = 131072;
constexpr int LDS_CTL_OFF = LDS_MAIN;
constexpr int LDS_BYTES = LDS_MAIN + 1024;

template <bool GPERM = false> __device__ __forceinline__ void cvt_item(const float* __restrict__ W, int ld, int k0, int csrc, int ncv, const float* __restrict__ gs, bf16* dst, int dstK, int drow, LAS float* scr, int lane) {
    const int lc = (lane < ncv) ? lane : ncv - 1;
    const float* wp = W + (size_t)k0 * ld + csrc + lc;
#pragma unroll
    for (int kb = 0; kb < 64; kb += 16) { float v[16];
#pragma unroll
        for (int j = 0; j < 16; ++j) v[j] = __builtin_nontemporal_load(wp + (size_t)(kb + j) * ld);
#pragma unroll
        for (int j = 0; j < 16; ++j) scr[(kb + j) * 65 + lane] = v[j]; }
    asm volatile("s_waitcnt lgkmcnt(0)" ::: "memory");
    const int kc = lane & 7;
    f32x4 g0 = {1.f, 1.f, 1.f, 1.f}, g1 = g0; if (gs) { g0 = *(const f32x4*)(gs + k0 + 8 * kc); g1 = *(const f32x4*)(gs + k0 + 8 * kc + 4); }
#pragma unroll
    for (int i = 0; i < 8; ++i) { const int nn = (lane >> 3) + 8 * i; const LAS float* sp = scr + (8 * kc) * 65 + nn;
        u32x4 o; o.x = pk2(sp[0 * 65] * g0[0], sp[1 * 65] * g0[1]); o.y = pk2(sp[2 * 65] * g0[2], sp[3 * 65] * g0[3]); o.z = pk2(sp[4 * 65] * g1[0], sp[5 * 65] * g1[1]); o.w = pk2(sp[6 * 65] * g1[2], sp[7 * 65] * g1[3]);
        const int rr = GPERM ? 32 * ((nn >> 4) & 3) + 8 * ((nn >> 2) & 3) + (nn & 3) : nn;
        if (nn < ncv) *(u32x4*)(dst + (size_t)(drow + rr) * dstK + k0 + 8 * kc) = o; }
    asm volatile("s_waitcnt lgkmcnt(0)" ::: "memory");
}
__device__ __forceinline__ void cvt_item8(const float* __restrict__ W, int ld, int k0, int csrc, int ncv, const float* __restrict__ gs, float scale, unsigned char* dst, int dstK, int drow, LAS float* scr, int lane) {
    const int lc = (lane < ncv) ? lane : ncv - 1;
    const float* wp = W + (size_t)k0 * ld + csrc + lc;
#pragma unroll
    for (int kb = 0; kb < 64; kb += 16) { float v[16];
#pragma unroll
        for (int j = 0; j < 16; ++j) v[j] = __builtin_nontemporal_load(wp + (size_t)(kb + j) * ld);
#pragma unroll
        for (int j = 0; j < 16; ++j) scr[(kb + j) * 65 + lane] = v[j]; }
    asm volatile("s_waitcnt lgkmcnt(0)" ::: "memory");
    const int kc = lane & 3; float gg[16];
#pragma unroll
    for (int j = 0; j < 16; ++j) gg[j] = gs ? gs[k0 + 16 * kc + j] * scale : scale;
#pragma unroll
    for (int i = 0; i < 4; ++i) { const int nn = (lane >> 2) + 16 * i; const LAS float* sp = scr + (16 * kc) * 65 + nn; u32x4 o;
#pragma unroll
        for (int q = 0; q < 4; ++q) { int t = 0; t = __builtin_amdgcn_cvt_pk_fp8_f32(sp[(4 * q) * 65] * gg[4 * q], sp[(4 * q + 1) * 65] * gg[4 * q + 1], t, false); t = __builtin_amdgcn_cvt_pk_fp8_f32(sp[(4 * q + 2) * 65] * gg[4 * q + 2], sp[(4 * q + 3) * 65] * gg[4 * q + 3], t, true); o[q] = (unsigned)t; }
        if (nn < ncv) *(u32x4*)(dst + (size_t)(drow + nn) * dstK + k0 + 16 * kc) = o; }
    asm volatile("s_waitcnt lgkmcnt(0)" ::: "memory");
}
struct CvtCtx { int gw, ngw, base, lane; LAS float* scr; };
__device__ __forceinline__ void cvt_job_gates(CvtCtx& cx, const float* W, int ld, int K, int csrc0, const float* gs, bf16* dst) {
    const int nnb = 64, nit = (K >> 6) * nnb;
    int first = cx.gw - (cx.base % cx.ngw); if (first < 0) first += cx.ngw;
    for (int it = first; it < nit; it += cx.ngw) { const int kb = it / nnb, nb = it - kb * nnb, i = nb >> 4, cc = (nb & 15) * 64;
        cvt_item<true>(W, ld, kb * 64, csrc0 + nb * 64, 64, gs, dst, K, 256 * (cc >> 6) + 128 * (i >> 1) + 4 * (i & 1), cx.scr, cx.lane); }
    cx.base += nit;
}
__device__ __forceinline__ void cvt_job(CvtCtx& cx, const float* W, int ld, int K, int csrc0, int ncols, const float* gs, bf16* dst, int drow_base, int rs128) {
    const int nnb = (ncols + 63) >> 6, nit = (K >> 6) * nnb;
    int first = cx.gw - (cx.base % cx.ngw); if (first < 0) first += cx.ngw;
    for (int it = first; it < nit; it += cx.ngw) { const int kb = it / nnb, nb = it - kb * nnb, c = nb * 64; const int ncv = (ncols - c) < 64 ? (ncols - c) : 64;
        cvt_item(W, ld, kb * 64, csrc0 + c, ncv, gs, dst, K, drow_base + (c >> 7) * rs128 + (c & 127), cx.scr, cx.lane); }
    cx.base += nit;
}
__device__ __forceinline__ void cvt_job8(CvtCtx& cx, const float* W, int ld, int K, int csrc0, int ncols, const float* gs, float scale, unsigned char* dst, int drow_base, int rs128) {
    const int nnb = (ncols + 63) >> 6, nit = (K >> 6) * nnb;
    int first = cx.gw - (cx.base % cx.ngw); if (first < 0) first += cx.ngw;
    for (int it = first; it < nit; it += cx.ngw) { const int kb = it / nnb, nb = it - kb * nnb, c = nb * 64; const int ncv = (ncols - c) < 64 ? (ncols - c) : 64;
        cvt_item8(W, ld, kb * 64, csrc0 + c, ncv, gs, scale, dst, K, drow_base + (c >> 7) * rs128 + (c & 127), cx.scr, cx.lane); }
    cx.base += nit;
}
__device__ __forceinline__ void zero_rows_bf16(int gtid, int nthr, bf16* dst, size_t nelem) {
    u32x4 z = {0u, 0u, 0u, 0u};
    for (size_t i = (size_t)gtid * 8; i < nelem; i += (size_t)nthr * 8) *(u32x4*)(dst + i) = z;
}


__device__ __forceinline__ int rcol(int t, int rot) { return ((((t >> 3) + rot) & 7) << 3) + (t & 7); }
__device__ __forceinline__ int rcol4(int t, int rot) { return ((((t >> 3) + rot) & 3) << 3) + (t & 7); }
constexpr int AT_ST = 72;
constexpr int AT_KS = 0, AT_VT = AT_KS + 2 * 64 * AT_ST * 2, AT_KSC = AT_VT + 2 * 64 * AT_ST * 2, AT_BUFB = AT_KSC + 2 * 64 * 4, AT_BIAS = 2 * AT_BUFB, AT_END = AT_BIAS + 8 * 264 * 4;
__device__ __forceinline__ void attn_drain(const ArgsD& a, int l, LAS unsigned char* lds, LAS unsigned* lctl, unsigned* qctr, const bf16* z, bf16* o) {
    const int tid = opq_v((int)threadIdx.x), lane = tid & 63, wid = __builtin_amdgcn_readfirstlane(tid >> 6);
    const int hs = wid >> 2, qb = wid & 3, fr = lane & 15, g = lane >> 4, ql = 16 * qb + fr, row = tid >> 3, ch = tid & 7;
    constexpr unsigned NU = BATCH * NCH * 4;
    __syncthreads();
    { const float* rb = a.in[I_ATT_BIAS]; LAS float* ball = (LAS float*)(lds + AT_BIAS); float bv[5];
#pragma unroll
      for (int j = 0; j < 5; ++j) { const int i = tid + 512 * j; bv[j] = rb[i < 8 * 257 ? i : 0]; }
#pragma unroll
      for (int j = 0; j < 5; ++j) { const int i = tid + 512 * j; if (i < 8 * 257) { const int hh = i / 257; ball[hh * 264 + (i - hh * 257)] = bv[j] * 1.44269504f; } } }
    f32x4 gq[4];
    { const float* qgp = a.in[I_ATT_QG] + l * 64; const float* kgp = a.in[I_ATT_KG] + l * 64;
      gq[0] = *(const f32x4*)(qgp + 8 * g) * *(const f32x4*)(kgp + 8 * g); gq[1] = *(const f32x4*)(qgp + 8 * g + 4) * *(const f32x4*)(kgp + 8 * g + 4);
      gq[2] = *(const f32x4*)(qgp + 32 + 8 * g) * *(const f32x4*)(kgp + 32 + 8 * g); gq[3] = *(const f32x4*)(qgp + 36 + 8 * g) * *(const f32x4*)(kgp + 36 + 8 * g); }
    if (tid == 0) lctl[32] = atomicAdd(qctr, 1u);
    __syncthreads();
    unsigned q = lctl[32], par = 0, un = 0;
    u32x4 wk[2], wv[2], wq0, wq1;
#define AT_KVPTR(q_, j_) (z + ((size_t)((int)((q_) & 7u)) * SEQ + ((31 - (int)((q_) >> 5)) - 8 + (j_)) * 64 + row) * ZC + C_ATT + 512 + (2 * (int)(((q_) >> 3) & 3u)) * 64 + 8 * ch)
#define AT_LOADKV(p_) do { wk[0] = *(const u32x4*)(p_); wv[0] = *(const u32x4*)((p_) + 512); wk[1] = *(const u32x4*)((p_) + 64); wv[1] = *(const u32x4*)((p_) + 576); } while (0)
#define AT_FETCHQ(q_) do { const int hp_ = (int)(((q_) >> 3) & 3u), c_ = 31 - (int)((q_) >> 5), b_ = (int)((q_) & 7u); const bf16* qp_ = z + ((size_t)b_ * SEQ + c_ * 64 + ql) * ZC + C_ATT + (2 * hp_ + hs) * 64 + 8 * g; \
        wq0 = *(const u32x4*)qp_; wq1 = *(const u32x4*)(qp_ + 32); } while (0)
    const bf16* kvp;
    { const unsigned q0_ = q < NU ? q : NU - 1; const int c0_ = 31 - (int)(q0_ >> 5); kvp = AT_KVPTR(q0_, (c0_ >= 8 ? 0 : 8 - c0_)); AT_LOADKV(kvp); AT_FETCHQ(q0_); }
    while (q < NU) {
        const int hp = (int)((q >> 3) & 3u), c = 31 - (int)(q >> 5), b = (int)(q & 7u), h = 2 * hp + hs;
        unsigned nq_r = NU; if (tid == 0) nq_r = atomicAdd(qctr, 1u);
        const LAS float* bias = (const LAS float*)(lds + AT_BIAS) + h * 264;
        bf16x8 qf[2];
        { f32x4 a0, a1, b0, b1; unpack8(wq0, a0, a1); unpack8(wq1, b0, b1);
          float ss = 0.f;
#pragma unroll
          for (int j = 0; j < 4; ++j) ss += a0[j] * a0[j] + a1[j] * a1[j] + b0[j] * b0[j] + b1[j] * b1[j];
          ss = xrows_sum(ss);
          const float sc = rsqrtf(ss * (1.0f / 64.0f) + NORM_EPS) * 0.125f;
          const u32x4 p0 = pack8(a0 * gq[0] * sc, a1 * gq[1] * sc), p1 = pack8(b0 * gq[2] * sc, b1 * gq[3] * sc);
          qf[0] = __builtin_bit_cast(bf16x8, p0); qf[1] = __builtin_bit_cast(bf16x8, p1); }
        f32x4 oT[4];
#pragma unroll
        for (int d = 0; d < 4; ++d) oT[d] = (f32x4){0.f, 0.f, 0.f, 0.f};
        float m = -1e30f, lsum = 0.f; unsigned nq = NU;
        for (int j = (c >= 8 ? 0 : 8 - c); j <= 8; ++j) {
            LAS unsigned char* buf = lds + par * AT_BUFB; par ^= 1u;
#pragma unroll
            for (int i = 0; i < 2; ++i) { const u32x4 wkk = wk[i], wvv = wv[i];
                *(LAS u32x4*)((LAS bf16*)(buf + AT_KS) + (i * 64 + row) * AT_ST + 8 * ch) = wkk;
                f32x4 k0, k1; unpack8(wkk, k0, k1); float q2 = 0.f;
#pragma unroll
                for (int e = 0; e < 4; ++e) q2 += k0[e] * k0[e] + k1[e] * k1[e];
                q2 = red8_sum(q2);
                if (ch == 0) ((LAS float*)(buf + AT_KSC))[i * 64 + row] = rsqrtf(q2 * (1.0f / 64.0f) + NORM_EPS) * 1.44269504f;
                LAS bf16* vt = (LAS bf16*)(buf + AT_VT) + (i * 64 + 8 * ch) * AT_ST + rcol(row, ch >> 1);
                vt[0 * AT_ST] = (bf16)(wvv.x & 0xffffu); vt[1 * AT_ST] = (bf16)(wvv.x >> 16); vt[2 * AT_ST] = (bf16)(wvv.y & 0xffffu); vt[3 * AT_ST] = (bf16)(wvv.y >> 16);
                vt[4 * AT_ST] = (bf16)(wvv.z & 0xffffu); vt[5 * AT_ST] = (bf16)(wvv.z >> 16); vt[6 * AT_ST] = (bf16)(wvv.w & 0xffffu); vt[7 * AT_ST] = (bf16)(wvv.w >> 16); }
            if (j == 8 && tid == 0) lctl[34 + (un & 1u)] = nq_r;
            __syncthreads();
            { const bf16* np = kvp + (size_t)64 * ZC;
              if (j == 8) { nq = lctl[34 + (un & 1u)]; const unsigned qn = nq < NU ? nq : NU - 1; const int cn_ = 31 - (int)(qn >> 5); np = AT_KVPTR(qn, (cn_ >= 8 ? 0 : 8 - cn_)); AT_FETCHQ(qn); }
              kvp = np; AT_LOADKV(kvp); }
            const LAS bf16* Ks = (const LAS bf16*)(buf + AT_KS) + hs * 64 * AT_ST; const LAS bf16* VT = (const LAS bf16*)(buf + AT_VT) + hs * 64 * AT_ST; const LAS float* ksc = (const LAS float*)(buf + AT_KSC) + hs * 64;
            f32x4 sT[4];
#pragma unroll
            for (int kb = 0; kb < 4; ++kb) { sT[kb] = (f32x4){0.f, 0.f, 0.f, 0.f};
#pragma unroll
                for (int ks = 0; ks < 2; ++ks) { const bf16x8 af = *(const LAS bf16x8*)(Ks + (16 * kb + fr) * AT_ST + 32 * ks + 8 * g); sT[kb] = __builtin_amdgcn_mfma_f32_16x16x32_bf16(af, qf[ks], sT[kb], 0, 0, 0); } }
            float mt = -1e30f;
            if (j <= 5) {
                const float bfar = bias[0];
#pragma unroll
                for (int kb = 0; kb < 4; ++kb) { const f32x4 kv = *(const LAS f32x4*)(ksc + 16 * kb + 4 * g);
#pragma unroll
                    for (int r = 0; r < 4; ++r) { const float sv = sT[kb][r] * kv[r] + bfar; sT[kb][r] = sv; mt = fmaxf(mt, sv); } }
            } else if (j >= 7) {
                const LAS float* bq = bias + ((j - 8) * 64 + 4 * g - ql + 128);
#pragma unroll
                for (int kb = 0; kb < 4; ++kb) { const f32x4 kv = *(const LAS f32x4*)(ksc + 16 * kb + 4 * g);
#pragma unroll
                    for (int r = 0; r < 4; ++r) { const float sv = sT[kb][r] * kv[r] + bq[16 * kb + r]; sT[kb][r] = sv; mt = fmaxf(mt, sv); } }
            } else {
#pragma unroll
                for (int kb = 0; kb < 4; ++kb) { const f32x4 kv = *(const LAS f32x4*)(ksc + 16 * kb + 4 * g);
#pragma unroll
                    for (int r = 0; r < 4; ++r) { int rel = -128 + 16 * kb + 4 * g + r - ql; rel = rel < -128 ? -128 : rel;
                        const float sv = sT[kb][r] * kv[r] + bias[rel + 128]; sT[kb][r] = sv; mt = fmaxf(mt, sv); } }
            }
            mt = xrows_max(mt);
            const float mn = fmaxf(m, mt); const float alpha = __builtin_amdgcn_exp2f(m - mn); m = mn; lsum *= alpha;
#pragma unroll
            for (int d = 0; d < 4; ++d) oT[d] = oT[d] * alpha;
#pragma unroll
            for (int kb = 0; kb < 4; ++kb)
#pragma unroll
                for (int r = 0; r < 4; ++r) { const float p = __builtin_amdgcn_exp2f(sT[kb][r] - mn); sT[kb][r] = p; lsum += p; }
#pragma unroll
            for (int ks = 0; ks < 2; ++ks) { u32x4 pw; pw.x = pg8::cvt_pk_bf16(sT[2 * ks][0], sT[2 * ks][1]); pw.y = pg8::cvt_pk_bf16(sT[2 * ks][2], sT[2 * ks][3]); pw.z = pg8::cvt_pk_bf16(sT[2 * ks + 1][0], sT[2 * ks + 1][1]); pw.w = pg8::cvt_pk_bf16(sT[2 * ks + 1][2], sT[2 * ks + 1][3]);
                const bf16x8 pf = __builtin_bit_cast(bf16x8, pw);
#pragma unroll
                for (int db = 0; db < 4; ++db) { const LAS bf16* vp = VT + (16 * db + fr) * AT_ST; const u32x2 v0 = *(const LAS u32x2*)(vp + rcol(32 * ks + 4 * g, db)), v1 = *(const LAS u32x2*)(vp + rcol(32 * ks + 4 * g + 16, db));
                    u32x4 vw; vw.x = v0.x; vw.y = v0.y; vw.z = v1.x; vw.w = v1.y;
                    oT[db] = __builtin_amdgcn_mfma_f32_16x16x32_bf16(__builtin_bit_cast(bf16x8, vw), pf, oT[db], 0, 0, 0); } }
        }
        lsum = xrows_sum(lsum);
        const float inv = 1.0f / lsum; bf16* op = o + ((size_t)b * SEQ + c * 64 + ql) * 2048 + 1024 + h * 64 + 4 * g;
#pragma unroll
        for (int db = 0; db < 4; ++db) { u32x2 w; w.x = pg8::cvt_pk_bf16(oT[db][0] * inv, oT[db][1] * inv); w.y = pg8::cvt_pk_bf16(oT[db][2] * inv, oT[db][3] * inv); *(u32x2*)(op + 16 * db) = w; }
        q = nq; ++un;
    }
#undef AT_KVPTR
#undef AT_LOADKV
#undef AT_FETCHQ
    __syncthreads();
}

typedef f32x4 acc4;
#define MFMA16(a_, b_, c_) __builtin_amdgcn_mfma_f32_16x16x32_bf16((a_), (b_), (c_), 0, 0, 0)
__device__ __forceinline__ bf16x8 frag_nat(const LAS bf16* base, int pitch, int row, int k0, int g) { return *(const LAS bf16x8*)(base + row * pitch + k0 + 8 * g); }
__device__ __forceinline__ bf16x8 frag_nat_rot(const LAS bf16* base, int row, int k0, int g) { return *(const LAS bf16x8*)(base + row * 72 + ((((k0 >> 3) + g + (row >> 4)) & 7) << 3)); }
__device__ __forceinline__ bf16x8 frag_perm(const LAS bf16* base, int pitch, int row, int k0, int g) { const LAS bf16* p = base + row * pitch + k0 + 4 * g; const u32x2 v0 = *(const LAS u32x2*)p, v1 = *(const LAS u32x2*)(p + 16);
    u32x4 w; w.x = v0.x; w.y = v0.y; w.z = v1.x; w.w = v1.y; return __builtin_bit_cast(bf16x8, w); }
__device__ __forceinline__ bf16x8 frag_acc(const acc4& lo, const acc4& hi) { u32x4 w; w.x = pg8::cvt_pk_bf16(lo[0], lo[1]); w.y = pg8::cvt_pk_bf16(lo[2], lo[3]); w.z = pg8::cvt_pk_bf16(hi[0], hi[1]); w.w = pg8::cvt_pk_bf16(hi[2], hi[3]); return __builtin_bit_cast(bf16x8, w); }
__device__ __forceinline__ float wave_incl_scan(float x, int lane) { (void)lane; return scan64(x); }

constexpr int P72 = 72, P136 = 136;
constexpr int MB_CM = 0, MB_BM = MB_CM + 64 * P136 * 2, MB_BMT = MB_BM + 64 * P136 * 2, MB_XDT = MB_BMT + 128 * P72 * 2, MB_XDTW = MB_XDT + 64 * P72 * 2, MB_P = MB_XDTW + 64 * P72 * 2,
              MB_Y = MB_P + 64 * P72 * 2, MB_ACS = MB_Y + 64 * 68 * 4, MB_DT = MB_ACS + 512, MB_END = MB_DT + 512;
static_assert(MB_END <= 159744, "mamba LDS");
__device__ __forceinline__ void mamba_bc_prepass(const ArgsD& a, int l, int gw, int ngw, int lane, const bf16* z, bf16* bcv) {
    const float* cw = a.in[I_SSM_CONVW] + (size_t)l * 4 * 1024 + 512 + 8 * lane; const float* cb = a.in[I_SSM_CONVB] + l * 1024 + 512 + 8 * lane;
    f32x4 w0[5], w1[5];
#pragma unroll
    for (int j = 0; j < 4; ++j) { w0[j] = *(const f32x4*)(cw + j * 1024); w1[j] = *(const f32x4*)(cw + j * 1024 + 4); }
    w0[4] = *(const f32x4*)cb; w1[4] = *(const f32x4*)(cb + 4);
    for (int rg = gw; rg < T / 8; rg += ngw) { const size_t t0 = (size_t)rg * 8; const bool first = ((rg * 8) & (SEQ - 1)) == 0;
        u32x4 rw[11];
#pragma unroll
        for (int i = 0; i < 11; ++i) { const size_t t = (first && i < 3) ? t0 : t0 + i - 3; rw[i] = *(const u32x4*)(z + t * ZC + C_SSM + 1024 + 8 * lane); }
        if (first) { rw[0] = (u32x4){0u, 0u, 0u, 0u}; rw[1] = rw[0]; rw[2] = rw[0]; }
#pragma unroll
        for (int i = 0; i < 8; ++i) { f32x4 o0 = w0[4], o1 = w1[4];
#pragma unroll
            for (int j = 0; j < 4; ++j) { f32x4 x0, x1; unpack8(rw[i + j], x0, x1); o0 += x0 * w0[j]; o1 += x1 * w1[j]; }
#pragma unroll
            for (int e = 0; e < 4; ++e) { o0[e] = siluf_(o0[e]); o1[e] = siluf_(o1[e]); }
            *(u32x4*)(bcv + (t0 + i) * 512 + 8 * lane) = pack8(o0, o1); } }
}
__device__ __forceinline__ void mamba_block_task(const ArgsD& a, int l, int bh, LAS unsigned char* lds, const bf16* z, const bf16* bcv, bf16* o, float* mssq) {
    const int tid = opq_v((int)threadIdx.x), lane = tid & 63, wid = __builtin_amdgcn_readfirstlane(tid >> 6), fr = lane & 15, g = lane >> 4;
    const int b = bh >> 3, hd = bh & 7, grp = hd >> 2;
    const float dtb = a.in[I_SSM_DTB][l * 8 + hd], Aneg = -__expf(a.in[I_SSM_ALOG][l * 8 + hd]), Dk = a.in[I_SSM_D][l * 8 + hd];
    LAS bf16* Cm = (LAS bf16*)(lds + MB_CM); LAS bf16* Bm = (LAS bf16*)(lds + MB_BM); LAS bf16* BmT = (LAS bf16*)(lds + MB_BMT); LAS bf16* xdtT = (LAS bf16*)(lds + MB_XDT); LAS bf16* xdtwT = (LAS bf16*)(lds + MB_XDTW);
    LAS bf16* Pm = (LAS bf16*)(lds + MB_P); LAS float* Yl = (LAS float*)(lds + MB_Y); LAS float* acs2 = (LAS float*)(lds + MB_ACS); LAS float* dts2 = (LAS float*)(lds + MB_DT);
    const int pb = wid & 3, lh = wid >> 2;
    const int row = tid >> 3, ch = tid & 7;
    f32x4 cw0[5], cw1[5];
    { const float* cw = a.in[I_SSM_CONVW] + (size_t)l * 4 * 1024 + hd * 64 + 8 * ch; const float* cb = a.in[I_SSM_CONVB] + l * 1024 + hd * 64 + 8 * ch;
#pragma unroll
      for (int j = 0; j < 4; ++j) { cw0[j] = *(const f32x4*)(cw + j * 1024); cw1[j] = *(const f32x4*)(cw + j * 1024 + 4); }
      cw0[4] = *(const f32x4*)cb; cw1[4] = *(const f32x4*)(cb + 4); }
    acc4 St[8];
#pragma unroll
    for (int nb = 0; nb < 8; ++nb) St[nb] = (acc4){0.f, 0.f, 0.f, 0.f};
    u32x4 n_gt, n_x[4], n_b0, n_b1, n_c0, n_c1; bf16 n_dt = 0;
#define MB_FETCH(cn_) do { const size_t tq_ = (size_t)b * SEQ + (cn_) * 64 + row; const bf16* zn_ = z + tq_ * ZC + C_SSM; n_gt = *(const u32x4*)(zn_ + hd * 64 + 8 * ch); \
        _Pragma("unroll") for (int k_ = 0; k_ < 4; ++k_) { const bool ok_ = ((cn_) * 64 + row - k_) >= 0; n_x[k_] = *(const u32x4*)(zn_ - (ok_ ? (size_t)k_ * ZC : (size_t)0) + 512 + hd * 64 + 8 * ch); }   \
        const bf16* bq_ = bcv + tq_ * 512 + grp * 128 + 8 * ch; n_b0 = *(const u32x4*)bq_; n_b1 = *(const u32x4*)(bq_ + 64); n_c0 = *(const u32x4*)(bq_ + 256); n_c1 = *(const u32x4*)(bq_ + 320); } while (0)
#define MB_DTSCAN(cn_) do { const float dt_ = softplusf_(bf2f(n_dt) + dtb); const float cs_ = wave_incl_scan(dt_ * Aneg, lane); dts2[((cn_) & 1) * 64 + lane] = dt_; acs2[((cn_) & 1) * 64 + lane] = cs_; } while (0)
    MB_FETCH(0);
    if (wid == 0) { n_dt = z[((size_t)b * SEQ + lane) * ZC + C_SSM + 1536 + hd]; MB_DTSCAN(0); n_dt = z[((size_t)b * SEQ + 64 + lane) * ZC + C_SSM + 1536 + hd]; }
    __syncthreads();
    for (int c = 0; c < NCH; ++c) {
        const size_t t0 = (size_t)b * SEQ + c * 64;
        const LAS float* acs = acs2 + (c & 1) * 64; const LAS float* dts = dts2 + (c & 1) * 64;
        const u32x4 c_gt = n_gt; u32x4 c_x;
        { const float dt = dts[row], wl = __expf(acs[63] - acs[row]);
          f32x4 x0 = cw0[4], x1 = cw1[4];
#pragma unroll
          for (int j = 0; j < 4; ++j) { f32x4 r0, r1; unpack8(n_x[3 - j], r0, r1); const float mk = (c * 64 + row - (3 - j) >= 0) ? 1.0f : 0.0f; x0 += r0 * (cw0[j] * mk); x1 += r1 * (cw1[j] * mk); }
#pragma unroll
          for (int e = 0; e < 4; ++e) { x0[e] = siluf_(x0[e]); x1[e] = siluf_(x1[e]); }
          c_x = pack8(x0, x1);
#pragma unroll
          for (int e = 0; e < 4; ++e) { const float v0 = x0[e] * dt, v1 = x1[e] * dt; xdtT[(8 * ch + e) * P72 + rcol(row, ch >> 1)] = (bf16)f2bf(v0); xdtT[(8 * ch + 4 + e) * P72 + rcol(row, ch >> 1)] = (bf16)f2bf(v1);
              xdtwT[(8 * ch + e) * P72 + rcol(row, ch >> 1)] = (bf16)f2bf(v0 * wl); xdtwT[(8 * ch + 4 + e) * P72 + rcol(row, ch >> 1)] = (bf16)f2bf(v1 * wl); }
#pragma unroll
          for (int i = 0; i < 2; ++i) { const int cc = ch + 8 * i; const u32x4 wb = i ? n_b1 : n_b0, wc = i ? n_c1 : n_c0;
              *(LAS u32x4*)(Bm + row * P136 + 8 * cc) = wb; *(LAS u32x4*)(Cm + row * P136 + 8 * cc) = wc;
              LAS bf16* bt = BmT + (8 * cc) * P72 + rcol(row, cc >> 1);
              bt[0 * P72] = (bf16)(wb.x & 0xffffu); bt[1 * P72] = (bf16)(wb.x >> 16); bt[2 * P72] = (bf16)(wb.y & 0xffffu); bt[3 * P72] = (bf16)(wb.y >> 16);
              bt[4 * P72] = (bf16)(wb.z & 0xffffu); bt[5 * P72] = (bf16)(wb.z >> 16); bt[6 * P72] = (bf16)(wb.w & 0xffffu); bt[7 * P72] = (bf16)(wb.w >> 16); } }
        __syncthreads();
        if (wid == 0 && c + 1 < NCH) MB_DTSCAN(c + 1);
        { const int lb = wid >> 1;
#pragma unroll
          for (int q = 0; q < 2; ++q) { const int sb = 2 * (wid & 1) + q; acc4 cb = (acc4){0.f, 0.f, 0.f, 0.f};
#pragma unroll
              for (int ks = 0; ks < 4; ++ks) cb = MFMA16(frag_nat(Cm, P136, 16 * lb + fr, 32 * ks, g), frag_nat(Bm, P136, 16 * sb + fr, 32 * ks, g), cb);
              const int sidx = 16 * sb + fr; const float as = acs[sidx];
#pragma unroll
              for (int r = 0; r < 4; ++r) { const int lidx = 16 * lb + 4 * g + r; const float v = (sidx <= lidx) ? cb[r] * __expf(acs[lidx] - as) : 0.f; Pm[lidx * P72 + sidx] = (bf16)f2bf(v); } } }
        __syncthreads();
        { const int cn = (c + 1 < NCH) ? c + 1 : c; MB_FETCH(cn); const int cd = (c + 2 < NCH) ? c + 2 : c; if (wid == 0) n_dt = z[((size_t)b * SEQ + cd * 64 + lane) * ZC + C_SSM + 1536 + hd]; }
#pragma unroll
        for (int q = 0; q < 2; ++q) { const int lb = 2 * lh + q; acc4 y = (acc4){0.f, 0.f, 0.f, 0.f};
#pragma unroll
            for (int kk = 0; kk < 4; ++kk) y = MFMA16(frag_perm(Cm, P136, 16 * lb + fr, 32 * kk, g), frag_acc(St[2 * kk], St[2 * kk + 1]), y);
#pragma unroll
            for (int r = 0; r < 4; ++r) y[r] *= __expf(acs[16 * lb + 4 * g + r]);
#pragma unroll
            for (int ks = 0; ks < 2; ++ks) y = MFMA16(frag_nat(Pm, P72, 16 * lb + fr, 32 * ks, g), frag_nat_rot(xdtT, 16 * pb + fr, 32 * ks, g), y);
#pragma unroll
            for (int r = 0; r < 4; ++r) Yl[(16 * lb + 4 * g + r) * 68 + 16 * pb + fr] = y[r]; }
        { const float dec = __expf(acs[63]);
#pragma unroll
          for (int nb = 0; nb < 8; ++nb) { St[nb] = St[nb] * dec;
#pragma unroll
              for (int ks = 0; ks < 2; ++ks) St[nb] = MFMA16(frag_nat_rot(BmT, 16 * nb + fr, 32 * ks, g), frag_nat_rot(xdtwT, 16 * pb + fr, 32 * ks, g), St[nb]); } }
        __syncthreads();
        { const size_t t = t0 + row;
          f32x4 x0, x1, g0, g1; unpack8(c_x, x0, x1); unpack8(c_gt, g0, g1);
          const f32x4 y0 = *(const LAS f32x4*)(Yl + row * 68 + 8 * ch), y1 = *(const LAS f32x4*)(Yl + row * 68 + 8 * ch + 4); f32x4 o0, o1; float q2 = 0.f;
#pragma unroll
          for (int e = 0; e < 4; ++e) { o0[e] = (y0[e] + x0[e] * Dk) * siluf_(g0[e]); o1[e] = (y1[e] + x1[e] * Dk) * siluf_(g1[e]); q2 += o0[e] * o0[e] + o1[e] * o1[e]; }
          *(u32x4*)(o + t * 2048 + 512 + hd * 64 + 8 * ch) = pack8(o0, o1);
          q2 = red8_sum(q2);
          if (ch == 0) mssq[t * 8 + hd] = q2; }
    }
#undef MB_FETCH
#undef MB_DTSCAN
    __syncthreads();
}

constexpr int P132 = 132;
constexpr int GL_BC = 0, GL_QG = GL_BC + 64 * 68 * 4, GL_KG = GL_QG + 64 * P72 * 2, GL_KDT = GL_KG + 64 * P72 * 2, GL_VT = GL_KDT + 64 * P72 * 2, GL_ATT = GL_VT + 128 * P72 * 2,
              GL_O = GL_ATT + 64 * P72 * 2, GL_GU = GL_O + 64 * P132 * 4, GL_END = GL_GU + 17 * 64 * 4;
static_assert(GL_END <= LDS_MAIN, "gla LDS");
constexpr int GP_GU = 0, GP_BC = GP_GU + 17 * 64 * 4, GP_END = GP_BC + 2 * 64 * 68 * 4;
__device__ __forceinline__ void gla_prepass(const ArgsD& a, int l, int bx, int G, LAS unsigned char* lds, bf16* z, float* gend) {
    const int tid = opq_v((int)threadIdx.x), lane = tid & 63, wid = __builtin_amdgcn_readfirstlane(tid >> 6), row = tid >> 3, ch = tid & 7;
    LAS float* gu = (LAS float*)(lds + GP_GU);
    constexpr int NUN = BATCH * 4 * NCH;
    int gu_h = -1; unsigned par = 0;
    u32x4 wx0, wx1, wq, wk;
#define GP_FETCH(u_) do { const int c_ = (u_) & 31, h_ = ((u_) >> 5) & 3, b_ = (u_) >> 7; const bf16* zn_ = z + ((size_t)b_ * SEQ + c_ * 64 + row) * ZC + C_GLA; \
        wx0 = *(const u32x4*)(zn_ + 1024); wx1 = *(const u32x4*)(zn_ + 1032); wq = *(const u32x4*)(zn_ + h_ * 64 + 8 * ch); wk = *(const u32x4*)(zn_ + 256 + h_ * 64 + 8 * ch); } while (0)
    { const int u0 = bx < NUN ? bx : NUN - 1; GP_FETCH(u0); }
    for (int u = bx; u < NUN; u += G) {
        const int c = u & 31, h = (u >> 5) & 3, b = u >> 7;
        if (gu_h != h) { gu_h = h; __syncthreads();
            const float* gup = a.in[I_GLA_GUP] + (size_t)l * 16 * 256 + h * 64; const float* gbp = a.in[I_GLA_GB] + l * 256 + h * 64; float gv[3];
#pragma unroll
            for (int j = 0; j < 3; ++j) { const int i = tid + 512 * j, ic = i < 17 * 64 ? i : 0, r = ic >> 6, k = ic & 63; gv[j] = (r < 16) ? gup[r * 256 + k] : gbp[k]; }
#pragma unroll
            for (int j = 0; j < 3; ++j) { const int i = tid + 512 * j; if (i < 17 * 64) gu[i] = gv[j]; }
            __syncthreads(); }
        LAS float* bc = (LAS float*)(lds + GP_BC) + par * (64 * 68); par ^= 1u;
        const u32x4 c_q = wq, c_k = wk; f32x4 xa, xb_, xc, xd; unpack8(wx0, xa, xb_); unpack8(wx1, xc, xd);
        { const int un = (u + G < NUN) ? u + G : u; GP_FETCH(un); }
        { f32x4 la0 = *(const LAS f32x4*)(gu + 16 * 64 + 8 * ch), la1 = *(const LAS f32x4*)(gu + 16 * 64 + 8 * ch + 4);
#pragma unroll
          for (int r = 0; r < 16; ++r) { const float xv = (r < 4) ? xa[r & 3] : (r < 8) ? xb_[r & 3] : (r < 12) ? xc[r & 3] : xd[r & 3];
              la0 += *(const LAS f32x4*)(gu + r * 64 + 8 * ch) * xv; la1 += *(const LAS f32x4*)(gu + r * 64 + 8 * ch + 4) * xv; }
#pragma unroll
          for (int e = 0; e < 4; ++e) { la0[e] = (fminf(la0[e], 0.f) - __logf(1.0f + __expf(-fabsf(la0[e])))) * (1.0f / 16.0f); la1[e] = (fminf(la1[e], 0.f) - __logf(1.0f + __expf(-fabsf(la1[e])))) * (1.0f / 16.0f); }
          *(LAS f32x4*)(bc + row * 68 + 8 * ch) = la0; *(LAS f32x4*)(bc + row * 68 + 8 * ch + 4) = la1; }
        __syncthreads();
#pragma unroll
        for (int q = 0; q < 8; ++q) { const int k = 8 * wid + q; const float v = scan64(bc[lane * 68 + k]); bc[lane * 68 + k] = v; }
        __syncthreads();
        { const f32x4 b0 = *(const LAS f32x4*)(bc + row * 68 + 8 * ch), b1 = *(const LAS f32x4*)(bc + row * 68 + 8 * ch + 4);
          f32x4 q0, q1, k0, k1, qa, qb_, ka, kb_; unpack8(c_q, q0, q1); unpack8(c_k, k0, k1);
#pragma unroll
          for (int e = 0; e < 4; ++e) { qa[e] = q0[e] * __expf(b0[e]) * 0.125f; qb_[e] = q1[e] * __expf(b1[e]) * 0.125f; ka[e] = k0[e] * __expf(-b0[e]); kb_[e] = k1[e] * __expf(-b1[e]); }
          bf16* zn = z + ((size_t)b * SEQ + c * 64 + row) * ZC + C_GLA; *(u32x4*)(zn + h * 64 + 8 * ch) = pack8(qa, qb_); *(u32x4*)(zn + 256 + h * 64 + 8 * ch) = pack8(ka, kb_);
          if (tid < 64) gend[(size_t)u * 64 + tid] = bc[63 * 68 + tid]; }
    }
#undef GP_FETCH
    __syncthreads();
}
__device__ __forceinline__ void gla_block_task(const ArgsD& a, int l, int bh, LAS unsigned char* lds, const bf16* z, const float* gend, bf16* o) {
    const int tid = opq_v((int)threadIdx.x), lane = tid & 63, wid = __builtin_amdgcn_readfirstlane(tid >> 6), fr = lane & 15, g = lane >> 4;
    const int b = bh >> 2, h = bh & 3;
    LAS float* endl = (LAS float*)(lds + GL_BC); LAS bf16* qg = (LAS bf16*)(lds + GL_QG); LAS bf16* kg = (LAS bf16*)(lds + GL_KG); LAS bf16* kgT = (LAS bf16*)(lds + GL_KDT); LAS bf16* vT = (LAS bf16*)(lds + GL_VT);
    LAS bf16* att = (LAS bf16*)(lds + GL_ATT); LAS float* Ol = (LAS float*)(lds + GL_O);
    const float* nwp = a.in[I_GLA_NW] + l * 128;
    acc4 St[4];
#pragma unroll
    for (int kb = 0; kb < 4; ++kb) St[kb] = (acc4){0.f, 0.f, 0.f, 0.f};
    const int row = tid >> 3, ch = tid & 7;
    const f32x4 nw0 = *(const f32x4*)(nwp + 16 * ch), nw1 = *(const f32x4*)(nwp + 16 * ch + 4), nw2 = *(const f32x4*)(nwp + 16 * ch + 8), nw3 = *(const f32x4*)(nwp + 16 * ch + 12);
    u32x4 n_q, n_k, n_v0, n_v1, n_g0, n_g1; float n_end = 0.f;
#define GL_FETCH(cn_) do { const bf16* zn_ = z + ((size_t)b * SEQ + (cn_) * 64 + row) * ZC + C_GLA; n_q = *(const u32x4*)(zn_ + h * 64 + 8 * ch); n_k = *(const u32x4*)(zn_ + 256 + h * 64 + 8 * ch); \
        n_v0 = *(const u32x4*)(zn_ + 512 + h * 128 + 8 * ch); n_v1 = *(const u32x4*)(zn_ + 512 + h * 128 + 8 * (ch + 8)); n_g0 = *(const u32x4*)(zn_ + 1040 + h * 128 + 16 * ch); n_g1 = *(const u32x4*)(zn_ + 1040 + h * 128 + 16 * ch + 8); \
        if (tid < 64) n_end = gend[((size_t)(b * 4 + h) * NCH + (cn_)) * 64 + tid]; } while (0)
    GL_FETCH(0);
    __syncthreads();
    for (int c = 0; c < NCH; ++c) {
        const size_t t0 = (size_t)b * SEQ + c * 64;
        const u32x4 c_g0 = n_g0, c_g1 = n_g1;
        { *(LAS u32x4*)(qg + row * P72 + 8 * ch) = n_q; *(LAS u32x4*)(kg + row * P72 + 8 * ch) = n_k;
          if (tid < 64) endl[tid] = n_end;
          { LAS bf16* kt = kgT + (8 * ch) * P72 + rcol(row, ch >> 1); const u32x4 wv = n_k;
            kt[0 * P72] = (bf16)(wv.x & 0xffffu); kt[1 * P72] = (bf16)(wv.x >> 16); kt[2 * P72] = (bf16)(wv.y & 0xffffu); kt[3 * P72] = (bf16)(wv.y >> 16);
            kt[4 * P72] = (bf16)(wv.z & 0xffffu); kt[5 * P72] = (bf16)(wv.z >> 16); kt[6 * P72] = (bf16)(wv.w & 0xffffu); kt[7 * P72] = (bf16)(wv.w >> 16); }
#pragma unroll
          for (int i = 0; i < 2; ++i) { const int cc = ch + 8 * i; const u32x4 wv = i ? n_v1 : n_v0; LAS bf16* vt = vT + (8 * cc) * P72 + rcol(row, cc >> 1);
              vt[0 * P72] = (bf16)(wv.x & 0xffffu); vt[1 * P72] = (bf16)(wv.x >> 16); vt[2 * P72] = (bf16)(wv.y & 0xffffu); vt[3 * P72] = (bf16)(wv.y >> 16);
              vt[4 * P72] = (bf16)(wv.z & 0xffffu); vt[5 * P72] = (bf16)(wv.z >> 16); vt[6 * P72] = (bf16)(wv.w & 0xffffu); vt[7 * P72] = (bf16)(wv.w >> 16); } }
        __syncthreads();
        { const int lb = wid >> 1;
#pragma unroll
          for (int q = 0; q < 2; ++q) { const int sb = 2 * (wid & 1) + q; acc4 at = (acc4){0.f, 0.f, 0.f, 0.f};
#pragma unroll
              for (int ks = 0; ks < 2; ++ks) at = MFMA16(frag_nat(qg, P72, 16 * lb + fr, 32 * ks, g), frag_nat(kg, P72, 16 * sb + fr, 32 * ks, g), at);
              const int sidx = 16 * sb + fr;
#pragma unroll
              for (int r = 0; r < 4; ++r) { const int lidx = 16 * lb + 4 * g + r; att[lidx * P72 + sidx] = (bf16)f2bf((sidx <= lidx) ? at[r] : 0.f); } } }
        __syncthreads();
        { const int cn = (c + 1 < NCH) ? c + 1 : c; GL_FETCH(cn); }
#pragma unroll
        for (int lb = 0; lb < 4; ++lb) { acc4 ov = (acc4){0.f, 0.f, 0.f, 0.f};
#pragma unroll
            for (int kk = 0; kk < 2; ++kk) ov = MFMA16(frag_perm(qg, P72, 16 * lb + fr, 32 * kk, g), frag_acc(St[2 * kk], St[2 * kk + 1]), ov);
#pragma unroll
            for (int ks = 0; ks < 2; ++ks) ov = MFMA16(frag_nat(att, P72, 16 * lb + fr, 32 * ks, g), frag_nat_rot(vT, 16 * wid + fr, 32 * ks, g), ov);
#pragma unroll
            for (int r = 0; r < 4; ++r) Ol[(16 * lb + 4 * g + r) * P132 + 16 * wid + fr] = ov[r]; }
#pragma unroll
        for (int kb = 0; kb < 4; ++kb) { const f32x4 bl = *(const LAS f32x4*)(endl + 16 * kb + 4 * g);
#pragma unroll
            for (int ks = 0; ks < 2; ++ks) St[kb] = MFMA16(frag_nat_rot(kgT, 16 * kb + fr, 32 * ks, g), frag_nat_rot(vT, 16 * wid + fr, 32 * ks, g), St[kb]);
#pragma unroll
            for (int r = 0; r < 4; ++r) St[kb][r] *= __expf(bl[r]); }
        __syncthreads();
        { const size_t t = t0 + row; float q2 = 0.f; f32x4 ov[4];
#pragma unroll
          for (int i = 0; i < 4; ++i) { ov[i] = *(const LAS f32x4*)(Ol + row * P132 + 16 * ch + 4 * i); q2 += ov[i][0] * ov[i][0] + ov[i][1] * ov[i][1] + ov[i][2] * ov[i][2] + ov[i][3] * ov[i][3]; }
          q2 = red8_sum(q2);
          const float sc = rsqrtf(q2 * (1.0f / 128.0f) + NORM_EPS);
#pragma unroll
          for (int i = 0; i < 2; ++i) { const u32x4 wg = i ? c_g1 : c_g0; f32x4 g0, g1; unpack8(wg, g0, g1);
              const f32x4 n0 = i ? nw2 : nw0, n1 = i ? nw3 : nw1; f32x4 r0, r1;
#pragma unroll
              for (int e = 0; e < 4; ++e) { r0[e] = ov[2 * i][e] * sc * n0[e] * siluf_(g0[e]); r1[e] = ov[2 * i + 1][e] * sc * n1[e] * siluf_(g1[e]); }
              *(u32x4*)(o + t * 2048 + 1536 + h * 128 + 16 * ch + 8 * i) = pack8(r0, r1); } }
    }
#undef GL_FETCH
    __syncthreads();
}

constexpr int RT = 32, P40 = 40, P328 = 328, P168 = 168;
constexpr int RW_REC = 29184;
constexpr int IM_AT = 0, IM_RT = IM_AT + RT * P72 * 2, IM_KPT = IM_RT + RT * P72 * 2, IM_BPT = IM_KPT + 64 * P40 * 2, IM_VT = IM_BPT + 64 * P40 * 2, IM_MAK = IM_VT + 64 * P40 * 2, IM_ARK = IM_MAK + RT * P40 * 2,
              IM_ARB = IM_ARK + RT * P40 * 2, IM_T1 = IM_ARB + RT * P40 * 2, IM_T2 = IM_T1 + 16 * P40 * 2, IM_GAM = IM_T2 + 16 * P40 * 2, IM_BON = IM_GAM + 256, IM_END = IM_BON + 128;
__device__ __forceinline__ int rw_piece_off(int p) {
    if (p < 512) { const int m = p >> 8, q = p & 255; return (m ? IM_RT : IM_AT) + (q >> 3) * (P72 * 2) + (q & 7) * 16; }
    p -= 512; if (p < 768) { const int m = p >> 8, q = p & 255; return IM_KPT + m * (64 * P40 * 2) + (q >> 2) * (P40 * 2) + (q & 3) * 16; }
    p -= 768; if (p < 384) { const int m = p >> 7, q = p & 127; return IM_MAK + m * (RT * P40 * 2) + (q >> 2) * (P40 * 2) + (q & 3) * 16; }
    p -= 384; if (p < 128) { const int m = p >> 6, q = p & 63; return IM_T1 + m * (16 * P40 * 2) + (q >> 2) * (P40 * 2) + (q & 3) * 16; }
    p -= 128; return IM_GAM + p * 16;
}
constexpr int RW_NPIECE = 1816;
__device__ __forceinline__ unsigned char* rw_rec_ptr(unsigned char* ws, int h, int b, int c) {
    unsigned char* base = (h < 4) ? ws + WS_XG : (h < 6) ? ws + WS_X + X_MIXED : ws + WS_Z + (size_t)T * ZC * 2;
    const int hl = (h < 4) ? h : (h < 6) ? h - 4 : h - 6;
    return base + ((size_t)(hl * BATCH + b) * (SEQ / RT) + c) * RW_REC;
}
static_assert((size_t)4 * BATCH * (SEQ / RT) * RW_REC <= XG_BYTES && (size_t)2 * BATCH * (SEQ / RT) * RW_REC <= (size_t)T * DM * 2 && (size_t)2 * BATCH * (SEQ / RT) * RW_REC <= Z_BYTES - (size_t)T * ZC * 2, "rwkv record regions");

constexpr int RW_WD = 0, RW_WA = RW_WD + 64 * P72 * 2, RW_WG = RW_WA + 64 * P72 * 2, RW_WV = RW_WG + 64 * P168 * 2, RW_HALF0 = RW_WV + 64 * P40 * 2;
constexpr int RH_XLR = 0, RH_LC = 0, RH_KH = RH_LC + RT * 68 * 4, RH_BH = RH_KH + RT * P72 * 2, RH_MAB = RH_BH + RT * P72 * 2, RH_R1_END = RH_MAB + RT * 33 * 4, RH_IMG = 22272, RH_PROJ = RH_IMG, RH_BYTES = RH_IMG + IM_END;
constexpr int RW_PAR = RW_HALF0 + 2 * RH_BYTES;
constexpr int RW_END = RW_PAR + 9 * 64 * 4;
static_assert(RH_R1_END <= RH_IMG && RT * P328 * 2 <= RH_IMG && 4 * RT * P72 * 2 <= IM_GAM && RW_END <= NWAVES * 20352 && (RH_IMG % 16) == 0 && (RH_BYTES % 16) == 0 && (RW_HALF0 % 16) == 0, "rwkv prep LDS");
constexpr int XLR_OFF = 512;
__device__ __forceinline__ void rwkv_xlr_prepass(const ArgsD& a, int l, int bx, int G, const bf16* z, bf16* o) {
    const int tid = opq_v((int)threadIdx.x);
    const float* mu = a.in[I_RW_MU] + l * 1824;
    for (int rb = bx; rb < T / 64; rb += G) {
        u32x4 wc_[5], wp_[5]; f32x4 m0_[5], m1_[5];
#pragma unroll
        for (int i = 0; i < 5; ++i) { const int it = tid + 512 * i, tk = it / 40, q = it - tk * 40; const size_t row = (size_t)rb * 64 + tk;
            const int col = (q < 36) ? 1536 + 8 * q : C_HV + 8 * (q - 36);
            const size_t prow = ((row & (SEQ - 1)) == 0) ? row : row - 1;
            wc_[i] = *(const u32x4*)(z + row * ZC + col); wp_[i] = *(const u32x4*)(z + prow * ZC + col);
            const int mcol = (q < 36) ? col : 1536;
            m0_[i] = *(const f32x4*)(mu + mcol); m1_[i] = *(const f32x4*)(mu + mcol + 4); }
#pragma unroll
        for (int i = 0; i < 5; ++i) { const int it = tid + 512 * i, tk = it / 40, q = it - tk * 40; const size_t row = (size_t)rb * 64 + tk; f32x4 c0v, c1v, p0v, p1v; unpack8(wc_[i], c0v, c1v); unpack8(wp_[i], p0v, p1v);
            if ((row & (SEQ - 1)) == 0) { p0v = (f32x4){0.f, 0.f, 0.f, 0.f}; p1v = p0v; }
            const f32x4 x0 = c0v + (p0v - c0v) * m0_[i], x1 = c1v + (p1v - c1v) * m1_[i];
            const float kk2 = (q < 8) ? 2.0f : 1.0f; f32x4 v0, v1;
#pragma unroll
            for (int e = 0; e < 4; ++e) { const float s0 = sigmoidf_(kk2 * x0[e]), s1 = sigmoidf_(kk2 * x1[e]);
                v0[e] = (q < 8) ? 2.0f * s0 - 1.0f : (q < 16) ? x0[e] : (q < 36) ? s0 : c0v[e]; v1[e] = (q < 8) ? 2.0f * s1 - 1.0f : (q < 16) ? x1[e] : (q < 36) ? s1 : c1v[e]; }
            *(u32x4*)(o + row * 2048 + XLR_OFF + 8 * q) = pack8(v0, v1); }
    }
}
struct PrepPf { u32x4 wzr, wzk, wzv, wpr, wpk, wpv, wvf, xl[5]; };
__device__ __forceinline__ void rwkv_prep_fetch(PrepPf& pf, int l, int h, int b, int cpair, const bf16* z, const bf16* vfirst, const bf16* o) {
    const int tid = opq_v((int)threadIdx.x), lt = tid & 255, c = cpair + (tid >> 8), tok = lt >> 3, C0 = h * 64 + 8 * (lt & 7);
    const size_t t0 = (size_t)b * SEQ + c * RT;
    const bf16* zp = z + (t0 + tok) * ZC + C0; pf.wzr = *(const u32x4*)zp; pf.wzk = *(const u32x4*)(zp + 512); pf.wzv = *(const u32x4*)(zp + 1024);
    const bf16* zq = (c == 0 && tok == 0) ? zp : zp - ZC; pf.wpr = *(const u32x4*)zq; pf.wpk = *(const u32x4*)(zq + 512); pf.wpv = *(const u32x4*)(zq + 1024);
    if (l == 1) pf.wvf = *(const u32x4*)(vfirst + (t0 + tok) * 512 + C0); else pf.wvf = (u32x4){0u, 0u, 0u, 0u};
#pragma unroll
    for (int i = 0; i < 5; ++i) { const int it = lt + 256 * i, tk = it / 40, q = it - tk * 40; pf.xl[i] = *(const u32x4*)(o + (t0 + tk) * 2048 + XLR_OFF + 8 * q); }
}
__device__ __forceinline__ void rwkv_prep_pair(const ArgsD& a, int l, int h, int b, int cpair, int nh, int nb, int ncpair, PrepPf& pf, int& wts_h, LAS unsigned char* lds, const bf16* z, bf16* vfirst, bf16* o, unsigned char* ws) {
    const int tid = opq_v((int)threadIdx.x), lane = tid & 63, wid = __builtin_amdgcn_readfirstlane(tid >> 6), fr = lane & 15, g = lane >> 4;
    const int hf = wid >> 2, lw = wid & 3, lt = tid & 255, c = cpair + hf;
    LAS bf16* Wd = (LAS bf16*)(lds + RW_WD); LAS bf16* Wa = (LAS bf16*)(lds + RW_WA); LAS bf16* Wg = (LAS bf16*)(lds + RW_WG); LAS bf16* Wv = (LAS bf16*)(lds + RW_WV);
    LAS unsigned char* hb_ = lds + RW_HALF0 + hf * RH_BYTES;
    LAS bf16* Xlr = (LAS bf16*)(hb_ + RH_XLR); LAS bf16* Proj = (LAS bf16*)(hb_ + RH_PROJ); LAS float* Lc = (LAS float*)(hb_ + RH_LC);
    LAS bf16* Kh = (LAS bf16*)(hb_ + RH_KH); LAS bf16* Bh = (LAS bf16*)(hb_ + RH_BH); LAS float* Mab = (LAS float*)(hb_ + RH_MAB); LAS unsigned char* img = hb_ + RH_IMG;
    LAS bf16* At = (LAS bf16*)(img + IM_AT); LAS bf16* Rt = (LAS bf16*)(img + IM_RT); LAS bf16* KpT = (LAS bf16*)(img + IM_KPT); LAS bf16* BpT = (LAS bf16*)(img + IM_BPT); LAS bf16* VT = (LAS bf16*)(img + IM_VT);
    LAS bf16* Mak = (LAS bf16*)(img + IM_MAK); LAS bf16* Ark = (LAS bf16*)(img + IM_ARK); LAS bf16* Arb = (LAS bf16*)(img + IM_ARB); LAS bf16* T1 = (LAS bf16*)(img + IM_T1); LAS bf16* T2 = (LAS bf16*)(img + IM_T2);
    LAS float* gam = (LAS float*)(img + IM_GAM); LAS float* bon = (LAS float*)(img + IM_BON);
    if (wts_h != h) { wts_h = h;
        const float* dup = a.in[I_RW_DECAY_UP] + (size_t)l * 64 * 512 + h * 64; const float* aup = a.in[I_RW_A_UP] + (size_t)l * 64 * 512 + h * 64; const float* gup = a.in[I_RW_GATE_UP] + (size_t)l * 160 * 512 + h * 64; const float* vup = a.in[I_VRES_UP] + h * 64;
        { const int k0 = tid >> 6, ch = tid & 63;
          float dv[8], av_[8], gv[20], vv_[4];
#pragma unroll
          for (int j = 0; j < 8; ++j) { dv[j] = dup[(k0 + 8 * j) * 512 + ch]; av_[j] = aup[(k0 + 8 * j) * 512 + ch]; }
#pragma unroll
          for (int j = 0; j < 4; ++j) vv_[j] = vup[(k0 + 8 * j) * 512 + ch];
#pragma unroll
          for (int j = 0; j < 20; ++j) gv[j] = gup[(k0 + 8 * j) * 512 + ch];
#pragma unroll
          for (int j = 0; j < 8; ++j) { Wd[ch * P72 + k0 + 8 * j] = (bf16)f2bf(dv[j]); Wa[ch * P72 + k0 + 8 * j] = (bf16)f2bf(av_[j]); }
#pragma unroll
          for (int j = 0; j < 4; ++j) Wv[ch * P40 + k0 + 8 * j] = (bf16)f2bf(vv_[j]);
#pragma unroll
          for (int j = 0; j < 20; ++j) Wg[ch * P168 + k0 + 8 * j] = (bf16)f2bf(gv[j]); }
        { const int p = tid >> 6, cc = h * 64 + (tid & 63); const float* mu_ = a.in[I_RW_MU] + l * 1824;
          float pv0 = 0.f, pv1 = 0.f;
          pv0 = (p == 0) ? mu_[cc] : (p == 1) ? mu_[512 + cc] : (p == 2) ? mu_[1024 + cc] : (p == 3) ? a.in[I_RW_W0][l * 512 + cc] : (p == 4) ? a.in[I_RW_A0][l * 512 + cc] : (p == 5) ? a.in[I_VRES_V0][cc] : (p == 6) ? a.in[I_RW_KK][l * 512 + cc] : a.in[I_RW_KA][l * 512 + cc];
          if (tid < 64) pv1 = a.in[I_RW_RK][l * 512 + cc];
          LAS float* par_ = (LAS float*)(lds + RW_PAR); par_[tid] = pv0; if (tid < 64) par_[512 + tid] = pv1; } }
    const float* mu = a.in[I_RW_MU] + l * 1824;
    const int tok = lt >> 3, c0 = 8 * (lt & 7), C0 = h * 64 + c0;
    const size_t t0 = (size_t)b * SEQ + c * RT;
    const u32x4 zz4 = {0u, 0u, 0u, 0u}; const bool ftok = (c == 0 && tok == 0);
    const u32x4 wzr = pf.wzr, wzk = pf.wzk, wzv = pf.wzv, wpr = ftok ? zz4 : pf.wpr, wpk = ftok ? zz4 : pf.wpk, wpv = ftok ? zz4 : pf.wpv, wvf = pf.wvf;
#pragma unroll
    for (int i = 0; i < 5; ++i) { const int it = lt + 256 * i, tk = it / 40, q = it - tk * 40; *(LAS u32x4*)(Xlr + tk * P328 + 8 * q) = pf.xl[i]; }
    __syncthreads();
    { const int cb = lw;
#pragma unroll
      for (int p = 0; p < 4; ++p) { const LAS bf16* Wp = (p == 0) ? Wd : (p == 1) ? Wa : (p == 2) ? Wg : Wv; const int wp = (p == 2) ? P168 : (p == 3) ? P40 : P72; const int kb0 = (p == 0) ? 0 : (p == 1) ? 64 : (p == 2) ? 128 : 288;
          const int nks = (p == 2) ? 5 : (p == 3) ? 1 : 2;
#pragma unroll
          for (int rb = 0; rb < 2; ++rb) { acc4 ac = (acc4){0.f, 0.f, 0.f, 0.f};
#pragma unroll
              for (int ks = 0; ks < nks; ++ks) ac = MFMA16(frag_nat(Xlr, P328, 16 * rb + fr, kb0 + 32 * ks, g), frag_nat(Wp, wp, 16 * cb + fr, 32 * ks, g), ac);
#pragma unroll
              for (int r = 0; r < 4; ++r) Proj[(p * RT + 16 * rb + 4 * g + r) * P72 + 16 * cb + fr] = (bf16)f2bf(ac[r]); } } }
    __syncthreads();
    f32x4 rr[2], kk_[2], vv[2], ap[2], bp[2];
    { const size_t row = t0 + tok; f32x4 zr[2], zk[2], zv[2], pr[2], pk[2], pv[2], dw[2], da[2], gg[2], vm[2], vf[2];
      unpack8(wzr, zr[0], zr[1]); unpack8(wzk, zk[0], zk[1]); unpack8(wzv, zv[0], zv[1]); unpack8(wpr, pr[0], pr[1]); unpack8(wpk, pk[0], pk[1]); unpack8(wpv, pv[0], pv[1]); unpack8(wvf, vf[0], vf[1]);
      unpack8(*(const LAS u32x4*)(Proj + (0 * RT + tok) * P72 + c0), dw[0], dw[1]); unpack8(*(const LAS u32x4*)(Proj + (1 * RT + tok) * P72 + c0), da[0], da[1]);
      unpack8(*(const LAS u32x4*)(Proj + (2 * RT + tok) * P72 + c0), gg[0], gg[1]); unpack8(*(const LAS u32x4*)(Proj + (3 * RT + tok) * P72 + c0), vm[0], vm[1]);
      f32x4 ee[2], av[2], vraw[2], kraw[2]; float n2 = 0.f;
#pragma unroll
      for (int hq = 0; hq < 2; ++hq) { const int Cq = C0 + 4 * hq;
          const LAS float* pq = (const LAS float*)(lds + RW_PAR) + c0 + 4 * hq; (void)Cq;
          const f32x4 mur = *(const LAS f32x4*)(pq), muk = *(const LAS f32x4*)(pq + 64), muv = *(const LAS f32x4*)(pq + 128);
          const f32x4 w0c = *(const LAS f32x4*)(pq + 192), a0c = *(const LAS f32x4*)(pq + 256), v0c = *(const LAS f32x4*)(pq + 320), kkc = *(const LAS f32x4*)(pq + 384);
          rr[hq] = zr[hq] + (pr[hq] - zr[hq]) * mur; kraw[hq] = zk[hq] + (pk[hq] - zk[hq]) * muk; vraw[hq] = zv[hq] + (pv[hq] - zv[hq]) * muv;
#pragma unroll
          for (int e = 0; e < 4; ++e) { ee[hq][e] = 0.60653066f * sigmoidf_(w0c[e] + dw[hq][e]); av[hq][e] = sigmoidf_(a0c[e] + da[hq][e]); const float kq = kraw[hq][e] * kkc[e]; n2 += kq * kq;
              vv[hq][e] = (l == 1) ? vraw[hq][e] + (vf[hq][e] - vraw[hq][e]) * sigmoidf_(v0c[e] + vm[hq][e]) : vraw[hq][e]; } }
      if (l == 0) *(u32x4*)(vfirst + row * 512 + C0) = pack8(vraw[0], vraw[1]);
      n2 = red8_sum(n2);
      const float inn = 1.0f / fmaxf(sqrtf(n2), 1e-12f); float bq = 0.f;
#pragma unroll
      for (int hq = 0; hq < 2; ++hq) { const LAS float* pq = (const LAS float*)(lds + RW_PAR) + c0 + 4 * hq; const f32x4 kkc = *(const LAS f32x4*)(pq + 384), kac = *(const LAS f32x4*)(pq + 448), rkc = *(const LAS f32x4*)(pq + 512);
#pragma unroll
          for (int e = 0; e < 4; ++e) { const float kkn = kraw[hq][e] * kkc[e] * inn; kk_[hq][e] = kraw[hq][e] * (1.0f + (av[hq][e] - 1.0f) * kac[e]); ap[hq][e] = -kkn; bp[hq][e] = kkn * av[hq][e]; bq += rr[hq][e] * kk_[hq][e] * rkc[e]; } }
      bq = red8_sum(bq);
      if ((lt & 7) == 0) bon[tok] = bq;
      *(LAS f32x4*)(Lc + tok * 68 + c0) = -ee[0]; *(LAS f32x4*)(Lc + tok * 68 + c0 + 4) = -ee[1];
      *(u32x4*)(o + row * 2048 + C0) = pack8(gg[0], gg[1]); }
    __syncthreads();
#pragma unroll
    for (int q = 0; q < 8; ++q) { const int ch = 16 * lw + 2 * q + (lane >> 5), tk = lane & 31; float x = Lc[tk * 68 + ch];
        x = scan32(x);
        Lc[tk * 68 + ch] = x; }
    __syncthreads();
#pragma unroll
    for (int hq = 0; hq < 2; ++hq) { const int cq = c0 + 4 * hq;
      const f32x4 Lt = *(const LAS f32x4*)(Lc + tok * 68 + cq), Ll = *(const LAS f32x4*)(Lc + (RT - 1) * 68 + cq); f32x4 Lp = (f32x4){0.f, 0.f, 0.f, 0.f}; if (tok > 0) Lp = *(const LAS f32x4*)(Lc + (tok - 1) * 68 + cq);
      f32x4 at_, rt_, kh_, bh_;
#pragma unroll
      for (int e = 0; e < 4; ++e) { const float ep = __expf(Lt[e]), em = __expf(-Lt[e]), el = __expf(Ll[e] - Lt[e]); at_[e] = ap[hq][e] * __expf(Lp[e]); rt_[e] = rr[hq][e] * ep; kh_[e] = kk_[hq][e] * em; bh_[e] = bp[hq][e] * em;
          const int tr_ = (cq + e) * P40 + rcol4(tok, cq >> 4);
          KpT[tr_] = (bf16)f2bf(kk_[hq][e] * el); BpT[tr_] = (bf16)f2bf(bp[hq][e] * el); VT[tr_] = (bf16)f2bf(vv[hq][e]); }
      u32x2 w; w.x = pk2(at_[0], at_[1]); w.y = pk2(at_[2], at_[3]); *(LAS u32x2*)(At + tok * P72 + cq) = w; w.x = pk2(rt_[0], rt_[1]); w.y = pk2(rt_[2], rt_[3]); *(LAS u32x2*)(Rt + tok * P72 + cq) = w;
      w.x = pk2(kh_[0], kh_[1]); w.y = pk2(kh_[2], kh_[3]); *(LAS u32x2*)(Kh + tok * P72 + cq) = w; w.x = pk2(bh_[0], bh_[1]); w.y = pk2(bh_[2], bh_[3]); *(LAS u32x2*)(Bh + tok * P72 + cq) = w;
      if (tok == 0) { f32x4 gv;
#pragma unroll
          for (int e = 0; e < 4; ++e) gv[e] = __expf(Ll[e]);
          *(LAS f32x4*)(gam + cq) = gv; } }
    __syncthreads();
    { const int rb = lw; const LAS bf16* Am = (rb < 2) ? At : Rt;
#pragma unroll
      for (int cb = 0; cb < 4; ++cb) { const LAS bf16* Bm_ = (cb < 2) ? Kh : Bh; acc4 gm = (acc4){0.f, 0.f, 0.f, 0.f};
#pragma unroll
          for (int ks = 0; ks < 2; ++ks) gm = MFMA16(frag_nat(Am, P72, 16 * (rb & 1) + fr, 32 * ks, g), frag_nat(Bm_, P72, 16 * (cb & 1) + fr, 32 * ks, g), gm);
          const int sidx = 16 * (cb & 1) + fr;
#pragma unroll
          for (int r = 0; r < 4; ++r) { const int tidx = 16 * (rb & 1) + 4 * g + r;
              if (rb < 2) { const float v = (sidx < tidx) ? gm[r] : 0.f; if (cb < 2) Mak[tidx * P40 + sidx] = (bf16)f2bf(v); else Mab[tidx * 33 + sidx] = v; }
              else { const float v = (sidx <= tidx) ? gm[r] : 0.f; if (cb < 2) Ark[tidx * P40 + sidx] = (bf16)f2bf(v); else Arb[tidx * P40 + sidx] = (bf16)f2bf(v); } } } }
    __syncthreads();
    rwkv_prep_fetch(pf, l, nh, nb, ncpair, z, vfirst, o);
    if (lw != 0) { unsigned char* rec = rw_rec_ptr(ws, h, b, c);
        for (int p = lt - 64; p < RW_NPIECE - 128; p += 192) { const int pp = (p < 1664) ? p : p + 128; *(u32x4*)(rec + 16 * pp) = *(const LAS u32x4*)(img + rw_piece_off(pp)); } }
    else {
        if (lane < 32) { const int blk = lane >> 4, cc = lane & 15; float x[16]; unsigned moff = (unsigned)((16 * blk) * 33 + 16 * blk) * 4u;
#pragma unroll
            for (int t = 0; t < 16; ++t) { float sacc = (t == cc) ? 1.0f : 0.f;
                if (t > 0) asm volatile("" : "+v"(moff) : "v"(x[t - 1]));
                const LAS float* mp = (const LAS float*)((LAS unsigned char*)Mab + moff) + t * 33;
#pragma unroll
                for (int s2 = 0; s2 < t; ++s2) sacc += mp[s2] * x[s2];
                x[t] = sacc; }
#pragma unroll
            for (int t = 0; t < 16; ++t) { if (blk == 0) { T1[t * P40 + cc] = (bf16)f2bf(x[t]); T1[t * P40 + 16 + cc] = 0; T2[t * P40 + cc] = (bf16)f2bf(Mab[(16 + t) * 33 + cc]); } else T2[t * P40 + 16 + cc] = (bf16)f2bf(x[t]); } }
        { unsigned char* rec = rw_rec_ptr(ws, h, b, c);
#pragma unroll
          for (int k = 0; k < 2; ++k) { const int p = 1664 + lane + 64 * k; *(u32x4*)(rec + 16 * p) = *(const LAS u32x4*)(img + rw_piece_off(p)); } }
    }
    __syncthreads();
}

constexpr int RC_IMG0 = 0, RC_IMG1 = ((IM_END + 255) / 256) * 256, RC_STAT = 2 * RC_IMG1, RC_DUMMY = RC_STAT + RT * 4 * 8, RC_END = RC_DUMMY + 256 * 16;
__device__ __forceinline__ void rwkv_chain_task(const ArgsD& a, int l, int bh, LAS unsigned char* lds, bf16* o, unsigned char* ws) {
    const int tid = opq_v((int)threadIdx.x), lane = tid & 63, wid = __builtin_amdgcn_readfirstlane(tid >> 6), fr = lane & 15, g = lane >> 4;
    const int b = bh >> 3, h = bh & 7;
    LAS f32x2* stat = (LAS f32x2*)(lds + RC_STAT);
    const int ib = wid & 3, Ci = h * 64 + 16 * ib + fr;
    const float lnw = a.in[I_RW_LNW][l * 512 + Ci], lnb = a.in[I_RW_LNB][l * 512 + Ci];
    acc4 St[4];
#pragma unroll
    for (int jb = 0; jb < 4; ++jb) St[jb] = (acc4){0.f, 0.f, 0.f, 0.f};
    u32x4 pv[8]; int poff[8];
#pragma unroll
    for (int i = 0; i < 8; ++i) { const int p = tid - 256 + 256 * i; poff[i] = (p >= 0 && p < RW_NPIECE) ? rw_piece_off(p) : RC_DUMMY + 16 * (tid & 255); pv[i] = (u32x4){0u, 0u, 0u, 0u}; }
#define RC_FETCH(rec_) do { _Pragma("unroll") for (int i_ = 0; i_ < 8; ++i_) { const int p_ = tid - 256 + 256 * i_; pv[i_] = *(const u32x4*)((rec_) + 16 * (p_ < RW_NPIECE ? p_ : 0)); } } while (0)
#define RC_PUT(dst_) do { _Pragma("unroll") for (int i_ = 0; i_ < 8; ++i_) { *(LAS u32x4*)(((i_ < 7 || tid < 256 + RW_NPIECE - 7 * 256) ? (dst_) : lds) + poff[i_]) = pv[i_]; } } while (0)
    if (wid >= 4) { RC_FETCH(rw_rec_ptr(ws, h, b, 0)); RC_PUT(lds + RC_IMG0); RC_FETCH(rw_rec_ptr(ws, h, b, 1)); }
    __syncthreads();
    for (int c = 0; c < SEQ / RT; ++c) {
        LAS unsigned char* img = lds + ((c & 1) ? RC_IMG1 : RC_IMG0);
        acc4 Y0 = (acc4){0.f, 0.f, 0.f, 0.f}, Y1 = Y0; unsigned gpk[2][4] = {{0, 0, 0, 0}, {0, 0, 0, 0}};
        if (wid >= 4) { RC_PUT(lds + ((c & 1) ? RC_IMG0 : RC_IMG1)); const int cf = (c + 2 < SEQ / RT) ? c + 2 : c; RC_FETCH(rw_rec_ptr(ws, h, b, cf)); }
        else {
            { const size_t tq = (size_t)b * SEQ + c * RT;
#pragma unroll
              for (int hb = 0; hb < 2; ++hb)
#pragma unroll
                  for (int r = 0; r < 4; ++r) gpk[hb][r] = o[(tq + 16 * hb + 4 * g + r) * 2048 + Ci]; }
            const LAS bf16* At = (const LAS bf16*)(img + IM_AT); const LAS bf16* Rt = (const LAS bf16*)(img + IM_RT); const LAS bf16* KpT = (const LAS bf16*)(img + IM_KPT); const LAS bf16* BpT = (const LAS bf16*)(img + IM_BPT); const LAS bf16* VT = (const LAS bf16*)(img + IM_VT);
            const LAS bf16* Mak = (const LAS bf16*)(img + IM_MAK); const LAS bf16* Ark = (const LAS bf16*)(img + IM_ARK); const LAS bf16* Arb = (const LAS bf16*)(img + IM_ARB); const LAS bf16* T1 = (const LAS bf16*)(img + IM_T1); const LAS bf16* T2 = (const LAS bf16*)(img + IM_T2);
            const LAS float* gam = (const LAS float*)(img + IM_GAM);
            const bf16x8 Sb0 = frag_acc(St[0], St[1]), Sb1 = frag_acc(St[2], St[3]); const bf16x8 vtf = *(const LAS bf16x8*)(VT + (16 * ib + fr) * P40 + rcol4(8 * g, ib));
            acc4 X0 = (acc4){0.f, 0.f, 0.f, 0.f}, X1 = X0;
            X0 = MFMA16(frag_perm(At, P72, fr, 0, g), Sb0, X0); X0 = MFMA16(frag_perm(At, P72, fr, 32, g), Sb1, X0); X0 = MFMA16(frag_nat(Mak, P40, fr, 0, g), vtf, X0);
            X1 = MFMA16(frag_perm(At, P72, 16 + fr, 0, g), Sb0, X1); X1 = MFMA16(frag_perm(At, P72, 16 + fr, 32, g), Sb1, X1); X1 = MFMA16(frag_nat(Mak, P40, 16 + fr, 0, g), vtf, X1);
            Y0 = MFMA16(frag_perm(Rt, P72, fr, 0, g), Sb0, Y0); Y0 = MFMA16(frag_perm(Rt, P72, fr, 32, g), Sb1, Y0); Y0 = MFMA16(frag_nat(Ark, P40, fr, 0, g), vtf, Y0);
            Y1 = MFMA16(frag_perm(Rt, P72, 16 + fr, 0, g), Sb0, Y1); Y1 = MFMA16(frag_perm(Rt, P72, 16 + fr, 32, g), Sb1, Y1); Y1 = MFMA16(frag_nat(Ark, P40, 16 + fr, 0, g), vtf, Y1);
            const acc4 zero4 = (acc4){0.f, 0.f, 0.f, 0.f};
            const acc4 U0 = MFMA16(frag_perm(T1, P40, fr, 0, g), frag_acc(X0, zero4), zero4);
            const bf16x8 t2f = frag_perm(T2, P40, fr, 0, g);
            const acc4 W1 = MFMA16(t2f, frag_acc(U0, zero4), X1);
            const acc4 U1 = MFMA16(t2f, frag_acc(zero4, W1), zero4);
            const bf16x8 Ub = frag_acc(U0, U1);
            Y0 = MFMA16(frag_perm(Arb, P40, fr, 0, g), Ub, Y0); Y1 = MFMA16(frag_perm(Arb, P40, 16 + fr, 0, g), Ub, Y1);
#pragma unroll
            for (int jb = 0; jb < 4; ++jb) { const f32x4 gm = *(const LAS f32x4*)(gam + 16 * jb + 4 * g); St[jb] = St[jb] * gm;
                const bf16x8 kpf = *(const LAS bf16x8*)(KpT + (16 * jb + fr) * P40 + rcol4(8 * g, jb));
                const LAS bf16* bpp = BpT + (16 * jb + fr) * P40; const u32x2 bv0 = *(const LAS u32x2*)(bpp + rcol4(4 * g, jb)), bv1 = *(const LAS u32x2*)(bpp + rcol4(4 * g + 16, jb)); u32x4 bw; bw.x = bv0.x; bw.y = bv0.y; bw.z = bv1.x; bw.w = bv1.y;
                St[jb] = MFMA16(kpf, vtf, St[jb]); St[jb] = MFMA16(__builtin_bit_cast(bf16x8, bw), Ub, St[jb]); }
#pragma unroll
            for (int r = 0; r < 4; ++r) { float s0 = Y0[r], q0 = Y0[r] * Y0[r], s1 = Y1[r], q1 = Y1[r] * Y1[r];
                s0 = red16_sum(s0); q0 = red16_sum(q0); s1 = red16_sum(s1); q1 = red16_sum(q1);
                if (fr == 0) { stat[(4 * g + r) * 4 + ib] = (f32x2){s0, q0}; stat[(16 + 4 * g + r) * 4 + ib] = (f32x2){s1, q1}; } }
        }
        __syncthreads();
        if (wid < 4) {
            const LAS bf16* VT = (const LAS bf16*)(img + IM_VT); const LAS float* bon = (const LAS float*)(img + IM_BON);
            const size_t t0 = (size_t)b * SEQ + c * RT;
#pragma unroll
            for (int hb = 0; hb < 2; ++hb) { const u32x2 vw = *(const LAS u32x2*)(VT + (16 * ib + fr) * P40 + rcol4(16 * hb + 4 * g, ib)); const f32x4 vv = (f32x4){lo2f(vw.x), hi2f(vw.x), lo2f(vw.y), hi2f(vw.y)};
#pragma unroll
                for (int r = 0; r < 4; ++r) { const int t = 16 * hb + 4 * g + r; const f32x2 s0 = stat[t * 4 + 0], s1 = stat[t * 4 + 1], s2 = stat[t * 4 + 2], s3 = stat[t * 4 + 3];
                    const float mean = ((s0.x + s1.x) + (s2.x + s3.x)) * (1.0f / 64.0f); const float ex2 = ((s0.y + s1.y) + (s2.y + s3.y)) * (1.0f / 64.0f);
                    const float rstd = rsqrtf(fmaxf(ex2 - mean * mean, 0.f) + 64e-5f); const float y = hb ? Y1[r] : Y0[r];
                    bf16* op = o + (t0 + t) * 2048 + Ci; const float gg = bf2f((bf16)gpk[hb][r]);
                    *op = (bf16)f2bf((((y - mean) * rstd * lnw + lnb) + bon[t] * vv[r]) * gg); } }
        }
        __syncthreads();
    }
}

#define XB_TMO      128
#define XB_XCNT(j)  (256  + 64 * (j))
#define XB_XSUB(j)  (1280 + 64 * (j))
#define XB_XGEN(j)  (2304 + 64 * (j))
#define XB_TOP      3328
#define XB_TOPGEN   3392
#define XCD_BAR_WORDS 3456
#define XB_SPIN_CAP (1u << 20)
__device__ __forceinline__ unsigned xb_ld(unsigned* p)              { return __hip_atomic_load(p, __ATOMIC_RELAXED, __HIP_MEMORY_SCOPE_AGENT); }
__device__ __forceinline__ unsigned xb_add(unsigned* p, unsigned v) { return __hip_atomic_fetch_add(p, v, __ATOMIC_RELAXED, __HIP_MEMORY_SCOPE_AGENT); }
__device__ __forceinline__ unsigned xb_xcc_id() { return (unsigned)__builtin_amdgcn_s_getreg((3 << 11) | 20) & 0xFu; }
#define XB_SPIN(cond, bar) do { unsigned _sp = 0; while (cond) { __builtin_amdgcn_s_sleep(1); \
    if ((++_sp & 255u) == 0u) { if (xb_ld(&(bar)[XB_TMO])) break; if (_sp > XB_SPIN_CAP) { atomicAdd(&(bar)[XB_TMO], 1u); break; } } } } while (0)
__device__ __forceinline__ void xcd_barrier_complete(unsigned* bar, unsigned x, unsigned& nloc, unsigned& nx) {
    const unsigned G = gridDim.x * gridDim.y * gridDim.z;
    unsigned sum, cnt, mine, sp = 0u;
    for (;;) {
        sum = 0u; cnt = 0u; mine = 0u;
#pragma unroll
        for (unsigned j = 0; j < 16; ++j) { const unsigned c = xb_ld(&bar[XB_XCNT(j)]); sum += c; cnt += (c > 0u) ? 1u : 0u; mine = (j == x) ? c : mine; }
        if (sum == G) break;
        __builtin_amdgcn_s_sleep(1);
        if ((++sp & 255u) == 0u) { if (xb_ld(&bar[XB_TMO])) break; if (sp > XB_SPIN_CAP) { atomicAdd(&bar[XB_TMO], 1u); break; } }
    }
    nloc = mine > 0u ? mine : 1u; nx = cnt > 0u ? cnt : 1u;
}
__device__ __forceinline__ void xcd_barrier(unsigned* bar, volatile LAS unsigned* st) {
    asm volatile("s_waitcnt vmcnt(0)" ::: "memory");
    __syncthreads();
    if (threadIdx.x == 0) {
        __builtin_amdgcn_s_waitcnt(0);
        unsigned nloc = st[0], nx = st[1]; const unsigned x = st[2];
        if (nloc == 0u) { xcd_barrier_complete(bar, x, nloc, nx); st[0] = nloc; st[1] = nx; }
        const unsigned old = xb_add(&bar[XB_XSUB(x)], 1u);
        const unsigned gen = old / nloc;
        if (old + 1u == (gen + 1u) * nloc) {
            __builtin_amdgcn_fence(__ATOMIC_RELEASE, "agent");
            asm volatile("s_waitcnt vmcnt(0)" ::: "memory");
            const unsigned og = xb_add(&bar[XB_TOP], 1u);
            const unsigned tg = og / nx;
            if (og + 1u == (tg + 1u) * nx) xb_add(&bar[XB_TOPGEN], 1u);
            else XB_SPIN(xb_ld(&bar[XB_TOPGEN]) == tg, bar);
            __builtin_amdgcn_fence(__ATOMIC_ACQUIRE, "agent");
            xb_add(&bar[XB_XGEN(x)], 1u);
            asm volatile("s_waitcnt vmcnt(0)" ::: "memory");
        } else {
            XB_SPIN(xb_ld(&bar[XB_XGEN(x)]) == gen, bar);
            __builtin_amdgcn_fence(__ATOMIC_ACQUIRE, "agent");
            asm volatile("s_waitcnt vmcnt(0)" ::: "memory");
        }
    }
    __syncthreads();
}

constexpr int LDS_WSCR = 20352;
constexpr int LDS_TOTAL = NWAVES * LDS_WSCR + 1024;
static_assert(LDS_TOTAL <= 163840 && NWAVES * LDS_WSCR >= LDS_MAIN, "LDS map");
constexpr int NPH = 22;
#ifndef MIXMASK
#define MIXMASK 15
#endif
#define MIX_T(bit, call) do { if ((MIXMASK) & (bit)) { call; } } while (0)

#define PHASE_PTRS \
    const int tid = opq_v((int)threadIdx.x), lane = tid & 63, wid = __builtin_amdgcn_readfirstlane(tid >> 6); (void)lane; (void)wid; \
    const int G = opq_s((int)gridDim.x), bx = opq_s((int)blockIdx.x); const int gw = bx * NWAVES + wid, ngw = G * NWAVES; (void)gw; (void)ngw; \
    LAS unsigned char* lds = (LAS unsigned char*)lds_raw; LAS unsigned* lctl = (LAS unsigned*)(lds + NWAVES * LDS_WSCR); (void)lctl; \
    ArgsD a; a.in.tab = (LAS unsigned long long*)(lds + NWAVES * LDS_WSCR + 640); \
    unsigned char* ws = a.ws(); float* a_out = a.out(); (void)a_out; \
    unsigned* ctl = (unsigned*)(ws + WS_CTL); (void)ctl; \
    float* ssb = (float*)(ws + WS_SMALL + SM_SS); (void)ssb; \
    float* mssq = (float*)(ws + WS_SMALL + SM_MSSQ); (void)mssq; \
    int* tok_e = (int*)(ws + WS_SMALL + SM_TOKE); float* tok_g = (float*)(ws + WS_SMALL + SM_TOKG); float* tok_rs = (float*)(ws + WS_SMALL + SM_TOKRS); (void)tok_e; (void)tok_g; (void)tok_rs; \
    int* tok_slot = (int*)(ws + WS_SMALL + SM_TOKSLOT); int* row_tok = (int*)(ws + WS_SMALL + SM_ROWTOK); float* row_gate = (float*)(ws + WS_SMALL + SM_ROWGATE); float* row_rs = (float*)(ws + WS_SMALL + SM_ROWRS); (void)tok_slot; (void)row_tok; (void)row_gate; (void)row_rs; \
    bf16* xb = (bf16*)(ws + WS_XB); (void)xb; \
    bf16* vfirst = (bf16*)(ws + WS_X + X_VFIRST); bf16* mixed = (bf16*)(ws + WS_X + X_MIXED); bf16* obuf = (bf16*)(ws + WS_X + X_O); (void)vfirst; (void)mixed; (void)obuf; \
    unsigned char* wreg = ws + WS_X + X_W; (void)wreg; \
    bf16* zbuf = (bf16*)(ws + WS_Z); bf16* gates = zbuf; bf16* hidden = zbuf; bf16* act = zbuf; (void)gates; (void)hidden; (void)act; \
    bf16* xg = (bf16*)(ws + WS_XG); bf16* ybuf = xg; bf16* rwarr = xg; (void)ybuf; (void)rwarr; bf16* ypart = (bf16*)(ws + WS_Z + (size_t)128 * MiB); (void)ypart; bf16* bcv = (bf16*)(ws + WS_BCV); (void)bcv; float* gend = (float*)(ws + WS_GEND); (void)gend; \
    bf16* moe_w13 = (bf16*)(ws + WS_X + MOE_W13); bf16* moe_w2 = (bf16*)(ws + WS_X + MOE_W2); (void)moe_w13; (void)moe_w2;

#define IDLE_CVT_BEGIN(nwg_) { const int p0_ = (nwg_) % G; if (bx >= p0_) { CvtCtx cx; cx.gw = (bx - p0_) * NWAVES + wid; cx.ngw = (G - p0_) * NWAVES; cx.base = 0; cx.lane = lane; cx.scr = (LAS float*)(lds + wid * LDS_WSCR); \
        const int zt_ = (bx - p0_) * NTHREADS + tid, zn_ = (G - p0_) * NTHREADS; (void)zt_; (void)zn_;
#define IDLE_CVT_END } }
#define CVT_LAYER_REST(l_) do { const float* win_ = a.in[I_WIN] + (size_t)(l_) * DM * IN_COLS; const float* nm_ = a.in[I_NORM_MIX] + (l_) * DM; \
        cvt_job_gates(cx, win_, IN_COLS, DM, MIXC, nm_, (bf16*)(wreg + W_G) + (size_t)(l_) * 4096 * DM); \
        for (int i_ = 0; i_ < 4; ++i_) cvt_job(cx, a.in[I_WBRANCH] + ((size_t)(l_) * 4 + i_) * 512 * DM, DM, 512, 0, DM, nullptr, (bf16*)(wreg + W_B) + ((size_t)(l_) * 4 + i_) * DM * 512, 0, 128); \
        cvt_job(cx, a.in[I_WOUT] + (size_t)(l_) * DM * DM, DM, DM, 0, DM, nullptr, (bf16*)(wreg + W_O) + (size_t)(l_) * DM * DM, 0, 128); } while (0)
template <int LO, int HI>
__device__ __forceinline__ void mk_body(const Args& ka) {
    extern __shared__ __attribute__((aligned(16))) unsigned char lds_raw[];
    { LAS unsigned long long* ptab = (LAS unsigned long long*)((LAS unsigned char*)lds_raw + NWAVES * LDS_WSCR + 640);
      const int t0 = threadIdx.x;
      if (t0 < N_IN) ptab[t0] = (unsigned long long)ka.in[t0];
      if (t0 == N_IN) ptab[t0] = (unsigned long long)ka.out;
      if (t0 == N_IN + 1) ptab[t0] = (unsigned long long)ka.ws;
#if !MK_PER_PHASE
      if (t0 == 64) { LAS unsigned* st = (LAS unsigned*)((LAS unsigned char*)lds_raw + NWAVES * LDS_WSCR + 992); st[0] = 0u; st[1] = 0u; const unsigned x = xb_xcc_id(); st[2] = x;
          (void)xb_add((unsigned*)(ka.ws + WS_CTL) + CW_BAR + XB_XCNT(x), 1u); }
#endif
      __syncthreads(); }
#if MK_PER_PHASE
#define GRID_BAR() do { } while (0)
#else
#define GRID_BAR() do { unsigned char* ws_ = ArgsD{PT{(LAS unsigned long long*)((LAS unsigned char*)lds_raw + NWAVES * LDS_WSCR + 640)}}.ws(); \
    xcd_barrier((unsigned*)(ws_ + WS_CTL) + CW_BAR, (volatile LAS unsigned*)((LAS unsigned char*)lds_raw + NWAVES * LDS_WSCR + 992)); } while (0)
#endif
#define IN(k) (LO <= (k) && (k) < HI)
#if MK_PER_PHASE
#define SPLIT_ARRIVE(w) do { } while (0)
#define SPLIT_WAIT(w) do { } while (0)
#else
#define SPLIT_ARRIVE(w) do { asm volatile("s_waitcnt vmcnt(0)" ::: "memory"); __syncthreads(); if (threadIdx.x == 0) { unsigned* c_ = (unsigned*)(ArgsD{PT{(LAS unsigned long long*)((LAS unsigned char*)lds_raw + NWAVES * LDS_WSCR + 640)}}.ws() + WS_CTL); \
        __builtin_amdgcn_fence(__ATOMIC_RELEASE, "agent"); asm volatile("s_waitcnt vmcnt(0)" ::: "memory"); xb_add(c_ + CW_SPLIT + 64 * (w), 1u); } } while (0)
#define SPLIT_WAIT(w) do { if (threadIdx.x == 0) { unsigned* c_ = (unsigned*)(ArgsD{PT{(LAS unsigned long long*)((LAS unsigned char*)lds_raw + NWAVES * LDS_WSCR + 640)}}.ws() + WS_CTL); \
        XB_SPIN(xb_ld(c_ + CW_SPLIT + 64 * (w)) < gridDim.x, c_ + CW_BAR); __builtin_amdgcn_fence(__ATOMIC_ACQUIRE, "agent"); asm volatile("s_waitcnt vmcnt(0)" ::: "memory"); } __syncthreads(); } while (0)
#endif
#define SEAM(k) do { if (IN(k) && IN((k) + 1)) GRID_BAR(); } while (0)

    if (IN(0)) { PHASE_PTRS
        CvtCtx cx; cx.gw = gw; cx.ngw = ngw; cx.base = 0; cx.lane = lane; cx.scr = (LAS float*)(lds + wid * LDS_WSCR);
        { const float* win = a.in[I_WIN]; const float* nm = a.in[I_NORM_MIX]; bf16* winT = (bf16*)(wreg + W_IN);
          cvt_job(cx, win, IN_COLS, DM, 0, MIXC, nm, winT, 0, 128);
          zero_rows_bf16(bx * NTHREADS + tid, G * NTHREADS, winT + (size_t)C_HV * DM, (size_t)(ZC - C_HV) * DM); }
        const float* x = a.in[I_X];
        for (int m = gw; m < T; m += ngw) { const f32x4* xr = (const f32x4*)(x + (size_t)m * DM) + lane; float s = 0.f;
#pragma unroll
            for (int j = 0; j < 4; ++j) { const f32x4 v = xr[64 * j]; s += (v[0] * v[0] + v[1] * v[1]) + (v[2] * v[2] + v[3] * v[3]); u32x2 w; w.x = pk2(v[0], v[1]); w.y = pk2(v[2], v[3]); *((u32x2*)(xb + (size_t)m * DM) + lane + 64 * j) = w; }
            s = wave_sum(s); if (lane < 16) ssb[(size_t)m * 16 + lane] = (lane == 0) ? s : 0.f; }
    }
#if MK_PER_PHASE
    SEAM(0);
#else
    if (IN(0) && IN(1)) { if (ka.ws == nullptr) cg::this_grid().sync();
                          GRID_BAR(); }
#endif

#pragma unroll
    for (int l = 0; l < 2; ++l) {
        const int pb = 1 + 9 * l;
#define ss_mix (ssb + (size_t)(l == 0 ? 0 : 2) * T * 16)
#define ss_ffn (l == 0 ? ssb + (size_t)T * 16 : (float*)nullptr)
        if (IN(pb + 0)) { PHASE_PTRS
            pg8::Gemm g{DM, DM, DM}; pg8::StaticOrder S; S.init(xb, (bf16*)(wreg + W_IN) + (size_t)l * ZC * DM, DM, DM, T, ZC, G, bx);
            EpiScaleBf16<0> E{zbuf, ZC, ss_mix};
            pg8::gemm_phase(lds, g, S, E);
            IDLE_CVT_BEGIN((T / 256) * (ZC / 256))
                CVT_LAYER_REST(l);
                if (l == 0) {
#if FFN_FP8
                    cvt_job8(cx, a.in[I_FFN_W1], FFN, DM, 0, FFN, a.in[I_NORM_FFN], 32.0f, wreg + W_13, 0, 256);
                    cvt_job8(cx, a.in[I_FFN_W3], FFN, DM, 0, FFN, a.in[I_NORM_FFN], 32.0f, wreg + W_13, 128, 256);
                    cvt_job8(cx, a.in[I_FFN_W2], DM, FFN, 0, DM, nullptr, 64.0f, wreg + W_2, 0, 128);
#else
                    cvt_job(cx, a.in[I_FFN_W1], FFN, DM, 0, FFN, a.in[I_NORM_FFN], (bf16*)(wreg + W_13), 0, 256);
                    cvt_job(cx, a.in[I_FFN_W3], FFN, DM, 0, FFN, a.in[I_NORM_FFN], (bf16*)(wreg + W_13), 128, 256);
                    cvt_job(cx, a.in[I_FFN_W2], DM, FFN, 0, DM, nullptr, (bf16*)(wreg + W_2), 0, 128);
#endif
                }
            IDLE_CVT_END
        }
        SEAM(pb + 0);
        if (IN(pb + 1)) { PHASE_PTRS
            rwkv_xlr_prepass(a, l, bx, G, zbuf, obuf);
            if (IN(pb + 2)) SPLIT_ARRIVE(2 + l);
            mamba_bc_prepass(a, l, gw, ngw, lane, zbuf, bcv);
            gla_prepass(a, l, bx, G, lds, zbuf, gend);
        }
        if (IN(pb + 1) && IN(pb + 2)) SPLIT_WAIT(2 + l);
        if (IN(pb + 2)) { PHASE_PTRS
            const int npair = 8 * BATCH * (SEQ / RT) / 2, ppb = (npair + G - 1) / G; int wts_h = -1;
            const int u0 = bx * ppb, u1 = ((bx + 1) * ppb < npair) ? (bx + 1) * ppb : npair;
            if (u0 < u1) { PrepPf pf; rwkv_prep_fetch(pf, l, u0 >> 8, (u0 >> 5) & 7, 2 * (u0 & 31), zbuf, vfirst, obuf);
                for (int u = u0; u < u1; ++u) { const int un = (u + 1 < u1) ? u + 1 : u;
                    rwkv_prep_pair(a, l, u >> 8, (u >> 5) & 7, 2 * (u & 31), un >> 8, (un >> 5) & 7, 2 * (un & 31), pf, wts_h, lds, zbuf, vfirst, obuf, ws); } } }
        SEAM(pb + 2);
        if (IN(pb + 3)) { PHASE_PTRS
            if (bx < 64) { MIX_T(1, rwkv_chain_task(a, l, bx, lds, obuf, ws)); }
            else if (bx < 128) { MIX_T(2, mamba_block_task(a, l, bx - 64, lds, zbuf, bcv, obuf, mssq)); }
            else if (bx < 160) { MIX_T(4, gla_block_task(a, l, bx - 128, lds, zbuf, gend, obuf)); }
            MIX_T(8, attn_drain(a, l, lds, lctl, ctl + CW_ATTQ + l, zbuf, obuf));
        }
        SEAM(pb + 3);
        if (IN(pb + 4)) { PHASE_PTRS
            const float* nw = a.in[I_SSM_NORMW] + l * 512;
            for (int m = gw; m < T; m += ngw) { const int g = lane >> 5; const float* q = mssq + (size_t)m * 8 + g * 4; const float sc = rsqrtf((q[0] + q[1] + q[2] + q[3]) * (1.0f / 256.0f) + NORM_EPS);
                bf16* p = obuf + (size_t)m * 2048 + 512 + lane * 8; const u32x4 w = *(const u32x4*)p; f32x4 v0, v1; unpack8(w, v0, v1);
                const f32x4 n0 = *(const f32x4*)(nw + lane * 8), n1 = *(const f32x4*)(nw + lane * 8 + 4);
                *(u32x4*)p = pack8(v0 * n0 * sc, v1 * n1 * sc); }
            pg8::Gemm g{DM, DM, DM}; pg8::StaticOrder S; S.init(xb, (bf16*)(wreg + W_G) + (size_t)l * 4096 * DM, DM, DM, T, 4096, G, bx);
            EpiGateRatio E{gates, ss_mix};
            pg8::gemm_phase(lds, g, S, E);
        }
        SEAM(pb + 4);
        if (IN(pb + 5)) { PHASE_PTRS
            pg8::Gemm g{2048, 512, 512}; MixOrder S{(const char*)obuf, (const char*)((bf16*)(wreg + W_B) + (size_t)l * 4 * DM * 512), G, bx};
            EpiMix E{gates, mixed};
            pg8::gemm_phase(lds, g, S, E);
        }
        SEAM(pb + 5);
        if (IN(pb + 6)) { PHASE_PTRS
            pg8::Gemm g{DM, DM, DM}; pg8::StaticOrder S; S.init(mixed, (bf16*)(wreg + W_O) + (size_t)l * DM * DM, DM, DM, T, DM, G, bx);
            EpiResid<false> E{l == 0 ? a.in[I_X] : a_out, a_out, xb, ss_ffn, (FFN_FP8 && l == 0) ? (unsigned char*)xg : (unsigned char*)nullptr};
            pg8::gemm_phase(lds, g, S, E);
        }
        if (l == 0) SEAM(pb + 6); else if (IN(pb + 6) && IN(pb + 7)) SPLIT_ARRIVE(0);
        if (l == 0) {
            if (IN(pb + 7)) { PHASE_PTRS
#if FFN_FP8
                pg8::Gemm g{DM / 2, DM / 2, DM / 2}; pg8::StaticOrder S; S.init(xg, (bf16*)(wreg + W_13), DM / 2, DM / 2, T, 2 * FFN, G, bx);
                EpiSwiglu<false, true> E{hidden, FFN, ss_ffn};
#else
                pg8::Gemm g{DM, DM, DM}; pg8::StaticOrder S; S.init(xb, (bf16*)(wreg + W_13), DM, DM, T, 2 * FFN, G, bx);
                EpiSwiglu<false, false> E{hidden, FFN, ss_ffn};
#endif
                pg8::gemm_phase(lds, g, S, E);
                IDLE_CVT_BEGIN((T / 256) * (2 * FFN / 256))
                    const float* win = a.in[I_WIN] + (size_t)DM * IN_COLS; const float* nm = a.in[I_NORM_MIX] + DM; bf16* winT = (bf16*)(wreg + W_IN) + (size_t)ZC * DM;
                    cvt_job(cx, win, IN_COLS, DM, 0, MIXC, nm, winT, 0, 128);
                    cvt_job(cx, a.in[I_VRES_DOWN], 32, DM, 0, 32, nm, winT, C_HV, 128);
                    zero_rows_bf16(zt_, zn_, winT + (size_t)(C_HV + 32) * DM, (size_t)(ZC - C_HV - 32) * DM);
                IDLE_CVT_END
            }
            SEAM(pb + 7);
            if (IN(pb + 8)) { PHASE_PTRS
#if FFN_FP8
                pg8::Gemm g{FFN / 2, FFN / 2, FFN / 2}; pg8::StaticOrder S; S.init(hidden, (bf16*)(wreg + W_2), FFN / 2, FFN / 2, T, DM, G, bx);
                EpiResid<true> E{a_out, a_out, xb, ssb + (size_t)2 * T * 16, nullptr};
#else
                pg8::Gemm g{FFN, FFN, FFN}; pg8::StaticOrder S; S.init(hidden, (bf16*)(wreg + W_2), FFN, FFN, T, DM, G, bx);
                EpiResid<false> E{a_out, a_out, xb, ssb + (size_t)2 * T * 16, nullptr};
#endif
                pg8::gemm_phase(lds, g, S, E);
            }
            SEAM(pb + 8);
        }
    }
    if (IN(17)) { PHASE_PTRS
        if (tid < 8) lctl[tid] = 0u;
        __syncthreads();
        const float* nf_ = a.in[I_NORM_FFN] + DM;
        CvtCtx cx; cx.gw = gw; cx.ngw = ngw; cx.base = 0; cx.lane = lane; cx.scr = (LAS float*)(lds + wid * LDS_WSCR);
#define MOE_CVT13(e_) do { unsigned char* w13_8 = (unsigned char*)moe_w13 + (size_t)(e_) * 2 * EDIM * DM; \
            cvt_job8(cx, a.in[I_MOE_W1] + (size_t)(e_) * DM * EDIM, EDIM, DM, 0, EDIM, nf_, 32.0f, w13_8, 0, 256); cvt_job8(cx, a.in[I_MOE_W3] + (size_t)(e_) * DM * EDIM, EDIM, DM, 0, EDIM, nf_, 32.0f, w13_8, 128, 256); } while (0)
        for (int e = 0; e < NEXP; ++e) { unsigned char* w2_8 = (unsigned char*)moe_w13 + (size_t)NEXP * 2 * EDIM * DM + (size_t)e * DM * EDIM;
            cvt_job8(cx, a.in[I_MOE_W2] + (size_t)e * EDIM * DM, DM, EDIM, 0, DM, nullptr, 64.0f, w2_8, 0, 128); }
        for (int e = 0; e < 2; ++e) MOE_CVT13(e);
        if (IN(16)) SPLIT_WAIT(0);
        const float* nf = a.in[I_NORM_FFN] + DM; const float* wr = a.in[I_MOE_ROUTER];
        f32x4 nv[4];
        { const int m0 = gw < T ? gw : 0; const f32x4* xr = (const f32x4*)(a_out + (size_t)m0 * DM) + lane;
#pragma unroll
          for (int j = 0; j < 4; ++j) nv[j] = xr[64 * j]; }
        for (int m = gw; m < T; m += ngw) { f32x4 v[4]; float s = 0.f;
#pragma unroll
            for (int j = 0; j < 4; ++j) { v[j] = nv[j]; s += (v[j][0] * v[j][0] + v[j][1] * v[j][1]) + (v[j][2] * v[j][2] + v[j][3] * v[j][3]); }
            { const int mn = (m + ngw < T) ? m + ngw : m; const f32x4* xr = (const f32x4*)(a_out + (size_t)mn * DM) + lane;
#pragma unroll
              for (int j = 0; j < 4; ++j) nv[j] = xr[64 * j]; }
            const float rs = rsqrtf(wave_sum(s) * (1.0f / DM) + NORM_EPS);
            float lg[8];
#pragma unroll
            for (int e = 0; e < 8; ++e) lg[e] = 0.f;
#pragma unroll
            for (int j = 0; j < 4; ++j) { const int k0 = 4 * (lane + 64 * j); const f32x4 gn = *(const f32x4*)(nf + k0);
#pragma unroll
                for (int q = 0; q < 4; ++q) { const float hf = v[j][q] * rs * gn[q]; const f32x4 w0 = *(const f32x4*)(wr + (size_t)(k0 + q) * 8), w1 = *(const f32x4*)(wr + (size_t)(k0 + q) * 8 + 4);
                    lg[0] += hf * w0[0]; lg[1] += hf * w0[1]; lg[2] += hf * w0[2]; lg[3] += hf * w0[3]; lg[4] += hf * w1[0]; lg[5] += hf * w1[1]; lg[6] += hf * w1[2]; lg[7] += hf * w1[3]; } }
#pragma unroll
            for (int e = 0; e < 8; ++e) lg[e] = wave_sum(lg[e]);
            int e0 = 0; float v0 = lg[0];
#pragma unroll
            for (int e = 1; e < 8; ++e) if (lg[e] > v0) { v0 = lg[e]; e0 = e; }
            int e1 = -1; float v1 = -3.0e38f;
#pragma unroll
            for (int e = 0; e < 8; ++e) if (e != e0 && lg[e] > v1) { v1 = lg[e]; e1 = e; }
            if (e1 < 0) { e1 = (e0 == 0) ? 1 : 0; v1 = v0; }
            const float g0 = 1.0f / (1.0f + __expf(v1 - v0));
            if (lane == 0) { tok_e[2 * m] = e0; tok_e[2 * m + 1] = e1; tok_g[2 * m] = g0; tok_g[2 * m + 1] = 1.0f - g0; tok_rs[m] = rs;
                __hip_atomic_fetch_add(lctl + e0, 1u, __ATOMIC_RELAXED, __HIP_MEMORY_SCOPE_WORKGROUP); __hip_atomic_fetch_add(lctl + e1, 1u, __ATOMIC_RELAXED, __HIP_MEMORY_SCOPE_WORKGROUP); } }
        __syncthreads();
        if (tid < 8) atomicAdd(ctl + CW_MOECNT + tid, lctl[tid]);
        if (IN(18)) SPLIT_ARRIVE(1);
        for (int e = 2; e < NEXP; ++e) MOE_CVT13(e);
#undef MOE_CVT13
    }
    if (IN(17) && IN(18)) SPLIT_WAIT(1);

    if (IN(18)) { PHASE_PTRS
        unsigned cnt[8]; int base[8];
        { int acc = 0;
#pragma unroll
          for (int e = 0; e < 8; ++e) { cnt[e] = (unsigned)__builtin_amdgcn_readfirstlane((int)__hip_atomic_load(ctl + CW_MOECNT + e, __ATOMIC_RELAXED, __HIP_MEMORY_SCOPE_AGENT)); base[e] = acc; acc += (int)((cnt[e] + 255u) & ~255u); } }
        LAS unsigned* lcnt = lctl; LAS int* lstart = (LAS int*)(lctl + 8); LAS int* pslot = (LAS int*)(lctl + 16);
        for (int tgp = bx; tgp < T / 64; tgp += G) {
            if (tid < 8) lcnt[tid] = 0u;
            __syncthreads();
            int e0 = 0, e1 = 0, r0 = 0, r1 = 0; const int tok = tgp * 64 + tid;
            if (tid < 64) { e0 = tok_e[2 * tok]; e1 = tok_e[2 * tok + 1]; r0 = (int)__hip_atomic_fetch_add(lcnt + e0, 1u, __ATOMIC_RELAXED, __HIP_MEMORY_SCOPE_WORKGROUP); r1 = (int)__hip_atomic_fetch_add(lcnt + e1, 1u, __ATOMIC_RELAXED, __HIP_MEMORY_SCOPE_WORKGROUP); }
            __syncthreads();
            if (tid < 8) { int bsel = 0;
#pragma unroll
                for (int e = 0; e < 8; ++e) bsel = (tid == e) ? base[e] : bsel;
                lstart[tid] = bsel + (int)atomicAdd(ctl + CW_MOECUR + tid, lcnt[tid]); }
            __syncthreads();
            if (tid < 64) { const int s0 = lstart[e0] + r0, s1 = lstart[e1] + r1; pslot[2 * tid] = s0; pslot[2 * tid + 1] = s1;
                { int enc0 = s0, enc1 = s1;
#pragma unroll
                  for (int e = 0; e < 8; ++e) { const int fullr = (int)(cnt[e] & ~255u); int pi = 0;
#pragma unroll
                      for (int q = 0; q < 8; ++q) pi += (q < e && (cnt[q] & 255u)) ? 1 : 0;
                      if (e0 == e && s0 - base[e] >= fullr) enc0 = -(1 + pi * 256 + (s0 - base[e] - fullr));
                      if (e1 == e && s1 - base[e] >= fullr) enc1 = -(1 + pi * 256 + (s1 - base[e] - fullr)); }
                  tok_slot[2 * tok] = enc0; tok_slot[2 * tok + 1] = enc1; }
                const float rs = tok_rs[tok];
                row_tok[s0] = tok; row_tok[s1] = tok; row_gate[s0] = tok_g[2 * tok]; row_gate[s1] = tok_g[2 * tok + 1]; row_rs[s0] = rs; row_rs[s1] = rs; }
            __syncthreads();
            { u32x4 sv[8][2];
#pragma unroll
              for (int q = 0; q < 8; ++q) { const u32x4* src = (const u32x4*)(xb + (size_t)(tgp * 64 + wid * 8 + q) * DM) + 2 * lane; sv[q][0] = src[0]; sv[q][1] = src[1]; }
#pragma unroll
              for (int q = 0; q < 8; ++q) { const int tl = wid * 8 + q;
                f32x4 v0, v1, v2, v3; unpack8(sv[q][0], v0, v1); unpack8(sv[q][1], v2, v3); u32x4 w8; int t;
                t = 0; t = __builtin_amdgcn_cvt_pk_fp8_f32(v0[0], v0[1], t, false); t = __builtin_amdgcn_cvt_pk_fp8_f32(v0[2], v0[3], t, true); w8.x = (unsigned)t;
                t = 0; t = __builtin_amdgcn_cvt_pk_fp8_f32(v1[0], v1[1], t, false); t = __builtin_amdgcn_cvt_pk_fp8_f32(v1[2], v1[3], t, true); w8.y = (unsigned)t;
                t = 0; t = __builtin_amdgcn_cvt_pk_fp8_f32(v2[0], v2[1], t, false); t = __builtin_amdgcn_cvt_pk_fp8_f32(v2[2], v2[3], t, true); w8.z = (unsigned)t;
                t = 0; t = __builtin_amdgcn_cvt_pk_fp8_f32(v3[0], v3[1], t, false); t = __builtin_amdgcn_cvt_pk_fp8_f32(v3[2], v3[3], t, true); w8.w = (unsigned)t;
#pragma unroll
                for (int k = 0; k < 2; ++k) *((u32x4*)((unsigned char*)xg + (size_t)pslot[2 * tl + k] * DM) + lane) = w8; } }
            __syncthreads();
        }
        for (int idx = gw; idx < 8 * 256; idx += ngw) { const int e = idx >> 8, r = idx & 255; unsigned ce = 0; int be = 0;
#pragma unroll
            for (int q = 0; q < 8; ++q) { ce = (e == q) ? cnt[q] : ce; be = (e == q) ? base[q] : be; }
            const int rem = (int)(ce & 255u);
            if (rem != 0 && r >= rem) { const int slot = be + (int)(ce & ~255u) + r; u32x4 zz = {0u, 0u, 0u, 0u}; *((u32x4*)((unsigned char*)xg + (size_t)slot * DM) + lane) = zz;
                if (lane == 0) { row_tok[slot] = -1; row_gate[slot] = 0.f; row_rs[slot] = 0.f; } } }
    }
    SEAM(18);
    if (IN(19)) { PHASE_PTRS
        unsigned cnt[8];
#pragma unroll
        for (int e = 0; e < 8; ++e) cnt[e] = (unsigned)__builtin_amdgcn_readfirstlane((int)__hip_atomic_load(ctl + CW_MOECNT + e, __ATOMIC_RELAXED, __HIP_MEMORY_SCOPE_AGENT));
        pg8::Gemm g{DM / 2, DM / 2, DM / 2}; MoeOrder S; S.init(xg, DM / 2, moe_w13, DM / 2, (size_t)2 * EDIM * DM, 2 * EDIM / 256, cnt, G, bx);
        EpiSwiglu<true> E{act, EDIM, row_rs};
        pg8::gemm_phase(lds, g, S, E);
    }
    SEAM(19);
    if (IN(20)) { PHASE_PTRS
        unsigned cnt[8];
#pragma unroll
        for (int e = 0; e < 8; ++e) cnt[e] = (unsigned)__builtin_amdgcn_readfirstlane((int)__hip_atomic_load(ctl + CW_MOECNT + e, __ATOMIC_RELAXED, __HIP_MEMORY_SCOPE_AGENT));
        pg8::Gemm g{EDIM / 2, EDIM / 2, EDIM / 2}; MoeDownOrder S; S.init(act, EDIM / 2, (unsigned char*)moe_w13 + (size_t)NEXP * 2 * EDIM * DM, EDIM / 2, (size_t)DM * EDIM, cnt, G, bx);
        EpiMoeDownSplit E{ybuf, ypart, row_gate};
        pg8::gemm_phase(lds, g, S, E);
    }
    SEAM(20);
    if (IN(21)) { PHASE_PTRS
        int ns0 = 0, ns1 = 0; if (gw < T) { ns0 = tok_slot[2 * gw]; ns1 = tok_slot[2 * gw + 1]; }
        for (int m = gw; m < T; m += ngw) { const int s0 = __builtin_amdgcn_readfirstlane(ns0), s1 = __builtin_amdgcn_readfirstlane(ns1); f32x4* xr = (f32x4*)(a_out + (size_t)m * DM) + lane;
            { const int mn = (m + ngw < T) ? m + ngw : m; ns0 = tok_slot[2 * mn]; ns1 = tok_slot[2 * mn + 1]; }
            f32x4 v[4]; u32x2 ya[4], yb[4];
            const u32x2* y0 = (const u32x2*)((s0 >= 0 ? ybuf + (size_t)s0 * DM : ypart + (size_t)(-1 - s0) * DM)) + lane;
            const u32x2* y1 = (const u32x2*)((s1 >= 0 ? ybuf + (size_t)s1 * DM : ypart + (size_t)(-1 - s1) * DM)) + lane;
#pragma unroll
            for (int j = 0; j < 4; ++j) { v[j] = xr[64 * j]; ya[j] = y0[64 * j]; yb[j] = y1[64 * j]; }
#pragma unroll
            for (int j = 0; j < 4; ++j) { v[j][0] += lo2f(ya[j].x) + lo2f(yb[j].x); v[j][1] += hi2f(ya[j].x) + hi2f(yb[j].x); v[j][2] += lo2f(ya[j].y) + lo2f(yb[j].y); v[j][3] += hi2f(ya[j].y) + hi2f(yb[j].y); }
#pragma unroll
            for (int k = 0; k < 2; ++k) { const int sk = k ? s1 : s0;
                if (sk < 0) { const int pr = -1 - sk;
#pragma unroll 1
                    for (int q = 1; q < MD_KSPLIT; ++q) { const u32x2* yq = (const u32x2*)(ypart + ((size_t)q * (8 * 256) + pr) * DM) + lane;
#pragma unroll
                        for (int j = 0; j < 4; ++j) { const u32x2 p = yq[64 * j]; v[j][0] += lo2f(p.x); v[j][1] += hi2f(p.x); v[j][2] += lo2f(p.y); v[j][3] += hi2f(p.y); } } } }
#pragma unroll
            for (int j = 0; j < 4; ++j) xr[64 * j] = v[j]; }
    }
#undef IN
#undef SEAM
#undef GRID_BAR
#undef ss_mix
#undef ss_ffn
}
template <int LO, int HI> __global__ void __launch_bounds__(NTHREADS, 2) mk_fwd(Args a) { mk_body<LO, HI>(a); }

template <int PH> static void set_attr(bool& ok) { if constexpr (PH < NPH) { ok = ok && (hipFuncSetAttribute((const void*)mk_fwd<PH, PH + 1>, hipFuncAttributeMaxDynamicSharedMemorySize, LDS_TOTAL) == hipSuccess); set_attr<PH + 1>(ok); } }
template <int PH> static void launch_phases(const Args& a, int grid, hipStream_t stream) { if constexpr (PH < NPH) { hipLaunchKernelGGL((mk_fwd<PH, PH + 1>), dim3(grid), dim3(NTHREADS), LDS_TOTAL, stream, a); launch_phases<PH + 1>(a, grid, stream); } }
extern "C" void kernel_launch(void* const* d_in, const int* in_sizes, int n_in, void* d_out, int out_size, void* d_ws, size_t ws_size, hipStream_t stream) {
    static int grid = 0;
    if (!grid) {
        if (n_in != N_IN || out_size != T * DM || ws_size < WS_END) { fprintf(stderr, "kernel_launch: unexpected problem: n_in %d out %d ws %zu (need %zu)\n", n_in, out_size, ws_size, (size_t)WS_END); grid = -1; return; }
        int dev = 0, cus = 0, per_cu = 0;
        (void)hipGetDevice(&dev); (void)hipDeviceGetAttribute(&cus, hipDeviceAttributeMultiprocessorCount, dev);
#if MK_PER_PHASE
        { bool ok = true; set_attr<0>(ok); if (!ok) { fprintf(stderr, "kernel_launch: hipFuncSetAttribute failed\n"); grid = -1; return; } per_cu = 1; }
#else
        if (hipFuncSetAttribute((const void*)mk_fwd<0, NPH>, hipFuncAttributeMaxDynamicSharedMemorySize, LDS_TOTAL) != hipSuccess) { fprintf(stderr, "kernel_launch: hipFuncSetAttribute failed\n"); grid = -1; return; }
        if (hipOccupancyMaxActiveBlocksPerMultiprocessor(&per_cu, (const void*)mk_fwd<0, NPH>, NTHREADS, LDS_TOTAL) != hipSuccess || per_cu < 1) { fprintf(stderr, "kernel_launch: occupancy query failed (%d)\n", per_cu); grid = -1; return; }
#endif
        grid = cus;
    }
    if (grid <= 0) return;
    (void)hipMemsetAsync((char*)d_ws + WS_CTL, 0, 32768, stream);
    Args a{};
    for (int i = 0; i < N_IN; ++i) a.in[i] = (const float*)d_in[i];
    a.out = (float*)d_out; a.ws = (unsigned char*)d_ws;
#if MK_PER_PHASE
    launch_phases<0>(a, grid, stream);
#else
    void* args[] = {&a};
    hipError_t e = hipLaunchCooperativeKernel((const void*)mk_fwd<0, NPH>, dim3(grid), dim3(NTHREADS), args, LDS_TOTAL, stream);
    if (e != hipSuccess) fprintf(stderr, "cooperative launch failed: %s (grid %d)\n", hipGetErrorString(e), grid);
#endif
}
```

```cpp
#include <hip/hip_runtime.h>
#include <hip/hip_cooperative_groups.h>
#include <cstdio>
#include <cstdint>
namespace cg = cooperative_groups;

#ifndef FFN_FP8
#define FFN_FP8 0
#endif
#ifndef MK_PER_PHASE
#define MK_PER_PHASE 0
#endif

#define LAS __attribute__((address_space(3)))
typedef unsigned short bf16;
typedef short bf16x8 __attribute__((ext_vector_type(8)));
typedef float f32x4 __attribute__((ext_vector_type(4)));
typedef float f32x2 __attribute__((ext_vector_type(2)));
typedef unsigned u32x4 __attribute__((ext_vector_type(4)));
typedef unsigned u32x2 __attribute__((ext_vector_type(2)));

constexpr int BATCH = 8, SEQ = 2048, DM = 1024, T = BATCH * SEQ;
constexpr int CHUNK = 64, NCH = SEQ / CHUNK;
constexpr int IN_COLS = 10552, MIXC = 6456;
constexpr int ZC = 6656;
constexpr int C_RWKV = 0, C_SSM = 1824, C_ATT = 3368, C_GLA = 4904, C_HV = 6456;
constexpr int FFN = 2816, NEXP = 8, EDIM = 3584;
constexpr int MOE_ROWS = 2 * T + NEXP * 256;
constexpr float NORM_EPS = 1e-6f;

constexpr size_t MiB = 1u << 20;
constexpr size_t WS_CTL = 0;
constexpr size_t CTL_BYTES = 1 * MiB;
constexpr size_t WS_SMALL = WS_CTL + CTL_BYTES;
constexpr size_t SM_SS = 0;
constexpr size_t SM_MSSQ = SM_SS + 3 * (size_t)T * 16 * 4;
constexpr size_t SM_TOKE = SM_MSSQ + (size_t)T * 8 * 4;
constexpr size_t SM_TOKG = SM_TOKE + (size_t)T * 2 * 4;
constexpr size_t SM_TOKRS = SM_TOKG + (size_t)T * 2 * 4;
constexpr size_t SM_TOKSLOT = SM_TOKRS + (size_t)T * 4;
constexpr size_t SM_ROWTOK = SM_TOKSLOT + (size_t)T * 2 * 4;
constexpr size_t SM_ROWGATE = SM_ROWTOK + (size_t)MOE_ROWS * 4;
constexpr size_t SM_ROWRS = SM_ROWGATE + (size_t)MOE_ROWS * 4;
constexpr size_t SM_END = SM_ROWRS + (size_t)MOE_ROWS * 4;
static_assert(SM_END <= 6 * MiB, "small region");
constexpr size_t WS_XB = WS_SMALL + 6 * MiB;
constexpr size_t WS_X = WS_XB + (size_t)T * DM * 2;
constexpr size_t X_VFIRST = 0;
constexpr size_t X_MIXED = X_VFIRST + (size_t)T * 512 * 2;
constexpr size_t X_O = X_MIXED + (size_t)T * DM * 2;
constexpr size_t X_W = X_O + (size_t)T * 2048 * 2;
constexpr size_t W_IN = 0;
constexpr size_t W_G = W_IN + 2 * (size_t)ZC * DM * 2;
constexpr size_t W_B = W_G + 2 * (size_t)4096 * DM * 2;
constexpr size_t W_O = W_B + 2 * 4 * (size_t)DM * 512 * 2;
constexpr size_t W_13 = W_O + 2 * (size_t)DM * DM * 2;
constexpr size_t W_2 = W_13 + (size_t)2 * FFN * DM * 2;
constexpr size_t W_END = W_2 + (size_t)DM * FFN * 2;
constexpr size_t X_BYTES = X_W + W_END;
constexpr size_t MOE_W13 = 0;
constexpr size_t MOE_W2 = MOE_W13 + (size_t)NEXP * 2 * EDIM * DM * 2;
constexpr size_t MOE_WEND = MOE_W2 + (size_t)NEXP * DM * EDIM * 2;
static_assert(MOE_WEND <= X_BYTES, "MoE weights must fit the X region");
constexpr size_t WS_Z = WS_X + X_BYTES;
constexpr size_t Z_BYTES = (size_t)MOE_ROWS * EDIM * 2;
static_assert((size_t)T * ZC * 2 <= Z_BYTES, "z fits");
constexpr size_t WS_XG = WS_Z + Z_BYTES;
constexpr size_t XG_BYTES = (size_t)MOE_ROWS * DM * 2;
static_assert(4 * (size_t)T * 512 * 2 <= XG_BYTES, "rwkv arrays fit");
constexpr size_t WS_BCV = WS_XG + (size_t)4 * BATCH * (SEQ / 32) * 29184;
constexpr size_t WS_GEND = WS_BCV + (size_t)T * 512 * 2;
constexpr size_t WS_END = (WS_XG + XG_BYTES > WS_GEND + (size_t)BATCH * 4 * NCH * 64 * 4) ? WS_XG + XG_BYTES : WS_GEND + (size_t)BATCH * 4 * NCH * 64 * 4;

constexpr int CW_MOECNT = 64;
constexpr int CW_MOECUR = 128;
constexpr int CW_ATTQ = 192;
constexpr int CW_SPLIT = 256;
constexpr int CW_BAR = 1024;

__device__ __forceinline__ float bf2f(bf16 v) { return __builtin_bit_cast(float, (unsigned)v << 16); }
typedef __bf16 bf16x2_hw __attribute__((ext_vector_type(2)));
__device__ __forceinline__ unsigned pk2(float lo, float hi) { const f32x2 v = {lo, hi}; return __builtin_bit_cast(unsigned, __builtin_convertvector(v, bf16x2_hw)); }
__device__ __forceinline__ unsigned f2bf(float f) { return pk2(f, 0.f) & 0xffffu; }
__device__ __forceinline__ float lo2f(unsigned w) { return __builtin_bit_cast(float, w << 16); }
__device__ __forceinline__ float hi2f(unsigned w) { return __builtin_bit_cast(float, w & 0xffff0000u); }
__device__ __forceinline__ float sigmoidf_(float x) { return __builtin_amdgcn_rcpf(1.0f + __expf(-x)); }
__device__ __forceinline__ float siluf_(float x) { return x * __builtin_amdgcn_rcpf(1.0f + __expf(-x)); }
__device__ __forceinline__ float tanhf_(float x) { return 2.0f * __builtin_amdgcn_rcpf(1.0f + __expf(-2.0f * x)) - 1.0f; }
__device__ __forceinline__ float softplusf_(float x) { return x > 20.f ? x : __logf(1.0f + __expf(x)); }
template <int CTRL, int ROWMASK = 0xF, bool BOUND = true> __device__ __forceinline__ float dpp_f(float x) { return __builtin_bit_cast(float, __builtin_amdgcn_update_dpp(0, __builtin_bit_cast(int, x), CTRL, ROWMASK, 0xF, BOUND)); }
__device__ __forceinline__ float red8_sum(float x) { x += dpp_f<0xB1>(x); x += dpp_f<0x4E>(x); x += dpp_f<0x141>(x); return x; }
__device__ __forceinline__ float red16_sum(float x) { x = red8_sum(x); x += dpp_f<0x140>(x); return x; }
__device__ __forceinline__ float scan16(float x) { x += dpp_f<0x111>(x); x += dpp_f<0x112>(x); x += dpp_f<0x114>(x); x += dpp_f<0x118>(x); return x; }
__device__ __forceinline__ float scan32(float x) { x = scan16(x); x += dpp_f<0x142, 0xA, false>(x); return x; }
__device__ __forceinline__ float scan64(float x) { x = scan32(x); x += dpp_f<0x143, 0xC, false>(x); return x; }
__device__ __forceinline__ float xrows_sum(float v) { const int x = __builtin_bit_cast(int, v); const auto a = __builtin_amdgcn_permlane16_swap(x, x, false, false); v = __builtin_bit_cast(float, (int)a[0]) + __builtin_bit_cast(float, (int)a[1]);
    const int y = __builtin_bit_cast(int, v); const auto b = __builtin_amdgcn_permlane32_swap(y, y, false, false); return __builtin_bit_cast(float, (int)b[0]) + __builtin_bit_cast(float, (int)b[1]); }
__device__ __forceinline__ float xrows_max(float v) { const int x = __builtin_bit_cast(int, v); const auto a = __builtin_amdgcn_permlane16_swap(x, x, false, false); v = fmaxf(__builtin_bit_cast(float, (int)a[0]), __builtin_bit_cast(float, (int)a[1]));
    const int y = __builtin_bit_cast(int, v); const auto b = __builtin_amdgcn_permlane32_swap(y, y, false, false); return fmaxf(__builtin_bit_cast(float, (int)b[0]), __builtin_bit_cast(float, (int)b[1])); }
__device__ __forceinline__ float wave_sum(float v) { return xrows_sum(red16_sum(v)); }
__device__ __forceinline__ int opq_v(int x) { asm volatile("" : "+v"(x)); return x; }
__device__ __forceinline__ int opq_s(int x) { asm volatile("" : "+s"(x)); return x; }
__device__ __forceinline__ float rdlane(float v, int l) { return __builtin_bit_cast(float, __builtin_amdgcn_readlane(__builtin_bit_cast(int, v), l)); }

namespace pg8 {
constexpr int BM = 256, BK = 64, HALF = 128, HTB = HALF * BK * 2, STAGE_BYTES = 8 * HTB, NXCD = 8, WGM = 8;
__host__ __device__ __forceinline__ int lds_byte(int r, int c) { const int st = (r >> 4) * 2 + (c >> 5), rr = r & 15, cc = c & 31, ob = rr * 64 + cc * 2; return st * 1024 + (ob ^ (((ob >> 9) & 1) << 5)); }
__host__ __device__ __forceinline__ void stage_rc(int b, int& R, int& C) { const int st = b / 1024, sb = b % 1024, swz = sb ^ (((sb >> 9) & 1) << 5); R = (st >> 1) * 16 + swz / 64; C = (st & 1) * 32 + (swz % 64) / 2; }
__host__ __device__ __forceinline__ int perm32(int rho) { const int n = rho >> 4, i = rho & 15; return 8 * (i >> 2) + 4 * n + (i & 3); }

typedef int v4i __attribute__((ext_vector_type(4)));
typedef int v8i __attribute__((ext_vector_type(8)));
struct Unit { int pm, pn, e, kq; };
struct Gemm { int lda, ldb, K; };

struct StaticOrder {
    static constexpr bool VARNT = false;
    const char* A; const char* Bt; size_t tstepA, tstepB;
    int nM, nN, nwg, G, c;
    __device__ __forceinline__ void init(const void* A_, const void* Bt_, int lda, int ldb, int M, int N, int G_, int c_) { A = (const char*)A_; Bt = (const char*)Bt_; tstepA = (size_t)BM * lda * 2; tstepB = (size_t)BM * ldb * 2; nM = M / BM; nN = N / BM; nwg = nM * nN; G = G_; c = c_; }
    __device__ __forceinline__ bool next(int i, Unit& u) const {
        const long L = (long)i * G + c; if (L >= nwg) return false;
        int wgid = (int)L; { const int q = nwg / NXCD, r = nwg % NXCD, xcd = wgid % NXCD, off = wgid / NXCD; wgid = (xcd < r ? xcd * (q + 1) : r * (q + 1) + (xcd - r) * q) + off; }
        const int nig = WGM * nN, gid = wgid / nig, fm = gid * WGM, gsz = (nM - fm) < WGM ? (nM - fm) : WGM;
        u.pm = fm + ((wgid % nig) % gsz); u.pn = (wgid % nig) / gsz; u.e = 0; return true;
    }
    __device__ __forceinline__ const char* a_ptr(const Unit& u) const { return A + (size_t)u.pm * tstepA; }
    __device__ __forceinline__ const char* b_ptr(const Unit& u) const { return Bt + (size_t)u.pn * tstepB; }
};

typedef __bf16 bf16x2_t __attribute__((ext_vector_type(2)));
__device__ __forceinline__ unsigned cvt_pk_bf16(float lo, float hi) { const f32x2 v = {lo, hi}; return __builtin_bit_cast(unsigned, __builtin_convertvector(v, bf16x2_t)); }

template <class Epi, class Sched>
__device__ __forceinline__ void gemm_phase(LAS unsigned char* lds, const Gemm g, const Sched& S, const Epi& E) {
    const int tid = opq_v((int)threadIdx.x), wid = __builtin_amdgcn_readfirstlane(tid >> 6), lane = tid & 63, wr = wid >> 2, wc = wid & 3, fr = lane & 15, fq = lane >> 4;
    const int nt = opq_s(g.K / BK);
    unsigned voffA[2], voffB[2];
#pragma unroll
    for (int i = 0; i < 2; ++i) { int R, C; stage_rc(tid * 16 + i * 8192, R, C); const int Rb = Epi::PERM ? ((R & ~31) + perm32(R & 31)) : R;
        voffA[i] = (unsigned)(R * g.lda + C) * 2u; voffB[i] = (unsigned)(Rb * g.ldb + C) * 2u; }
    const size_t kstep = (size_t)(BK * 2);
    const size_t hstepA = (size_t)HALF * g.lda * 2, hstepB = (size_t)HALF * g.ldb * 2;
    const unsigned ldsw = (unsigned)wid * 1024u;
    const int aoff = lds_byte(wr * 64 + fr, fq * 8), boff = lds_byte(wc * 32 + fr, fq * 8);
#define PG8_SA(b, h) (((b) * 2 + (h)) * HTB)
#define PG8_SB(b, h) ((4 + (b) * 2 + (h)) * HTB)
#define PG8_STAGE(bufoff, gbase, voff) do { _Pragma("unroll") for (int _i = 0; _i < 2; ++_i) \
        __builtin_amdgcn_global_load_lds((const unsigned*)((const char*)(gbase) + (voff)[_i]), (LAS unsigned*)(lds + (bufoff) + ldsw + _i * 8192), 16, 0, 0); } while (0)
#define PG8_LDA(dst, b, h) do { _Pragma("unroll") for (int m = 0; m < 4; ++m) { if constexpr (Epi::F8) { const v4i lo_ = *(const LAS v4i*)(lds + PG8_SA(b, h) + aoff + m * 2048), hi_ = *(const LAS v4i*)(lds + PG8_SA(b, h) + aoff + m * 2048 + 1024); \
            dst##8[m] = __builtin_shufflevector(lo_, hi_, 0, 1, 2, 3, 4, 5, 6, 7); } else { _Pragma("unroll") for (int k = 0; k < 2; ++k) dst[m][k] = *(const LAS bf16x8*)(lds + PG8_SA(b, h) + aoff + m * 2048 + k * 1024); } } } while (0)
#define PG8_LDB(dst, b, h) do { _Pragma("unroll") for (int n = 0; n < 2; ++n) { if constexpr (Epi::F8) { const v4i lo_ = *(const LAS v4i*)(lds + PG8_SB(b, h) + boff + n * 2048), hi_ = *(const LAS v4i*)(lds + PG8_SB(b, h) + boff + n * 2048 + 1024); \
            dst##8[n] = __builtin_shufflevector(lo_, hi_, 0, 1, 2, 3, 4, 5, 6, 7); } else { _Pragma("unroll") for (int k = 0; k < 2; ++k) dst[n][k] = *(const LAS bf16x8*)(lds + PG8_SB(b, h) + boff + n * 2048 + k * 1024); } } } while (0)
#define PG8_MMA(ai, bj, At, Bt) do { __builtin_amdgcn_s_setprio(1); _Pragma("unroll") for (int m = 0; m < 4; ++m) _Pragma("unroll") for (int n = 0; n < 2; ++n) { \
        if constexpr (Epi::F8) asm volatile("v_mfma_scale_f32_16x16x128_f8f6f4 %0, %1, %2, %0, %3, %3 op_sel_hi:[0,0,0]" : "+v"(acc[ai][bj][m][n]) : "v"(Bt##8[n]), "v"(At##8[m]), "v"(f8scale));   \
        else { _Pragma("unroll") for (int k = 0; k < 2; ++k) acc[ai][bj][m][n] = __builtin_amdgcn_mfma_f32_16x16x32_bf16(Bt[n][k], At[m][k], acc[ai][bj][m][n], 0, 0, 0); } } \
        __builtin_amdgcn_s_setprio(0); } while (0)
#define PG8_WAIT_V(n) asm volatile("s_waitcnt vmcnt(" #n ")" ::: "memory")
#define PG8_WAIT_L(n) asm volatile("s_waitcnt lgkmcnt(" #n ")" ::: "memory")
#define PG8_BAR __builtin_amdgcn_s_barrier()
#define PG8_SCHED __builtin_amdgcn_sched_barrier(0)
    Unit cur, nxt; int ui = 0;
    if (!S.next(0, cur)) return;
    f32x4 acc[2][2][4][2];
#pragma unroll
    for (int a = 0; a < 2; ++a)
#pragma unroll
        for (int b = 0; b < 2; ++b)
#pragma unroll
            for (int m = 0; m < 4; ++m)
#pragma unroll
                for (int n = 0; n < 2; ++n) acc[a][b][m][n] = (f32x4){0.f, 0.f, 0.f, 0.f};
    const int f8scale = opq_v(0x7f7f7f7f);
    bf16x8 At[4][2], B0[2][2], B1[2][2]; v8i At8[4], B08[2], B18[2];
    const char* cA = S.a_ptr(cur); const char* cB = S.b_ptr(cur);
    PG8_STAGE(PG8_SB(0, 0), cB, voffB); PG8_STAGE(PG8_SB(0, 1), cB + hstepB, voffB); PG8_STAGE(PG8_SA(0, 0), cA, voffA); PG8_STAGE(PG8_SA(0, 1), cA + hstepA, voffA);
    if (wr == 1) PG8_BAR;
    PG8_WAIT_V(2); PG8_BAR;
    PG8_STAGE(PG8_SB(1, 0), cB + kstep, voffB); PG8_STAGE(PG8_SA(1, 0), cA + kstep, voffA); PG8_STAGE(PG8_SB(1, 1), cB + hstepB + kstep, voffB);
    PG8_WAIT_V(6); PG8_BAR;
    for (;;) {
        const bool has_next = S.next(ui + 1, nxt);
        int ntc = nt; if constexpr (Sched::VARNT) ntc = opq_s(S.nt_of(cur));
        const char* nA = has_next ? S.a_ptr(nxt) : cA; const char* nB = has_next ? S.b_ptr(nxt) : cB;
#pragma unroll 1
        for (int t = 0; t < ntc; t += 2) {
            const bool last = (t == ntc - 2);
            const char* a1 = cA + (size_t)(t + 1) * kstep;
            const char* a2 = last ? nA : cA + (size_t)(t + 2) * kstep; const char* b2 = last ? nB : cB + (size_t)(t + 2) * kstep;
            const char* a3 = a2 + kstep; const char* b3 = b2 + kstep;
            PG8_LDB(B0, 0, 0); PG8_LDB(B1, 0, 1); PG8_SCHED; PG8_LDA(At, 0, 0); PG8_STAGE(PG8_SA(1, 1), a1 + hstepA, voffA);
            PG8_WAIT_V(8); PG8_WAIT_L(0); PG8_BAR; PG8_MMA(0, 0, At, B0); PG8_MMA(0, 1, At, B1); PG8_BAR; PG8_SCHED;
            PG8_LDA(At, 0, 1); PG8_STAGE(PG8_SB(0, 0), b2, voffB); PG8_STAGE(PG8_SB(0, 1), b2 + hstepB, voffB); PG8_STAGE(PG8_SA(0, 0), a2, voffA);
            PG8_WAIT_V(8); PG8_WAIT_L(0); PG8_BAR; PG8_MMA(1, 0, At, B0); PG8_MMA(1, 1, At, B1); PG8_BAR; PG8_SCHED;
            PG8_LDB(B0, 1, 0); PG8_LDB(B1, 1, 1); PG8_SCHED; PG8_LDA(At, 1, 0); PG8_STAGE(PG8_SA(0, 1), a2 + hstepA, voffA);
            PG8_WAIT_V(8); PG8_WAIT_L(0); PG8_BAR; PG8_MMA(0, 0, At, B0); PG8_MMA(0, 1, At, B1); PG8_BAR; PG8_SCHED;
            PG8_LDA(At, 1, 1); PG8_STAGE(PG8_SB(1, 0), b3, voffB); PG8_STAGE(PG8_SB(1, 1), b3 + hstepB, voffB); PG8_STAGE(PG8_SA(1, 0), a3, voffA);
            PG8_WAIT_V(8); PG8_WAIT_L(0); PG8_BAR; PG8_MMA(1, 0, At, B0); PG8_MMA(1, 1, At, B1); PG8_BAR; PG8_SCHED;
        }
        if (wr == 0) PG8_BAR;
        if constexpr (Epi::F8) asm volatile("s_nop 15\n\ts_nop 15" ::: "memory");
        E(acc, cur, wr, wc, fr, fq);
        if (!has_next) break;
        if constexpr (!Epi::CHAIN) {
#pragma unroll
        for (int a = 0; a < 2; ++a)
#pragma unroll
            for (int b = 0; b < 2; ++b)
#pragma unroll
                for (int m = 0; m < 4; ++m)
#pragma unroll
                    for (int n = 0; n < 2; ++n) acc[a][b][m][n] = (f32x4){0.f, 0.f, 0.f, 0.f};
        }
        cur = nxt; cA = nA; cB = nB; ++ui;
        if (wr == 1) PG8_BAR;
    }
    PG8_WAIT_V(0);
    PG8_BAR;
#undef PG8_SA
#undef PG8_SB
#undef PG8_STAGE
#undef PG8_LDA
#undef PG8_LDB
#undef PG8_MMA
#undef PG8_WAIT_V
#undef PG8_WAIT_L
#undef PG8_BAR
#undef PG8_SCHED
}
}

using pg8::Unit;
__device__ __forceinline__ u32x4 pack8(f32x4 v0, f32x4 v1) { u32x4 w; w.x = pg8::cvt_pk_bf16(v0[0], v0[1]); w.y = pg8::cvt_pk_bf16(v0[2], v0[3]); w.z = pg8::cvt_pk_bf16(v1[0], v1[1]); w.w = pg8::cvt_pk_bf16(v1[2], v1[3]); return w; }
__device__ __forceinline__ f32x4 sig4(f32x4 v) { return (f32x4){sigmoidf_(v[0]), sigmoidf_(v[1]), sigmoidf_(v[2]), sigmoidf_(v[3])}; }
__device__ __forceinline__ void unpack8(u32x4 w, f32x4& a, f32x4& b) { a = (f32x4){lo2f(w.x), hi2f(w.x), lo2f(w.y), hi2f(w.y)}; b = (f32x4){lo2f(w.z), hi2f(w.z), lo2f(w.w), hi2f(w.w)}; }

__device__ __forceinline__ void rs8_from_parts(const float* ss, int row0, int fq, float (&rs)[2][4]) {
    f32x4 p[2][4];
#pragma unroll
    for (int ai = 0; ai < 2; ++ai)
#pragma unroll
        for (int m = 0; m < 4; ++m) p[ai][m] = *(const f32x4*)(ss + (size_t)(row0 + ai * 128 + m * 16) * 16 + 4 * fq);
#pragma unroll
    for (int ai = 0; ai < 2; ++ai)
#pragma unroll
        for (int m = 0; m < 4; ++m) { float t = (p[ai][m][0] + p[ai][m][1]) + (p[ai][m][2] + p[ai][m][3]); t = xrows_sum(t); rs[ai][m] = __builtin_amdgcn_rsqf(t * (1.0f / DM) + NORM_EPS); }
}
template <int ACT> struct EpiScaleBf16 {
    static constexpr bool PERM = true, CHAIN = false, F8 = false;
    bf16* O; int ldc; const float* ss;
    __device__ __forceinline__ void operator()(f32x4 (&acc)[2][2][4][2], const Unit& u, int wr, int wc, int fr, int fq) const {
        const int row0 = u.pm * 256 + wr * 64 + fr, col0 = u.pn * 256 + wc * 32 + 8 * fq;
        float rs[2][4]; rs8_from_parts(ss, row0, fq, rs);
#pragma unroll
        for (int ai = 0; ai < 2; ++ai)
#pragma unroll
            for (int m = 0; m < 4; ++m) { const int row = row0 + ai * 128 + m * 16; const float s = rs[ai][m];
                bf16* rowp = O + (size_t)row * ldc + col0;
#pragma unroll
                for (int bj = 0; bj < 2; ++bj) { f32x4 v0 = acc[ai][bj][m][0] * s, v1 = acc[ai][bj][m][1] * s;
                    if (ACT == 1) { v0 = sig4(v0); v1 = sig4(v1); }
                    *(u32x4*)(rowp + bj * 128) = pack8(v0, v1); }
                asm volatile("" ::: "memory"); }
    }
};
struct EpiGateRatio {
    static constexpr bool PERM = true, CHAIN = false, F8 = false;
    bf16* O; const float* ss;
    __device__ __forceinline__ void operator()(const f32x4 (&acc)[2][2][4][2], const Unit& u, int wr, int wc, int fr, int fq) const {
        const int row0 = u.pm * 256 + wr * 64 + fr, c0 = u.pn * 64 + wc * 16 + 4 * fq;
        float rs[2][4]; rs8_from_parts(ss, row0, fq, rs);
#pragma unroll
        for (int ai = 0; ai < 2; ++ai)
#pragma unroll
            for (int m = 0; m < 4; ++m) { const int row = row0 + ai * 128 + m * 16; const float s = rs[ai][m];
                f32x4 g[4];
#pragma unroll
                for (int i = 0; i < 4; ++i) { g[i] = sig4(acc[ai][i >> 1][m][i & 1] * s);
#pragma unroll
                    for (int j = 0; j < 4; ++j) g[i][j] = fmaxf(g[i][j], 1e-30f); }
                bf16* rowp = O + (size_t)row * 4096 + c0;
#pragma unroll
                for (int i = 0; i < 4; ++i) { f32x4 r = g[i];
                    if (i < 3) {
#pragma unroll
                        for (int j = 0; j < 4; ++j) r[j] = g[i][j] * __builtin_amdgcn_rcpf(g[i + 1][j]); }
                    u32x2 w; w.x = pg8::cvt_pk_bf16(r[0], r[1]); w.y = pg8::cvt_pk_bf16(r[2], r[3]); *(u32x2*)(rowp + i * 1024) = w; }
                asm volatile("" ::: "memory"); }
    }
};
template <bool MOE, bool F8_ = MOE> struct EpiSwiglu {
    static constexpr bool PERM = true, CHAIN = false, F8 = F8_;
    bf16* O; int ldc; const float* rsrc;
    __device__ __forceinline__ void operator()(f32x4 (&acc)[2][2][4][2], const Unit& u, int wr, int wc, int fr, int fq) const {
        const int row0 = u.pm * 256 + wr * 64 + fr, col0 = u.pn * 128 + wc * 32 + 8 * fq;
        float rs[2][4];
        if (MOE) {
#pragma unroll
            for (int ai = 0; ai < 2; ++ai)
#pragma unroll
                for (int m = 0; m < 4; ++m) rs[ai][m] = rsrc[row0 + ai * 128 + m * 16]; }
        else rs8_from_parts(rsrc, row0, fq, rs);
        if (F8) {
#pragma unroll
            for (int ai = 0; ai < 2; ++ai)
#pragma unroll
                for (int m = 0; m < 4; ++m) rs[ai][m] *= (1.0f / 32.0f); }
#pragma unroll
        for (int ai = 0; ai < 2; ++ai)
#pragma unroll
            for (int m = 0; m < 4; ++m) { const int row = row0 + ai * 128 + m * 16; const float s = rs[ai][m];
                f32x4 o[2];
#pragma unroll
                for (int n = 0; n < 2; ++n) { const f32x4 ar = acc[ai][0][m][n], br = acc[ai][1][m][n]; const float ks = s * -1.44269504f, s2 = s * s;
#pragma unroll
                    for (int j = 0; j < 4; ++j) o[n][j] = (ar[j] * br[j]) * (s2 * __builtin_amdgcn_rcpf(1.0f + __builtin_amdgcn_exp2f(ar[j] * ks))); }
                if constexpr (F8) { u32x2 w8; int t0_ = 0, t1_ = 0; t0_ = __builtin_amdgcn_cvt_pk_fp8_f32(o[0][0], o[0][1], t0_, false); t0_ = __builtin_amdgcn_cvt_pk_fp8_f32(o[0][2], o[0][3], t0_, true);
                    t1_ = __builtin_amdgcn_cvt_pk_fp8_f32(o[1][0], o[1][1], t1_, false); t1_ = __builtin_amdgcn_cvt_pk_fp8_f32(o[1][2], o[1][3], t1_, true); w8.x = (unsigned)t0_; w8.y = (unsigned)t1_;
                    *(u32x2*)((unsigned char*)O + (size_t)row * ldc + col0) = w8; }
                else *(u32x4*)(O + (size_t)row * ldc + col0) = pack8(o[0], o[1]);
                asm volatile("" ::: "memory"); }
    }
};
template <bool F8_ = false> struct EpiResid {
    static constexpr bool PERM = false, CHAIN = false, F8 = F8_;
    const float* xin; float* out; bf16* xb; float* ss; unsigned char* xb8;
    __device__ __forceinline__ void operator()(f32x4 (&acc)[2][2][4][2], const Unit& u, int wr, int wc, int fr, int fq) const {
        const int row0 = u.pm * 256 + wr * 64 + fr, col0 = u.pn * 256 + wc * 32 + 4 * fq;
#pragma unroll
        for (int ai = 0; ai < 2; ++ai)
#pragma unroll
            for (int m = 0; m < 4; ++m) { const int row = row0 + ai * 128 + m * 16; const size_t off = (size_t)row * DM + col0; float q = 0.f;
#pragma unroll
                for (int bj = 0; bj < 2; ++bj)
#pragma unroll
                    for (int n = 0; n < 2; ++n) { const f32x4 xi = *(const f32x4*)(xin + off + bj * 128 + n * 16); const f32x4 v = F8 ? xi + acc[ai][bj][m][n] * (1.0f / 64.0f) : xi + acc[ai][bj][m][n];
                        *(f32x4*)(out + off + bj * 128 + n * 16) = v; u32x2 w; w.x = pg8::cvt_pk_bf16(v[0], v[1]); w.y = pg8::cvt_pk_bf16(v[2], v[3]);
                        *(u32x2*)(xb + off + bj * 128 + n * 16) = w;
                        if (xb8) { int t8 = 0; t8 = __builtin_amdgcn_cvt_pk_fp8_f32(v[0], v[1], t8, false); t8 = __builtin_amdgcn_cvt_pk_fp8_f32(v[2], v[3], t8, true); *(int*)(xb8 + off + bj * 128 + n * 16) = t8; }
                        q += (v[0] * v[0] + v[1] * v[1]) + (v[2] * v[2] + v[3] * v[3]); }
                q = xrows_sum(q);
                if (fq == 0 && ss) ss[(size_t)row * 16 + u.pn * 4 + wc] = q;
                if (m & 1) asm volatile("" ::: "memory"); }
    }
};
struct EpiMix {
    static constexpr bool PERM = true, CHAIN = true, F8 = false;
    const bf16* gates; bf16* mixed;
    __device__ __forceinline__ void operator()(f32x4 (&acc)[2][2][4][2], const Unit& u, int wr, int wc, int fr, int fq) const {
        const int row0 = u.pm * 256 + wr * 64 + fr, col0 = u.pn * 256 + wc * 32 + 8 * fq; const int i = u.e;
#pragma unroll
        for (int ai = 0; ai < 2; ++ai)
#pragma unroll
            for (int m = 0; m < 4; ++m) { const int row = row0 + ai * 128 + m * 16;
#pragma unroll
                for (int bj = 0; bj < 2; ++bj) { const bf16* gp = gates + (size_t)row * 4096 + i * 1024 + col0 + bj * 128;
                    f32x4 r0, r1; unpack8(*(const u32x4*)gp, r0, r1);
                    if (i < 3) { acc[ai][bj][m][0] = acc[ai][bj][m][0] * r0; acc[ai][bj][m][1] = acc[ai][bj][m][1] * r1; }
                    else {
                        *(u32x4*)(mixed + (size_t)row * DM + col0 + bj * 128) = pack8(acc[ai][bj][m][0] * r0, acc[ai][bj][m][1] * r1);
                        acc[ai][bj][m][0] = (f32x4){0.f, 0.f, 0.f, 0.f}; acc[ai][bj][m][1] = (f32x4){0.f, 0.f, 0.f, 0.f};
                    } } }
    }
};
struct MixOrder {
    static constexpr bool VARNT = false;
    const char* O; const char* Wb; int G, c;
    __device__ __forceinline__ bool next(int i, Unit& u) const {
        const int grp = (i >> 2) * G + c; if (grp >= 256) return false;
        int wgid = grp; { const int xcd = wgid % 8, off = wgid / 8; wgid = xcd * 32 + off; }
        const int nig = 8 * 4, gid = wgid / nig; u.pm = gid * 8 + ((wgid % nig) % 8); u.pn = (wgid % nig) / 8; u.e = i & 3; return true;
    }
    __device__ __forceinline__ const char* a_ptr(const Unit& u) const { return O + ((size_t)u.pm * 256 * 2048 + (size_t)u.e * 512) * 2; }
    __device__ __forceinline__ const char* b_ptr(const Unit& u) const { return Wb + ((size_t)u.e * DM * 512 + (size_t)u.pn * 256 * 512) * 2; }
};
struct MoeOrder {
    static constexpr bool VARNT = false;
    const char* A; const char* Bt; size_t tstepA, tstepB, estepB; int nN, ntiles, G, c;
    int te0, te1, te2, te3, te4, te5, te6;
    __device__ __forceinline__ void init(const void* A_, int lda, const void* Bt_, int ldb, size_t estepB_, int nN_, const unsigned* cnt, int G_, int c_) {
        A = (const char*)A_; Bt = (const char*)Bt_; tstepA = (size_t)256 * lda * 2; tstepB = (size_t)256 * ldb * 2; estepB = estepB_; nN = nN_; G = G_; c = c_;
        int acc = 0; acc += (int)((cnt[0] + 255u) >> 8); te0 = acc; acc += (int)((cnt[1] + 255u) >> 8); te1 = acc; acc += (int)((cnt[2] + 255u) >> 8); te2 = acc; acc += (int)((cnt[3] + 255u) >> 8); te3 = acc;
        acc += (int)((cnt[4] + 255u) >> 8); te4 = acc; acc += (int)((cnt[5] + 255u) >> 8); te5 = acc; acc += (int)((cnt[6] + 255u) >> 8); te6 = acc; acc += (int)((cnt[7] + 255u) >> 8); ntiles = acc;
    }
    __device__ __forceinline__ bool next(int i, Unit& u) const {
        const long L = (long)i * G + c; if (L >= (long)ntiles * nN) return false;
        const int mt = (int)(L / nN); u.pm = mt; u.pn = (int)(L % nN);
        u.e = (mt >= te0) + (mt >= te1) + (mt >= te2) + (mt >= te3) + (mt >= te4) + (mt >= te5) + (mt >= te6); return true;
    }
    __device__ __forceinline__ const char* a_ptr(const Unit& u) const { return A + (size_t)u.pm * tstepA; }
    __device__ __forceinline__ const char* b_ptr(const Unit& u) const { return Bt + (size_t)u.e * estepB + (size_t)u.pn * tstepB; }
};

constexpr int MD_KSPLIT = 7, MD_KTILES = 4;
struct MoeDownOrder {
    static constexpr bool VARNT = true;
    const char* A; const char* Bt; size_t tstepA, tstepB, estepB; int G, c, nsplit, nfull4;
    int tb[8], fe[8];
    unsigned pmask;
    __device__ __forceinline__ void init(const void* A_, int lda, const void* Bt_, int ldb, size_t estepB_, const unsigned* cnt, int G_, int c_) {
        A = (const char*)A_; Bt = (const char*)Bt_; tstepA = (size_t)256 * lda * 2; tstepB = (size_t)256 * ldb * 2; estepB = estepB_; G = G_; c = c_;
        int acc = 0, np = 0, nf = 0; pmask = 0u;
#pragma unroll
        for (int e = 0; e < 8; ++e) { tb[e] = acc; fe[e] = (int)(cnt[e] >> 8); const int p = (cnt[e] & 255u) ? 1 : 0; pmask |= (unsigned)p << e; acc += fe[e] + p; np += p; nf += fe[e]; }
        nsplit = np * 4 * MD_KSPLIT; nfull4 = nf * 4;
    }
    __device__ __forceinline__ bool next(int i, Unit& u) const {
        const long L = (long)i * G + c; if (L >= (long)nsplit + nfull4) return false;
        if (L < nsplit) { const int sidx = (int)L, pi = sidx / (4 * MD_KSPLIT), w = sidx - pi * (4 * MD_KSPLIT); u.pn = w / MD_KSPLIT; u.kq = w - u.pn * MD_KSPLIT;
            int e = 0, seen = 0;
#pragma unroll
            for (int q = 0; q < 8; ++q) { const int has = (int)((pmask >> q) & 1u); if (has && seen == pi) e = q; seen += has; }
            int tbe = 0, fee = 0;
#pragma unroll
            for (int q = 0; q < 8; ++q) { tbe = (e == q) ? tb[q] : tbe; fee = (e == q) ? fe[q] : fee; }
            u.e = e; u.pm = tbe + fee; u.kq |= pi << 8; }
        else { const int f = (int)L - nsplit, ft = f >> 2; u.pn = f & 3; u.kq = -1; int e = 0, rem = ft, pm = 0, done = 0;
#pragma unroll
            for (int q = 0; q < 8; ++q) { if (!done) { if (rem < fe[q]) { e = q; pm = tb[q] + rem; done = 1; } else rem -= fe[q]; } }
            u.e = e; u.pm = pm; }
        return true;
    }
    __device__ __forceinline__ int nt_of(const Unit& u) const { return u.kq < 0 ? MD_KSPLIT * MD_KTILES : MD_KTILES; }
    __device__ __forceinline__ const char* a_ptr(const Unit& u) const { return A + (size_t)u.pm * tstepA + (u.kq < 0 ? (size_t)0 : (size_t)(u.kq & 255) * (MD_KTILES * 128)); }
    __device__ __forceinline__ const char* b_ptr(const Unit& u) const { return Bt + (size_t)u.e * estepB + (size_t)u.pn * tstepB + (u.kq < 0 ? (size_t)0 : (size_t)(u.kq & 255) * (MD_KTILES * 128)); }
};
struct EpiMoeDownSplit {
    static constexpr bool PERM = true, CHAIN = false, F8 = true;
    bf16* Y; bf16* Yp; const float* rgate;
    __device__ __forceinline__ void operator()(f32x4 (&acc)[2][2][4][2], const Unit& u, int wr, int wc, int fr, int fq) const {
        const int rl0 = wr * 64 + fr, col0 = u.pn * 256 + wc * 32 + 8 * fq;
        bf16* dst = (u.kq < 0) ? Y + (size_t)u.pm * 256 * DM : Yp + ((size_t)(u.kq & 255) * (8 * 256) + (size_t)(u.kq >> 8) * 256) * DM;
#pragma unroll
        for (int ai = 0; ai < 2; ++ai)
#pragma unroll
            for (int m = 0; m < 4; ++m) { const int rl = rl0 + ai * 128 + m * 16; const float s = rgate[u.pm * 256 + rl] * (1.0f / 64.0f);
#pragma unroll
                for (int bj = 0; bj < 2; ++bj) *(u32x4*)(dst + (size_t)rl * DM + col0 + bj * 128) = pack8(acc[ai][bj][m][0] * s, acc[ai][bj][m][1] * s); }
    }
};

enum { I_X = 0, I_WIN, I_NORM_MIX, I_RW_MU, I_RW_DECAY_UP, I_RW_W0, I_RW_A_UP, I_RW_A0, I_RW_GATE_UP, I_RW_KK, I_RW_KA, I_RW_RK, I_RW_LNW, I_RW_LNB,
       I_VRES_DOWN, I_VRES_UP, I_VRES_V0, I_SSM_CONVW, I_SSM_CONVB, I_SSM_DTB, I_SSM_ALOG, I_SSM_D, I_SSM_NORMW, I_ATT_QG, I_ATT_KG, I_ATT_BIAS,
       I_GLA_GUP, I_GLA_GB, I_GLA_NW, I_WBRANCH, I_WOUT, I_NORM_FFN, I_FFN_W1, I_FFN_W3, I_FFN_W2, I_MOE_ROUTER, I_MOE_W1, I_MOE_W3, I_MOE_W2, N_IN };
struct Args { const float* in[N_IN]; float* out; unsigned char* ws; };
static_assert(sizeof(Args) == (N_IN + 2) * 8, "Args has no padding");

struct PT { const LAS unsigned long long* tab;
    __device__ __forceinline__ const float* operator[](int i) const { const unsigned long long v = tab[i];
        const unsigned lo = __builtin_amdgcn_readfirstlane((unsigned)v), hi = __builtin_amdgcn_readfirstlane((unsigned)(v >> 32)); return (const float*)(const __attribute__((address_space(1))) float*)(((unsigned long long)hi << 32) | lo); } };
struct ArgsD { PT in;
    __device__ __forceinline__ float* out() const { return (float*)in[N_IN]; }
    __device__ __forceinline__ unsigned char* ws() const { return (unsigned char*)in[N_IN + 1]; } };
constexpr int NWAVES = 8, NTHREADS = 512;
constexpr int LDS_MAIN = 131072;
constexpr int LDS_CTL_OFF = LDS_MAIN;
constexpr int LDS_BYTES = LDS_MAIN + 1024;

template <bool GPERM = false> __device__ __forceinline__ void cvt_item(const float* __restrict__ W, int ld, int k0, int csrc, int ncv, const float* __restrict__ gs, bf16* dst, int dstK, int drow, LAS float* scr, int lane) {
    const int lc = (lane < ncv) ? lane : ncv - 1;
    const float* wp = W + (size_t)k0 * ld + csrc + lc;
#pragma unroll
    for (int kb = 0; kb < 64; kb += 16) { float v[16];
#pragma unroll
        for (int j = 0; j < 16; ++j) v[j] = __builtin_nontemporal_load(wp + (size_t)(kb + j) * ld);
#pragma unroll
        for (int j = 0; j < 16; ++j) scr[(kb + j) * 65 + lane] = v[j]; }
    asm volatile("s_waitcnt lgkmcnt(0)" ::: "memory");
    const int kc = lane & 7;
    f32x4 g0 = {1.f, 1.f, 1.f, 1.f}, g1 = g0; if (gs) { g0 = *(const f32x4*)(gs + k0 + 8 * kc); g1 = *(const f32x4*)(gs + k0 + 8 * kc + 4); }
#pragma unroll
    for (int i = 0; i < 8; ++i) { const int nn = (lane >> 3) + 8 * i; const LAS float* sp = scr + (8 * kc) * 65 + nn;
        u32x4 o; o.x = pk2(sp[0 * 65] * g0[0], sp[1 * 65] * g0[1]); o.y = pk2(sp[2 * 65] * g0[2], sp[3 * 65] * g0[3]); o.z = pk2(sp[4 * 65] * g1[0], sp[5 * 65] * g1[1]); o.w = pk2(sp[6 * 65] * g1[2], sp[7 * 65] * g1[3]);
        const int rr = GPERM ? 32 * ((nn >> 4) & 3) + 8 * ((nn >> 2) & 3) + (nn & 3) : nn;
        if (nn < ncv) *(u32x4*)(dst + (size_t)(drow + rr) * dstK + k0 + 8 * kc) = o; }
    asm volatile("s_waitcnt lgkmcnt(0)" ::: "memory");
}
__device__ __forceinline__ void cvt_item8(const float* __restrict__ W, int ld, int k0, int csrc, int ncv, const float* __restrict__ gs, float scale, unsigned char* dst, int dstK, int drow, LAS float* scr, int lane) {
    const int lc = (lane < ncv) ? lane : ncv - 1;
    const float* wp = W + (size_t)k0 * ld + csrc + lc;
#pragma unroll
    for (int kb = 0; kb < 64; kb += 16) { float v[16];
#pragma unroll
        for (int j = 0; j < 16; ++j) v[j] = __builtin_nontemporal_load(wp + (size_t)(kb + j) * ld);
#pragma unroll
        for (int j = 0; j < 16; ++j) scr[(kb + j) * 65 + lane] = v[j]; }
    asm volatile("s_waitcnt lgkmcnt(0)" ::: "memory");
    const int kc = lane & 3; float gg[16];
#pragma unroll
    for (int j = 0; j < 16; ++j) gg[j] = gs ? gs[k0 + 16 * kc + j] * scale : scale;
#pragma unroll
    for (int i = 0; i < 4; ++i) { const int nn = (lane >> 2) + 16 * i; const LAS float* sp = scr + (16 * kc) * 65 + nn; u32x4 o;
#pragma unroll
        for (int q = 0; q < 4; ++q) { int t = 0; t = __builtin_amdgcn_cvt_pk_fp8_f32(sp[(4 * q) * 65] * gg[4 * q], sp[(4 * q + 1) * 65] * gg[4 * q + 1], t, false); t = __builtin_amdgcn_cvt_pk_fp8_f32(sp[(4 * q + 2) * 65] * gg[4 * q + 2], sp[(4 * q + 3) * 65] * gg[4 * q + 3], t, true); o[q] = (unsigned)t; }
        if (nn < ncv) *(u32x4*)(dst + (size_t)(drow + nn) * dstK + k0 + 16 * kc) = o; }
    asm volatile("s_waitcnt lgkmcnt(0)" ::: "memory");
}
struct CvtCtx { int gw, ngw, base, lane; LAS float* scr; };
__device__ __forceinline__ void cvt_job_gates(CvtCtx& cx, const float* W, int ld, int K, int csrc0, const float* gs, bf16* dst) {
    const int nnb = 64, nit = (K >> 6) * nnb;
    int first = cx.gw - (cx.base % cx.ngw); if (first < 0) first += cx.ngw;
    for (int it = first; it < nit; it += cx.ngw) { const int kb = it / nnb, nb = it - kb * nnb, i = nb >> 4, cc = (nb & 15) * 64;
        cvt_item<true>(W, ld, kb * 64, csrc0 + nb * 64, 64, gs, dst, K, 256 * (cc >> 6) + 128 * (i >> 1) + 4 * (i & 1), cx.scr, cx.lane); }
    cx.base += nit;
}
__device__ __forceinline__ void cvt_job(CvtCtx& cx, const float* W, int ld, int K, int csrc0, int ncols, const float* gs, bf16* dst, int drow_base, int rs128) {
    const int nnb = (ncols + 63) >> 6, nit = (K >> 6) * nnb;
    int first = cx.gw - (cx.base % cx.ngw); if (first < 0) first += cx.ngw;
    for (int it = first; it < nit; it += cx.ngw) { const int kb = it / nnb, nb = it - kb * nnb, c = nb * 64; const int ncv = (ncols - c) < 64 ? (ncols - c) : 64;
        cvt_item(W, ld, kb * 64, csrc0 + c, ncv, gs, dst, K, drow_base + (c >> 7) * rs128 + (c & 127), cx.scr, cx.lane); }
    cx.base += nit;
}
__device__ __forceinline__ void cvt_job8(CvtCtx& cx, const float* W, int ld, int K, int csrc0, int ncols, const float* gs, float scale, unsigned char* dst, int drow_base, int rs128) {
    const int nnb = (ncols + 63) >> 6, nit = (K >> 6) * nnb;
    int first = cx.gw - (cx.base % cx.ngw); if (first < 0) first += cx.ngw;
    for (int it = first; it < nit; it += cx.ngw) { const int kb = it / nnb, nb = it - kb * nnb, c = nb * 64; const int ncv = (ncols - c) < 64 ? (ncols - c) : 64;
        cvt_item8(W, ld, kb * 64, csrc0 + c, ncv, gs, scale, dst, K, drow_base + (c >> 7) * rs128 + (c & 127), cx.scr, cx.lane); }
    cx.base += nit;
}
__device__ __forceinline__ void zero_rows_bf16(int gtid, int nthr, bf16* dst, size_t nelem) {
    u32x4 z = {0u, 0u, 0u, 0u};
    for (size_t i = (size_t)gtid * 8; i < nelem; i += (size_t)nthr * 8) *(u32x4*)(dst + i) = z;
}


__device__ __forceinline__ int rcol(int t, int rot) { return ((((t >> 3) + rot) & 7) << 3) + (t & 7); }
__device__ __forceinline__ int rcol4(int t, int rot) { return ((((t >> 3) + rot) & 3) << 3) + (t & 7); }
constexpr int AT_ST = 72;
constexpr int AT_KS = 0, AT_VT = AT_KS + 2 * 64 * AT_ST * 2, AT_KSC = AT_VT + 2 * 64 * AT_ST * 2, AT_BUFB = AT_KSC + 2 * 64 * 4, AT_BIAS = 2 * AT_BUFB, AT_END = AT_BIAS + 8 * 264 * 4;
__device__ __forceinline__ void attn_drain(const ArgsD& a, int l, LAS unsigned char* lds, LAS unsigned* lctl, unsigned* qctr, const bf16* z, bf16* o) {
    const int tid = opq_v((int)threadIdx.x), lane = tid & 63, wid = __builtin_amdgcn_readfirstlane(tid >> 6);
    const int hs = wid >> 2, qb = wid & 3, fr = lane & 15, g = lane >> 4, ql = 16 * qb + fr, row = tid >> 3, ch = tid & 7;
    constexpr unsigned NU = BATCH * NCH * 4;
    __syncthreads();
    { const float* rb = a.in[I_ATT_BIAS]; LAS float* ball = (LAS float*)(lds + AT_BIAS); float bv[5];
#pragma unroll
      for (int j = 0; j < 5; ++j) { const int i = tid + 512 * j; bv[j] = rb[i < 8 * 257 ? i : 0]; }
#pragma unroll
      for (int j = 0; j < 5; ++j) { const int i = tid + 512 * j; if (i < 8 * 257) { const int hh = i / 257; ball[hh * 264 + (i - hh * 257)] = bv[j] * 1.44269504f; } } }
    f32x4 gq[4];
    { const float* qgp = a.in[I_ATT_QG] + l * 64; const float* kgp = a.in[I_ATT_KG] + l * 64;
      gq[0] = *(const f32x4*)(qgp + 8 * g) * *(const f32x4*)(kgp + 8 * g); gq[1] = *(const f32x4*)(qgp + 8 * g + 4) * *(const f32x4*)(kgp + 8 * g + 4);
      gq[2] = *(const f32x4*)(qgp + 32 + 8 * g) * *(const f32x4*)(kgp + 32 + 8 * g); gq[3] = *(const f32x4*)(qgp + 36 + 8 * g) * *(const f32x4*)(kgp + 36 + 8 * g); }
    if (tid == 0) lctl[32] = atomicAdd(qctr, 1u);
    __syncthreads();
    unsigned q = lctl[32], par = 0, un = 0;
    u32x4 wk[2], wv[2], wq0, wq1;
#define AT_KVPTR(q_, j_) (z + ((size_t)((int)((q_) & 7u)) * SEQ + ((31 - (int)((q_) >> 5)) - 8 + (j_)) * 64 + row) * ZC + C_ATT + 512 + (2 * (int)(((q_) >> 3) & 3u)) * 64 + 8 * ch)
#define AT_LOADKV(p_) do { wk[0] = *(const u32x4*)(p_); wv[0] = *(const u32x4*)((p_) + 512); wk[1] = *(const u32x4*)((p_) + 64); wv[1] = *(const u32x4*)((p_) + 576); } while (0)
#define AT_FETCHQ(q_) do { const int hp_ = (int)(((q_) >> 3) & 3u), c_ = 31 - (int)((q_) >> 5), b_ = (int)((q_) & 7u); const bf16* qp_ = z + ((size_t)b_ * SEQ + c_ * 64 + ql) * ZC + C_ATT + (2 * hp_ + hs) * 64 + 8 * g; \
        wq0 = *(const u32x4*)qp_; wq1 = *(const u32x4*)(qp_ + 32); } while (0)
    const bf16* kvp;
    { const unsigned q0_ = q < NU ? q : NU - 1; const int c0_ = 31 - (int)(q0_ >> 5); kvp = AT_KVPTR(q0_, (c0_ >= 8 ? 0 : 8 - c0_)); AT_LOADKV(kvp); AT_FETCHQ(q0_); }
    while (q < NU) {
        const int hp = (int)((q >> 3) & 3u), c = 31 - (int)(q >> 5), b = (int)(q & 7u), h = 2 * hp + hs;
        unsigned nq_r = NU; if (tid == 0) nq_r = atomicAdd(qctr, 1u);
        const LAS float* bias = (const LAS float*)(lds + AT_BIAS) + h * 264;
        bf16x8 qf[2];
        { f32x4 a0, a1, b0, b1; unpack8(wq0, a0, a1); unpack8(wq1, b0, b1);
          float ss = 0.f;
#pragma unroll
          for (int j = 0; j < 4; ++j) ss += a0[j] * a0[j] + a1[j] * a1[j] + b0[j] * b0[j] + b1[j] * b1[j];
          ss = xrows_sum(ss);
          const float sc = rsqrtf(ss * (1.0f / 64.0f) + NORM_EPS) * 0.125f;
          const u32x4 p0 = pack8(a0 * gq[0] * sc, a1 * gq[1] * sc), p1 = pack8(b0 * gq[2] * sc, b1 * gq[3] * sc);
          qf[0] = __builtin_bit_cast(bf16x8, p0); qf[1] = __builtin_bit_cast(bf16x8, p1); }
        f32x4 oT[4];
#pragma unroll
        for (int d = 0; d < 4; ++d) oT[d] = (f32x4){0.f, 0.f, 0.f, 0.f};
        float m = -1e30f, lsum = 0.f; unsigned nq = NU;
        for (int j = (c >= 8 ? 0 : 8 - c); j <= 8; ++j) {
            LAS unsigned char* buf = lds + par * AT_BUFB; par ^= 1u;
#pragma unroll
            for (int i = 0; i < 2; ++i) { const u32x4 wkk = wk[i], wvv = wv[i];
                *(LAS u32x4*)((LAS bf16*)(buf + AT_KS) + (i * 64 + row) * AT_ST + 8 * ch) = wkk;
                f32x4 k0, k1; unpack8(wkk, k0, k1); float q2 = 0.f;
#pragma unroll
                for (int e = 0; e < 4; ++e) q2 += k0[e] * k0[e] + k1[e] * k1[e];
                q2 = red8_sum(q2);
                if (ch == 0) ((LAS float*)(buf + AT_KSC))[i * 64 + row] = rsqrtf(q2 * (1.0f / 64.0f) + NORM_EPS) * 1.44269504f;
                LAS bf16* vt = (LAS bf16*)(buf + AT_VT) + (i * 64 + 8 * ch) * AT_ST + rcol(row, ch >> 1);
                vt[0 * AT_ST] = (bf16)(wvv.x & 0xffffu); vt[1 * AT_ST] = (bf16)(wvv.x >> 16); vt[2 * AT_ST] = (bf16)(wvv.y & 0xffffu); vt[3 * AT_ST] = (bf16)(wvv.y >> 16);
                vt[4 * AT_ST] = (bf16)(wvv.z & 0xffffu); vt[5 * AT_ST] = (bf16)(wvv.z >> 16); vt[6 * AT_ST] = (bf16)(wvv.w & 0xffffu); vt[7 * AT_ST] = (bf16)(wvv.w >> 16); }
            if (j == 8 && tid == 0) lctl[34 + (un & 1u)] = nq_r;
            __syncthreads();
            { const bf16* np = kvp + (size_t)64 * ZC;
              if (j == 8) { nq = lctl[34 + (un & 1u)]; const unsigned qn = nq < NU ? nq : NU - 1; const int cn_ = 31 - (int)(qn >> 5); np = AT_KVPTR(qn, (cn_ >= 8 ? 0 : 8 - cn_)); AT_FETCHQ(qn); }
              kvp = np; AT_LOADKV(kvp); }
            const LAS bf16* Ks = (const LAS bf16*)(buf + AT_KS) + hs * 64 * AT_ST; const LAS bf16* VT = (const LAS bf16*)(buf + AT_VT) + hs * 64 * AT_ST; const LAS float* ksc = (const LAS float*)(buf + AT_KSC) + hs * 64;
            f32x4 sT[4];
#pragma unroll
            for (int kb = 0; kb < 4; ++kb) { sT[kb] = (f32x4){0.f, 0.f, 0.f, 0.f};
#pragma unroll
                for (int ks = 0; ks < 2; ++ks) { const bf16x8 af = *(const LAS bf16x8*)(Ks + (16 * kb + fr) * AT_ST + 32 * ks + 8 * g); sT[kb] = __builtin_amdgcn_mfma_f32_16x16x32_bf16(af, qf[ks], sT[kb], 0, 0, 0); } }
            float mt = -1e30f;
            if (j <= 5) {
                const float bfar = bias[0];
#pragma unroll
                for (int kb = 0; kb < 4; ++kb) { const f32x4 kv = *(const LAS f32x4*)(ksc + 16 * kb + 4 * g);
#pragma unroll
                    for (int r = 0; r < 4; ++r) { const float sv = sT[kb][r] * kv[r] + bfar; sT[kb][r] = sv; mt = fmaxf(mt, sv); } }
            } else if (j >= 7) {
                const LAS float* bq = bias + ((j - 8) * 64 + 4 * g - ql + 128);
#pragma unroll
                for (int kb = 0; kb < 4; ++kb) { const f32x4 kv = *(const LAS f32x4*)(ksc + 16 * kb + 4 * g);
#pragma unroll
                    for (int r = 0; r < 4; ++r) { const float sv = sT[kb][r] * kv[r] + bq[16 * kb + r]; sT[kb][r] = sv; mt = fmaxf(mt, sv); } }
            } else {
#pragma unroll
                for (int kb = 0; kb < 4; ++kb) { const f32x4 kv = *(const LAS f32x4*)(ksc + 16 * kb + 4 * g);
#pragma unroll
                    for (int r = 0; r < 4; ++r) { int rel = -128 + 16 * kb + 4 * g + r - ql; rel = rel < -128 ? -128 : rel;
                        const float sv = sT[kb][r] * kv[r] + bias[rel + 128]; sT[kb][r] = sv; mt = fmaxf(mt, sv); } }
            }
            mt = xrows_max(mt);
            const float mn = fmaxf(m, mt); const float alpha = __builtin_amdgcn_exp2f(m - mn); m = mn; lsum *= alpha;
#pragma unroll
            for (int d = 0; d < 4; ++d) oT[d] = oT[d] * alpha;
#pragma unroll
            for (int kb = 0; kb < 4; ++kb)
#pragma unroll
                for (int r = 0; r < 4; ++r) { const float p = __builtin_amdgcn_exp2f(sT[kb][r] - mn); sT[kb][r] = p; lsum += p; }
#pragma unroll
            for (int ks = 0; ks < 2; ++ks) { u32x4 pw; pw.x = pg8::cvt_pk_bf16(sT[2 * ks][0], sT[2 * ks][1]); pw.y = pg8::cvt_pk_bf16(sT[2 * ks][2], sT[2 * ks][3]); pw.z = pg8::cvt_pk_bf16(sT[2 * ks + 1][0], sT[2 * ks + 1][1]); pw.w = pg8::cvt_pk_bf16(sT[2 * ks + 1][2], sT[2 * ks + 1][3]);
                const bf16x8 pf = __builtin_bit_cast(bf16x8, pw);
#pragma unroll
                for (int db = 0; db < 4; ++db) { const LAS bf16* vp = VT + (16 * db + fr) * AT_ST; const u32x2 v0 = *(const LAS u32x2*)(vp + rcol(32 * ks + 4 * g, db)), v1 = *(const LAS u32x2*)(vp + rcol(32 * ks + 4 * g + 16, db));
                    u32x4 vw; vw.x = v0.x; vw.y = v0.y; vw.z = v1.x; vw.w = v1.y;
                    oT[db] = __builtin_amdgcn_mfma_f32_16x16x32_bf16(__builtin_bit_cast(bf16x8, vw), pf, oT[db], 0, 0, 0); } }
        }
        lsum = xrows_sum(lsum);
        const float inv = 1.0f / lsum; bf16* op = o + ((size_t)b * SEQ + c * 64 + ql) * 2048 + 1024 + h * 64 + 4 * g;
#pragma unroll
        for (int db = 0; db < 4; ++db) { u32x2 w; w.x = pg8::cvt_pk_bf16(oT[db][0] * inv, oT[db][1] * inv); w.y = pg8::cvt_pk_bf16(oT[db][2] * inv, oT[db][3] * inv); *(u32x2*)(op + 16 * db) = w; }
        q = nq; ++un;
    }
#undef AT_KVPTR
#undef AT_LOADKV
#undef AT_FETCHQ
    __syncthreads();
}

typedef f32x4 acc4;
#define MFMA16(a_, b_, c_) __builtin_amdgcn_mfma_f32_16x16x32_bf16((a_), (b_), (c_), 0, 0, 0)
__device__ __forceinline__ bf16x8 frag_nat(const LAS bf16* base, int pitch, int row, int k0, int g) { return *(const LAS bf16x8*)(base + row * pitch + k0 + 8 * g); }
__device__ __forceinline__ bf16x8 frag_nat_rot(const LAS bf16* base, int row, int k0, int g) { return *(const LAS bf16x8*)(base + row * 72 + ((((k0 >> 3) + g + (row >> 4)) & 7) << 3)); }
__device__ __forceinline__ bf16x8 frag_perm(const LAS bf16* base, int pitch, int row, int k0, int g) { const LAS bf16* p = base + row * pitch + k0 + 4 * g; const u32x2 v0 = *(const LAS u32x2*)p, v1 = *(const LAS u32x2*)(p + 16);
    u32x4 w; w.x = v0.x; w.y = v0.y; w.z = v1.x; w.w = v1.y; return __builtin_bit_cast(bf16x8, w); }
__device__ __forceinline__ bf16x8 frag_acc(const acc4& lo, const acc4& hi) { u32x4 w; w.x = pg8::cvt_pk_bf16(lo[0], lo[1]); w.y = pg8::cvt_pk_bf16(lo[2], lo[3]); w.z = pg8::cvt_pk_bf16(hi[0], hi[1]); w.w = pg8::cvt_pk_bf16(hi[2], hi[3]); return __builtin_bit_cast(bf16x8, w); }
__device__ __forceinline__ float wave_incl_scan(float x, int lane) { (void)lane; return scan64(x); }

constexpr int P72 = 72, P136 = 136;
constexpr int MB_CM = 0, MB_BM = MB_CM + 64 * P136 * 2, MB_BMT = MB_BM + 64 * P136 * 2, MB_XDT = MB_BMT + 128 * P72 * 2, MB_XDTW = MB_XDT + 64 * P72 * 2, MB_P = MB_XDTW + 64 * P72 * 2,
              MB_Y = MB_P + 64 * P72 * 2, MB_ACS = MB_Y + 64 * 68 * 4, MB_DT = MB_ACS + 512, MB_END = MB_DT + 512;
static_assert(MB_END <= 159744, "mamba LDS");
__device__ __forceinline__ void mamba_bc_prepass(const ArgsD& a, int l, int gw, int ngw, int lane, const bf16* z, bf16* bcv) {
    const float* cw = a.in[I_SSM_CONVW] + (size_t)l * 4 * 1024 + 512 + 8 * lane; const float* cb = a.in[I_SSM_CONVB] + l * 1024 + 512 + 8 * lane;
    f32x4 w0[5], w1[5];
#pragma unroll
    for (int j = 0; j < 4; ++j) { w0[j] = *(const f32x4*)(cw + j * 1024); w1[j] = *(const f32x4*)(cw + j * 1024 + 4); }
    w0[4] = *(const f32x4*)cb; w1[4] = *(const f32x4*)(cb + 4);
    for (int rg = gw; rg < T / 8; rg += ngw) { const size_t t0 = (size_t)rg * 8; const bool first = ((rg * 8) & (SEQ - 1)) == 0;
        u32x4 rw[11];
#pragma unroll
        for (int i = 0; i < 11; ++i) { const size_t t = (first && i < 3) ? t0 : t0 + i - 3; rw[i] = *(const u32x4*)(z + t * ZC + C_SSM + 1024 + 8 * lane); }
        if (first) { rw[0] = (u32x4){0u, 0u, 0u, 0u}; rw[1] = rw[0]; rw[2] = rw[0]; }
#pragma unroll
        for (int i = 0; i < 8; ++i) { f32x4 o0 = w0[4], o1 = w1[4];
#pragma unroll
            for (int j = 0; j < 4; ++j) { f32x4 x0, x1; unpack8(rw[i + j], x0, x1); o0 += x0 * w0[j]; o1 += x1 * w1[j]; }
#pragma unroll
            for (int e = 0; e < 4; ++e) { o0[e] = siluf_(o0[e]); o1[e] = siluf_(o1[e]); }
            *(u32x4*)(bcv + (t0 + i) * 512 + 8 * lane) = pack8(o0, o1); } }
}
__device__ __forceinline__ void mamba_block_task(const ArgsD& a, int l, int bh, LAS unsigned char* lds, const bf16* z, const bf16* bcv, bf16* o, float* mssq) {
    const int tid = opq_v((int)threadIdx.x), lane = tid & 63, wid = __builtin_amdgcn_readfirstlane(tid >> 6), fr = lane & 15, g = lane >> 4;
    const int b = bh >> 3, hd = bh & 7, grp = hd >> 2;
    const float dtb = a.in[I_SSM_DTB][l * 8 + hd], Aneg = -__expf(a.in[I_SSM_ALOG][l * 8 + hd]), Dk = a.in[I_SSM_D][l * 8 + hd];
    LAS bf16* Cm = (LAS bf16*)(lds + MB_CM); LAS bf16* Bm = (LAS bf16*)(lds + MB_BM); LAS bf16* BmT = (LAS bf16*)(lds + MB_BMT); LAS bf16* xdtT = (LAS bf16*)(lds + MB_XDT); LAS bf16* xdtwT = (LAS bf16*)(lds + MB_XDTW);
    LAS bf16* Pm = (LAS bf16*)(lds + MB_P); LAS float* Yl = (LAS float*)(lds + MB_Y); LAS float* acs2 = (LAS float*)(lds + MB_ACS); LAS float* dts2 = (LAS float*)(lds + MB_DT);
    const int pb = wid & 3, lh = wid >> 2;
    const int row = tid >> 3, ch = tid & 7;
    f32x4 cw0[5], cw1[5];
    { const float* cw = a.in[I_SSM_CONVW] + (size_t)l * 4 * 1024 + hd * 64 + 8 * ch; const float* cb = a.in[I_SSM_CONVB] + l * 1024 + hd * 64 + 8 * ch;
#pragma unroll
      for (int j = 0; j < 4; ++j) { cw0[j] = *(const f32x4*)(cw + j * 1024); cw1[j] = *(const f32x4*)(cw + j * 1024 + 4); }
      cw0[4] = *(const f32x4*)cb; cw1[4] = *(const f32x4*)(cb + 4); }
    acc4 St[8];
#pragma unroll
    for (int nb = 0; nb < 8; ++nb) St[nb] = (acc4){0.f, 0.f, 0.f, 0.f};
    u32x4 n_gt, n_x[4], n_b0, n_b1, n_c0, n_c1; bf16 n_dt = 0;
#define MB_FETCH(cn_) do { const size_t tq_ = (size_t)b * SEQ + (cn_) * 64 + row; const bf16* zn_ = z + tq_ * ZC + C_SSM; n_gt = *(const u32x4*)(zn_ + hd * 64 + 8 * ch); \
        _Pragma("unroll") for (int k_ = 0; k_ < 4; ++k_) { const bool ok_ = ((cn_) * 64 + row - k_) >= 0; n_x[k_] = *(const u32x4*)(zn_ - (ok_ ? (size_t)k_ * ZC : (size_t)0) + 512 + hd * 64 + 8 * ch); }   \
        const bf16* bq_ = bcv + tq_ * 512 + grp * 128 + 8 * ch; n_b0 = *(const u32x4*)bq_; n_b1 = *(const u32x4*)(bq_ + 64); n_c0 = *(const u32x4*)(bq_ + 256); n_c1 = *(const u32x4*)(bq_ + 320); } while (0)
#define MB_DTSCAN(cn_) do { const float dt_ = softplusf_(bf2f(n_dt) + dtb); const float cs_ = wave_incl_scan(dt_ * Aneg, lane); dts2[((cn_) & 1) * 64 + lane] = dt_; acs2[((cn_) & 1) * 64 + lane] = cs_; } while (0)
    MB_FETCH(0);
    if (wid == 0) { n_dt = z[((size_t)b * SEQ + lane) * ZC + C_SSM + 1536 + hd]; MB_DTSCAN(0); n_dt = z[((size_t)b * SEQ + 64 + lane) * ZC + C_SSM + 1536 + hd]; }
    __syncthreads();
    for (int c = 0; c < NCH; ++c) {
        const size_t t0 = (size_t)b * SEQ + c * 64;
        const LAS float* acs = acs2 + (c & 1) * 64; const LAS float* dts = dts2 + (c & 1) * 64;
        const u32x4 c_gt = n_gt; u32x4 c_x;
        { const float dt = dts[row], wl = __expf(acs[63] - acs[row]);
          f32x4 x0 = cw0[4], x1 = cw1[4];
#pragma unroll
          for (int j = 0; j < 4; ++j) { f32x4 r0, r1; unpack8(n_x[3 - j], r0, r1); const float mk = (c * 64 + row - (3 - j) >= 0) ? 1.0f : 0.0f; x0 += r0 * (cw0[j] * mk); x1 += r1 * (cw1[j] * mk); }
#pragma unroll
          for (int e = 0; e < 4; ++e) { x0[e] = siluf_(x0[e]); x1[e] = siluf_(x1[e]); }
          c_x = pack8(x0, x1);
#pragma unroll
          for (int e = 0; e < 4; ++e) { const float v0 = x0[e] * dt, v1 = x1[e] * dt; xdtT[(8 * ch + e) * P72 + rcol(row, ch >> 1)] = (bf16)f2bf(v0); xdtT[(8 * ch + 4 + e) * P72 + rcol(row, ch >> 1)] = (bf16)f2bf(v1);
              xdtwT[(8 * ch + e) * P72 + rcol(row, ch >> 1)] = (bf16)f2bf(v0 * wl); xdtwT[(8 * ch + 4 + e) * P72 + rcol(row, ch >> 1)] = (bf16)f2bf(v1 * wl); }
#pragma unroll
          for (int i = 0; i < 2; ++i) { const int cc = ch + 8 * i; const u32x4 wb = i ? n_b1 : n_b0, wc = i ? n_c1 : n_c0;
              *(LAS u32x4*)(Bm + row * P136 + 8 * cc) = wb; *(LAS u32x4*)(Cm + row * P136 + 8 * cc) = wc;
              LAS bf16* bt = BmT + (8 * cc) * P72 + rcol(row, cc >> 1);
              bt[0 * P72] = (bf16)(wb.x & 0xffffu); bt[1 * P72] = (bf16)(wb.x >> 16); bt[2 * P72] = (bf16)(wb.y & 0xffffu); bt[3 * P72] = (bf16)(wb.y >> 16);
              bt[4 * P72] = (bf16)(wb.z & 0xffffu); bt[5 * P72] = (bf16)(wb.z >> 16); bt[6 * P72] = (bf16)(wb.w & 0xffffu); bt[7 * P72] = (bf16)(wb.w >> 16); } }
        __syncthreads();
        if (wid == 0 && c + 1 < NCH) MB_DTSCAN(c + 1);
        { const int lb = wid >> 1;
#pragma unroll
          for (int q = 0; q < 2; ++q) { const int sb = 2 * (wid & 1) + q; acc4 cb = (acc4){0.f, 0.f, 0.f, 0.f};
#pragma unroll
              for (int ks = 0; ks < 4; ++ks) cb = MFMA16(frag_nat(Cm, P136, 16 * lb + fr, 32 * ks, g), frag_nat(Bm, P136, 16 * sb + fr, 32 * ks, g), cb);
              const int sidx = 16 * sb + fr; const float as = acs[sidx];
#pragma unroll
              for (int r = 0; r < 4; ++r) { const int lidx = 16 * lb + 4 * g + r; const float v = (sidx <= lidx) ? cb[r] * __expf(acs[lidx] - as) : 0.f; Pm[lidx * P72 + sidx] = (bf16)f2bf(v); } } }
        __syncthreads();
        { const int cn = (c + 1 < NCH) ? c + 1 : c; MB_FETCH(cn); const int cd = (c + 2 < NCH) ? c + 2 : c; if (wid == 0) n_dt = z[((size_t)b * SEQ + cd * 64 + lane) * ZC + C_SSM + 1536 + hd]; }
#pragma unroll
        for (int q = 0; q < 2; ++q) { const int lb = 2 * lh + q; acc4 y = (acc4){0.f, 0.f, 0.f, 0.f};
#pragma unroll
            for (int kk = 0; kk < 4; ++kk) y = MFMA16(frag_perm(Cm, P136, 16 * lb + fr, 32 * kk, g), frag_acc(St[2 * kk], St[2 * kk + 1]), y);
#pragma unroll
            for (int r = 0; r < 4; ++r) y[r] *= __expf(acs[16 * lb + 4 * g + r]);
#pragma unroll
            for (int ks = 0; ks < 2; ++ks) y = MFMA16(frag_nat(Pm, P72, 16 * lb + fr, 32 * ks, g), frag_nat_rot(xdtT, 16 * pb + fr, 32 * ks, g), y);
#pragma unroll
            for (int r = 0; r < 4; ++r) Yl[(16 * lb + 4 * g + r) * 68 + 16 * pb + fr] = y[r]; }
        { const float dec = __expf(acs[63]);
#pragma unroll
          for (int nb = 0; nb < 8; ++nb) { St[nb] = St[nb] * dec;
#pragma unroll
              for (int ks = 0; ks < 2; ++ks) St[nb] = MFMA16(frag_nat_rot(BmT, 16 * nb + fr, 32 * ks, g), frag_nat_rot(xdtwT, 16 * pb + fr, 32 * ks, g), St[nb]); } }
        __syncthreads();
        { const size_t t = t0 + row;
          f32x4 x0, x1, g0, g1; unpack8(c_x, x0, x1); unpack8(c_gt, g0, g1);
          const f32x4 y0 = *(const LAS f32x4*)(Yl + row * 68 + 8 * ch), y1 = *(const LAS f32x4*)(Yl + row * 68 + 8 * ch + 4); f32x4 o0, o1; float q2 = 0.f;
#pragma unroll
          for (int e = 0; e < 4; ++e) { o0[e] = (y0[e] + x0[e] * Dk) * siluf_(g0[e]); o1[e] = (y1[e] + x1[e] * Dk) * siluf_(g1[e]); q2 += o0[e] * o0[e] + o1[e] * o1[e]; }
          *(u32x4*)(o + t * 2048 + 512 + hd * 64 + 8 * ch) = pack8(o0, o1);
          q2 = red8_sum(q2);
          if (ch == 0) mssq[t * 8 + hd] = q2; }
    }
#undef MB_FETCH
#undef MB_DTSCAN
    __syncthreads();
}

constexpr int P132 = 132;
constexpr int GL_BC = 0, GL_QG = GL_BC + 64 * 68 * 4, GL_KG = GL_QG + 64 * P72 * 2, GL_KDT = GL_KG + 64 * P72 * 2, GL_VT = GL_KDT + 64 * P72 * 2, GL_ATT = GL_VT + 128 * P72 * 2,
              GL_O = GL_ATT + 64 * P72 * 2, GL_GU = GL_O + 64 * P132 * 4, GL_END = GL_GU + 17 * 64 * 4;
static_assert(GL_END <= LDS_MAIN, "gla LDS");
constexpr int GP_GU = 0, GP_BC = GP_GU + 17 * 64 * 4, GP_END = GP_BC + 2 * 64 * 68 * 4;
__device__ __forceinline__ void gla_prepass(const ArgsD& a, int l, int bx, int G, LAS unsigned char* lds, bf16* z, float* gend) {
    const int tid = opq_v((int)threadIdx.x), lane = tid & 63, wid = __builtin_amdgcn_readfirstlane(tid >> 6), row = tid >> 3, ch = tid & 7;
    LAS float* gu = (LAS float*)(lds + GP_GU);
    constexpr int NUN = BATCH * 4 * NCH;
    int gu_h = -1; unsigned par = 0;
    u32x4 wx0, wx1, wq, wk;
#define GP_FETCH(u_) do { const int c_ = (u_) & 31, h_ = ((u_) >> 5) & 3, b_ = (u_) >> 7; const bf16* zn_ = z + ((size_t)b_ * SEQ + c_ * 64 + row) * ZC + C_GLA; \
        wx0 = *(const u32x4*)(zn_ + 1024); wx1 = *(const u32x4*)(zn_ + 1032); wq = *(const u32x4*)(zn_ + h_ * 64 + 8 * ch); wk = *(const u32x4*)(zn_ + 256 + h_ * 64 + 8 * ch); } while (0)
    { const int u0 = bx < NUN ? bx : NUN - 1; GP_FETCH(u0); }
    for (int u = bx; u < NUN; u += G) {
        const int c = u & 31, h = (u >> 5) & 3, b = u >> 7;
        if (gu_h != h) { gu_h = h; __syncthreads();
            const float* gup = a.in[I_GLA_GUP] + (size_t)l * 16 * 256 + h * 64; const float* gbp = a.in[I_GLA_GB] + l * 256 + h * 64; float gv[3];
#pragma unroll
            for (int j = 0; j < 3; ++j) { const int i = tid + 512 * j, ic = i < 17 * 64 ? i : 0, r = ic >> 6, k = ic & 63; gv[j] = (r < 16) ? gup[r * 256 + k] : gbp[k]; }
#pragma unroll
            for (int j = 0; j < 3; ++j) { const int i = tid + 512 * j; if (i < 17 * 64) gu[i] = gv[j]; }
            __syncthreads(); }
        LAS float* bc = (LAS float*)(lds + GP_BC) + par * (64 * 68); par ^= 1u;
        const u32x4 c_q = wq, c_k = wk; f32x4 xa, xb_, xc, xd; unpack8(wx0, xa, xb_); unpack8(wx1, xc, xd);
        { const int un = (u + G < NUN) ? u + G : u; GP_FETCH(un); }
        { f32x4 la0 = *(const LAS f32x4*)(gu + 16 * 64 + 8 * ch), la1 = *(const LAS f32x4*)(gu + 16 * 64 + 8 * ch + 4);
#pragma unroll
          for (int r = 0; r < 16; ++r) { const float xv = (r < 4) ? xa[r & 3] : (r < 8) ? xb_[r & 3] : (r < 12) ? xc[r & 3] : xd[r & 3];
              la0 += *(const LAS f32x4*)(gu + r * 64 + 8 * ch) * xv; la1 += *(const LAS f32x4*)(gu + r * 64 + 8 * ch + 4) * xv; }
#pragma unroll
          for (int e = 0; e < 4; ++e) { la0[e] = (fminf(la0[e], 0.f) - __logf(1.0f + __expf(-fabsf(la0[e])))) * (1.0f / 16.0f); la1[e] = (fminf(la1[e], 0.f) - __logf(1.0f + __expf(-fabsf(la1[e])))) * (1.0f / 16.0f); }
          *(LAS f32x4*)(bc + row * 68 + 8 * ch) = la0; *(LAS f32x4*)(bc + row * 68 + 8 * ch + 4) = la1; }
        __syncthreads();
#pragma unroll
        for (int q = 0; q < 8; ++q) { const int k = 8 * wid + q; const float v = scan64(bc[lane * 68 + k]); bc[lane * 68 + k] = v; }
        __syncthreads();
        { const f32x4 b0 = *(const LAS f32x4*)(bc + row * 68 + 8 * ch), b1 = *(const LAS f32x4*)(bc + row * 68 + 8 * ch + 4);
          f32x4 q0, q1, k0, k1, qa, qb_, ka, kb_; unpack8(c_q, q0, q1); unpack8(c_k, k0, k1);
#pragma unroll
          for (int e = 0; e < 4; ++e) { qa[e] = q0[e] * __expf(b0[e]) * 0.125f; qb_[e] = q1[e] * __expf(b1[e]) * 0.125f; ka[e] = k0[e] * __expf(-b0[e]); kb_[e] = k1[e] * __expf(-b1[e]); }
          bf16* zn = z + ((size_t)b * SEQ + c * 64 + row) * ZC + C_GLA; *(u32x4*)(zn + h * 64 + 8 * ch) = pack8(qa, qb_); *(u32x4*)(zn + 256 + h * 64 + 8 * ch) = pack8(ka, kb_);
          if (tid < 64) gend[(size_t)u * 64 + tid] = bc[63 * 68 + tid]; }
    }
#undef GP_FETCH
    __syncthreads();
}
__device__ __forceinline__ void gla_block_task(const ArgsD& a, int l, int bh, LAS unsigned char* lds, const bf16* z, const float* gend, bf16* o) {
    const int tid = opq_v((int)threadIdx.x), lane = tid & 63, wid = __builtin_amdgcn_readfirstlane(tid >> 6), fr = lane & 15, g = lane >> 4;
    const int b = bh >> 2, h = bh & 3;
    LAS float* endl = (LAS float*)(lds + GL_BC); LAS bf16* qg = (LAS bf16*)(lds + GL_QG); LAS bf16* kg = (LAS bf16*)(lds + GL_KG); LAS bf16* kgT = (LAS bf16*)(lds + GL_KDT); LAS bf16* vT = (LAS bf16*)(lds + GL_VT);
    LAS bf16* att = (LAS bf16*)(lds + GL_ATT); LAS float* Ol = (LAS float*)(lds + GL_O);
    const float* nwp = a.in[I_GLA_NW] + l * 128;
    acc4 St[4];
#pragma unroll
    for (int kb = 0; kb < 4; ++kb) St[kb] = (acc4){0.f, 0.f, 0.f, 0.f};
    const int row = tid >> 3, ch = tid & 7;
    const f32x4 nw0 = *(const f32x4*)(nwp + 16 * ch), nw1 = *(const f32x4*)(nwp + 16 * ch + 4), nw2 = *(const f32x4*)(nwp + 16 * ch + 8), nw3 = *(const f32x4*)(nwp + 16 * ch + 12);
    u32x4 n_q, n_k, n_v0, n_v1, n_g0, n_g1; float n_end = 0.f;
#define GL_FETCH(cn_) do { const bf16* zn_ = z + ((size_t)b * SEQ + (cn_) * 64 + row) * ZC + C_GLA; n_q = *(const u32x4*)(zn_ + h * 64 + 8 * ch); n_k = *(const u32x4*)(zn_ + 256 + h * 64 + 8 * ch); \
        n_v0 = *(const u32x4*)(zn_ + 512 + h * 128 + 8 * ch); n_v1 = *(const u32x4*)(zn_ + 512 + h * 128 + 8 * (ch + 8)); n_g0 = *(const u32x4*)(zn_ + 1040 + h * 128 + 16 * ch); n_g1 = *(const u32x4*)(zn_ + 1040 + h * 128 + 16 * ch + 8); \
        if (tid < 64) n_end = gend[((size_t)(b * 4 + h) * NCH + (cn_)) * 64 + tid]; } while (0)
    GL_FETCH(0);
    __syncthreads();
    for (int c = 0; c < NCH; ++c) {
        const size_t t0 = (size_t)b * SEQ + c * 64;
        const u32x4 c_g0 = n_g0, c_g1 = n_g1;
        { *(LAS u32x4*)(qg + row * P72 + 8 * ch) = n_q; *(LAS u32x4*)(kg + row * P72 + 8 * ch) = n_k;
          if (tid < 64) endl[tid] = n_end;
          { LAS bf16* kt = kgT + (8 * ch) * P72 + rcol(row, ch >> 1); const u32x4 wv = n_k;
            kt[0 * P72] = (bf16)(wv.x & 0xffffu); kt[1 * P72] = (bf16)(wv.x >> 16); kt[2 * P72] = (bf16)(wv.y & 0xffffu); kt[3 * P72] = (bf16)(wv.y >> 16);
            kt[4 * P72] = (bf16)(wv.z & 0xffffu); kt[5 * P72] = (bf16)(wv.z >> 16); kt[6 * P72] = (bf16)(wv.w & 0xffffu); kt[7 * P72] = (bf16)(wv.w >> 16); }
#pragma unroll
          for (int i = 0; i < 2; ++i) { const int cc = ch + 8 * i; const u32x4 wv = i ? n_v1 : n_v0; LAS bf16* vt = vT + (8 * cc) * P72 + rcol(row, cc >> 1);
              vt[0 * P72] = (bf16)(wv.x & 0xffffu); vt[1 * P72] = (bf16)(wv.x >> 16); vt[2 * P72] = (bf16)(wv.y & 0xffffu); vt[3 * P72] = (bf16)(wv.y >> 16);
              vt[4 * P72] = (bf16)(wv.z & 0xffffu); vt[5 * P72] = (bf16)(wv.z >> 16); vt[6 * P72] = (bf16)(wv.w & 0xffffu); vt[7 * P72] = (bf16)(wv.w >> 16); } }
        __syncthreads();
        { const int lb = wid >> 1;
#pragma unroll
          for (int q = 0; q < 2; ++q) { const int sb = 2 * (wid & 1) + q; acc4 at = (acc4){0.f, 0.f, 0.f, 0.f};
#pragma unroll
              for (int ks = 0; ks < 2; ++ks) at = MFMA16(frag_nat(qg, P72, 16 * lb + fr, 32 * ks, g), frag_nat(kg, P72, 16 * sb + fr, 32 * ks, g), at);
              const int sidx = 16 * sb + fr;
#pragma unroll
              for (int r = 0; r < 4; ++r) { const int lidx = 16 * lb + 4 * g + r; att[lidx * P72 + sidx] = (bf16)f2bf((sidx <= lidx) ? at[r] : 0.f); } } }
        __syncthreads();
        { const int cn = (c + 1 < NCH) ? c + 1 : c; GL_FETCH(cn); }
#pragma unroll
        for (int lb = 0; lb < 4; ++lb) { acc4 ov = (acc4){0.f, 0.f, 0.f, 0.f};
#pragma unroll
            for (int kk = 0; kk < 2; ++kk) ov = MFMA16(frag_perm(qg, P72, 16 * lb + fr, 32 * kk, g), frag_acc(St[2 * kk], St[2 * kk + 1]), ov);
#pragma unroll
            for (int ks = 0; ks < 2; ++ks) ov = MFMA16(frag_nat(att, P72, 16 * lb + fr, 32 * ks, g), frag_nat_rot(vT, 16 * wid + fr, 32 * ks, g), ov);
#pragma unroll
            for (int r = 0; r < 4; ++r) Ol[(16 * lb + 4 * g + r) * P132 + 16 * wid + fr] = ov[r]; }
#pragma unroll
        for (int kb = 0; kb < 4; ++kb) { const f32x4 bl = *(const LAS f32x4*)(endl + 16 * kb + 4 * g);
#pragma unroll
            for (int ks = 0; ks < 2; ++ks) St[kb] = MFMA16(frag_nat_rot(kgT, 16 * kb + fr, 32 * ks, g), frag_nat_rot(vT, 16 * wid + fr, 32 * ks, g), St[kb]);
#pragma unroll
            for (int r = 0; r < 4; ++r) St[kb][r] *= __expf(bl[r]); }
        __syncthreads();
        { const size_t t = t0 + row; float q2 = 0.f; f32x4 ov[4];
#pragma unroll
          for (int i = 0; i < 4; ++i) { ov[i] = *(const LAS f32x4*)(Ol + row * P132 + 16 * ch + 4 * i); q2 += ov[i][0] * ov[i][0] + ov[i][1] * ov[i][1] + ov[i][2] * ov[i][2] + ov[i][3] * ov[i][3]; }
          q2 = red8_sum(q2);
          const float sc = rsqrtf(q2 * (1.0f / 128.0f) + NORM_EPS);
#pragma unroll
          for (int i = 0; i < 2; ++i) { const u32x4 wg = i ? c_g1 : c_g0; f32x4 g0, g1; unpack8(wg, g0, g1);
              const f32x4 n0 = i ? nw2 : nw0, n1 = i ? nw3 : nw1; f32x4 r0, r1;
#pragma unroll
              for (int e = 0; e < 4; ++e) { r0[e] = ov[2 * i][e] * sc * n0[e] * siluf_(g0[e]); r1[e] = ov[2 * i + 1][e] * sc * n1[e] * siluf_(g1[e]); }
              *(u32x4*)(o + t * 2048 + 1536 + h * 128 + 16 * ch + 8 * i) = pack8(r0, r1); } }
    }
#undef GL_FETCH
    __syncthreads();
}

constexpr int RT = 32, P40 = 40, P328 = 328, P168 = 168;
constexpr int RW_REC = 29184;
constexpr int IM_AT = 0, IM_RT = IM_AT + RT * P72 * 2, IM_KPT = IM_RT + RT * P72 * 2, IM_BPT = IM_KPT + 64 * P40 * 2, IM_VT = IM_BPT + 64 * P40 * 2, IM_MAK = IM_VT + 64 * P40 * 2, IM_ARK = IM_MAK + RT * P40 * 2,
              IM_ARB = IM_ARK + RT * P40 * 2, IM_T1 = IM_ARB + RT * P40 * 2, IM_T2 = IM_T1 + 16 * P40 * 2, IM_GAM = IM_T2 + 16 * P40 * 2, IM_BON = IM_GAM + 256, IM_END = IM_BON + 128;
__device__ __forceinline__ int rw_piece_off(int p) {
    if (p < 512) { const int m = p >> 8, q = p & 255; return (m ? IM_RT : IM_AT) + (q >> 3) * (P72 * 2) + (q & 7) * 16; }
    p -= 512; if (p < 768) { const int m = p >> 8, q = p & 255; return IM_KPT + m * (64 * P40 * 2) + (q >> 2) * (P40 * 2) + (q & 3) * 16; }
    p -= 768; if (p < 384) { const int m = p >> 7, q = p & 127; return IM_MAK + m * (RT * P40 * 2) + (q >> 2) * (P40 * 2) + (q & 3) * 16; }
    p -= 384; if (p < 128) { const int m = p >> 6, q = p & 63; return IM_T1 + m * (16 * P40 * 2) + (q >> 2) * (P40 * 2) + (q & 3) * 16; }
    p -= 128; return IM_GAM + p * 16;
}
constexpr int RW_NPIECE = 1816;
__device__ __forceinline__ unsigned char* rw_rec_ptr(unsigned char* ws, int h, int b, int c) {
    unsigned char* base = (h < 4) ? ws + WS_XG : (h < 6) ? ws + WS_X + X_MIXED : ws + WS_Z + (size_t)T * ZC * 2;
    const int hl = (h < 4) ? h : (h < 6) ? h - 4 : h - 6;
    return base + ((size_t)(hl * BATCH + b) * (SEQ / RT) + c) * RW_REC;
}
static_assert((size_t)4 * BATCH * (SEQ / RT) * RW_REC <= XG_BYTES && (size_t)2 * BATCH * (SEQ / RT) * RW_REC <= (size_t)T * DM * 2 && (size_t)2 * BATCH * (SEQ / RT) * RW_REC <= Z_BYTES - (size_t)T * ZC * 2, "rwkv record regions");

constexpr int RW_WD = 0, RW_WA = RW_WD + 64 * P72 * 2, RW_WG = RW_WA + 64 * P72 * 2, RW_WV = RW_WG + 64 * P168 * 2, RW_HALF0 = RW_WV + 64 * P40 * 2;
constexpr int RH_XLR = 0, RH_LC = 0, RH_KH = RH_LC + RT * 68 * 4, RH_BH = RH_KH + RT * P72 * 2, RH_MAB = RH_BH + RT * P72 * 2, RH_R1_END = RH_MAB + RT * 33 * 4, RH_IMG = 22272, RH_PROJ = RH_IMG, RH_BYTES = RH_IMG + IM_END;
constexpr int RW_PAR = RW_HALF0 + 2 * RH_BYTES;
constexpr int RW_END = RW_PAR + 9 * 64 * 4;
static_assert(RH_R1_END <= RH_IMG && RT * P328 * 2 <= RH_IMG && 4 * RT * P72 * 2 <= IM_GAM && RW_END <= NWAVES * 20352 && (RH_IMG % 16) == 0 && (RH_BYTES % 16) == 0 && (RW_HALF0 % 16) == 0, "rwkv prep LDS");
constexpr int XLR_OFF = 512;
__device__ __forceinline__ void rwkv_xlr_prepass(const ArgsD& a, int l, int bx, int G, const bf16* z, bf16* o) {
    const int tid = opq_v((int)threadIdx.x);
    const float* mu = a.in[I_RW_MU] + l * 1824;
    for (int rb = bx; rb < T / 64; rb += G) {
        u32x4 wc_[5], wp_[5]; f32x4 m0_[5], m1_[5];
#pragma unroll
        for (int i = 0; i < 5; ++i) { const int it = tid + 512 * i, tk = it / 40, q = it - tk * 40; const size_t row = (size_t)rb * 64 + tk;
            const int col = (q < 36) ? 1536 + 8 * q : C_HV + 8 * (q - 36);
            const size_t prow = ((row & (SEQ - 1)) == 0) ? row : row - 1;
            wc_[i] = *(const u32x4*)(z + row * ZC + col); wp_[i] = *(const u32x4*)(z + prow * ZC + col);
            const int mcol = (q < 36) ? col : 1536;
            m0_[i] = *(const f32x4*)(mu + mcol); m1_[i] = *(const f32x4*)(mu + mcol + 4); }
#pragma unroll
        for (int i = 0; i < 5; ++i) { const int it = tid + 512 * i, tk = it / 40, q = it - tk * 40; const size_t row = (size_t)rb * 64 + tk; f32x4 c0v, c1v, p0v, p1v; unpack8(wc_[i], c0v, c1v); unpack8(wp_[i], p0v, p1v);
            if ((row & (SEQ - 1)) == 0) { p0v = (f32x4){0.f, 0.f, 0.f, 0.f}; p1v = p0v; }
            const f32x4 x0 = c0v + (p0v - c0v) * m0_[i], x1 = c1v + (p1v - c1v) * m1_[i];
            const float kk2 = (q < 8) ? 2.0f : 1.0f; f32x4 v0, v1;
#pragma unroll
            for (int e = 0; e < 4; ++e) { const float s0 = sigmoidf_(kk2 * x0[e]), s1 = sigmoidf_(kk2 * x1[e]);
                v0[e] = (q < 8) ? 2.0f * s0 - 1.0f : (q < 16) ? x0[e] : (q < 36) ? s0 : c0v[e]; v1[e] = (q < 8) ? 2.0f * s1 - 1.0f : (q < 16) ? x1[e] : (q < 36) ? s1 : c1v[e]; }
            *(u32x4*)(o + row * 2048 + XLR_OFF + 8 * q) = pack8(v0, v1); }
    }
}
struct PrepPf { u32x4 wzr, wzk, wzv, wpr, wpk, wpv, wvf, xl[5]; };
__device__ __forceinline__ void rwkv_prep_fetch(PrepPf& pf, int l, int h, int b, int cpair, const bf16* z, const bf16* vfirst, const bf16* o) {
    const int tid = opq_v((int)threadIdx.x), lt = tid & 255, c = cpair + (tid >> 8), tok = lt >> 3, C0 = h * 64 + 8 * (lt & 7);
    const size_t t0 = (size_t)b * SEQ + c * RT;
    const bf16* zp = z + (t0 + tok) * ZC + C0; pf.wzr = *(const u32x4*)zp; pf.wzk = *(const u32x4*)(zp + 512); pf.wzv = *(const u32x4*)(zp + 1024);
    const bf16* zq = (c == 0 && tok == 0) ? zp : zp - ZC; pf.wpr = *(const u32x4*)zq; pf.wpk = *(const u32x4*)(zq + 512); pf.wpv = *(const u32x4*)(zq + 1024);
    if (l == 1) pf.wvf = *(const u32x4*)(vfirst + (t0 + tok) * 512 + C0); else pf.wvf = (u32x4){0u, 0u, 0u, 0u};
#pragma unroll
    for (int i = 0; i < 5; ++i) { const int it = lt + 256 * i, tk = it / 40, q = it - tk * 40; pf.xl[i] = *(const u32x4*)(o + (t0 + tk) * 2048 + XLR_OFF + 8 * q); }
}
__device__ __forceinline__ void rwkv_prep_pair(const ArgsD& a, int l, int h, int b, int cpair, int nh, int nb, int ncpair, PrepPf& pf, int& wts_h, LAS unsigned char* lds, const bf16* z, bf16* vfirst, bf16* o, unsigned char* ws) {
    const int tid = opq_v((int)threadIdx.x), lane = tid & 63, wid = __builtin_amdgcn_readfirstlane(tid >> 6), fr = lane & 15, g = lane >> 4;
    const int hf = wid >> 2, lw = wid & 3, lt = tid & 255, c = cpair + hf;
    LAS bf16* Wd = (LAS bf16*)(lds + RW_WD); LAS bf16* Wa = (LAS bf16*)(lds + RW_WA); LAS bf16* Wg = (LAS bf16*)(lds + RW_WG); LAS bf16* Wv = (LAS bf16*)(lds + RW_WV);
    LAS unsigned char* hb_ = lds + RW_HALF0 + hf * RH_BYTES;
    LAS bf16* Xlr = (LAS bf16*)(hb_ + RH_XLR); LAS bf16* Proj = (LAS bf16*)(hb_ + RH_PROJ); LAS float* Lc = (LAS float*)(hb_ + RH_LC);
    LAS bf16* Kh = (LAS bf16*)(hb_ + RH_KH); LAS bf16* Bh = (LAS bf16*)(hb_ + RH_BH); LAS float* Mab = (LAS float*)(hb_ + RH_MAB); LAS unsigned char* img = hb_ + RH_IMG;
    LAS bf16* At = (LAS bf16*)(img + IM_AT); LAS bf16* Rt = (LAS bf16*)(img + IM_RT); LAS bf16* KpT = (LAS bf16*)(img + IM_KPT); LAS bf16* BpT = (LAS bf16*)(img + IM_BPT); LAS bf16* VT = (LAS bf16*)(img + IM_VT);
    LAS bf16* Mak = (LAS bf16*)(img + IM_MAK); LAS bf16* Ark = (LAS bf16*)(img + IM_ARK); LAS bf16* Arb = (LAS bf16*)(img + IM_ARB); LAS bf16* T1 = (LAS bf16*)(img + IM_T1); LAS bf16* T2 = (LAS bf16*)(img + IM_T2);
    LAS float* gam = (LAS float*)(img + IM_GAM); LAS float* bon = (LAS float*)(img + IM_BON);
    if (wts_h != h) { wts_h = h;
        const float* dup = a.in[I_RW_DECAY_UP] + (size_t)l * 64 * 512 + h * 64; const float* aup = a.in[I_RW_A_UP] + (size_t)l * 64 * 512 + h * 64; const float* gup = a.in[I_RW_GATE_UP] + (size_t)l * 160 * 512 + h * 64; const float* vup = a.in[I_VRES_UP] + h * 64;
        { const int k0 = tid >> 6, ch = tid & 63;
          float dv[8], av_[8], gv[20], vv_[4];
#pragma unroll
          for (int j = 0; j < 8; ++j) { dv[j] = dup[(k0 + 8 * j) * 512 + ch]; av_[j] = aup[(k0 + 8 * j) * 512 + ch]; }
#pragma unroll
          for (int j = 0; j < 4; ++j) vv_[j] = vup[(k0 + 8 * j) * 512 + ch];
#pragma unroll
          for (int j = 0; j < 20; ++j) gv[j] = gup[(k0 + 8 * j) * 512 + ch];
#pragma unroll
          for (int j = 0; j < 8; ++j) { Wd[ch * P72 + k0 + 8 * j] = (bf16)f2bf(dv[j]); Wa[ch * P72 + k0 + 8 * j] = (bf16)f2bf(av_[j]); }
#pragma unroll
          for (int j = 0; j < 4; ++j) Wv[ch * P40 + k0 + 8 * j] = (bf16)f2bf(vv_[j]);
#pragma unroll
          for (int j = 0; j < 20; ++j) Wg[ch * P168 + k0 + 8 * j] = (bf16)f2bf(gv[j]); }
        { const int p = tid >> 6, cc = h * 64 + (tid & 63); const float* mu_ = a.in[I_RW_MU] + l * 1824;
          float pv0 = 0.f, pv1 = 0.f;
          pv0 = (p == 0) ? mu_[cc] : (p == 1) ? mu_[512 + cc] : (p == 2) ? mu_[1024 + cc] : (p == 3) ? a.in[I_RW_W0][l * 512 + cc] : (p == 4) ? a.in[I_RW_A0][l * 512 + cc] : (p == 5) ? a.in[I_VRES_V0][cc] : (p == 6) ? a.in[I_RW_KK][l * 512 + cc] : a.in[I_RW_KA][l * 512 + cc];
          if (tid < 64) pv1 = a.in[I_RW_RK][l * 512 + cc];
          LAS float* par_ = (LAS float*)(lds + RW_PAR); par_[tid] = pv0; if (tid < 64) par_[512 + tid] = pv1; } }
    const float* mu = a.in[I_RW_MU] + l * 1824;
    const int tok = lt >> 3, c0 = 8 * (lt & 7), C0 = h * 64 + c0;
    const size_t t0 = (size_t)b * SEQ + c * RT;
    const u32x4 zz4 = {0u, 0u, 0u, 0u}; const bool ftok = (c == 0 && tok == 0);
    const u32x4 wzr = pf.wzr, wzk = pf.wzk, wzv = pf.wzv, wpr = ftok ? zz4 : pf.wpr, wpk = ftok ? zz4 : pf.wpk, wpv = ftok ? zz4 : pf.wpv, wvf = pf.wvf;
#pragma unroll
    for (int i = 0; i < 5; ++i) { const int it = lt + 256 * i, tk = it / 40, q = it - tk * 40; *(LAS u32x4*)(Xlr + tk * P328 + 8 * q) = pf.xl[i]; }
    __syncthreads();
    { const int cb = lw;
#pragma unroll
      for (int p = 0; p < 4; ++p) { const LAS bf16* Wp = (p == 0) ? Wd : (p == 1) ? Wa : (p == 2) ? Wg : Wv; const int wp = (p == 2) ? P168 : (p == 3) ? P40 : P72; const int kb0 = (p == 0) ? 0 : (p == 1) ? 64 : (p == 2) ? 128 : 288;
          const int nks = (p == 2) ? 5 : (p == 3) ? 1 : 2;
#pragma unroll
          for (int rb = 0; rb < 2; ++rb) { acc4 ac = (acc4){0.f, 0.f, 0.f, 0.f};
#pragma unroll
              for (int ks = 0; ks < nks; ++ks) ac = MFMA16(frag_nat(Xlr, P328, 16 * rb + fr, kb0 + 32 * ks, g), frag_nat(Wp, wp, 16 * cb + fr, 32 * ks, g), ac);
#pragma unroll
              for (int r = 0; r < 4; ++r) Proj[(p * RT + 16 * rb + 4 * g + r) * P72 + 16 * cb + fr] = (bf16)f2bf(ac[r]); } } }
    __syncthreads();
    f32x4 rr[2], kk_[2], vv[2], ap[2], bp[2];
    { const size_t row = t0 + tok; f32x4 zr[2], zk[2], zv[2], pr[2], pk[2], pv[2], dw[2], da[2], gg[2], vm[2], vf[2];
      unpack8(wzr, zr[0], zr[1]); unpack8(wzk, zk[0], zk[1]); unpack8(wzv, zv[0], zv[1]); unpack8(wpr, pr[0], pr[1]); unpack8(wpk, pk[0], pk[1]); unpack8(wpv, pv[0], pv[1]); unpack8(wvf, vf[0], vf[1]);
      unpack8(*(const LAS u32x4*)(Proj + (0 * RT + tok) * P72 + c0), dw[0], dw[1]); unpack8(*(const LAS u32x4*)(Proj + (1 * RT + tok) * P72 + c0), da[0], da[1]);
      unpack8(*(const LAS u32x4*)(Proj + (2 * RT + tok) * P72 + c0), gg[0], gg[1]); unpack8(*(const LAS u32x4*)(Proj + (3 * RT + tok) * P72 + c0), vm[0], vm[1]);
      f32x4 ee[2], av[2], vraw[2], kraw[2]; float n2 = 0.f;
#pragma unroll
      for (int hq = 0; hq < 2; ++hq) { const int Cq = C0 + 4 * hq;
          const LAS float* pq = (const LAS float*)(lds + RW_PAR) + c0 + 4 * hq; (void)Cq;
          const f32x4 mur = *(const LAS f32x4*)(pq), muk = *(const LAS f32x4*)(pq + 64), muv = *(const LAS f32x4*)(pq + 128);
          const f32x4 w0c = *(const LAS f32x4*)(pq + 192), a0c = *(const LAS f32x4*)(pq + 256), v0c = *(const LAS f32x4*)(pq + 320), kkc = *(const LAS f32x4*)(pq + 384);
          rr[hq] = zr[hq] + (pr[hq] - zr[hq]) * mur; kraw[hq] = zk[hq] + (pk[hq] - zk[hq]) * muk; vraw[hq] = zv[hq] + (pv[hq] - zv[hq]) * muv;
#pragma unroll
          for (int e = 0; e < 4; ++e) { ee[hq][e] = 0.60653066f * sigmoidf_(w0c[e] + dw[hq][e]); av[hq][e] = sigmoidf_(a0c[e] + da[hq][e]); const float kq = kraw[hq][e] * kkc[e]; n2 += kq * kq;
              vv[hq][e] = (l == 1) ? vraw[hq][e] + (vf[hq][e] - vraw[hq][e]) * sigmoidf_(v0c[e] + vm[hq][e]) : vraw[hq][e]; } }
      if (l == 0) *(u32x4*)(vfirst + row * 512 + C0) = pack8(vraw[0], vraw[1]);
      n2 = red8_sum(n2);
      const float inn = 1.0f / fmaxf(sqrtf(n2), 1e-12f); float bq = 0.f;
#pragma unroll
      for (int hq = 0; hq < 2; ++hq) { const LAS float* pq = (const LAS float*)(lds + RW_PAR) + c0 + 4 * hq; const f32x4 kkc = *(const LAS f32x4*)(pq + 384), kac = *(const LAS f32x4*)(pq + 448), rkc = *(const LAS f32x4*)(pq + 512);
#pragma unroll
          for (int e = 0; e < 4; ++e) { const float kkn = kraw[hq][e] * kkc[e] * inn; kk_[hq][e] = kraw[hq][e] * (1.0f + (av[hq][e] - 1.0f) * kac[e]); ap[hq][e] = -kkn; bp[hq][e] = kkn * av[hq][e]; bq += rr[hq][e] * kk_[hq][e] * rkc[e]; } }
      bq = red8_sum(bq);
      if ((lt & 7) == 0) bon[tok] = bq;
      *(LAS f32x4*)(Lc + tok * 68 + c0) = -ee[0]; *(LAS f32x4*)(Lc + tok * 68 + c0 + 4) = -ee[1];
      *(u32x4*)(o + row * 2048 + C0) = pack8(gg[0], gg[1]); }
    __syncthreads();
#pragma unroll
    for (int q = 0; q < 8; ++q) { const int ch = 16 * lw + 2 * q + (lane >> 5), tk = lane & 31; float x = Lc[tk * 68 + ch];
        x = scan32(x);
        Lc[tk * 68 + ch] = x; }
    __syncthreads();
#pragma unroll
    for (int hq = 0; hq < 2; ++hq) { const int cq = c0 + 4 * hq;
      const f32x4 Lt = *(const LAS f32x4*)(Lc + tok * 68 + cq), Ll = *(const LAS f32x4*)(Lc + (RT - 1) * 68 + cq); f32x4 Lp = (f32x4){0.f, 0.f, 0.f, 0.f}; if (tok > 0) Lp = *(const LAS f32x4*)(Lc + (tok - 1) * 68 + cq);
      f32x4 at_, rt_, kh_, bh_;
#pragma unroll
      for (int e = 0; e < 4; ++e) { const float ep = __expf(Lt[e]), em = __expf(-Lt[e]), el = __expf(Ll[e] - Lt[e]); at_[e] = ap[hq][e] * __expf(Lp[e]); rt_[e] = rr[hq][e] * ep; kh_[e] = kk_[hq][e] * em; bh_[e] = bp[hq][e] * em;
          const int tr_ = (cq + e) * P40 + rcol4(tok, cq >> 4);
          KpT[tr_] = (bf16)f2bf(kk_[hq][e] * el); BpT[tr_] = (bf16)f2bf(bp[hq][e] * el); VT[tr_] = (bf16)f2bf(vv[hq][e]); }
      u32x2 w; w.x = pk2(at_[0], at_[1]); w.y = pk2(at_[2], at_[3]); *(LAS u32x2*)(At + tok * P72 + cq) = w; w.x = pk2(rt_[0], rt_[1]); w.y = pk2(rt_[2], rt_[3]); *(LAS u32x2*)(Rt + tok * P72 + cq) = w;
      w.x = pk2(kh_[0], kh_[1]); w.y = pk2(kh_[2], kh_[3]); *(LAS u32x2*)(Kh + tok * P72 + cq) = w; w.x = pk2(bh_[0], bh_[1]); w.y = pk2(bh_[2], bh_[3]); *(LAS u32x2*)(Bh + tok * P72 + cq) = w;
      if (tok == 0) { f32x4 gv;
#pragma unroll
          for (int e = 0; e < 4; ++e) gv[e] = __expf(Ll[e]);
          *(LAS f32x4*)(gam + cq) = gv; } }
    __syncthreads();
    { const int rb = lw; const LAS bf16* Am = (rb < 2) ? At : Rt;
#pragma unroll
      for (int cb = 0; cb < 4; ++cb) { const LAS bf16* Bm_ = (cb < 2) ? Kh : Bh; acc4 gm = (acc4){0.f, 0.f, 0.f, 0.f};
#pragma unroll
          for (int ks = 0; ks < 2; ++ks) gm = MFMA16(frag_nat(Am, P72, 16 * (rb & 1) + fr, 32 * ks, g), frag_nat(Bm_, P72, 16 * (cb & 1) + fr, 32 * ks, g), gm);
          const int sidx = 16 * (cb & 1) + fr;
#pragma unroll
          for (int r = 0; r < 4; ++r) { const int tidx = 16 * (rb & 1) + 4 * g + r;
              if (rb < 2) { const float v = (sidx < tidx) ? gm[r] : 0.f; if (cb < 2) Mak[tidx * P40 + sidx] = (bf16)f2bf(v); else Mab[tidx * 33 + sidx] = v; }
              else { const float v = (sidx <= tidx) ? gm[r] : 0.f; if (cb < 2) Ark[tidx * P40 + sidx] = (bf16)f2bf(v); else Arb[tidx * P40 + sidx] = (bf16)f2bf(v); } } } }
    __syncthreads();
    rwkv_prep_fetch(pf, l, nh, nb, ncpair, z, vfirst, o);
    if (lw != 0) { unsigned char* rec = rw_rec_ptr(ws, h, b, c);
        for (int p = lt - 64; p < RW_NPIECE - 128; p += 192) { const int pp = (p < 1664) ? p : p + 128; *(u32x4*)(rec + 16 * pp) = *(const LAS u32x4*)(img + rw_piece_off(pp)); } }
    else {
        if (lane < 32) { const int blk = lane >> 4, cc = lane & 15; float x[16]; unsigned moff = (unsigned)((16 * blk) * 33 + 16 * blk) * 4u;
#pragma unroll
            for (int t = 0; t < 16; ++t) { float sacc = (t == cc) ? 1.0f : 0.f;
                if (t > 0) asm volatile("" : "+v"(moff) : "v"(x[t - 1]));
                const LAS float* mp = (const LAS float*)((LAS unsigned char*)Mab + moff) + t * 33;
#pragma unroll
                for (int s2 = 0; s2 < t; ++s2) sacc += mp[s2] * x[s2];
                x[t] = sacc; }
#pragma unroll
            for (int t = 0; t < 16; ++t) { if (blk == 0) { T1[t * P40 + cc] = (bf16)f2bf(x[t]); T1[t * P40 + 16 + cc] = 0; T2[t * P40 + cc] = (bf16)f2bf(Mab[(16 + t) * 33 + cc]); } else T2[t * P40 + 16 + cc] = (bf16)f2bf(x[t]); } }
        { unsigned char* rec = rw_rec_ptr(ws, h, b, c);
#pragma unroll
          for (int k = 0; k < 2; ++k) { const int p = 1664 + lane + 64 * k; *(u32x4*)(rec + 16 * p) = *(const LAS u32x4*)(img + rw_piece_off(p)); } }
    }
    __syncthreads();
}

constexpr int RC_IMG0 = 0, RC_IMG1 = ((IM_END + 255) / 256) * 256, RC_STAT = 2 * RC_IMG1, RC_DUMMY = RC_STAT + RT * 4 * 8, RC_END = RC_DUMMY + 256 * 16;
__device__ __forceinline__ void rwkv_chain_task(const ArgsD& a, int l, int bh, LAS unsigned char* lds, bf16* o, unsigned char* ws) {
    const int tid = opq_v((int)threadIdx.x), lane = tid & 63, wid = __builtin_amdgcn_readfirstlane(tid >> 6), fr = lane & 15, g = lane >> 4;
    const int b = bh >> 3, h = bh & 7;
    LAS f32x2* stat = (LAS f32x2*)(lds + RC_STAT);
    const int ib = wid & 3, Ci = h * 64 + 16 * ib + fr;
    const float lnw = a.in[I_RW_LNW][l * 512 + Ci], lnb = a.in[I_RW_LNB][l * 512 + Ci];
    acc4 St[4];
#pragma unroll
    for (int jb = 0; jb < 4; ++jb) St[jb] = (acc4){0.f, 0.f, 0.f, 0.f};
    u32x4 pv[8]; int poff[8];
#pragma unroll
    for (int i = 0; i < 8; ++i) { const int p = tid - 256 + 256 * i; poff[i] = (p >= 0 && p < RW_NPIECE) ? rw_piece_off(p) : RC_DUMMY + 16 * (tid & 255); pv[i] = (u32x4){0u, 0u, 0u, 0u}; }
#define RC_FETCH(rec_) do { _Pragma("unroll") for (int i_ = 0; i_ < 8; ++i_) { const int p_ = tid - 256 + 256 * i_; pv[i_] = *(const u32x4*)((rec_) + 16 * (p_ < RW_NPIECE ? p_ : 0)); } } while (0)
#define RC_PUT(dst_) do { _Pragma("unroll") for (int i_ = 0; i_ < 8; ++i_) { *(LAS u32x4*)(((i_ < 7 || tid < 256 + RW_NPIECE - 7 * 256) ? (dst_) : lds) + poff[i_]) = pv[i_]; } } while (0)
    if (wid >= 4) { RC_FETCH(rw_rec_ptr(ws, h, b, 0)); RC_PUT(lds + RC_IMG0); RC_FETCH(rw_rec_ptr(ws, h, b, 1)); }
    __syncthreads();
    for (int c = 0; c < SEQ / RT; ++c) {
        LAS unsigned char* img = lds + ((c & 1) ? RC_IMG1 : RC_IMG0);
        acc4 Y0 = (acc4){0.f, 0.f, 0.f, 0.f}, Y1 = Y0; unsigned gpk[2][4] = {{0, 0, 0, 0}, {0, 0, 0, 0}};
        if (wid >= 4) { RC_PUT(lds + ((c & 1) ? RC_IMG0 : RC_IMG1)); const int cf = (c + 2 < SEQ / RT) ? c + 2 : c; RC_FETCH(rw_rec_ptr(ws, h, b, cf)); }
        else {
            { const size_t tq = (size_t)b * SEQ + c * RT;
#pragma unroll
              for (int hb = 0; hb < 2; ++hb)
#pragma unroll
                  for (int r = 0; r < 4; ++r) gpk[hb][r] = o[(tq + 16 * hb + 4 * g + r) * 2048 + Ci]; }
            const LAS bf16* At = (const LAS bf16*)(img + IM_AT); const LAS bf16* Rt = (const LAS bf16*)(img + IM_RT); const LAS bf16* KpT = (const LAS bf16*)(img + IM_KPT); const LAS bf16* BpT = (const LAS bf16*)(img + IM_BPT); const LAS bf16* VT = (const LAS bf16*)(img + IM_VT);
            const LAS bf16* Mak = (const LAS bf16*)(img + IM_MAK); const LAS bf16* Ark = (const LAS bf16*)(img + IM_ARK); const LAS bf16* Arb = (const LAS bf16*)(img + IM_ARB); const LAS bf16* T1 = (const LAS bf16*)(img + IM_T1); const LAS bf16* T2 = (const LAS bf16*)(img + IM_T2);
            const LAS float* gam = (const LAS float*)(img + IM_GAM);
            const bf16x8 Sb0 = frag_acc(St[0], St[1]), Sb1 = frag_acc(St[2], St[3]); const bf16x8 vtf = *(const LAS bf16x8*)(VT + (16 * ib + fr) * P40 + rcol4(8 * g, ib));
            acc4 X0 = (acc4){0.f, 0.f, 0.f, 0.f}, X1 = X0;
            X0 = MFMA16(frag_perm(At, P72, fr, 0, g), Sb0, X0); X0 = MFMA16(frag_perm(At, P72, fr, 32, g), Sb1, X0); X0 = MFMA16(frag_nat(Mak, P40, fr, 0, g), vtf, X0);
            X1 = MFMA16(frag_perm(At, P72, 16 + fr, 0, g), Sb0, X1); X1 = MFMA16(frag_perm(At, P72, 16 + fr, 32, g), Sb1, X1); X1 = MFMA16(frag_nat(Mak, P40, 16 + fr, 0, g), vtf, X1);
            Y0 = MFMA16(frag_perm(Rt, P72, fr, 0, g), Sb0, Y0); Y0 = MFMA16(frag_perm(Rt, P72, fr, 32, g), Sb1, Y0); Y0 = MFMA16(frag_nat(Ark, P40, fr, 0, g), vtf, Y0);
            Y1 = MFMA16(frag_perm(Rt, P72, 16 + fr, 0, g), Sb0, Y1); Y1 = MFMA16(frag_perm(Rt, P72, 16 + fr, 32, g), Sb1, Y1); Y1 = MFMA16(frag_nat(Ark, P40, 16 + fr, 0, g), vtf, Y1);
            const acc4 zero4 = (acc4){0.f, 0.f, 0.f, 0.f};
            const acc4 U0 = MFMA16(frag_perm(T1, P40, fr, 0, g), frag_acc(X0, zero4), zero4);
            const bf16x8 t2f = frag_perm(T2, P40, fr, 0, g);
            const acc4 W1 = MFMA16(t2f, frag_acc(U0, zero4), X1);
            const acc4 U1 = MFMA16(t2f, frag_acc(zero4, W1), zero4);
            const bf16x8 Ub = frag_acc(U0, U1);
            Y0 = MFMA16(frag_perm(Arb, P40, fr, 0, g), Ub, Y0); Y1 = MFMA16(frag_perm(Arb, P40, 16 + fr, 0, g), Ub, Y1);
#pragma unroll
            for (int jb = 0; jb < 4; ++jb) { const f32x4 gm = *(const LAS f32x4*)(gam + 16 * jb + 4 * g); St[jb] = St[jb] * gm;
                const bf16x8 kpf = *(const LAS bf16x8*)(KpT + (16 * jb + fr) * P40 + rcol4(8 * g, jb));
                const LAS bf16* bpp = BpT + (16 * jb + fr) * P40; const u32x2 bv0 = *(const LAS u32x2*)(bpp + rcol4(4 * g, jb)), bv1 = *(const LAS u32x2*)(bpp + rcol4(4 * g + 16, jb)); u32x4 bw; bw.x = bv0.x; bw.y = bv0.y; bw.z = bv1.x; bw.w = bv1.y;
                St[jb] = MFMA16(kpf, vtf, St[jb]); St[jb] = MFMA16(__builtin_bit_cast(bf16x8, bw), Ub, St[jb]); }
#pragma unroll
            for (int r = 0; r < 4; ++r) { float s0 = Y0[r], q0 = Y0[r] * Y0[r], s1 = Y1[r], q1 = Y1[r] * Y1[r];
                s0 = red16_sum(s0); q0 = red16_sum(q0); s1 = red16_sum(s1); q1 = red16_sum(q1);
                if (fr == 0) { stat[(4 * g + r) * 4 + ib] = (f32x2){s0, q0}; stat[(16 + 4 * g + r) * 4 + ib] = (f32x2){s1, q1}; } }
        }
        __syncthreads();
        if (wid < 4) {
            const LAS bf16* VT = (const LAS bf16*)(img + IM_VT); const LAS float* bon = (const LAS float*)(img + IM_BON);
            const size_t t0 = (size_t)b * SEQ + c * RT;
#pragma unroll
            for (int hb = 0; hb < 2; ++hb) { const u32x2 vw = *(const LAS u32x2*)(VT + (16 * ib + fr) * P40 + rcol4(16 * hb + 4 * g, ib)); const f32x4 vv = (f32x4){lo2f(vw.x), hi2f(vw.x), lo2f(vw.y), hi2f(vw.y)};
#pragma unroll
                for (int r = 0; r < 4; ++r) { const int t = 16 * hb + 4 * g + r; const f32x2 s0 = stat[t * 4 + 0], s1 = stat[t * 4 + 1], s2 = stat[t * 4 + 2], s3 = stat[t * 4 + 3];
                    const float mean = ((s0.x + s1.x) + (s2.x + s3.x)) * (1.0f / 64.0f); const float ex2 = ((s0.y + s1.y) + (s2.y + s3.y)) * (1.0f / 64.0f);
                    const float rstd = rsqrtf(fmaxf(ex2 - mean * mean, 0.f) + 64e-5f); const float y = hb ? Y1[r] : Y0[r];
                    bf16* op = o + (t0 + t) * 2048 + Ci; const float gg = bf2f((bf16)gpk[hb][r]);
                    *op = (bf16)f2bf((((y - mean) * rstd * lnw + lnb) + bon[t] * vv[r]) * gg); } }
        }
        __syncthreads();
    }
}

#define XB_TMO      128
#define XB_XCNT(j)  (256  + 64 * (j))
#define XB_XSUB(j)  (1280 + 64 * (j))
#define XB_XGEN(j)  (2304 + 64 * (j))
#define XB_TOP      3328
#define XB_TOPGEN   3392
#define XCD_BAR_WORDS 3456
#define XB_SPIN_CAP (1u << 20)
__device__ __forceinline__ unsigned xb_ld(unsigned* p)              { return __hip_atomic_load(p, __ATOMIC_RELAXED, __HIP_MEMORY_SCOPE_AGENT); }
__device__ __forceinline__ unsigned xb_add(unsigned* p, unsigned v) { return __hip_atomic_fetch_add(p, v, __ATOMIC_RELAXED, __HIP_MEMORY_SCOPE_AGENT); }
__device__ __forceinline__ unsigned xb_xcc_id() { return (unsigned)__builtin_amdgcn_s_getreg((3 << 11) | 20) & 0xFu; }
#define XB_SPIN(cond, bar) do { unsigned _sp = 0; while (cond) { __builtin_amdgcn_s_sleep(1); \
    if ((++_sp & 255u) == 0u) { if (xb_ld(&(bar)[XB_TMO])) break; if (_sp > XB_SPIN_CAP) { atomicAdd(&(bar)[XB_TMO], 1u); break; } } } } while (0)
__device__ __forceinline__ void xcd_barrier_complete(unsigned* bar, unsigned x, unsigned& nloc, unsigned& nx) {
    const unsigned G = gridDim.x * gridDim.y * gridDim.z;
    unsigned sum, cnt, mine, sp = 0u;
    for (;;) {
        sum = 0u; cnt = 0u; mine = 0u;
#pragma unroll
        for (unsigned j = 0; j < 16; ++j) { const unsigned c = xb_ld(&bar[XB_XCNT(j)]); sum += c; cnt += (c > 0u) ? 1u : 0u; mine = (j == x) ? c : mine; }
        if (sum == G) break;
        __builtin_amdgcn_s_sleep(1);
        if ((++sp & 255u) == 0u) { if (xb_ld(&bar[XB_TMO])) break; if (sp > XB_SPIN_CAP) { atomicAdd(&bar[XB_TMO], 1u); break; } }
    }
    nloc = mine > 0u ? mine : 1u; nx = cnt > 0u ? cnt : 1u;
}
__device__ __forceinline__ void xcd_barrier(unsigned* bar, volatile LAS unsigned* st) {
    asm volatile("s_waitcnt vmcnt(0)" ::: "memory");
    __syncthreads();
    if (threadIdx.x == 0) {
        __builtin_amdgcn_s_waitcnt(0);
        unsigned nloc = st[0], nx = st[1]; const unsigned x = st[2];
        if (nloc == 0u) { xcd_barrier_complete(bar, x, nloc, nx); st[0] = nloc; st[1] = nx; }
        const unsigned old = xb_add(&bar[XB_XSUB(x)], 1u);
        const unsigned gen = old / nloc;
        if (old + 1u == (gen + 1u) * nloc) {
            __builtin_amdgcn_fence(__ATOMIC_RELEASE, "agent");
            asm volatile("s_waitcnt vmcnt(0)" ::: "memory");
            const unsigned og = xb_add(&bar[XB_TOP], 1u);
            const unsigned tg = og / nx;
            if (og + 1u == (tg + 1u) * nx) xb_add(&bar[XB_TOPGEN], 1u);
            else XB_SPIN(xb_ld(&bar[XB_TOPGEN]) == tg, bar);
            __builtin_amdgcn_fence(__ATOMIC_ACQUIRE, "agent");
            xb_add(&bar[XB_XGEN(x)], 1u);
            asm volatile("s_waitcnt vmcnt(0)" ::: "memory");
        } else {
            XB_SPIN(xb_ld(&bar[XB_XGEN(x)]) == gen, bar);
            __builtin_amdgcn_fence(__ATOMIC_ACQUIRE, "agent");
            asm volatile("s_waitcnt vmcnt(0)" ::: "memory");
        }
    }
    __syncthreads();
}

constexpr int LDS_WSCR = 20352;
constexpr int LDS_TOTAL = NWAVES * LDS_WSCR + 1024;
static_assert(LDS_TOTAL <= 163840 && NWAVES * LDS_WSCR >= LDS_MAIN, "LDS map");
constexpr int NPH = 22;
#ifndef MIXMASK
#define MIXMASK 15
#endif
#define MIX_T(bit, call) do { if ((MIXMASK) & (bit)) { call; } } while (0)

#define PHASE_PTRS \
    const int tid = opq_v((int)threadIdx.x), lane = tid & 63, wid = __builtin_amdgcn_readfirstlane(tid >> 6); (void)lane; (void)wid; \
    const int G = opq_s((int)gridDim.x), bx = opq_s((int)blockIdx.x); const int gw = bx * NWAVES + wid, ngw = G * NWAVES; (void)gw; (void)ngw; \
    LAS unsigned char* lds = (LAS unsigned char*)lds_raw; LAS unsigned* lctl = (LAS unsigned*)(lds + NWAVES * LDS_WSCR); (void)lctl; \
    ArgsD a; a.in.tab = (LAS unsigned long long*)(lds + NWAVES * LDS_WSCR + 640); \
    unsigned char* ws = a.ws(); float* a_out = a.out(); (void)a_out; \
    unsigned* ctl = (unsigned*)(ws + WS_CTL); (void)ctl; \
    float* ssb = (float*)(ws + WS_SMALL + SM_SS); (void)ssb; \
    float* mssq = (float*)(ws + WS_SMALL + SM_MSSQ); (void)mssq; \
    int* tok_e = (int*)(ws + WS_SMALL + SM_TOKE); float* tok_g = (float*)(ws + WS_SMALL + SM_TOKG); float* tok_rs = (float*)(ws + WS_SMALL + SM_TOKRS); (void)tok_e; (void)tok_g; (void)tok_rs; \
    int* tok_slot = (int*)(ws + WS_SMALL + SM_TOKSLOT); int* row_tok = (int*)(ws + WS_SMALL + SM_ROWTOK); float* row_gate = (float*)(ws + WS_SMALL + SM_ROWGATE); float* row_rs = (float*)(ws + WS_SMALL + SM_ROWRS); (void)tok_slot; (void)row_tok; (void)row_gate; (void)row_rs; \
    bf16* xb = (bf16*)(ws + WS_XB); (void)xb; \
    bf16* vfirst = (bf16*)(ws + WS_X + X_VFIRST); bf16* mixed = (bf16*)(ws + WS_X + X_MIXED); bf16* obuf = (bf16*)(ws + WS_X + X_O); (void)vfirst; (void)mixed; (void)obuf; \
    unsigned char* wreg = ws + WS_X + X_W; (void)wreg; \
    bf16* zbuf = (bf16*)(ws + WS_Z); bf16* gates = zbuf; bf16* hidden = zbuf; bf16* act = zbuf; (void)gates; (void)hidden; (void)act; \
    bf16* xg = (bf16*)(ws + WS_XG); bf16* ybuf = xg; bf16* rwarr = xg; (void)ybuf; (void)rwarr; bf16* ypart = (bf16*)(ws + WS_Z + (size_t)128 * MiB); (void)ypart; bf16* bcv = (bf16*)(ws + WS_BCV); (void)bcv; float* gend = (float*)(ws + WS_GEND); (void)gend; \
    bf16* moe_w13 = (bf16*)(ws + WS_X + MOE_W13); bf16* moe_w2 = (bf16*)(ws + WS_X + MOE_W2); (void)moe_w13; (void)moe_w2;

#define IDLE_CVT_BEGIN(nwg_) { const int p0_ = (nwg_) % G; if (bx >= p0_) { CvtCtx cx; cx.gw = (bx - p0_) * NWAVES + wid; cx.ngw = (G - p0_) * NWAVES; cx.base = 0; cx.lane = lane; cx.scr = (LAS float*)(lds + wid * LDS_WSCR); \
        const int zt_ = (bx - p0_) * NTHREADS + tid, zn_ = (G - p0_) * NTHREADS; (void)zt_; (void)zn_;
#define IDLE_CVT_END } }
#define CVT_LAYER_REST(l_) do { const float* win_ = a.in[I_WIN] + (size_t)(l_) * DM * IN_COLS; const float* nm_ = a.in[I_NORM_MIX] + (l_) * DM; \
        cvt_job_gates(cx, win_, IN_COLS, DM, MIXC, nm_, (bf16*)(wreg + W_G) + (size_t)(l_) * 4096 * DM); \
        for (int i_ = 0; i_ < 4; ++i_) cvt_job(cx, a.in[I_WBRANCH] + ((size_t)(l_) * 4 + i_) * 512 * DM, DM, 512, 0, DM, nullptr, (bf16*)(wreg + W_B) + ((size_t)(l_) * 4 + i_) * DM * 512, 0, 128); \
        cvt_job(cx, a.in[I_WOUT] + (size_t)(l_) * DM * DM, DM, DM, 0, DM, nullptr, (bf16*)(wreg + W_O) + (size_t)(l_) * DM * DM, 0, 128); } while (0)
template <int LO, int HI>
__device__ __forceinline__ void mk_body(const Args& ka) {
    extern __shared__ __attribute__((aligned(16))) unsigned char lds_raw[];
    { LAS unsigned long long* ptab = (LAS unsigned long long*)((LAS unsigned char*)lds_raw + NWAVES * LDS_WSCR + 640);
      const int t0 = threadIdx.x;
      if (t0 < N_IN) ptab[t0] = (unsigned long long)ka.in[t0];
      if (t0 == N_IN) ptab[t0] = (unsigned long long)ka.out;
      if (t0 == N_IN + 1) ptab[t0] = (unsigned long long)ka.ws;
#if !MK_PER_PHASE
      if (t0 == 64) { LAS unsigned* st = (LAS unsigned*)((LAS unsigned char*)lds_raw + NWAVES * LDS_WSCR + 992); st[0] = 0u; st[1] = 0u; const unsigned x = xb_xcc_id(); st[2] = x;
          (void)xb_add((unsigned*)(ka.ws + WS_CTL) + CW_BAR + XB_XCNT(x), 1u); }
#endif
      __syncthreads(); }
#if MK_PER_PHASE
#define GRID_BAR() do { } while (0)
#else
#define GRID_BAR() do { unsigned char* ws_ = ArgsD{PT{(LAS unsigned long long*)((LAS unsigned char*)lds_raw + NWAVES * LDS_WSCR + 640)}}.ws(); \
    xcd_barrier((unsigned*)(ws_ + WS_CTL) + CW_BAR, (volatile LAS unsigned*)((LAS unsigned char*)lds_raw + NWAVES * LDS_WSCR + 992)); } while (0)
#endif
#define IN(k) (LO <= (k) && (k) < HI)
#if MK_PER_PHASE
#define SPLIT_ARRIVE(w) do { } while (0)
#define SPLIT_WAIT(w) do { } while (0)
#else
#define SPLIT_ARRIVE(w) do { asm volatile("s_waitcnt vmcnt(0)" ::: "memory"); __syncthreads(); if (threadIdx.x == 0) { unsigned* c_ = (unsigned*)(ArgsD{PT{(LAS unsigned long long*)((LAS unsigned char*)lds_raw + NWAVES * LDS_WSCR + 640)}}.ws() + WS_CTL); \
        __builtin_amdgcn_fence(__ATOMIC_RELEASE, "agent"); asm volatile("s_waitcnt vmcnt(0)" ::: "memory"); xb_add(c_ + CW_SPLIT + 64 * (w), 1u); } } while (0)
#define SPLIT_WAIT(w) do { if (threadIdx.x == 0) { unsigned* c_ = (unsigned*)(ArgsD{PT{(LAS unsigned long long*)((LAS unsigned char*)lds_raw + NWAVES * LDS_WSCR + 640)}}.ws() + WS_CTL); \
        XB_SPIN(xb_ld(c_ + CW_SPLIT + 64 * (w)) < gridDim.x, c_ + CW_BAR); __builtin_amdgcn_fence(__ATOMIC_ACQUIRE, "agent"); asm volatile("s_waitcnt vmcnt(0)" ::: "memory"); } __syncthreads(); } while (0)
#endif
#define SEAM(k) do { if (IN(k) && IN((k) + 1)) GRID_BAR(); } while (0)

    if (IN(0)) { PHASE_PTRS
        CvtCtx cx; cx.gw = gw; cx.ngw = ngw; cx.base = 0; cx.lane = lane; cx.scr = (LAS float*)(lds + wid * LDS_WSCR);
        { const float* win = a.in[I_WIN]; const float* nm = a.in[I_NORM_MIX]; bf16* winT = (bf16*)(wreg + W_IN);
          cvt_job(cx, win, IN_COLS, DM, 0, MIXC, nm, winT, 0, 128);
          zero_rows_bf16(bx * NTHREADS + tid, G * NTHREADS, winT + (size_t)C_HV * DM, (size_t)(ZC - C_HV) * DM); }
        const float* x = a.in[I_X];
        for (int m = gw; m < T; m += ngw) { const f32x4* xr = (const f32x4*)(x + (size_t)m * DM) + lane; float s = 0.f;
#pragma unroll
            for (int j = 0; j < 4; ++j) { const f32x4 v = xr[64 * j]; s += (v[0] * v[0] + v[1] * v[1]) + (v[2] * v[2] + v[3] * v[3]); u32x2 w; w.x = pk2(v[0], v[1]); w.y = pk2(v[2], v[3]); *((u32x2*)(xb + (size_t)m * DM) + lane + 64 * j) = w; }
            s = wave_sum(s); if (lane < 16) ssb[(size_t)m * 16 + lane] = (lane == 0) ? s : 0.f; }
    }
#if MK_PER_PHASE
    SEAM(0);
#else
    if (IN(0) && IN(1)) { if (ka.ws == nullptr) cg::this_grid().sync();
                          GRID_BAR(); }
#endif

#pragma unroll
    for (int l = 0; l < 2; ++l) {
        const int pb = 1 + 9 * l;
#define ss_mix (ssb + (size_t)(l == 0 ? 0 : 2) * T * 16)
#define ss_ffn (l == 0 ? ssb + (size_t)T * 16 : (float*)nullptr)
        if (IN(pb + 0)) { PHASE_PTRS
            pg8::Gemm g{DM, DM, DM}; pg8::StaticOrder S; S.init(xb, (bf16*)(wreg + W_IN) + (size_t)l * ZC * DM, DM, DM, T, ZC, G, bx);
            EpiScaleBf16<0> E{zbuf, ZC, ss_mix};
            pg8::gemm_phase(lds, g, S, E);
            IDLE_CVT_BEGIN((T / 256) * (ZC / 256))
                CVT_LAYER_REST(l);
                if (l == 0) {
#if FFN_FP8
                    cvt_job8(cx, a.in[I_FFN_W1], FFN, DM, 0, FFN, a.in[I_NORM_FFN], 32.0f, wreg + W_13, 0, 256);
                    cvt_job8(cx, a.in[I_FFN_W3], FFN, DM, 0, FFN, a.in[I_NORM_FFN], 32.0f, wreg + W_13, 128, 256);
                    cvt_job8(cx, a.in[I_FFN_W2], DM, FFN, 0, DM, nullptr, 64.0f, wreg + W_2, 0, 128);
#else
                    cvt_job(cx, a.in[I_FFN_W1], FFN, DM, 0, FFN, a.in[I_NORM_FFN], (bf16*)(wreg + W_13), 0, 256);
                    cvt_job(cx, a.in[I_FFN_W3], FFN, DM, 0, FFN, a.in[I_NORM_FFN], (bf16*)(wreg + W_13), 128, 256);
                    cvt_job(cx, a.in[I_FFN_W2], DM, FFN, 0, DM, nullptr, (bf16*)(wreg + W_2), 0, 128);
#endif
                }
            IDLE_CVT_END
        }
        SEAM(pb + 0);
        if (IN(pb + 1)) { PHASE_PTRS
            rwkv_xlr_prepass(a, l, bx, G, zbuf, obuf);
            if (IN(pb + 2)) SPLIT_ARRIVE(2 + l);
            mamba_bc_prepass(a, l, gw, ngw, lane, zbuf, bcv);
            gla_prepass(a, l, bx, G, lds, zbuf, gend);
        }
        if (IN(pb + 1) && IN(pb + 2)) SPLIT_WAIT(2 + l);
        if (IN(pb + 2)) { PHASE_PTRS
            const int npair = 8 * BATCH * (SEQ / RT) / 2, ppb = (npair + G - 1) / G; int wts_h = -1;
            const int u0 = bx * ppb, u1 = ((bx + 1) * ppb < npair) ? (bx + 1) * ppb : npair;
            if (u0 < u1) { PrepPf pf; rwkv_prep_fetch(pf, l, u0 >> 8, (u0 >> 5) & 7, 2 * (u0 & 31), zbuf, vfirst, obuf);
                for (int u = u0; u < u1; ++u) { const int un = (u + 1 < u1) ? u + 1 : u;
                    rwkv_prep_pair(a, l, u >> 8, (u >> 5) & 7, 2 * (u & 31), un >> 8, (un >> 5) & 7, 2 * (un & 31), pf, wts_h, lds, zbuf, vfirst, obuf, ws); } } }
        SEAM(pb + 2);
        if (IN(pb + 3)) { PHASE_PTRS
            if (bx < 64) { MIX_T(1, rwkv_chain_task(a, l, bx, lds, obuf, ws)); }
            else if (bx < 128) { MIX_T(2, mamba_block_task(a, l, bx - 64, lds, zbuf, bcv, obuf, mssq)); }
            else if (bx < 160) { MIX_T(4, gla_block_task(a, l, bx - 128, lds, zbuf, gend, obuf)); }
            MIX_T(8, attn_drain(a, l, lds, lctl, ctl + CW_ATTQ + l, zbuf, obuf));
        }
        SEAM(pb + 3);
        if (IN(pb + 4)) { PHASE_PTRS
            const float* nw = a.in[I_SSM_NORMW] + l * 512;
            for (int m = gw; m < T; m += ngw) { const int g = lane >> 5; const float* q = mssq + (size_t)m * 8 + g * 4; const float sc = rsqrtf((q[0] + q[1] + q[2] + q[3]) * (1.0f / 256.0f) + NORM_EPS);
                bf16* p = obuf + (size_t)m * 2048 + 512 + lane * 8; const u32x4 w = *(const u32x4*)p; f32x4 v0, v1; unpack8(w, v0, v1);
                const f32x4 n0 = *(const f32x4*)(nw + lane * 8), n1 = *(const f32x4*)(nw + lane * 8 + 4);
                *(u32x4*)p = pack8(v0 * n0 * sc, v1 * n1 * sc); }
            pg8::Gemm g{DM, DM, DM}; pg8::StaticOrder S; S.init(xb, (bf16*)(wreg + W_G) + (size_t)l * 4096 * DM, DM, DM, T, 4096, G, bx);
            EpiGateRatio E{gates, ss_mix};
            pg8::gemm_phase(lds, g, S, E);
        }
        SEAM(pb + 4);
        if (IN(pb + 5)) { PHASE_PTRS
            pg8::Gemm g{2048, 512, 512}; MixOrder S{(const char*)obuf, (const char*)((bf16*)(wreg + W_B) + (size_t)l * 4 * DM * 512), G, bx};
            EpiMix E{gates, mixed};
            pg8::gemm_phase(lds, g, S, E);
        }
        SEAM(pb + 5);
        if (IN(pb + 6)) { PHASE_PTRS
            pg8::Gemm g{DM, DM, DM}; pg8::StaticOrder S; S.init(mixed, (bf16*)(wreg + W_O) + (size_t)l * DM * DM, DM, DM, T, DM, G, bx);
            EpiResid<false> E{l == 0 ? a.in[I_X] : a_out, a_out, xb, ss_ffn, (FFN_FP8 && l == 0) ? (unsigned char*)xg : (unsigned char*)nullptr};
            pg8::gemm_phase(lds, g, S, E);
        }
        if (l == 0) SEAM(pb + 6); else if (IN(pb + 6) && IN(pb + 7)) SPLIT_ARRIVE(0);
        if (l == 0) {
            if (IN(pb + 7)) { PHASE_PTRS
#if FFN_FP8
                pg8::Gemm g{DM / 2, DM / 2, DM / 2}; pg8::StaticOrder S; S.init(xg, (bf16*)(wreg + W_13), DM / 2, DM / 2, T, 2 * FFN, G, bx);
                EpiSwiglu<false, true> E{hidden, FFN, ss_ffn};
#else
                pg8::Gemm g{DM, DM, DM}; pg8::StaticOrder S; S.init(xb, (bf16*)(wreg + W_13), DM, DM, T, 2 * FFN, G, bx);
                EpiSwiglu<false, false> E{hidden, FFN, ss_ffn};
#endif
                pg8::gemm_phase(lds, g, S, E);
                IDLE_CVT_BEGIN((T / 256) * (2 * FFN / 256))
                    const float* win = a.in[I_WIN] + (size_t)DM * IN_COLS; const float* nm = a.in[I_NORM_MIX] + DM; bf16* winT = (bf16*)(wreg + W_IN) + (size_t)ZC * DM;
                    cvt_job(cx, win, IN_COLS, DM, 0, MIXC, nm, winT, 0, 128);
                    cvt_job(cx, a.in[I_VRES_DOWN], 32, DM, 0, 32, nm, winT, C_HV, 128);
                    zero_rows_bf16(zt_, zn_, winT + (size_t)(C_HV + 32) * DM, (size_t)(ZC - C_HV - 32) * DM);
                IDLE_CVT_END
            }
            SEAM(pb + 7);
            if (IN(pb + 8)) { PHASE_PTRS
#if FFN_FP8
                pg8::Gemm g{FFN / 2, FFN / 2, FFN / 2}; pg8::StaticOrder S; S.init(hidden, (bf16*)(wreg + W_2), FFN / 2, FFN / 2, T, DM, G, bx);
                EpiResid<true> E{a_out, a_out, xb, ssb + (size_t)2 * T * 16, nullptr};
#else
                pg8::Gemm g{FFN, FFN, FFN}; pg8::StaticOrder S; S.init(hidden, (bf16*)(wreg + W_2), FFN, FFN, T, DM, G, bx);
                EpiResid<false> E{a_out, a_out, xb, ssb + (size_t)2 * T * 16, nullptr};
#endif
                pg8::gemm_phase(lds, g, S, E);
            }
            SEAM(pb + 8);
        }
    }
    if (IN(17)) { PHASE_PTRS
        if (tid < 8) lctl[tid] = 0u;
        __syncthreads();
        const float* nf_ = a.in[I_NORM_FFN] + DM;
        CvtCtx cx; cx.gw = gw; cx.ngw = ngw; cx.base = 0; cx.lane = lane; cx.scr = (LAS float*)(lds + wid * LDS_WSCR);
#define MOE_CVT13(e_) do { unsigned char* w13_8 = (unsigned char*)moe_w13 + (size_t)(e_) * 2 * EDIM * DM; \
            cvt_job8(cx, a.in[I_MOE_W1] + (size_t)(e_) * DM * EDIM, EDIM, DM, 0, EDIM, nf_, 32.0f, w13_8, 0, 256); cvt_job8(cx, a.in[I_MOE_W3] + (size_t)(e_) * DM * EDIM, EDIM, DM, 0, EDIM, nf_, 32.0f, w13_8, 128, 256); } while (0)
        for (int e = 0; e < NEXP; ++e) { unsigned char* w2_8 = (unsigned char*)moe_w13 + (size_t)NEXP * 2 * EDIM * DM + (size_t)e * DM * EDIM;
            cvt_job8(cx, a.in[I_MOE_W2] + (size_t)e * EDIM * DM, DM, EDIM, 0, DM, nullptr, 64.0f, w2_8, 0, 128); }
        for (int e = 0; e < 2; ++e) MOE_CVT13(e);
        if (IN(16)) SPLIT_WAIT(0);
        const float* nf = a.in[I_NORM_FFN] + DM; const float* wr = a.in[I_MOE_ROUTER];
        f32x4 nv[4];
        { const int m0 = gw < T ? gw : 0; const f32x4* xr = (const f32x4*)(a_out + (size_t)m0 * DM) + lane;
#pragma unroll
          for (int j = 0; j < 4; ++j) nv[j] = xr[64 * j]; }
        for (int m = gw; m < T; m += ngw) { f32x4 v[4]; float s = 0.f;
#pragma unroll
            for (int j = 0; j < 4; ++j) { v[j] = nv[j]; s += (v[j][0] * v[j][0] + v[j][1] * v[j][1]) + (v[j][2] * v[j][2] + v[j][3] * v[j][3]); }
            { const int mn = (m + ngw < T) ? m + ngw : m; const f32x4* xr = (const f32x4*)(a_out + (size_t)mn * DM) + lane;
#pragma unroll
              for (int j = 0; j < 4; ++j) nv[j] = xr[64 * j]; }
            const float rs = rsqrtf(wave_sum(s) * (1.0f / DM) + NORM_EPS);
            float lg[8];
#pragma unroll
            for (int e = 0; e < 8; ++e) lg[e] = 0.f;
#pragma unroll
            for (int j = 0; j < 4; ++j) { const int k0 = 4 * (lane + 64 * j); const f32x4 gn = *(const f32x4*)(nf + k0);
#pragma unroll
                for (int q = 0; q < 4; ++q) { const float hf = v[j][q] * rs * gn[q]; const f32x4 w0 = *(const f32x4*)(wr + (size_t)(k0 + q) * 8), w1 = *(const f32x4*)(wr + (size_t)(k0 + q) * 8 + 4);
                    lg[0] += hf * w0[0]; lg[1] += hf * w0[1]; lg[2] += hf * w0[2]; lg[3] += hf * w0[3]; lg[4] += hf * w1[0]; lg[5] += hf * w1[1]; lg[6] += hf * w1[2]; lg[7] += hf * w1[3]; } }
#pragma unroll
            for (int e = 0; e < 8; ++e) lg[e] = wave_sum(lg[e]);
            int e0 = 0; float v0 = lg[0];
#pragma unroll
            for (int e = 1; e < 8; ++e) if (lg[e] > v0) { v0 = lg[e]; e0 = e; }
            int e1 = -1; float v1 = -3.0e38f;
#pragma unroll
            for (int e = 0; e < 8; ++e) if (e != e0 && lg[e] > v1) { v1 = lg[e]; e1 = e; }
            if (e1 < 0) { e1 = (e0 == 0) ? 1 : 0; v1 = v0; }
            const float g0 = 1.0f / (1.0f + __expf(v1 - v0));
            if (lane == 0) { tok_e[2 * m] = e0; tok_e[2 * m + 1] = e1; tok_g[2 * m] = g0; tok_g[2 * m + 1] = 1.0f - g0; tok_rs[m] = rs;
                __hip_atomic_fetch_add(lctl + e0, 1u, __ATOMIC_RELAXED, __HIP_MEMORY_SCOPE_WORKGROUP); __hip_atomic_fetch_add(lctl + e1, 1u, __ATOMIC_RELAXED, __HIP_MEMORY_SCOPE_WORKGROUP); } }
        __syncthreads();
        if (tid < 8) atomicAdd(ctl + CW_MOECNT + tid, lctl[tid]);
        if (IN(18)) SPLIT_ARRIVE(1);
        for (int e = 2; e < NEXP; ++e) MOE_CVT13(e);
#undef MOE_CVT13
    }
    if (IN(17) && IN(18)) SPLIT_WAIT(1);

    if (IN(18)) { PHASE_PTRS
        unsigned cnt[8]; int base[8];
        { int acc = 0;
#pragma unroll
          for (int e = 0; e < 8; ++e) { cnt[e] = (unsigned)__builtin_amdgcn_readfirstlane((int)__hip_atomic_load(ctl + CW_MOECNT + e, __ATOMIC_RELAXED, __HIP_MEMORY_SCOPE_AGENT)); base[e] = acc; acc += (int)((cnt[e] + 255u) & ~255u); } }
        LAS unsigned* lcnt = lctl; LAS int* lstart = (LAS int*)(lctl + 8); LAS int* pslot = (LAS int*)(lctl + 16);
        for (int tgp = bx; tgp < T / 64; tgp += G) {
            if (tid < 8) lcnt[tid] = 0u;
            __syncthreads();
            int e0 = 0, e1 = 0, r0 = 0, r1 = 0; const int tok = tgp * 64 + tid;
            if (tid < 64) { e0 = tok_e[2 * tok]; e1 = tok_e[2 * tok + 1]; r0 = (int)__hip_atomic_fetch_add(lcnt + e0, 1u, __ATOMIC_RELAXED, __HIP_MEMORY_SCOPE_WORKGROUP); r1 = (int)__hip_atomic_fetch_add(lcnt + e1, 1u, __ATOMIC_RELAXED, __HIP_MEMORY_SCOPE_WORKGROUP); }
            __syncthreads();
            if (tid < 8) { int bsel = 0;
#pragma unroll
                for (int e = 0; e < 8; ++e) bsel = (tid == e) ? base[e] : bsel;
                lstart[tid] = bsel + (int)atomicAdd(ctl + CW_MOECUR + tid, lcnt[tid]); }
            __syncthreads();
            if (tid < 64) { const int s0 = lstart[e0] + r0, s1 = lstart[e1] + r1; pslot[2 * tid] = s0; pslot[2 * tid + 1] = s1;
                { int enc0 = s0, enc1 = s1;
#pragma unroll
                  for (int e = 0; e < 8; ++e) { const int fullr = (int)(cnt[e] & ~255u); int pi = 0;
#pragma unroll
                      for (int q = 0; q < 8; ++q) pi += (q < e && (cnt[q] & 255u)) ? 1 : 0;
                      if (e0 == e && s0 - base[e] >= fullr) enc0 = -(1 + pi * 256 + (s0 - base[e] - fullr));
                      if (e1 == e && s1 - base[e] >= fullr) enc1 = -(1 + pi * 256 + (s1 - base[e] - fullr)); }
                  tok_slot[2 * tok] = enc0; tok_slot[2 * tok + 1] = enc1; }
                const float rs = tok_rs[tok];
                row_tok[s0] = tok; row_tok[s1] = tok; row_gate[s0] = tok_g[2 * tok]; row_gate[s1] = tok_g[2 * tok + 1]; row_rs[s0] = rs; row_rs[s1] = rs; }
            __syncthreads();
            { u32x4 sv[8][2];
#pragma unroll
              for (int q = 0; q < 8; ++q) { const u32x4* src = (const u32x4*)(xb + (size_t)(tgp * 64 + wid * 8 + q) * DM) + 2 * lane; sv[q][0] = src[0]; sv[q][1] = src[1]; }
#pragma unroll
              for (int q = 0; q < 8; ++q) { const int tl = wid * 8 + q;
                f32x4 v0, v1, v2, v3; unpack8(sv[q][0], v0, v1); unpack8(sv[q][1], v2, v3); u32x4 w8; int t;
                t = 0; t = __builtin_amdgcn_cvt_pk_fp8_f32(v0[0], v0[1], t, false); t = __builtin_amdgcn_cvt_pk_fp8_f32(v0[2], v0[3], t, true); w8.x = (unsigned)t;
                t = 0; t = __builtin_amdgcn_cvt_pk_fp8_f32(v1[0], v1[1], t, false); t = __builtin_amdgcn_cvt_pk_fp8_f32(v1[2], v1[3], t, true); w8.y = (unsigned)t;
                t = 0; t = __builtin_amdgcn_cvt_pk_fp8_f32(v2[0], v2[1], t, false); t = __builtin_amdgcn_cvt_pk_fp8_f32(v2[2], v2[3], t, true); w8.z = (unsigned)t;
                t = 0; t = __builtin_amdgcn_cvt_pk_fp8_f32(v3[0], v3[1], t, false); t = __builtin_amdgcn_cvt_pk_fp8_f32(v3[2], v3[3], t, true); w8.w = (unsigned)t;
#pragma unroll
                for (int k = 0; k < 2; ++k) *((u32x4*)((unsigned char*)xg + (size_t)pslot[2 * tl + k] * DM) + lane) = w8; } }
            __syncthreads();
        }
        for (int idx = gw; idx < 8 * 256; idx += ngw) { const int e = idx >> 8, r = idx & 255; unsigned ce = 0; int be = 0;
#pragma unroll
            for (int q = 0; q < 8; ++q) { ce = (e == q) ? cnt[q] : ce; be = (e == q) ? base[q] : be; }
            const int rem = (int)(ce & 255u);
            if (rem != 0 && r >= rem) { const int slot = be + (int)(ce & ~255u) + r; u32x4 zz = {0u, 0u, 0u, 0u}; *((u32x4*)((unsigned char*)xg + (size_t)slot * DM) + lane) = zz;
                if (lane == 0) { row_tok[slot] = -1; row_gate[slot] = 0.f; row_rs[slot] = 0.f; } } }
    }
    SEAM(18);
    if (IN(19)) { PHASE_PTRS
        unsigned cnt[8];
#pragma unroll
        for (int e = 0; e < 8; ++e) cnt[e] = (unsigned)__builtin_amdgcn_readfirstlane((int)__hip_atomic_load(ctl + CW_MOECNT + e, __ATOMIC_RELAXED, __HIP_MEMORY_SCOPE_AGENT));
        pg8::Gemm g{DM / 2, DM / 2, DM / 2}; MoeOrder S; S.init(xg, DM / 2, moe_w13, DM / 2, (size_t)2 * EDIM * DM, 2 * EDIM / 256, cnt, G, bx);
        EpiSwiglu<true> E{act, EDIM, row_rs};
        pg8::gemm_phase(lds, g, S, E);
    }
    SEAM(19);
    if (IN(20)) { PHASE_PTRS
        unsigned cnt[8];
#pragma unroll
        for (int e = 0; e < 8; ++e) cnt[e] = (unsigned)__builtin_amdgcn_readfirstlane((int)__hip_atomic_load(ctl + CW_MOECNT + e, __ATOMIC_RELAXED, __HIP_MEMORY_SCOPE_AGENT));
        pg8::Gemm g{EDIM / 2, EDIM / 2, EDIM / 2}; MoeDownOrder S; S.init(act, EDIM / 2, (unsigned char*)moe_w13 + (size_t)NEXP * 2 * EDIM * DM, EDIM / 2, (size_t)DM * EDIM, cnt, G, bx);
        EpiMoeDownSplit E{ybuf, ypart, row_gate};
        pg8::gemm_phase(lds, g, S, E);
    }
    SEAM(20);
    if (IN(21)) { PHASE_PTRS
        int ns0 = 0, ns1 = 0; if (gw < T) { ns0 = tok_slot[2 * gw]; ns1 = tok_slot[2 * gw + 1]; }
        for (int m = gw; m < T; m += ngw) { const int s0 = __builtin_amdgcn_readfirstlane(ns0), s1 = __builtin_amdgcn_readfirstlane(ns1); f32x4* xr = (f32x4*)(a_out + (size_t)m * DM) + lane;
            { const int mn = (m + ngw < T) ? m + ngw : m; ns0 = tok_slot[2 * mn]; ns1 = tok_slot[2 * mn + 1]; }
            f32x4 v[4]; u32x2 ya[4], yb[4];
            const u32x2* y0 = (const u32x2*)((s0 >= 0 ? ybuf + (size_t)s0 * DM : ypart + (size_t)(-1 - s0) * DM)) + lane;
            const u32x2* y1 = (const u32x2*)((s1 >= 0 ? ybuf + (size_t)s1 * DM : ypart + (size_t)(-1 - s1) * DM)) + lane;
#pragma unroll
            for (int j = 0; j < 4; ++j) { v[j] = xr[64 * j]; ya[j] = y0[64 * j]; yb[j] = y1[64 * j]; }
#pragma unroll
            for (int j = 0; j < 4; ++j) { v[j][0] += lo2f(ya[j].x) + lo2f(yb[j].x); v[j][1] += hi2f(ya[j].x) + hi2f(yb[j].x); v[j][2] += lo2f(ya[j].y) + lo2f(yb[j].y); v[j][3] += hi2f(ya[j].y) + hi2f(yb[j].y); }
#pragma unroll
            for (int k = 0; k < 2; ++k) { const int sk = k ? s1 : s0;
                if (sk < 0) { const int pr = -1 - sk;
#pragma unroll 1
                    for (int q = 1; q < MD_KSPLIT; ++q) { const u32x2* yq = (const u32x2*)(ypart + ((size_t)q * (8 * 256) + pr) * DM) + lane;
#pragma unroll
                        for (int j = 0; j < 4; ++j) { const u32x2 p = yq[64 * j]; v[j][0] += lo2f(p.x); v[j][1] += hi2f(p.x); v[j][2] += lo2f(p.y); v[j][3] += hi2f(p.y); } } } }
#pragma unroll
            for (int j = 0; j < 4; ++j) xr[64 * j] = v[j]; }
    }
#undef IN
#undef SEAM
#undef GRID_BAR
#undef ss_mix
#undef ss_ffn
}
template <int LO, int HI> __global__ void __launch_bounds__(NTHREADS, 2) mk_fwd(Args a) { mk_body<LO, HI>(a); }

template <int PH> static void set_attr(bool& ok) { if constexpr (PH < NPH) { ok = ok && (hipFuncSetAttribute((const void*)mk_fwd<PH, PH + 1>, hipFuncAttributeMaxDynamicSharedMemorySize, LDS_TOTAL) == hipSuccess); set_attr<PH + 1>(ok); } }
template <int PH> static void launch_phases(const Args& a, int grid, hipStream_t stream) { if constexpr (PH < NPH) { hipLaunchKernelGGL((mk_fwd<PH, PH + 1>), dim3(grid), dim3(NTHREADS), LDS_TOTAL, stream, a); launch_phases<PH + 1>(a, grid, stream); } }
extern "C" void kernel_launch(void* const* d_in, const int* in_sizes, int n_in, void* d_out, int out_size, void* d_ws, size_t ws_size, hipStream_t stream) {
    static int grid = 0;
    if (!grid) {
        if (n_in != N_IN || out_size != T * DM || ws_size < WS_END) { fprintf(stderr, "kernel_launch: unexpected problem: n_in %d out %d ws %zu (need %zu)\n", n_in, out_size, ws_size, (size_t)WS_END); grid = -1; return; }
        int dev = 0, cus = 0, per_cu = 0;
        (void)hipGetDevice(&dev); (void)hipDeviceGetAttribute(&cus, hipDeviceAttributeMultiprocessorCount, dev);
#if MK_PER_PHASE
        { bool ok = true; set_attr<0>(ok); if (!ok) { fprintf(stderr, "kernel_launch: hipFuncSetAttribute failed\n"); grid = -1; return; } per_cu = 1; }
#else
        if (hipFuncSetAttribute((const void*)mk_fwd<0, NPH>, hipFuncAttributeMaxDynamicSharedMemorySize, LDS_TOTAL) != hipSuccess) { fprintf(stderr, "kernel_launch: hipFuncSetAttribute failed\n"); grid = -1; return; }
        if (hipOccupancyMaxActiveBlocksPerMultiprocessor(&per_cu, (const void*)mk_fwd<0, NPH>, NTHREADS, LDS_TOTAL) != hipSuccess || per_cu < 1) { fprintf(stderr, "kernel_launch: occupancy query failed (%d)\n", per_cu); grid = -1; return; }
#endif
        grid = cus;
    }
    if (grid <= 0) return;
    (void)hipMemsetAsync((char*)d_ws + WS_CTL, 0, 32768, stream);
    Args a{};
    for (int i = 0; i < N_IN; ++i) a.in[i] = (const float*)d_in[i];
    a.out = (float*)d_out; a.ws = (unsigned char*)d_ws;
#if MK_PER_PHASE
    launch_phases<0>(a, grid, stream);
#else
    void* args[] = {&a};
    hipError_t e = hipLaunchCooperativeKernel((const void*)mk_fwd<0, NPH>, dim3(grid), dim3(NTHREADS), args, LDS_TOTAL, stream);
    if (e != hipSuccess) fprintf(stderr, "cooperative launch failed: %s (grid %d)\n", hipGetErrorString(e), grid);
#endif
}
```

```cpp
#include <hip/hip_runtime.h>
#include <hip/hip_cooperative_groups.h>
#include <cstdio>
#include <cstdint>
namespace cg = cooperative_groups;

#ifndef FFN_FP8
#define FFN_FP8 0
#endif
#ifndef MK_PER_PHASE
#define MK_PER_PHASE 0
#endif

#define LAS __attribute__((address_space(3)))
typedef unsigned short bf16;
typedef short bf16x8 __attribute__((ext_vector_type(8)));
typedef float f32x4 __attribute__((ext_vector_type(4)));
typedef float f32x2 __attribute__((ext_vector_type(2)));
typedef unsigned u32x4 __attribute__((ext_vector_type(4)));
typedef unsigned u32x2 __attribute__((ext_vector_type(2)));

constexpr int BATCH = 8, SEQ = 2048, DM = 1024, T = BATCH * SEQ;
constexpr int CHUNK = 64, NCH = SEQ / CHUNK;
constexpr int IN_COLS = 10552, MIXC = 6456;
constexpr int ZC = 6656;
constexpr int C_RWKV = 0, C_SSM = 1824, C_ATT = 3368, C_GLA = 4904, C_HV = 6456;
constexpr int FFN = 2816, NEXP = 8, EDIM = 3584;
constexpr int MOE_ROWS = 2 * T + NEXP * 256;
constexpr float NORM_EPS = 1e-6f;

constexpr size_t MiB = 1u << 20;
constexpr size_t WS_CTL = 0;
constexpr size_t CTL_BYTES = 1 * MiB;
constexpr size_t WS_SMALL = WS_CTL + CTL_BYTES;
constexpr size_t SM_SS = 0;
constexpr size_t SM_MSSQ = SM_SS + 3 * (size_t)T * 16 * 4;
constexpr size_t SM_TOKE = SM_MSSQ + (size_t)T * 8 * 4;
constexpr size_t SM_TOKG = SM_TOKE + (size_t)T * 2 * 4;
constexpr size_t SM_TOKRS = SM_TOKG + (size_t)T * 2 * 4;
constexpr size_t SM_TOKSLOT = SM_TOKRS + (size_t)T * 4;
constexpr size_t SM_ROWTOK = SM_TOKSLOT + (size_t)T * 2 * 4;
constexpr size_t SM_ROWGATE = SM_ROWTOK + (size_t)MOE_ROWS * 4;
constexpr size_t SM_ROWRS = SM_ROWGATE + (size_t)MOE_ROWS * 4;
constexpr size_t SM_END = SM_ROWRS + (size_t)MOE_ROWS * 4;
static_assert(SM_END <= 6 * MiB, "small region");
constexpr size_t WS_XB = WS_SMALL + 6 * MiB;
constexpr size_t WS_X = WS_XB + (size_t)T * DM * 2;
constexpr size_t X_VFIRST = 0;
constexpr size_t X_MIXED = X_VFIRST + (size_t)T * 512 * 2;
constexpr size_t X_O = X_MIXED + (size_t)T * DM * 2;
constexpr size_t X_W = X_O + (size_t)T * 2048 * 2;
constexpr size_t W_IN = 0;
constexpr size_t W_G = W_IN + 2 * (size_t)ZC * DM * 2;
constexpr size_t W_B = W_G + 2 * (size_t)4096 * DM * 2;
constexpr size_t W_O = W_B + 2 * 4 * (size_t)DM * 512 * 2;
constexpr size_t W_13 = W_O + 2 * (size_t)DM * DM * 2;
constexpr size_t W_2 = W_13 + (size_t)2 * FFN * DM * 2;
constexpr size_t W_END = W_2 + (size_t)DM * FFN * 2;
constexpr size_t X_BYTES = X_W + W_END;
constexpr size_t MOE_W13 = 0;
constexpr size_t MOE_W2 = MOE_W13 + (size_t)NEXP * 2 * EDIM * DM * 2;
constexpr size_t MOE_WEND = MOE_W2 + (size_t)NEXP * DM * EDIM * 2;
static_assert(MOE_WEND <= X_BYTES, "MoE weights must fit the X region");
static_assert((size_t)3 * DM * EDIM <= (size_t)ZC * DM * 2 && (size_t)2 * DM * EDIM <= (size_t)3 * FFN * DM * 2, "early MoE w2 copies fit the dead weight spaces");
constexpr size_t WS_Z = WS_X + X_BYTES;
constexpr size_t Z_BYTES = (size_t)MOE_ROWS * EDIM * 2;
static_assert((size_t)T * ZC * 2 <= Z_BYTES, "z fits");
constexpr size_t WS_XG = WS_Z + Z_BYTES;
constexpr size_t XG_BYTES = (size_t)MOE_ROWS * DM * 2;
static_assert(4 * (size_t)T * 512 * 2 <= XG_BYTES, "rwkv arrays fit");
constexpr size_t WS_BCV = WS_XG + (size_t)4 * BATCH * (SEQ / 32) * 29184;
constexpr size_t WS_GEND = WS_BCV + (size_t)T * 512 * 2;
constexpr size_t WS_END = (WS_XG + XG_BYTES > WS_GEND + (size_t)BATCH * 4 * NCH * 64 * 4) ? WS_XG + XG_BYTES : WS_GEND + (size_t)BATCH * 4 * NCH * 64 * 4;

constexpr int CW_MOECNT = 64;
constexpr int CW_MOECUR = 128;
constexpr int CW_ATTQ = 192;
constexpr int CW_SPLIT = 256;
constexpr int CW_BAR = 1024;

__device__ __forceinline__ float bf2f(bf16 v) { return __builtin_bit_cast(float, (unsigned)v << 16); }
typedef __bf16 bf16x2_hw __attribute__((ext_vector_type(2)));
__device__ __forceinline__ unsigned pk2(float lo, float hi) { const f32x2 v = {lo, hi}; return __builtin_bit_cast(unsigned, __builtin_convertvector(v, bf16x2_hw)); }
__device__ __forceinline__ unsigned f2bf(float f) { return pk2(f, 0.f) & 0xffffu; }
__device__ __forceinline__ float lo2f(unsigned w) { return __builtin_bit_cast(float, w << 16); }
__device__ __forceinline__ float hi2f(unsigned w) { return __builtin_bit_cast(float, w & 0xffff0000u); }
__device__ __forceinline__ float sigmoidf_(float x) { return __builtin_amdgcn_rcpf(1.0f + __expf(-x)); }
__device__ __forceinline__ float siluf_(float x) { return x * __builtin_amdgcn_rcpf(1.0f + __expf(-x)); }
__device__ __forceinline__ float tanhf_(float x) { return 2.0f * __builtin_amdgcn_rcpf(1.0f + __expf(-2.0f * x)) - 1.0f; }
__device__ __forceinline__ float softplusf_(float x) { return x > 20.f ? x : __logf(1.0f + __expf(x)); }
template <int CTRL, int ROWMASK = 0xF, bool BOUND = true> __device__ __forceinline__ float dpp_f(float x) { return __builtin_bit_cast(float, __builtin_amdgcn_update_dpp(0, __builtin_bit_cast(int, x), CTRL, ROWMASK, 0xF, BOUND)); }
__device__ __forceinline__ float red8_sum(float x) { x += dpp_f<0xB1>(x); x += dpp_f<0x4E>(x); x += dpp_f<0x141>(x); return x; }
__device__ __forceinline__ float red16_sum(float x) { x = red8_sum(x); x += dpp_f<0x140>(x); return x; }
__device__ __forceinline__ float scan16(float x) { x += dpp_f<0x111>(x); x += dpp_f<0x112>(x); x += dpp_f<0x114>(x); x += dpp_f<0x118>(x); return x; }
__device__ __forceinline__ float scan32(float x) { x = scan16(x); x += dpp_f<0x142, 0xA, false>(x); return x; }
__device__ __forceinline__ float scan64(float x) { x = scan32(x); x += dpp_f<0x143, 0xC, false>(x); return x; }
__device__ __forceinline__ float xrows_sum(float v) { const int x = __builtin_bit_cast(int, v); const auto a = __builtin_amdgcn_permlane16_swap(x, x, false, false); v = __builtin_bit_cast(float, (int)a[0]) + __builtin_bit_cast(float, (int)a[1]);
    const int y = __builtin_bit_cast(int, v); const auto b = __builtin_amdgcn_permlane32_swap(y, y, false, false); return __builtin_bit_cast(float, (int)b[0]) + __builtin_bit_cast(float, (int)b[1]); }
__device__ __forceinline__ float xrows_max(float v) { const int x = __builtin_bit_cast(int, v); const auto a = __builtin_amdgcn_permlane16_swap(x, x, false, false); v = fmaxf(__builtin_bit_cast(float, (int)a[0]), __builtin_bit_cast(float, (int)a[1]));
    const int y = __builtin_bit_cast(int, v); const auto b = __builtin_amdgcn_permlane32_swap(y, y, false, false); return fmaxf(__builtin_bit_cast(float, (int)b[0]), __builtin_bit_cast(float, (int)b[1])); }
__device__ __forceinline__ float wave_sum(float v) { return xrows_sum(red16_sum(v)); }
__device__ __forceinline__ u32x4 pair16(u32x2 a, u32x2 b) {
    const auto rx = __builtin_amdgcn_permlane16_swap((int)a.x, (int)b.x, false, false); const auto ry = __builtin_amdgcn_permlane16_swap((int)a.y, (int)b.y, false, false);
    u32x4 o; o.x = (unsigned)rx[0]; o.y = (unsigned)ry[0]; o.z = (unsigned)rx[1]; o.w = (unsigned)ry[1]; return o; }
__device__ __forceinline__ int opq_v(int x) { asm volatile("" : "+v"(x)); return x; }
__device__ __forceinline__ int opq_s(int x) { asm volatile("" : "+s"(x)); return x; }
__device__ __forceinline__ float rdlane(float v, int l) { return __builtin_bit_cast(float, __builtin_amdgcn_readlane(__builtin_bit_cast(int, v), l)); }

namespace pg8 {
constexpr int BM = 256, BK = 64, HALF = 128, HTB = HALF * BK * 2, STAGE_BYTES = 8 * HTB, NXCD = 8, WGM = 8;
__host__ __device__ __forceinline__ int lds_byte(int r, int c) { const int st = (r >> 4) * 2 + (c >> 5), rr = r & 15, cc = c & 31, ob = rr * 64 + cc * 2; return st * 1024 + (ob ^ (((ob >> 9) & 1) << 5)); }
__host__ __device__ __forceinline__ void stage_rc(int b, int& R, int& C) { const int st = b / 1024, sb = b % 1024, swz = sb ^ (((sb >> 9) & 1) << 5); R = (st >> 1) * 16 + swz / 64; C = (st & 1) * 32 + (swz % 64) / 2; }
__host__ __device__ __forceinline__ int perm32(int rho) { const int n = rho >> 4, i = rho & 15; return 8 * (i >> 2) + 4 * n + (i & 3); }

typedef int v4i __attribute__((ext_vector_type(4)));
typedef int v8i __attribute__((ext_vector_type(8)));
struct Unit { int pm, pn, e, kq; };
struct Gemm { int lda, ldb, K; };

struct StaticOrder {
    static constexpr bool VARNT = false;
    const char* A; const char* Bt; size_t tstepA, tstepB;
    int nM, nN, nwg, G, c;
    __device__ __forceinline__ void init(const void* A_, const void* Bt_, int lda, int ldb, int M, int N, int G_, int c_) { A = (const char*)A_; Bt = (const char*)Bt_; tstepA = (size_t)BM * lda * 2; tstepB = (size_t)BM * ldb * 2; nM = M / BM; nN = N / BM; nwg = nM * nN; G = G_; c = c_; }
    __device__ __forceinline__ bool next(int i, Unit& u) const {
        const long L = (long)i * G + c; if (L >= nwg) return false;
        int wgid = (int)L; { const int q = nwg / NXCD, r = nwg % NXCD, xcd = wgid % NXCD, off = wgid / NXCD; wgid = (xcd < r ? xcd * (q + 1) : r * (q + 1) + (xcd - r) * q) + off; }
        const int nig = WGM * nN, gid = wgid / nig, fm = gid * WGM, gsz = (nM - fm) < WGM ? (nM - fm) : WGM;
        u.pm = fm + ((wgid % nig) % gsz); u.pn = (wgid % nig) / gsz; u.e = 0; return true;
    }
    __device__ __forceinline__ const char* a_ptr(const Unit& u) const { return A + (size_t)u.pm * tstepA; }
    __device__ __forceinline__ const char* b_ptr(const Unit& u) const { return Bt + (size_t)u.pn * tstepB; }
};

typedef __bf16 bf16x2_t __attribute__((ext_vector_type(2)));
__device__ __forceinline__ unsigned cvt_pk_bf16(float lo, float hi) { const f32x2 v = {lo, hi}; return __builtin_bit_cast(unsigned, __builtin_convertvector(v, bf16x2_t)); }

template <class Epi, class Sched>
__device__ __forceinline__ void gemm_phase(LAS unsigned char* lds, const Gemm g, const Sched& S, const Epi& E) {
    const int tid = opq_v((int)threadIdx.x), wid = __builtin_amdgcn_readfirstlane(tid >> 6), lane = tid & 63, wr = wid >> 2, wc = wid & 3, fr = lane & 15, fq = lane >> 4;
    const int nt = opq_s(g.K / BK);
    unsigned voffA[2], voffB[2];
#pragma unroll
    for (int i = 0; i < 2; ++i) { int R, C; stage_rc(tid * 16 + i * 8192, R, C); const int Rb = Epi::PERM ? ((R & ~31) + perm32(R & 31)) : R;
        voffA[i] = (unsigned)(R * g.lda + C) * 2u; voffB[i] = (unsigned)(Rb * g.ldb + C) * 2u; }
    const size_t kstep = (size_t)(BK * 2);
    const size_t hstepA = (size_t)HALF * g.lda * 2, hstepB = (size_t)HALF * g.ldb * 2;
    const unsigned ldsw = (unsigned)wid * 1024u;
    const int aoff = lds_byte(wr * 64 + fr, fq * 8), boff = lds_byte(wc * 32 + fr, fq * 8);
#define PG8_SA(b, h) (((b) * 2 + (h)) * HTB)
#define PG8_SB(b, h) ((4 + (b) * 2 + (h)) * HTB)
#define PG8_STAGE(bufoff, gbase, voff) do { _Pragma("unroll") for (int _i = 0; _i < 2; ++_i) \
        __builtin_amdgcn_global_load_lds((const unsigned*)((const char*)(gbase) + (voff)[_i]), (LAS unsigned*)(lds + (bufoff) + ldsw + _i * 8192), 16, 0, 0); } while (0)
#define PG8_LDA(dst, b, h) do { _Pragma("unroll") for (int m = 0; m < 4; ++m) { if constexpr (Epi::F8) { const v4i lo_ = *(const LAS v4i*)(lds + PG8_SA(b, h) + aoff + m * 2048), hi_ = *(const LAS v4i*)(lds + PG8_SA(b, h) + aoff + m * 2048 + 1024); \
            dst##8[m] = __builtin_shufflevector(lo_, hi_, 0, 1, 2, 3, 4, 5, 6, 7); } else { _Pragma("unroll") for (int k = 0; k < 2; ++k) dst[m][k] = *(const LAS bf16x8*)(lds + PG8_SA(b, h) + aoff + m * 2048 + k * 1024); } } } while (0)
#define PG8_LDB(dst, b, h) do { _Pragma("unroll") for (int n = 0; n < 2; ++n) { if constexpr (Epi::F8) { const v4i lo_ = *(const LAS v4i*)(lds + PG8_SB(b, h) + boff + n * 2048), hi_ = *(const LAS v4i*)(lds + PG8_SB(b, h) + boff + n * 2048 + 1024); \
            dst##8[n] = __builtin_shufflevector(lo_, hi_, 0, 1, 2, 3, 4, 5, 6, 7); } else { _Pragma("unroll") for (int k = 0; k < 2; ++k) dst[n][k] = *(const LAS bf16x8*)(lds + PG8_SB(b, h) + boff + n * 2048 + k * 1024); } } } while (0)
#define PG8_MMA(ai, bj, At, Bt) do { __builtin_amdgcn_s_setprio(1); _Pragma("unroll") for (int m = 0; m < 4; ++m) _Pragma("unroll") for (int n = 0; n < 2; ++n) { \
        if constexpr (Epi::F8) asm volatile("v_mfma_scale_f32_16x16x128_f8f6f4 %0, %1, %2, %0, %3, %3 op_sel_hi:[0,0,0]" : "+v"(acc[ai][bj][m][n]) : "v"(Bt##8[n]), "v"(At##8[m]), "v"(f8scale));   \
        else { _Pragma("unroll") for (int k = 0; k < 2; ++k) acc[ai][bj][m][n] = __builtin_amdgcn_mfma_f32_16x16x32_bf16(Bt[n][k], At[m][k], acc[ai][bj][m][n], 0, 0, 0); } } \
        __builtin_amdgcn_s_setprio(0); } while (0)
#define PG8_WAIT_V(n) asm volatile("s_waitcnt vmcnt(" #n ")" ::: "memory")
#define PG8_WAIT_L(n) asm volatile("s_waitcnt lgkmcnt(" #n ")" ::: "memory")
#define PG8_BAR __builtin_amdgcn_s_barrier()
#define PG8_SCHED __builtin_amdgcn_sched_barrier(0)
    Unit cur, nxt; int ui = 0;
    if (!S.next(0, cur)) return;
    f32x4 acc[2][2][4][2];
#pragma unroll
    for (int a = 0; a < 2; ++a)
#pragma unroll
        for (int b = 0; b < 2; ++b)
#pragma unroll
            for (int m = 0; m < 4; ++m)
#pragma unroll
                for (int n = 0; n < 2; ++n) acc[a][b][m][n] = (f32x4){0.f, 0.f, 0.f, 0.f};
    const int f8scale = opq_v(0x7f7f7f7f);
    bf16x8 At[4][2], B0[2][2], B1[2][2]; v8i At8[4], B08[2], B18[2];
    const char* cA = S.a_ptr(cur); const char* cB = S.b_ptr(cur);
    PG8_STAGE(PG8_SB(0, 0), cB, voffB); PG8_STAGE(PG8_SB(0, 1), cB + hstepB, voffB); PG8_STAGE(PG8_SA(0, 0), cA, voffA); PG8_STAGE(PG8_SA(0, 1), cA + hstepA, voffA);
    if (wr == 1) PG8_BAR;
    PG8_WAIT_V(2); PG8_BAR;
    PG8_STAGE(PG8_SB(1, 0), cB + kstep, voffB); PG8_STAGE(PG8_SA(1, 0), cA + kstep, voffA); PG8_STAGE(PG8_SB(1, 1), cB + hstepB + kstep, voffB);
    PG8_WAIT_V(6); PG8_BAR;
    for (;;) {
        const bool has_next = S.next(ui + 1, nxt);
        int ntc = nt; if constexpr (Sched::VARNT) ntc = opq_s(S.nt_of(cur));
        const char* nA = has_next ? S.a_ptr(nxt) : cA; const char* nB = has_next ? S.b_ptr(nxt) : cB;
#pragma unroll 1
        for (int t = 0; t < ntc; t += 2) {
            const bool last = (t == ntc - 2);
            const char* a1 = cA + (size_t)(t + 1) * kstep;
            const char* a2 = last ? nA : cA + (size_t)(t + 2) * kstep; const char* b2 = last ? nB : cB + (size_t)(t + 2) * kstep;
            const char* a3 = a2 + kstep; const char* b3 = b2 + kstep;
            PG8_LDB(B0, 0, 0); PG8_LDB(B1, 0, 1); PG8_SCHED; PG8_LDA(At, 0, 0); PG8_STAGE(PG8_SA(1, 1), a1 + hstepA, voffA);
            PG8_WAIT_V(8); PG8_WAIT_L(0); PG8_BAR; PG8_MMA(0, 0, At, B0); PG8_MMA(0, 1, At, B1); PG8_BAR; PG8_SCHED;
            PG8_LDA(At, 0, 1); PG8_STAGE(PG8_SB(0, 0), b2, voffB); PG8_STAGE(PG8_SB(0, 1), b2 + hstepB, voffB); PG8_STAGE(PG8_SA(0, 0), a2, voffA);
            PG8_WAIT_V(8); PG8_WAIT_L(0); PG8_BAR; PG8_MMA(1, 0, At, B0); PG8_MMA(1, 1, At, B1); PG8_BAR; PG8_SCHED;
            PG8_LDB(B0, 1, 0); PG8_LDB(B1, 1, 1); PG8_SCHED; PG8_LDA(At, 1, 0); PG8_STAGE(PG8_SA(0, 1), a2 + hstepA, voffA);
            PG8_WAIT_V(8); PG8_WAIT_L(0); PG8_BAR; PG8_MMA(0, 0, At, B0); PG8_MMA(0, 1, At, B1); PG8_BAR; PG8_SCHED;
            PG8_LDA(At, 1, 1); PG8_STAGE(PG8_SB(1, 0), b3, voffB); PG8_STAGE(PG8_SB(1, 1), b3 + hstepB, voffB); PG8_STAGE(PG8_SA(1, 0), a3, voffA);
            PG8_WAIT_V(8); PG8_WAIT_L(0); PG8_BAR; PG8_MMA(1, 0, At, B0); PG8_MMA(1, 1, At, B1); PG8_BAR; PG8_SCHED;
        }
        if (wr == 0) PG8_BAR;
        if constexpr (Epi::F8) asm volatile("s_nop 15\n\ts_nop 15" ::: "memory");
        E(acc, cur, wr, wc, fr, fq);
        if (!has_next) break;
        if constexpr (!Epi::CHAIN) {
#pragma unroll
        for (int a = 0; a < 2; ++a)
#pragma unroll
            for (int b = 0; b < 2; ++b)
#pragma unroll
                for (int m = 0; m < 4; ++m)
#pragma unroll
                    for (int n = 0; n < 2; ++n) acc[a][b][m][n] = (f32x4){0.f, 0.f, 0.f, 0.f};
        }
        cur = nxt; cA = nA; cB = nB; ++ui;
        if (wr == 1) PG8_BAR;
    }
    PG8_WAIT_V(0);
    PG8_BAR;
#undef PG8_SA
#undef PG8_SB
#undef PG8_STAGE
#undef PG8_LDA
#undef PG8_LDB
#undef PG8_MMA
#undef PG8_WAIT_V
#undef PG8_WAIT_L
#undef PG8_BAR
#undef PG8_SCHED
}
}

using pg8::Unit;
__device__ __forceinline__ u32x4 pack8(f32x4 v0, f32x4 v1) { u32x4 w; w.x = pg8::cvt_pk_bf16(v0[0], v0[1]); w.y = pg8::cvt_pk_bf16(v0[2], v0[3]); w.z = pg8::cvt_pk_bf16(v1[0], v1[1]); w.w = pg8::cvt_pk_bf16(v1[2], v1[3]); return w; }
__device__ __forceinline__ f32x4 sig4(f32x4 v) { return (f32x4){sigmoidf_(v[0]), sigmoidf_(v[1]), sigmoidf_(v[2]), sigmoidf_(v[3])}; }
__device__ __forceinline__ void unpack8(u32x4 w, f32x4& a, f32x4& b) { a = (f32x4){lo2f(w.x), hi2f(w.x), lo2f(w.y), hi2f(w.y)}; b = (f32x4){lo2f(w.z), hi2f(w.z), lo2f(w.w), hi2f(w.w)}; }

__device__ __forceinline__ void rs8_from_parts(const float* ss, int row0, int fq, float (&rs)[2][4]) {
    f32x4 p[2][4];
#pragma unroll
    for (int ai = 0; ai < 2; ++ai)
#pragma unroll
        for (int m = 0; m < 4; ++m) p[ai][m] = *(const f32x4*)(ss + (size_t)(row0 + ai * 128 + m * 16) * 16 + 4 * fq);
#pragma unroll
    for (int ai = 0; ai < 2; ++ai)
#pragma unroll
        for (int m = 0; m < 4; ++m) { float t = (p[ai][m][0] + p[ai][m][1]) + (p[ai][m][2] + p[ai][m][3]); t = xrows_sum(t); rs[ai][m] = __builtin_amdgcn_rsqf(t * (1.0f / DM) + NORM_EPS); }
}
template <int ACT> struct EpiScaleBf16 {
    static constexpr bool PERM = true, CHAIN = false, F8 = false;
    bf16* O; int ldc; const float* ss;
    __device__ __forceinline__ void operator()(f32x4 (&acc)[2][2][4][2], const Unit& u, int wr, int wc, int fr, int fq) const {
        const int row0 = u.pm * 256 + wr * 64 + fr, col0 = u.pn * 256 + wc * 32 + 8 * fq;
        float rs[2][4]; rs8_from_parts(ss, row0, fq, rs);
#pragma unroll
        for (int ai = 0; ai < 2; ++ai)
#pragma unroll
            for (int m = 0; m < 4; ++m) { const int row = row0 + ai * 128 + m * 16; const float s = rs[ai][m];
                bf16* rowp = O + (size_t)row * ldc + col0;
#pragma unroll
                for (int bj = 0; bj < 2; ++bj) { f32x4 v0 = acc[ai][bj][m][0] * s, v1 = acc[ai][bj][m][1] * s;
                    if (ACT == 1) { v0 = sig4(v0); v1 = sig4(v1); }
                    *(u32x4*)(rowp + bj * 128) = pack8(v0, v1); }
                asm volatile("" ::: "memory"); }
    }
};
struct EpiGateRatio {
    static constexpr bool PERM = true, CHAIN = false, F8 = false;
    bf16* O; const float* ss;
    __device__ __forceinline__ void operator()(const f32x4 (&acc)[2][2][4][2], const Unit& u, int wr, int wc, int fr, int fq) const {
        const int row0 = u.pm * 256 + wr * 64 + fr, c0 = u.pn * 64 + wc * 16 + 4 * fq;
        float rs[2][4]; rs8_from_parts(ss, row0, fq, rs);
#pragma unroll
        for (int ai = 0; ai < 2; ++ai)
#pragma unroll
            for (int m = 0; m < 4; ++m) { const int row = row0 + ai * 128 + m * 16; const float s = rs[ai][m];
                const float ks = s * -1.44269504f; f32x4 d[4], r[4];
#pragma unroll
                for (int i = 0; i < 4; ++i) { const f32x4 av = acc[ai][i >> 1][m][i & 1];
#pragma unroll
                    for (int j = 0; j < 4; ++j) { d[i][j] = 1.0f + __builtin_amdgcn_exp2f(__builtin_amdgcn_fmed3f(av[j] * ks, -126.0f, 80.0f)); r[i][j] = __builtin_amdgcn_rcpf(d[i][j]); } }
                bf16* rowp = O + (size_t)row * 4096 + c0;
#pragma unroll
                for (int ip = 0; ip < 2; ++ip) { u32x2 w2[2];
#pragma unroll
                    for (int k = 0; k < 2; ++k) { const int i = 2 * ip + k; const f32x4 rho = (i < 3) ? d[i + 1] * r[i] : r[3]; w2[k].x = pg8::cvt_pk_bf16(rho[0], rho[1]); w2[k].y = pg8::cvt_pk_bf16(rho[2], rho[3]); }
                    *(u32x4*)(rowp + (2 * ip + (fq & 1)) * 1024 - 4 * (fq & 1)) = pair16(w2[0], w2[1]); }
                asm volatile("" ::: "memory"); }
    }
};
template <bool MOE, bool F8_ = MOE> struct EpiSwiglu {
    static constexpr bool PERM = true, CHAIN = false, F8 = F8_;
    bf16* O; int ldc; const float* rsrc;
    __device__ __forceinline__ void operator()(f32x4 (&acc)[2][2][4][2], const Unit& u, int wr, int wc, int fr, int fq) const {
        const int row0 = u.pm * 256 + wr * 64 + fr, col0 = u.pn * 128 + wc * 32 + 8 * fq;
        float rs[2][4];
        if (MOE) {
#pragma unroll
            for (int ai = 0; ai < 2; ++ai)
#pragma unroll
                for (int m = 0; m < 4; ++m) rs[ai][m] = rsrc[row0 + ai * 128 + m * 16]; }
        else rs8_from_parts(rsrc, row0, fq, rs);
        if (F8) {
#pragma unroll
            for (int ai = 0; ai < 2; ++ai)
#pragma unroll
                for (int m = 0; m < 4; ++m) rs[ai][m] *= (1.0f / 32.0f); }
#pragma unroll
        for (int ai = 0; ai < 2; ++ai) { u32x2 w8p[2];
#pragma unroll
            for (int m = 0; m < 4; ++m) { const int row = row0 + ai * 128 + m * 16; const float s = rs[ai][m];
                f32x4 o[2];
#pragma unroll
                for (int n = 0; n < 2; ++n) { const f32x4 ar = acc[ai][0][m][n], br = acc[ai][1][m][n]; const float ks = s * -1.44269504f, s2 = s * s;
#pragma unroll
                    for (int j = 0; j < 4; ++j) o[n][j] = (ar[j] * br[j]) * (s2 * __builtin_amdgcn_rcpf(1.0f + __builtin_amdgcn_exp2f(ar[j] * ks))); }
                if constexpr (F8) { u32x2 w8; int t0_ = 0, t1_ = 0; t0_ = __builtin_amdgcn_cvt_pk_fp8_f32(o[0][0], o[0][1], t0_, false); t0_ = __builtin_amdgcn_cvt_pk_fp8_f32(o[0][2], o[0][3], t0_, true);
                    t1_ = __builtin_amdgcn_cvt_pk_fp8_f32(o[1][0], o[1][1], t1_, false); t1_ = __builtin_amdgcn_cvt_pk_fp8_f32(o[1][2], o[1][3], t1_, true); w8.x = (unsigned)t0_; w8.y = (unsigned)t1_;
                    w8p[m & 1] = w8;
                    if (m & 1) {
                        const int rw = row - 16 + 16 * (fq & 1);
                        *(u32x4*)((unsigned char*)O + (size_t)rw * ldc + col0 - 8 * (fq & 1)) = pair16(w8p[0], w8p[1]); } }
                else *(u32x4*)(O + (size_t)row * ldc + col0) = pack8(o[0], o[1]);
                asm volatile("" ::: "memory"); } }
    }
};
template <bool F8_ = false> struct EpiResid {
    static constexpr bool PERM = false, CHAIN = false, F8 = F8_;
    const float* xin; float* out; bf16* xb; float* ss; unsigned char* xb8;
    __device__ __forceinline__ void operator()(f32x4 (&acc)[2][2][4][2], const Unit& u, int wr, int wc, int fr, int fq) const {
        const int row0 = u.pm * 256 + wr * 64 + fr, col0 = u.pn * 256 + wc * 32 + 4 * fq;
#pragma unroll
        for (int ai = 0; ai < 2; ++ai)
#pragma unroll
            for (int mp = 0; mp < 2; ++mp) {
                f32x4 xi[2][2][2];
#pragma unroll
                for (int mm = 0; mm < 2; ++mm) { const size_t off = (size_t)(row0 + ai * 128 + (2 * mp + mm) * 16) * DM + col0;
#pragma unroll
                    for (int bj = 0; bj < 2; ++bj)
#pragma unroll
                        for (int n = 0; n < 2; ++n) xi[mm][bj][n] = *(const f32x4*)(xin + off + bj * 128 + n * 16); }
#pragma unroll
                for (int mm = 0; mm < 2; ++mm) { const int m = 2 * mp + mm; const int row = row0 + ai * 128 + m * 16; const size_t off = (size_t)row * DM + col0; float q = 0.f;
#pragma unroll
                    for (int bj = 0; bj < 2; ++bj) { u32x2 wn[2];
#pragma unroll
                        for (int n = 0; n < 2; ++n) { const f32x4 v = F8 ? xi[mm][bj][n] + acc[ai][bj][m][n] * (1.0f / 64.0f) : xi[mm][bj][n] + acc[ai][bj][m][n];
                            *(f32x4*)(out + off + bj * 128 + n * 16) = v; wn[n].x = pg8::cvt_pk_bf16(v[0], v[1]); wn[n].y = pg8::cvt_pk_bf16(v[2], v[3]);
                            if (xb8) { int t8 = 0; t8 = __builtin_amdgcn_cvt_pk_fp8_f32(v[0], v[1], t8, false); t8 = __builtin_amdgcn_cvt_pk_fp8_f32(v[2], v[3], t8, true); *(int*)(xb8 + off + bj * 128 + n * 16) = t8; }
                            q += (v[0] * v[0] + v[1] * v[1]) + (v[2] * v[2] + v[3] * v[3]); }
                        *(u32x4*)(xb + off + bj * 128 + (fq & 1) * 16 - 4 * (fq & 1)) = pair16(wn[0], wn[1]); }
                    q = xrows_sum(q);
                    if (fq == 0 && ss) ss[(size_t)row * 16 + u.pn * 4 + wc] = q; }
                asm volatile("" ::: "memory"); }
    }
};
struct EpiMix {
    static constexpr bool PERM = true, CHAIN = true, F8 = false;
    const bf16* gates; bf16* mixed;
    __device__ __forceinline__ void operator()(f32x4 (&acc)[2][2][4][2], const Unit& u, int wr, int wc, int fr, int fq) const {
        const int row0 = u.pm * 256 + wr * 64 + fr, col0 = u.pn * 256 + wc * 32 + 8 * fq; const int i = u.e;
#pragma unroll
        for (int ai = 0; ai < 2; ++ai) {
            u32x4 gw_[4][2];
#pragma unroll
            for (int m = 0; m < 4; ++m)
#pragma unroll
                for (int bj = 0; bj < 2; ++bj) gw_[m][bj] = *(const u32x4*)(gates + (size_t)(row0 + ai * 128 + m * 16) * 4096 + i * 1024 + col0 + bj * 128);
#pragma unroll
            for (int m = 0; m < 4; ++m) { const int row = row0 + ai * 128 + m * 16;
#pragma unroll
                for (int bj = 0; bj < 2; ++bj) { f32x4 r0, r1; unpack8(gw_[m][bj], r0, r1);
                    if (i < 3) { acc[ai][bj][m][0] = acc[ai][bj][m][0] * r0; acc[ai][bj][m][1] = acc[ai][bj][m][1] * r1; }
                    else {
                        *(u32x4*)(mixed + (size_t)row * DM + col0 + bj * 128) = pack8(acc[ai][bj][m][0] * r0, acc[ai][bj][m][1] * r1);
                        acc[ai][bj][m][0] = (f32x4){0.f, 0.f, 0.f, 0.f}; acc[ai][bj][m][1] = (f32x4){0.f, 0.f, 0.f, 0.f};
                    } } } }
    }
};
struct MixOrder {
    static constexpr bool VARNT = false;
    const char* O; const char* Wb; int G, c;
    __device__ __forceinline__ bool next(int i, Unit& u) const {
        const int grp = (i >> 2) * G + c; if (grp >= 256) return false;
        int wgid = grp; { const int xcd = wgid % 8, off = wgid / 8; wgid = xcd * 32 + off; }
        const int nig = 8 * 4, gid = wgid / nig; u.pm = gid * 8 + ((wgid % nig) % 8); u.pn = (wgid % nig) / 8; u.e = i & 3; return true;
    }
    __device__ __forceinline__ const char* a_ptr(const Unit& u) const { return O + ((size_t)u.pm * 256 * 2048 + (size_t)u.e * 512) * 2; }
    __device__ __forceinline__ const char* b_ptr(const Unit& u) const { return Wb + ((size_t)u.e * DM * 512 + (size_t)u.pn * 256 * 512) * 2; }
};
struct MoeOrder {
    static constexpr bool VARNT = false;
    const char* A; const char* Bt; size_t tstepA, tstepB, estepB; int nN, ntiles, G, c;
    int te0, te1, te2, te3, te4, te5, te6;
    __device__ __forceinline__ void init(const void* A_, int lda, const void* Bt_, int ldb, size_t estepB_, int nN_, const unsigned* cnt, int G_, int c_) {
        A = (const char*)A_; Bt = (const char*)Bt_; tstepA = (size_t)256 * lda * 2; tstepB = (size_t)256 * ldb * 2; estepB = estepB_; nN = nN_; G = G_; c = c_;
        int acc = 0; acc += (int)((cnt[0] + 255u) >> 8); te0 = acc; acc += (int)((cnt[1] + 255u) >> 8); te1 = acc; acc += (int)((cnt[2] + 255u) >> 8); te2 = acc; acc += (int)((cnt[3] + 255u) >> 8); te3 = acc;
        acc += (int)((cnt[4] + 255u) >> 8); te4 = acc; acc += (int)((cnt[5] + 255u) >> 8); te5 = acc; acc += (int)((cnt[6] + 255u) >> 8); te6 = acc; acc += (int)((cnt[7] + 255u) >> 8); ntiles = acc;
    }
    __device__ __forceinline__ bool next(int i, Unit& u) const {
        const long L = (long)i * G + c; if (L >= (long)ntiles * nN) return false;
        const int mt = (int)(L / nN); u.pm = mt; u.pn = (int)(L % nN);
        u.e = (mt >= te0) + (mt >= te1) + (mt >= te2) + (mt >= te3) + (mt >= te4) + (mt >= te5) + (mt >= te6); return true;
    }
    __device__ __forceinline__ const char* a_ptr(const Unit& u) const { return A + (size_t)u.pm * tstepA; }
    __device__ __forceinline__ const char* b_ptr(const Unit& u) const { return Bt + (size_t)u.e * estepB + (size_t)u.pn * tstepB; }
};

constexpr int MD_EARLY = 3, MD_EARLY2 = 5, MD_EARLY3 = 6;
constexpr int MD_KSPLIT = 7, MD_KTILES = 4;
struct MoeDownOrder {
    static constexpr bool VARNT = true;
    const char* A; const char* Bt; const char* BtE; size_t tstepA, tstepB, estepB; int G, c, nsplit, nfull4;
    int tb[8], fe[8];
    unsigned pmask;
    __device__ __forceinline__ void init(const void* A_, int lda, const void* Bt_, int ldb, size_t estepB_, const unsigned* cnt, int G_, int c_) {
        A = (const char*)A_; Bt = (const char*)Bt_; tstepA = (size_t)256 * lda * 2; tstepB = (size_t)256 * ldb * 2; estepB = estepB_; G = G_; c = c_;
        int acc = 0, np = 0, nf = 0; pmask = 0u;
#pragma unroll
        for (int e = 0; e < 8; ++e) { tb[e] = acc; fe[e] = (int)(cnt[e] >> 8); const int p = (cnt[e] & 255u) ? 1 : 0; pmask |= (unsigned)p << e; acc += fe[e] + p; np += p; nf += fe[e]; }
        nsplit = np * 4 * MD_KSPLIT; nfull4 = nf * 4;
    }
    __device__ __forceinline__ bool next(int i, Unit& u) const {
        const long L = (long)i * G + c; if (L >= (long)nsplit + nfull4) return false;
        if (L < nsplit) { const int sidx = (int)L, pi = sidx / (4 * MD_KSPLIT), w = sidx - pi * (4 * MD_KSPLIT); u.pn = w / MD_KSPLIT; u.kq = w - u.pn * MD_KSPLIT;
            int e = 0, seen = 0;
#pragma unroll
            for (int q = 0; q < 8; ++q) { const int has = (int)((pmask >> q) & 1u); if (has && seen == pi) e = q; seen += has; }
            int tbe = 0, fee = 0;
#pragma unroll
            for (int q = 0; q < 8; ++q) { tbe = (e == q) ? tb[q] : tbe; fee = (e == q) ? fe[q] : fee; }
            u.e = e; u.pm = tbe + fee; u.kq |= pi << 8; }
        else { const int f = (int)L - nsplit, ft = f >> 2; u.pn = f & 3; u.kq = -1; int e = 0, rem = ft, pm = 0, done = 0;
#pragma unroll
            for (int q = 0; q < 8; ++q) { if (!done) { if (rem < fe[q]) { e = q; pm = tb[q] + rem; done = 1; } else rem -= fe[q]; } }
            u.e = e; u.pm = pm; }
        return true;
    }
    __device__ __forceinline__ int nt_of(const Unit& u) const { return u.kq < 0 ? MD_KSPLIT * MD_KTILES : MD_KTILES; }
    __device__ __forceinline__ const char* a_ptr(const Unit& u) const { return A + (size_t)u.pm * tstepA + (u.kq < 0 ? (size_t)0 : (size_t)(u.kq & 255) * (MD_KTILES * 128)); }
    __device__ __forceinline__ const char* b_ptr(const Unit& u) const { return (u.e < MD_EARLY ? BtE : u.e < MD_EARLY2 ? BtE + ((size_t)W_13 - (size_t)W_IN - (size_t)MD_EARLY * DM * EDIM) : u.e < MD_EARLY3 ? BtE + ((size_t)W_G - (size_t)W_IN - (size_t)MD_EARLY2 * DM * EDIM) : Bt) + (size_t)u.e * estepB + (size_t)u.pn * tstepB + (u.kq < 0 ? (size_t)0 : (size_t)(u.kq & 255) * (MD_KTILES * 128)); }
};
struct EpiMoeDownSplit {
    static constexpr bool PERM = true, CHAIN = false, F8 = true;
    bf16* Y; bf16* Yp; const float* rgate;
    __device__ __forceinline__ void operator()(f32x4 (&acc)[2][2][4][2], const Unit& u, int wr, int wc, int fr, int fq) const {
        const int rl0 = wr * 64 + fr, col0 = u.pn * 256 + wc * 32 + 8 * fq;
        bf16* dst = (u.kq < 0) ? Y + (size_t)u.pm * 256 * DM : Yp + ((size_t)(u.kq & 255) * (8 * 256) + (size_t)(u.kq >> 8) * 256) * DM;
        float sg[2][4];
#pragma unroll
        for (int ai = 0; ai < 2; ++ai)
#pragma unroll
            for (int m = 0; m < 4; ++m) sg[ai][m] = rgate[u.pm * 256 + rl0 + ai * 128 + m * 16];
#pragma unroll
        for (int ai = 0; ai < 2; ++ai)
#pragma unroll
            for (int m = 0; m < 4; ++m) { const int rl = rl0 + ai * 128 + m * 16; const float s = sg[ai][m] * (1.0f / 64.0f);
#pragma unroll
                for (int bj = 0; bj < 2; ++bj) *(u32x4*)(dst + (size_t)rl * DM + col0 + bj * 128) = pack8(acc[ai][bj][m][0] * s, acc[ai][bj][m][1] * s); }
    }
};

enum { I_X = 0, I_WIN, I_NORM_MIX, I_RW_MU, I_RW_DECAY_UP, I_RW_W0, I_RW_A_UP, I_RW_A0, I_RW_GATE_UP, I_RW_KK, I_RW_KA, I_RW_RK, I_RW_LNW, I_RW_LNB,
       I_VRES_DOWN, I_VRES_UP, I_VRES_V0, I_SSM_CONVW, I_SSM_CONVB, I_SSM_DTB, I_SSM_ALOG, I_SSM_D, I_SSM_NORMW, I_ATT_QG, I_ATT_KG, I_ATT_BIAS,
       I_GLA_GUP, I_GLA_GB, I_GLA_NW, I_WBRANCH, I_WOUT, I_NORM_FFN, I_FFN_W1, I_FFN_W3, I_FFN_W2, I_MOE_ROUTER, I_MOE_W1, I_MOE_W3, I_MOE_W2, N_IN };
struct Args { const float* in[N_IN]; float* out; unsigned char* ws; };
static_assert(sizeof(Args) == (N_IN + 2) * 8, "Args has no padding");

struct PT { const LAS unsigned long long* tab;
    __device__ __forceinline__ const float* operator[](int i) const { const unsigned long long v = tab[i];
        const unsigned lo = __builtin_amdgcn_readfirstlane((unsigned)v), hi = __builtin_amdgcn_readfirstlane((unsigned)(v >> 32)); return (const float*)(const __attribute__((address_space(1))) float*)(((unsigned long long)hi << 32) | lo); } };
struct ArgsD { PT in;
    __device__ __forceinline__ float* out() const { return (float*)in[N_IN]; }
    __device__ __forceinline__ unsigned char* ws() const { return (unsigned char*)in[N_IN + 1]; } };
constexpr int NWAVES = 8, NTHREADS = 512;
constexpr int LDS_MAIN = 131072;
constexpr int LDS_CTL_OFF = LDS_MAIN;
constexpr int LDS_BYTES = LDS_MAIN + 1024;

template <bool GPERM = false> __device__ __forceinline__ void cvt_item(const float* __restrict__ W, int ld, int k0, int csrc, int ncv, const float* __restrict__ gs, bf16* dst, int dstK, int drow, LAS float* scr, int lane) {
    const int lc = (lane < ncv) ? lane : ncv - 1;
    const float* wp = W + (size_t)k0 * ld + csrc + lc;
    const int kc = lane & 7;
    f32x4 g0 = {1.f, 1.f, 1.f, 1.f}, g1 = g0; if (gs) { g0 = *(const f32x4*)(gs + k0 + 8 * kc); g1 = *(const f32x4*)(gs + k0 + 8 * kc + 4); }
#pragma unroll
    for (int kb = 0; kb < 64; kb += 16) { float v[16];
#pragma unroll
        for (int j = 0; j < 16; ++j) v[j] = __builtin_nontemporal_load(wp + (size_t)(kb + j) * ld);
#pragma unroll
        for (int j = 0; j < 16; ++j) scr[(kb + j) * 65 + lane] = v[j]; }
    asm volatile("s_waitcnt lgkmcnt(0)" ::: "memory");
#pragma unroll
    for (int i = 0; i < 8; ++i) { const int nn = (lane >> 3) + 8 * i; const LAS float* sp = scr + (8 * kc) * 65 + nn;
        u32x4 o; o.x = pk2(sp[0 * 65] * g0[0], sp[1 * 65] * g0[1]); o.y = pk2(sp[2 * 65] * g0[2], sp[3 * 65] * g0[3]); o.z = pk2(sp[4 * 65] * g1[0], sp[5 * 65] * g1[1]); o.w = pk2(sp[6 * 65] * g1[2], sp[7 * 65] * g1[3]);
        const int rr = GPERM ? 32 * ((nn >> 4) & 3) + 8 * ((nn >> 2) & 3) + (nn & 3) : nn;
        if (nn < ncv) *(u32x4*)(dst + (size_t)(drow + rr) * dstK + k0 + 8 * kc) = o; }
    asm volatile("s_waitcnt lgkmcnt(0)" ::: "memory");
}
__device__ __forceinline__ void cvt_item8(const float* __restrict__ W, int ld, int k0, int csrc, int ncv, const float* __restrict__ gs, float scale, unsigned char* dst, int dstK, int drow, LAS float* scr, int lane) {
    const int lc = (lane < ncv) ? lane : ncv - 1;
    const float* wp = W + (size_t)k0 * ld + csrc + lc;
    const int kc = lane & 3; f32x4 gq[4];
#pragma unroll
    for (int j = 0; j < 4; ++j) gq[j] = gs ? *(const f32x4*)(gs + k0 + 16 * kc + 4 * j) : (f32x4){1.f, 1.f, 1.f, 1.f};
#pragma unroll
    for (int kb = 0; kb < 64; kb += 16) { float v[16];
#pragma unroll
        for (int j = 0; j < 16; ++j) v[j] = __builtin_nontemporal_load(wp + (size_t)(kb + j) * ld);
#pragma unroll
        for (int j = 0; j < 16; ++j) scr[(kb + j) * 65 + lane] = v[j]; }
    asm volatile("s_waitcnt lgkmcnt(0)" ::: "memory");
    float gg[16];
#pragma unroll
    for (int j = 0; j < 16; ++j) gg[j] = gq[j >> 2][j & 3] * scale;
#pragma unroll
    for (int i = 0; i < 4; ++i) { const int nn = (lane >> 2) + 16 * i; const LAS float* sp = scr + (16 * kc) * 65 + nn; u32x4 o;
#pragma unroll
        for (int q = 0; q < 4; ++q) { int t = 0; t = __builtin_amdgcn_cvt_pk_fp8_f32(sp[(4 * q) * 65] * gg[4 * q], sp[(4 * q + 1) * 65] * gg[4 * q + 1], t, false); t = __builtin_amdgcn_cvt_pk_fp8_f32(sp[(4 * q + 2) * 65] * gg[4 * q + 2], sp[(4 * q + 3) * 65] * gg[4 * q + 3], t, true); o[q] = (unsigned)t; }
        if (nn < ncv) *(u32x4*)(dst + (size_t)(drow + nn) * dstK + k0 + 16 * kc) = o; }
    asm volatile("s_waitcnt lgkmcnt(0)" ::: "memory");
}
struct CvtCtx { int gw, ngw, base, lane; LAS float* scr; };
__device__ __forceinline__ void cvt_job_gates(CvtCtx& cx, const float* W, int ld, int K, int csrc0, const float* gs, bf16* dst) {
    const int nnb = 64, nit = (K >> 6) * nnb;
    int first = cx.gw - (cx.base % cx.ngw); if (first < 0) first += cx.ngw;
    for (int it = first; it < nit; it += cx.ngw) { const int kb = it / nnb, nb = it - kb * nnb, i = nb >> 4, cc = (nb & 15) * 64;
        cvt_item<true>(W, ld, kb * 64, csrc0 + nb * 64, 64, gs, dst, K, 256 * (cc >> 6) + 128 * (i >> 1) + 4 * (i & 1), cx.scr, cx.lane); }
    cx.base += nit;
}
__device__ __forceinline__ void cvt_job(CvtCtx& cx, const float* W, int ld, int K, int csrc0, int ncols, const float* gs, bf16* dst, int drow_base, int rs128) {
    const int nnb = (ncols + 63) >> 6, nit = (K >> 6) * nnb;
    int first = cx.gw - (cx.base % cx.ngw); if (first < 0) first += cx.ngw;
    for (int it = first; it < nit; it += cx.ngw) { const int kb = it / nnb, nb = it - kb * nnb, c = nb * 64; const int ncv = (ncols - c) < 64 ? (ncols - c) : 64;
        cvt_item(W, ld, kb * 64, csrc0 + c, ncv, gs, dst, K, drow_base + (c >> 7) * rs128 + (c & 127), cx.scr, cx.lane); }
    cx.base += nit;
}
__device__ __forceinline__ void cvt_job8(CvtCtx& cx, const float* W, int ld, int K, int csrc0, int ncols, const float* gs, float scale, unsigned char* dst, int drow_base, int rs128) {
    const int nnb = (ncols + 63) >> 6, nit = (K >> 6) * nnb;
    int first = cx.gw - (cx.base % cx.ngw); if (first < 0) first += cx.ngw;
    for (int it = first; it < nit; it += cx.ngw) { const int kb = it / nnb, nb = it - kb * nnb, c = nb * 64; const int ncv = (ncols - c) < 64 ? (ncols - c) : 64;
        cvt_item8(W, ld, kb * 64, csrc0 + c, ncv, gs, scale, dst, K, drow_base + (c >> 7) * rs128 + (c & 127), cx.scr, cx.lane); }
    cx.base += nit;
}
__device__ __forceinline__ void zero_rows_bf16(int gtid, int nthr, bf16* dst, size_t nelem) {
    u32x4 z = {0u, 0u, 0u, 0u};
    for (size_t i = (size_t)gtid * 8; i < nelem; i += (size_t)nthr * 8) *(u32x4*)(dst + i) = z;
}


__device__ __forceinline__ int rcol(int t, int rot) { return ((((t >> 3) + rot) & 7) << 3) + (t & 7); }
__device__ __forceinline__ int rcol4(int t, int rot) { return ((((t >> 3) + rot) & 3) << 3) + (t & 7); }
typedef short s16x4 __attribute__((ext_vector_type(4)));
__device__ __forceinline__ u32x2 lds_tr4(const LAS bf16* p) { return __builtin_bit_cast(u32x2, __builtin_amdgcn_ds_read_tr16_b64_v4i16((LAS s16x4*)p)); }
__device__ __forceinline__ bf16x8 frag_tr(const LAS bf16* base, int pitch, int k0, int col0, int fr, int g) {
    const LAS bf16* p = base + (k0 + 8 * g + (fr >> 2)) * pitch + col0 + 4 * (fr & 3); const u32x2 a = lds_tr4(p), b = lds_tr4(p + 4 * pitch);
    u32x4 w; w.x = a.x; w.y = a.y; w.z = b.x; w.w = b.y; return __builtin_bit_cast(bf16x8, w); }
constexpr int AT_ST = 72;
constexpr int AT_KS = 0, AT_VT = AT_KS + 2 * 64 * AT_ST * 2, AT_KSC = AT_VT + 2 * 64 * AT_ST * 2, AT_BUFB = AT_KSC + 2 * 64 * 4, AT_BIAS = 2 * AT_BUFB, AT_END = AT_BIAS + 8 * 264 * 4;
__device__ __forceinline__ void attn_drain(const ArgsD& a, int l, LAS unsigned char* lds, LAS unsigned* lctl, unsigned* qctr, const bf16* z, bf16* o) {
    const int tid = opq_v((int)threadIdx.x), lane = tid & 63, wid = __builtin_amdgcn_readfirstlane(tid >> 6);
    const int hs = wid >> 2, qb = wid & 3, fr = lane & 15, g = lane >> 4, ql = 16 * qb + fr, row = tid >> 3, ch = tid & 7;
    constexpr unsigned NU = BATCH * NCH * 4;
    __syncthreads();
    { const float* rb = a.in[I_ATT_BIAS]; LAS float* ball = (LAS float*)(lds + AT_BIAS); float bv[5];
#pragma unroll
      for (int j = 0; j < 5; ++j) { const int i = tid + 512 * j; bv[j] = rb[i < 8 * 257 ? i : 0]; }
#pragma unroll
      for (int j = 0; j < 5; ++j) { const int i = tid + 512 * j; if (i < 8 * 257) { const int hh = i / 257; ball[hh * 264 + (i - hh * 257)] = bv[j] * 1.44269504f; } } }
    f32x4 gq[4];
    { const float* qgp = a.in[I_ATT_QG] + l * 64; const float* kgp = a.in[I_ATT_KG] + l * 64;
      gq[0] = *(const f32x4*)(qgp + 8 * g) * *(const f32x4*)(kgp + 8 * g); gq[1] = *(const f32x4*)(qgp + 8 * g + 4) * *(const f32x4*)(kgp + 8 * g + 4);
      gq[2] = *(const f32x4*)(qgp + 32 + 8 * g) * *(const f32x4*)(kgp + 32 + 8 * g); gq[3] = *(const f32x4*)(qgp + 36 + 8 * g) * *(const f32x4*)(kgp + 36 + 8 * g); }
    if (tid == 0) lctl[32] = atomicAdd(qctr, 1u);
    __syncthreads();
    unsigned q = lctl[32], par = 0, un = 0;
    u32x4 wk[2], wv[2], wq0, wq1;
#define AT_KVPTR(q_, j_) (z + ((size_t)((int)((q_) & 7u)) * SEQ + ((31 - (int)((q_) >> 5)) - 8 + (j_)) * 64 + row) * ZC + C_ATT + 512 + (2 * (int)(((q_) >> 3) & 3u)) * 64 + 8 * ch)
#define AT_LOADKV(p_) do { wk[0] = *(const u32x4*)(p_); wv[0] = *(const u32x4*)((p_) + 512); wk[1] = *(const u32x4*)((p_) + 64); wv[1] = *(const u32x4*)((p_) + 576); } while (0)
#define AT_FETCHQ(q_) do { const int hp_ = (int)(((q_) >> 3) & 3u), c_ = 31 - (int)((q_) >> 5), b_ = (int)((q_) & 7u); const bf16* qp_ = z + ((size_t)b_ * SEQ + c_ * 64 + ql) * ZC + C_ATT + (2 * hp_ + hs) * 64 + 8 * g; \
        wq0 = *(const u32x4*)qp_; wq1 = *(const u32x4*)(qp_ + 32); } while (0)
    const bf16* kvp;
    { const unsigned q0_ = q < NU ? q : NU - 1; const int c0_ = 31 - (int)(q0_ >> 5); kvp = AT_KVPTR(q0_, (c0_ >= 8 ? 0 : 8 - c0_)); AT_LOADKV(kvp); AT_FETCHQ(q0_); }
    while (q < NU) {
        const int hp = (int)((q >> 3) & 3u), c = 31 - (int)(q >> 5), b = (int)(q & 7u), h = 2 * hp + hs;
        unsigned nq_r = NU; if (tid == 0) nq_r = atomicAdd(qctr, 1u);
        const LAS float* bias = (const LAS float*)(lds + AT_BIAS) + h * 264;
        bf16x8 qf[2];
        { f32x4 a0, a1, b0, b1; unpack8(wq0, a0, a1); unpack8(wq1, b0, b1);
          float ss = 0.f;
#pragma unroll
          for (int j = 0; j < 4; ++j) ss += a0[j] * a0[j] + a1[j] * a1[j] + b0[j] * b0[j] + b1[j] * b1[j];
          ss = xrows_sum(ss);
          const float sc = rsqrtf(ss * (1.0f / 64.0f) + NORM_EPS) * 0.125f;
          const u32x4 p0 = pack8(a0 * gq[0] * sc, a1 * gq[1] * sc), p1 = pack8(b0 * gq[2] * sc, b1 * gq[3] * sc);
          qf[0] = __builtin_bit_cast(bf16x8, p0); qf[1] = __builtin_bit_cast(bf16x8, p1); }
        f32x4 oT[4];
#pragma unroll
        for (int d = 0; d < 4; ++d) oT[d] = (f32x4){0.f, 0.f, 0.f, 0.f};
        float m = -1e30f, lsum = 0.f; unsigned nq = NU;
        for (int j = (c >= 8 ? 0 : 8 - c); j <= 8; ++j) {
            LAS unsigned char* buf = lds + par * AT_BUFB; par ^= 1u;
#pragma unroll
            for (int i = 0; i < 2; ++i) { const u32x4 wkk = wk[i], wvv = wv[i];
                *(LAS u32x4*)((LAS bf16*)(buf + AT_KS) + (i * 64 + row) * AT_ST + 8 * ch) = wkk;
                f32x4 k0, k1; unpack8(wkk, k0, k1); float q2 = 0.f;
#pragma unroll
                for (int e = 0; e < 4; ++e) q2 += k0[e] * k0[e] + k1[e] * k1[e];
                q2 = red8_sum(q2);
                if (ch == 0) ((LAS float*)(buf + AT_KSC))[i * 64 + row] = rsqrtf(q2 * (1.0f / 64.0f) + NORM_EPS) * 1.44269504f;
                *(LAS u32x4*)((LAS bf16*)(buf + AT_VT) + (i * 64 + row) * AT_ST + 8 * ch) = wvv; }
            if (j == 8 && tid == 0) lctl[34 + (un & 1u)] = nq_r;
            __syncthreads();
            { const bf16* np = kvp + (size_t)64 * ZC;
              if (j == 8) { nq = lctl[34 + (un & 1u)]; const unsigned qn = nq < NU ? nq : NU - 1; const int cn_ = 31 - (int)(qn >> 5); np = AT_KVPTR(qn, (cn_ >= 8 ? 0 : 8 - cn_)); AT_FETCHQ(qn); }
              kvp = np; AT_LOADKV(kvp); }
            const LAS bf16* Ks = (const LAS bf16*)(buf + AT_KS) + hs * 64 * AT_ST; const LAS bf16* VT = (const LAS bf16*)(buf + AT_VT) + hs * 64 * AT_ST; const LAS float* ksc = (const LAS float*)(buf + AT_KSC) + hs * 64;
            f32x4 sT[4];
#pragma unroll
            for (int kb = 0; kb < 4; ++kb) { sT[kb] = (f32x4){0.f, 0.f, 0.f, 0.f};
#pragma unroll
                for (int ks = 0; ks < 2; ++ks) { const bf16x8 af = *(const LAS bf16x8*)(Ks + (16 * kb + fr) * AT_ST + 32 * ks + 8 * g); sT[kb] = __builtin_amdgcn_mfma_f32_16x16x32_bf16(af, qf[ks], sT[kb], 0, 0, 0); } }
            float mt = -1e30f;
            if (j <= 5) {
                const float bfar = bias[0];
#pragma unroll
                for (int kb = 0; kb < 4; ++kb) { const f32x4 kv = *(const LAS f32x4*)(ksc + 16 * kb + 4 * g);
#pragma unroll
                    for (int r = 0; r < 4; ++r) { const float sv = sT[kb][r] * kv[r] + bfar; sT[kb][r] = sv; mt = fmaxf(mt, sv); } }
            } else if (j >= 7) {
                const LAS float* bq = bias + ((j - 8) * 64 + 4 * g - ql + 128);
#pragma unroll
                for (int kb = 0; kb < 4; ++kb) { const f32x4 kv = *(const LAS f32x4*)(ksc + 16 * kb + 4 * g);
#pragma unroll
                    for (int r = 0; r < 4; ++r) { const float sv = sT[kb][r] * kv[r] + bq[16 * kb + r]; sT[kb][r] = sv; mt = fmaxf(mt, sv); } }
            } else {
#pragma unroll
                for (int kb = 0; kb < 4; ++kb) { const f32x4 kv = *(const LAS f32x4*)(ksc + 16 * kb + 4 * g);
#pragma unroll
                    for (int r = 0; r < 4; ++r) { int rel = -128 + 16 * kb + 4 * g + r - ql; rel = rel < -128 ? -128 : rel;
                        const float sv = sT[kb][r] * kv[r] + bias[rel + 128]; sT[kb][r] = sv; mt = fmaxf(mt, sv); } }
            }
            mt = xrows_max(mt);
            const float mn = fmaxf(m, mt); const float alpha = __builtin_amdgcn_exp2f(m - mn); m = mn; lsum *= alpha;
#pragma unroll
            for (int d = 0; d < 4; ++d) oT[d] = oT[d] * alpha;
#pragma unroll
            for (int kb = 0; kb < 4; ++kb)
#pragma unroll
                for (int r = 0; r < 4; ++r) { const float p = __builtin_amdgcn_exp2f(sT[kb][r] - mn); sT[kb][r] = p; lsum += p; }
#pragma unroll
            for (int ks = 0; ks < 2; ++ks) { u32x4 pw; pw.x = pg8::cvt_pk_bf16(sT[2 * ks][0], sT[2 * ks][1]); pw.y = pg8::cvt_pk_bf16(sT[2 * ks][2], sT[2 * ks][3]); pw.z = pg8::cvt_pk_bf16(sT[2 * ks + 1][0], sT[2 * ks + 1][1]); pw.w = pg8::cvt_pk_bf16(sT[2 * ks + 1][2], sT[2 * ks + 1][3]);
                const bf16x8 pf = __builtin_bit_cast(bf16x8, pw);
#pragma unroll
                for (int db = 0; db < 4; ++db) { const LAS bf16* vp = VT + (32 * ks + 4 * g + (fr >> 2)) * AT_ST + 16 * db + 4 * (fr & 3);
                    const u32x2 v0 = lds_tr4(vp), v1 = lds_tr4(vp + 16 * AT_ST);
                    u32x4 vw; vw.x = v0.x; vw.y = v0.y; vw.z = v1.x; vw.w = v1.y;
                    oT[db] = __builtin_amdgcn_mfma_f32_16x16x32_bf16(__builtin_bit_cast(bf16x8, vw), pf, oT[db], 0, 0, 0); } }
        }
        lsum = xrows_sum(lsum);
        const float inv = 1.0f / lsum; bf16* op = o + ((size_t)b * SEQ + c * 64 + ql) * 2048 + 1024 + h * 64 + 4 * g;
#pragma unroll
        for (int dp = 0; dp < 2; ++dp) { u32x2 w[2];
#pragma unroll
            for (int k = 0; k < 2; ++k) { const int db = 2 * dp + k; w[k].x = pg8::cvt_pk_bf16(oT[db][0] * inv, oT[db][1] * inv); w[k].y = pg8::cvt_pk_bf16(oT[db][2] * inv, oT[db][3] * inv); }
            *(u32x4*)(op + 16 * (2 * dp + (g & 1)) - 4 * (g & 1)) = pair16(w[0], w[1]); }
        q = nq; ++un;
    }
#undef AT_KVPTR
#undef AT_LOADKV
#undef AT_FETCHQ
    __syncthreads();
}

typedef f32x4 acc4;
#define MFMA16(a_, b_, c_) __builtin_amdgcn_mfma_f32_16x16x32_bf16((a_), (b_), (c_), 0, 0, 0)
__device__ __forceinline__ bf16x8 frag_nat(const LAS bf16* base, int pitch, int row, int k0, int g) { return *(const LAS bf16x8*)(base + row * pitch + k0 + 8 * g); }
__device__ __forceinline__ bf16x8 frag_nat_rot(const LAS bf16* base, int row, int k0, int g) { return *(const LAS bf16x8*)(base + row * 72 + ((((k0 >> 3) + g + (row >> 4)) & 7) << 3)); }
__device__ __forceinline__ bf16x8 frag_perm(const LAS bf16* base, int pitch, int row, int k0, int g) { const LAS bf16* p = base + row * pitch + k0 + 4 * g; const u32x2 v0 = *(const LAS u32x2*)p, v1 = *(const LAS u32x2*)(p + 16);
    u32x4 w; w.x = v0.x; w.y = v0.y; w.z = v1.x; w.w = v1.y; return __builtin_bit_cast(bf16x8, w); }
__device__ __forceinline__ bf16x8 frag_acc(const acc4& lo, const acc4& hi) { u32x4 w; w.x = pg8::cvt_pk_bf16(lo[0], lo[1]); w.y = pg8::cvt_pk_bf16(lo[2], lo[3]); w.z = pg8::cvt_pk_bf16(hi[0], hi[1]); w.w = pg8::cvt_pk_bf16(hi[2], hi[3]); return __builtin_bit_cast(bf16x8, w); }
__device__ __forceinline__ float wave_incl_scan(float x, int lane) { (void)lane; return scan64(x); }

constexpr int P72 = 72, P136 = 136;
constexpr int MB_CM = 0, MB_BM = MB_CM + 64 * P136 * 2, MB_BMT = MB_BM + 64 * P136 * 2, MB_XDT = MB_BMT + 128 * P72 * 2, MB_XDTW = MB_XDT + 64 * P72 * 2, MB_P = MB_XDTW + 64 * P72 * 2,
              MB_Y = MB_P + 64 * P72 * 2, MB_ACS = MB_Y + 64 * 68 * 4, MB_DT = MB_ACS + 512, MB_END = MB_DT + 512;
static_assert(MB_END <= 159744, "mamba LDS");
__device__ __forceinline__ void mamba_bc_prepass(const ArgsD& a, int l, int gw, int ngw, int lane, const bf16* z, bf16* bcv) {
    const float* cw = a.in[I_SSM_CONVW] + (size_t)l * 4 * 1024 + 512 + 8 * lane; const float* cb = a.in[I_SSM_CONVB] + l * 1024 + 512 + 8 * lane;
    f32x4 w0[5], w1[5];
#pragma unroll
    for (int j = 0; j < 4; ++j) { w0[j] = *(const f32x4*)(cw + j * 1024); w1[j] = *(const f32x4*)(cw + j * 1024 + 4); }
    w0[4] = *(const f32x4*)cb; w1[4] = *(const f32x4*)(cb + 4);
    for (int rg = gw; rg < T / 8; rg += ngw) { const size_t t0 = (size_t)rg * 8; const bool first = ((rg * 8) & (SEQ - 1)) == 0;
        u32x4 rw[11];
#pragma unroll
        for (int i = 0; i < 11; ++i) { const size_t t = (first && i < 3) ? t0 : t0 + i - 3; rw[i] = *(const u32x4*)(z + t * ZC + C_SSM + 1024 + 8 * lane); }
        if (first) { rw[0] = (u32x4){0u, 0u, 0u, 0u}; rw[1] = rw[0]; rw[2] = rw[0]; }
#pragma unroll
        for (int i = 0; i < 8; ++i) { f32x4 o0 = w0[4], o1 = w1[4];
#pragma unroll
            for (int j = 0; j < 4; ++j) { f32x4 x0, x1; unpack8(rw[i + j], x0, x1); o0 += x0 * w0[j]; o1 += x1 * w1[j]; }
#pragma unroll
            for (int e = 0; e < 4; ++e) { o0[e] = siluf_(o0[e]); o1[e] = siluf_(o1[e]); }
            *(u32x4*)(bcv + (t0 + i) * 512 + 8 * lane) = pack8(o0, o1); } }
}
__device__ __forceinline__ void mamba_block_task(const ArgsD& a, int l, int bh, LAS unsigned char* lds, const bf16* z, const bf16* bcv, bf16* o, float* mssq) {
    const int tid = opq_v((int)threadIdx.x), lane = tid & 63, wid = __builtin_amdgcn_readfirstlane(tid >> 6), fr = lane & 15, g = lane >> 4;
    const int b = bh >> 3, hd = bh & 7, grp = hd >> 2;
    const float dtb = a.in[I_SSM_DTB][l * 8 + hd], Aneg = -__expf(a.in[I_SSM_ALOG][l * 8 + hd]), Dk = a.in[I_SSM_D][l * 8 + hd];
    LAS bf16* Cm = (LAS bf16*)(lds + MB_CM); LAS bf16* Bm = (LAS bf16*)(lds + MB_BM); LAS bf16* BmT = (LAS bf16*)(lds + MB_BMT); LAS bf16* xdtT = (LAS bf16*)(lds + MB_XDT); LAS bf16* xdtwT = (LAS bf16*)(lds + MB_XDTW);
    LAS bf16* Pm = (LAS bf16*)(lds + MB_P); LAS float* Yl = (LAS float*)(lds + MB_Y); LAS float* acs2 = (LAS float*)(lds + MB_ACS); LAS float* dts2 = (LAS float*)(lds + MB_DT);
    const int pb = wid & 3, lh = wid >> 2;
    const int row = tid >> 3, ch = tid & 7;
    f32x4 cw0[5], cw1[5];
    { const float* cw = a.in[I_SSM_CONVW] + (size_t)l * 4 * 1024 + hd * 64 + 8 * ch; const float* cb = a.in[I_SSM_CONVB] + l * 1024 + hd * 64 + 8 * ch;
#pragma unroll
      for (int j = 0; j < 4; ++j) { cw0[j] = *(const f32x4*)(cw + j * 1024); cw1[j] = *(const f32x4*)(cw + j * 1024 + 4); }
      cw0[4] = *(const f32x4*)cb; cw1[4] = *(const f32x4*)(cb + 4); }
    acc4 St[8];
#pragma unroll
    for (int nb = 0; nb < 8; ++nb) St[nb] = (acc4){0.f, 0.f, 0.f, 0.f};
    u32x4 n_gt, n_x[4], n_b0, n_b1, n_c0, n_c1; bf16 n_dt = 0;
#define MB_FETCH(cn_) do { const size_t tq_ = (size_t)b * SEQ + (cn_) * 64 + row; const bf16* zn_ = z + tq_ * ZC + C_SSM; n_gt = *(const u32x4*)(zn_ + hd * 64 + 8 * ch); \
        _Pragma("unroll") for (int k_ = 0; k_ < 4; ++k_) { const bool ok_ = ((cn_) * 64 + row - k_) >= 0; n_x[k_] = *(const u32x4*)(zn_ - (ok_ ? (size_t)k_ * ZC : (size_t)0) + 512 + hd * 64 + 8 * ch); }   \
        const bf16* bq_ = bcv + tq_ * 512 + grp * 128 + 8 * ch; n_b0 = *(const u32x4*)bq_; n_b1 = *(const u32x4*)(bq_ + 64); n_c0 = *(const u32x4*)(bq_ + 256); n_c1 = *(const u32x4*)(bq_ + 320); } while (0)
#define MB_DTSCAN(cn_) do { const float dt_ = softplusf_(bf2f(n_dt) + dtb); const float cs_ = wave_incl_scan(dt_ * Aneg, lane); dts2[((cn_) & 1) * 64 + lane] = dt_; acs2[((cn_) & 1) * 64 + lane] = cs_; } while (0)
    MB_FETCH(0);
    if (wid == 0) { n_dt = z[((size_t)b * SEQ + lane) * ZC + C_SSM + 1536 + hd]; MB_DTSCAN(0); n_dt = z[((size_t)b * SEQ + 64 + lane) * ZC + C_SSM + 1536 + hd]; }
    __syncthreads();
    for (int c = 0; c < NCH; ++c) {
        const size_t t0 = (size_t)b * SEQ + c * 64;
        const LAS float* acs = acs2 + (c & 1) * 64; const LAS float* dts = dts2 + (c & 1) * 64;
        const u32x4 c_gt = n_gt; u32x4 c_x;
        { const float dt = dts[row], wl = __expf(acs[63] - acs[row]);
          f32x4 x0 = cw0[4], x1 = cw1[4];
#pragma unroll
          for (int j = 0; j < 4; ++j) { f32x4 r0, r1; unpack8(n_x[3 - j], r0, r1); const float mk = (c * 64 + row - (3 - j) >= 0) ? 1.0f : 0.0f; x0 += r0 * (cw0[j] * mk); x1 += r1 * (cw1[j] * mk); }
#pragma unroll
          for (int e = 0; e < 4; ++e) { x0[e] = siluf_(x0[e]); x1[e] = siluf_(x1[e]); }
          c_x = pack8(x0, x1);
          { const f32x4 d0 = x0 * dt, d1 = x1 * dt;
            *(LAS u32x4*)(xdtT + row * P72 + 8 * ch) = pack8(d0, d1); *(LAS u32x4*)(xdtwT + row * P72 + 8 * ch) = pack8(d0 * wl, d1 * wl); }
#pragma unroll
          for (int i = 0; i < 2; ++i) { const int cc = ch + 8 * i; const u32x4 wb = i ? n_b1 : n_b0, wc = i ? n_c1 : n_c0;
              *(LAS u32x4*)(Bm + row * P136 + 8 * cc) = wb; *(LAS u32x4*)(Cm + row * P136 + 8 * cc) = wc;
              } }
        __syncthreads();
        if (wid == 0 && c + 1 < NCH) MB_DTSCAN(c + 1);
        { const int lb = wid >> 1;
#pragma unroll
          for (int q = 0; q < 2; ++q) { const int sb = 2 * (wid & 1) + q; acc4 cb = (acc4){0.f, 0.f, 0.f, 0.f};
#pragma unroll
              for (int ks = 0; ks < 4; ++ks) cb = MFMA16(frag_nat(Cm, P136, 16 * lb + fr, 32 * ks, g), frag_nat(Bm, P136, 16 * sb + fr, 32 * ks, g), cb);
              const int sidx = 16 * sb + fr; const float as = acs[sidx];
#pragma unroll
              for (int r = 0; r < 4; ++r) { const int lidx = 16 * lb + 4 * g + r; const float v = (sidx <= lidx) ? cb[r] * __expf(acs[lidx] - as) : 0.f; Pm[lidx * P72 + sidx] = (bf16)f2bf(v); } } }
        __syncthreads();
        { const int cn = (c + 1 < NCH) ? c + 1 : c; MB_FETCH(cn); const int cd = (c + 2 < NCH) ? c + 2 : c; if (wid == 0) n_dt = z[((size_t)b * SEQ + cd * 64 + lane) * ZC + C_SSM + 1536 + hd]; }
#pragma unroll
        for (int q = 0; q < 2; ++q) { const int lb = 2 * lh + q; acc4 y = (acc4){0.f, 0.f, 0.f, 0.f};
#pragma unroll
            for (int kk = 0; kk < 4; ++kk) y = MFMA16(frag_perm(Cm, P136, 16 * lb + fr, 32 * kk, g), frag_acc(St[2 * kk], St[2 * kk + 1]), y);
#pragma unroll
            for (int r = 0; r < 4; ++r) y[r] *= __expf(acs[16 * lb + 4 * g + r]);
#pragma unroll
            for (int ks = 0; ks < 2; ++ks) y = MFMA16(frag_nat(Pm, P72, 16 * lb + fr, 32 * ks, g), frag_tr(xdtT, P72, 32 * ks, 16 * pb, fr, g), y);
#pragma unroll
            for (int r = 0; r < 4; ++r) Yl[(16 * lb + 4 * g + r) * 68 + 16 * pb + fr] = y[r]; }
        { const float dec = __expf(acs[63]);
#pragma unroll
          for (int nb = 0; nb < 8; ++nb) { St[nb] = St[nb] * dec;
#pragma unroll
              for (int ks = 0; ks < 2; ++ks) St[nb] = MFMA16(frag_tr(Bm, P136, 32 * ks, 16 * nb, fr, g), frag_tr(xdtwT, P72, 32 * ks, 16 * pb, fr, g), St[nb]); } }
        __syncthreads();
        { const size_t t = t0 + row;
          f32x4 x0, x1, g0, g1; unpack8(c_x, x0, x1); unpack8(c_gt, g0, g1);
          const f32x4 y0 = *(const LAS f32x4*)(Yl + row * 68 + 8 * ch), y1 = *(const LAS f32x4*)(Yl + row * 68 + 8 * ch + 4); f32x4 o0, o1; float q2 = 0.f;
#pragma unroll
          for (int e = 0; e < 4; ++e) { o0[e] = (y0[e] + x0[e] * Dk) * siluf_(g0[e]); o1[e] = (y1[e] + x1[e] * Dk) * siluf_(g1[e]); q2 += o0[e] * o0[e] + o1[e] * o1[e]; }
          *(u32x4*)(o + t * 2048 + 512 + hd * 64 + 8 * ch) = pack8(o0, o1);
          q2 = red8_sum(q2);
          if (ch == 0) mssq[t * 8 + hd] = q2; }
    }
#undef MB_FETCH
#undef MB_DTSCAN
    __syncthreads();
}

constexpr int P132 = 132;
constexpr int GL_BC = 0, GL_QG = GL_BC + 64 * 68 * 4, GL_KG = GL_QG + 64 * P72 * 2, GL_KDT = GL_KG + 64 * P72 * 2, GL_VT = GL_KDT + 64 * P72 * 2, GL_ATT = GL_VT + 128 * P72 * 2,
              GL_O = GL_ATT + 64 * P72 * 2, GL_GU = GL_O + 64 * P132 * 4, GL_END = GL_GU + 17 * 64 * 4;
static_assert(GL_END <= LDS_MAIN, "gla LDS");
constexpr int GP_GU = 0, GP_BC = GP_GU + 17 * 64 * 4, GP_END = GP_BC + 2 * 64 * 68 * 4;
__device__ __forceinline__ void gla_prepass(const ArgsD& a, int l, int bx, int G, LAS unsigned char* lds, bf16* z, float* gend) {
    const int tid = opq_v((int)threadIdx.x), lane = tid & 63, wid = __builtin_amdgcn_readfirstlane(tid >> 6), row = tid >> 3, ch = tid & 7;
    LAS float* gu = (LAS float*)(lds + GP_GU);
    constexpr int NUN = BATCH * 4 * NCH;
    int gu_h = -1; unsigned par = 0;
    u32x4 wx0, wx1, wq, wk;
#define GP_FETCH(u_) do { const int c_ = (u_) & 31, h_ = ((u_) >> 5) & 3, b_ = (u_) >> 7; const bf16* zn_ = z + ((size_t)b_ * SEQ + c_ * 64 + row) * ZC + C_GLA; \
        wx0 = *(const u32x4*)(zn_ + 1024); wx1 = *(const u32x4*)(zn_ + 1032); wq = *(const u32x4*)(zn_ + h_ * 64 + 8 * ch); wk = *(const u32x4*)(zn_ + 256 + h_ * 64 + 8 * ch); } while (0)
    { const int u0 = bx < NUN ? bx : NUN - 1; GP_FETCH(u0); }
    for (int u = bx; u < NUN; u += G) {
        const int c = u & 31, h = (u >> 5) & 3, b = u >> 7;
        if (gu_h != h) { gu_h = h; __syncthreads();
            const float* gup = a.in[I_GLA_GUP] + (size_t)l * 16 * 256 + h * 64; const float* gbp = a.in[I_GLA_GB] + l * 256 + h * 64; float gv[3];
#pragma unroll
            for (int j = 0; j < 3; ++j) { const int i = tid + 512 * j, ic = i < 17 * 64 ? i : 0, r = ic >> 6, k = ic & 63; gv[j] = (r < 16) ? gup[r * 256 + k] : gbp[k]; }
#pragma unroll
            for (int j = 0; j < 3; ++j) { const int i = tid + 512 * j; if (i < 17 * 64) gu[i] = gv[j]; }
            __syncthreads(); }
        LAS float* bc = (LAS float*)(lds + GP_BC) + par * (64 * 68); par ^= 1u;
        const u32x4 c_q = wq, c_k = wk; f32x4 xa, xb_, xc, xd; unpack8(wx0, xa, xb_); unpack8(wx1, xc, xd);
        { const int un = (u + G < NUN) ? u + G : u; GP_FETCH(un); }
        { f32x4 la0 = *(const LAS f32x4*)(gu + 16 * 64 + 8 * ch), la1 = *(const LAS f32x4*)(gu + 16 * 64 + 8 * ch + 4);
#pragma unroll
          for (int r = 0; r < 16; ++r) { const float xv = (r < 4) ? xa[r & 3] : (r < 8) ? xb_[r & 3] : (r < 12) ? xc[r & 3] : xd[r & 3];
              la0 += *(const LAS f32x4*)(gu + r * 64 + 8 * ch) * xv; la1 += *(const LAS f32x4*)(gu + r * 64 + 8 * ch + 4) * xv; }
#pragma unroll
          for (int e = 0; e < 4; ++e) { la0[e] = (fminf(la0[e], 0.f) - __logf(1.0f + __expf(-fabsf(la0[e])))) * (1.0f / 16.0f); la1[e] = (fminf(la1[e], 0.f) - __logf(1.0f + __expf(-fabsf(la1[e])))) * (1.0f / 16.0f); }
          *(LAS f32x4*)(bc + row * 68 + 8 * ch) = la0; *(LAS f32x4*)(bc + row * 68 + 8 * ch + 4) = la1; }
        __syncthreads();
#pragma unroll
        for (int q = 0; q < 8; ++q) { const int k = 8 * wid + q; const float v = scan64(bc[lane * 68 + k]); bc[lane * 68 + k] = v; }
        __syncthreads();
        { const f32x4 b0 = *(const LAS f32x4*)(bc + row * 68 + 8 * ch), b1 = *(const LAS f32x4*)(bc + row * 68 + 8 * ch + 4);
          f32x4 q0, q1, k0, k1, qa, qb_, ka, kb_; unpack8(c_q, q0, q1); unpack8(c_k, k0, k1);
#pragma unroll
          for (int e = 0; e < 4; ++e) { qa[e] = q0[e] * __expf(b0[e]) * 0.125f; qb_[e] = q1[e] * __expf(b1[e]) * 0.125f; ka[e] = k0[e] * __expf(-b0[e]); kb_[e] = k1[e] * __expf(-b1[e]); }
          bf16* zn = z + ((size_t)b * SEQ + c * 64 + row) * ZC + C_GLA; *(u32x4*)(zn + h * 64 + 8 * ch) = pack8(qa, qb_); *(u32x4*)(zn + 256 + h * 64 + 8 * ch) = pack8(ka, kb_);
          if (tid < 64) gend[(size_t)u * 64 + tid] = bc[63 * 68 + tid]; }
    }
#undef GP_FETCH
    __syncthreads();
}
__device__ __forceinline__ void gla_block_task(const ArgsD& a, int l, int bh, LAS unsigned char* lds, const bf16* z, const float* gend, bf16* o) {
    const int tid = opq_v((int)threadIdx.x), lane = tid & 63, wid = __builtin_amdgcn_readfirstlane(tid >> 6), fr = lane & 15, g = lane >> 4;
    const int b = bh >> 2, h = bh & 3;
    LAS float* endl = (LAS float*)(lds + GL_BC); LAS bf16* qg = (LAS bf16*)(lds + GL_QG); LAS bf16* kg = (LAS bf16*)(lds + GL_KG); LAS bf16* kgT = (LAS bf16*)(lds + GL_KDT); LAS bf16* vT = (LAS bf16*)(lds + GL_VT);
    LAS bf16* att = (LAS bf16*)(lds + GL_ATT); LAS float* Ol = (LAS float*)(lds + GL_O);
    const float* nwp = a.in[I_GLA_NW] + l * 128;
    acc4 St[4];
#pragma unroll
    for (int kb = 0; kb < 4; ++kb) St[kb] = (acc4){0.f, 0.f, 0.f, 0.f};
    const int row = tid >> 3, ch = tid & 7;
    const f32x4 nw0 = *(const f32x4*)(nwp + 16 * ch), nw1 = *(const f32x4*)(nwp + 16 * ch + 4), nw2 = *(const f32x4*)(nwp + 16 * ch + 8), nw3 = *(const f32x4*)(nwp + 16 * ch + 12);
    u32x4 n_q, n_k, n_v0, n_v1, n_g0, n_g1; float n_end = 0.f;
#define GL_FETCH(cn_) do { const bf16* zn_ = z + ((size_t)b * SEQ + (cn_) * 64 + row) * ZC + C_GLA; n_q = *(const u32x4*)(zn_ + h * 64 + 8 * ch); n_k = *(const u32x4*)(zn_ + 256 + h * 64 + 8 * ch); \
        n_v0 = *(const u32x4*)(zn_ + 512 + h * 128 + 8 * ch); n_v1 = *(const u32x4*)(zn_ + 512 + h * 128 + 8 * (ch + 8)); n_g0 = *(const u32x4*)(zn_ + 1040 + h * 128 + 16 * ch); n_g1 = *(const u32x4*)(zn_ + 1040 + h * 128 + 16 * ch + 8); \
        if (tid < 64) n_end = gend[((size_t)(b * 4 + h) * NCH + (cn_)) * 64 + tid]; } while (0)
    GL_FETCH(0);
    __syncthreads();
    for (int c = 0; c < NCH; ++c) {
        const size_t t0 = (size_t)b * SEQ + c * 64;
        const u32x4 c_g0 = n_g0, c_g1 = n_g1;
        { *(LAS u32x4*)(qg + row * P72 + 8 * ch) = n_q; *(LAS u32x4*)(kg + row * P72 + 8 * ch) = n_k;
          if (tid < 64) endl[tid] = n_end;
          *(LAS u32x4*)(vT + row * P136 + 8 * ch) = n_v0; *(LAS u32x4*)(vT + row * P136 + 8 * (ch + 8)) = n_v1; }
        __syncthreads();
        { const int lb = wid >> 1;
#pragma unroll
          for (int q = 0; q < 2; ++q) { const int sb = 2 * (wid & 1) + q; acc4 at = (acc4){0.f, 0.f, 0.f, 0.f};
#pragma unroll
              for (int ks = 0; ks < 2; ++ks) at = MFMA16(frag_nat(qg, P72, 16 * lb + fr, 32 * ks, g), frag_nat(kg, P72, 16 * sb + fr, 32 * ks, g), at);
              const int sidx = 16 * sb + fr;
#pragma unroll
              for (int r = 0; r < 4; ++r) { const int lidx = 16 * lb + 4 * g + r; att[lidx * P72 + sidx] = (bf16)f2bf((sidx <= lidx) ? at[r] : 0.f); } } }
        __syncthreads();
        { const int cn = (c + 1 < NCH) ? c + 1 : c; GL_FETCH(cn); }
#pragma unroll
        for (int lb = 0; lb < 4; ++lb) { acc4 ov = (acc4){0.f, 0.f, 0.f, 0.f};
#pragma unroll
            for (int kk = 0; kk < 2; ++kk) ov = MFMA16(frag_perm(qg, P72, 16 * lb + fr, 32 * kk, g), frag_acc(St[2 * kk], St[2 * kk + 1]), ov);
#pragma unroll
            for (int ks = 0; ks < 2; ++ks) ov = MFMA16(frag_nat(att, P72, 16 * lb + fr, 32 * ks, g), frag_tr(vT, P136, 32 * ks, 16 * wid, fr, g), ov);
#pragma unroll
            for (int r = 0; r < 4; ++r) Ol[(16 * lb + 4 * g + r) * P132 + 16 * wid + fr] = ov[r]; }
#pragma unroll
        for (int kb = 0; kb < 4; ++kb) { const f32x4 bl = *(const LAS f32x4*)(endl + 16 * kb + 4 * g);
#pragma unroll
            for (int ks = 0; ks < 2; ++ks) St[kb] = MFMA16(frag_tr(kg, P72, 32 * ks, 16 * kb, fr, g), frag_tr(vT, P136, 32 * ks, 16 * wid, fr, g), St[kb]);
#pragma unroll
            for (int r = 0; r < 4; ++r) St[kb][r] *= __expf(bl[r]); }
        __syncthreads();
        { const size_t t = t0 + row; float q2 = 0.f; f32x4 ov[4];
#pragma unroll
          for (int i = 0; i < 4; ++i) { ov[i] = *(const LAS f32x4*)(Ol + row * P132 + 16 * ch + 4 * i); q2 += ov[i][0] * ov[i][0] + ov[i][1] * ov[i][1] + ov[i][2] * ov[i][2] + ov[i][3] * ov[i][3]; }
          q2 = red8_sum(q2);
          const float sc = rsqrtf(q2 * (1.0f / 128.0f) + NORM_EPS);
#pragma unroll
          for (int i = 0; i < 2; ++i) { const u32x4 wg = i ? c_g1 : c_g0; f32x4 g0, g1; unpack8(wg, g0, g1);
              const f32x4 n0 = i ? nw2 : nw0, n1 = i ? nw3 : nw1; f32x4 r0, r1;
#pragma unroll
              for (int e = 0; e < 4; ++e) { r0[e] = ov[2 * i][e] * sc * n0[e] * siluf_(g0[e]); r1[e] = ov[2 * i + 1][e] * sc * n1[e] * siluf_(g1[e]); }
              *(u32x4*)(o + t * 2048 + 1536 + h * 128 + 16 * ch + 8 * i) = pack8(r0, r1); } }
    }
#undef GL_FETCH
    __syncthreads();
}

constexpr int RT = 32, P40 = 40, P328 = 328, P168 = 168;
constexpr int RW_REC = 29184;
constexpr int IM_AT = 0, IM_RT = IM_AT + RT * P72 * 2, IM_KPT = IM_RT + RT * P72 * 2, IM_BPT = IM_KPT + 64 * P40 * 2, IM_VT = IM_BPT + 64 * P40 * 2, IM_MAK = IM_VT + 64 * P40 * 2, IM_ARK = IM_MAK + RT * P40 * 2,
              IM_ARB = IM_ARK + RT * P40 * 2, IM_T1 = IM_ARB + RT * P40 * 2, IM_T2 = IM_T1 + 16 * P40 * 2, IM_GAM = IM_T2 + 16 * P40 * 2, IM_BON = IM_GAM + 256, IM_END = IM_BON + 128;
__device__ __forceinline__ int rw_piece_off(int p) {
    if (p < 512) { const int m = p >> 8, q = p & 255; return (m ? IM_RT : IM_AT) + (q >> 3) * (P72 * 2) + (q & 7) * 16; }
    p -= 512; if (p < 768) { const int m = p >> 8, q = p & 255; return IM_KPT + m * (64 * P40 * 2) + (q >> 2) * (P40 * 2) + (q & 3) * 16; }
    p -= 768; if (p < 384) { const int m = p >> 7, q = p & 127; return IM_MAK + m * (RT * P40 * 2) + (q >> 2) * (P40 * 2) + (q & 3) * 16; }
    p -= 384; if (p < 128) { const int m = p >> 6, q = p & 63; return IM_T1 + m * (16 * P40 * 2) + (q >> 2) * (P40 * 2) + (q & 3) * 16; }
    p -= 128; return IM_GAM + p * 16;
}
constexpr int RW_NPIECE = 1816;
__device__ __forceinline__ unsigned char* rw_rec_ptr(unsigned char* ws, int h, int b, int c) {
    unsigned char* base = (h < 4) ? ws + WS_XG : (h < 6) ? ws + WS_X + X_MIXED : ws + WS_Z + (size_t)T * ZC * 2;
    const int hl = (h < 4) ? h : (h < 6) ? h - 4 : h - 6;
    return base + ((size_t)(hl * BATCH + b) * (SEQ / RT) + c) * RW_REC;
}
static_assert((size_t)4 * BATCH * (SEQ / RT) * RW_REC <= XG_BYTES && (size_t)2 * BATCH * (SEQ / RT) * RW_REC <= (size_t)T * DM * 2 && (size_t)2 * BATCH * (SEQ / RT) * RW_REC <= Z_BYTES - (size_t)T * ZC * 2, "rwkv record regions");

constexpr int RW_WD = 0, RW_WA = RW_WD + 64 * P72 * 2, RW_WG = RW_WA + 64 * P72 * 2, RW_WV = RW_WG + 64 * P168 * 2, RW_HALF0 = RW_WV + 64 * P40 * 2;
constexpr int RH_XLR = 0, RH_LC = 0, RH_KH = RH_LC + RT * 68 * 4, RH_BH = RH_KH + RT * P72 * 2, RH_MAB = RH_BH + RT * P72 * 2, RH_R1_END = RH_MAB + RT * 33 * 4, RH_IMG = 22272, RH_PROJ = RH_IMG, RH_BYTES = RH_IMG + IM_END;
constexpr int RW_PAR = RW_HALF0 + 2 * RH_BYTES;
constexpr int RW_END = RW_PAR + 9 * 64 * 4;
static_assert(RH_R1_END <= RH_IMG && RT * P328 * 2 <= RH_IMG && 4 * RT * P72 * 2 <= IM_GAM && RW_END <= NWAVES * 20352 && (RH_IMG % 16) == 0 && (RH_BYTES % 16) == 0 && (RW_HALF0 % 16) == 0, "rwkv prep LDS");
constexpr int XLR_OFF = 512;
__device__ __forceinline__ void rwkv_xlr_prepass(const ArgsD& a, int l, int bx, int G, const bf16* z, bf16* o) {
    const int tid = opq_v((int)threadIdx.x);
    const float* mu = a.in[I_RW_MU] + l * 1824;
    for (int rb = bx; rb < T / 64; rb += G) {
        u32x4 wc_[5], wp_[5]; f32x4 m0_[5], m1_[5];
#pragma unroll
        for (int i = 0; i < 5; ++i) { const int it = tid + 512 * i, tk = it / 40, q = it - tk * 40; const size_t row = (size_t)rb * 64 + tk;
            const int col = (q < 36) ? 1536 + 8 * q : C_HV + 8 * (q - 36);
            const size_t prow = ((row & (SEQ - 1)) == 0) ? row : row - 1;
            wc_[i] = *(const u32x4*)(z + row * ZC + col); wp_[i] = *(const u32x4*)(z + prow * ZC + col);
            const int mcol = (q < 36) ? col : 1536;
            m0_[i] = *(const f32x4*)(mu + mcol); m1_[i] = *(const f32x4*)(mu + mcol + 4); }
#pragma unroll
        for (int i = 0; i < 5; ++i) { const int it = tid + 512 * i, tk = it / 40, q = it - tk * 40; const size_t row = (size_t)rb * 64 + tk; f32x4 c0v, c1v, p0v, p1v; unpack8(wc_[i], c0v, c1v); unpack8(wp_[i], p0v, p1v);
            if ((row & (SEQ - 1)) == 0) { p0v = (f32x4){0.f, 0.f, 0.f, 0.f}; p1v = p0v; }
            const f32x4 x0 = c0v + (p0v - c0v) * m0_[i], x1 = c1v + (p1v - c1v) * m1_[i];
            const float kk2 = (q < 8) ? 2.0f : 1.0f; f32x4 v0, v1;
#pragma unroll
            for (int e = 0; e < 4; ++e) { const float s0 = sigmoidf_(kk2 * x0[e]), s1 = sigmoidf_(kk2 * x1[e]);
                v0[e] = (q < 8) ? 2.0f * s0 - 1.0f : (q < 16) ? x0[e] : (q < 36) ? s0 : c0v[e]; v1[e] = (q < 8) ? 2.0f * s1 - 1.0f : (q < 16) ? x1[e] : (q < 36) ? s1 : c1v[e]; }
            *(u32x4*)(o + row * 2048 + XLR_OFF + 8 * q) = pack8(v0, v1); }
    }
}
struct PrepPf { u32x4 wzr, wzk, wzv, wpr, wpk, wpv, wvf, xl[5]; };
__device__ __forceinline__ void rwkv_prep_fetch(PrepPf& pf, int l, int h, int b, int cpair, const bf16* z, const bf16* vfirst, const bf16* o) {
    const int tid = opq_v((int)threadIdx.x), lt = tid & 255, c = cpair + (tid >> 8), tok = lt >> 3, C0 = h * 64 + 8 * (lt & 7);
    const size_t t0 = (size_t)b * SEQ + c * RT;
    const bf16* zp = z + (t0 + tok) * ZC + C0; pf.wzr = *(const u32x4*)zp; pf.wzk = *(const u32x4*)(zp + 512); pf.wzv = *(const u32x4*)(zp + 1024);
    const bf16* zq = (c == 0 && tok == 0) ? zp : zp - ZC; pf.wpr = *(const u32x4*)zq; pf.wpk = *(const u32x4*)(zq + 512); pf.wpv = *(const u32x4*)(zq + 1024);
    if (l == 1) pf.wvf = *(const u32x4*)(vfirst + (t0 + tok) * 512 + C0); else pf.wvf = (u32x4){0u, 0u, 0u, 0u};
#pragma unroll
    for (int i = 0; i < 5; ++i) { const int it = lt + 256 * i, tk = it / 40, q = it - tk * 40; pf.xl[i] = *(const u32x4*)(o + (t0 + tk) * 2048 + XLR_OFF + 8 * q); }
}
__device__ __forceinline__ void rwkv_prep_pair(const ArgsD& a, int l, int h, int b, int cpair, int nh, int nb, int ncpair, PrepPf& pf, int& wts_h, LAS unsigned char* lds, const bf16* z, bf16* vfirst, bf16* o, unsigned char* ws) {
    const int tid = opq_v((int)threadIdx.x), lane = tid & 63, wid = __builtin_amdgcn_readfirstlane(tid >> 6), fr = lane & 15, g = lane >> 4;
    const int hf = wid >> 2, lw = wid & 3, lt = tid & 255, c = cpair + hf;
    LAS bf16* Wd = (LAS bf16*)(lds + RW_WD); LAS bf16* Wa = (LAS bf16*)(lds + RW_WA); LAS bf16* Wg = (LAS bf16*)(lds + RW_WG); LAS bf16* Wv = (LAS bf16*)(lds + RW_WV);
    LAS unsigned char* hb_ = lds + RW_HALF0 + hf * RH_BYTES;
    LAS bf16* Xlr = (LAS bf16*)(hb_ + RH_XLR); LAS bf16* Proj = (LAS bf16*)(hb_ + RH_PROJ); LAS float* Lc = (LAS float*)(hb_ + RH_LC);
    LAS bf16* Kh = (LAS bf16*)(hb_ + RH_KH); LAS bf16* Bh = (LAS bf16*)(hb_ + RH_BH); LAS float* Mab = (LAS float*)(hb_ + RH_MAB); LAS unsigned char* img = hb_ + RH_IMG;
    LAS bf16* At = (LAS bf16*)(img + IM_AT); LAS bf16* Rt = (LAS bf16*)(img + IM_RT); LAS bf16* KpT = (LAS bf16*)(img + IM_KPT); LAS bf16* BpT = (LAS bf16*)(img + IM_BPT); LAS bf16* VT = (LAS bf16*)(img + IM_VT);
    LAS bf16* Mak = (LAS bf16*)(img + IM_MAK); LAS bf16* Ark = (LAS bf16*)(img + IM_ARK); LAS bf16* Arb = (LAS bf16*)(img + IM_ARB); LAS bf16* T1 = (LAS bf16*)(img + IM_T1); LAS bf16* T2 = (LAS bf16*)(img + IM_T2);
    LAS float* gam = (LAS float*)(img + IM_GAM); LAS float* bon = (LAS float*)(img + IM_BON);
    if (wts_h != h) { wts_h = h;
        const float* dup = a.in[I_RW_DECAY_UP] + (size_t)l * 64 * 512 + h * 64; const float* aup = a.in[I_RW_A_UP] + (size_t)l * 64 * 512 + h * 64; const float* gup = a.in[I_RW_GATE_UP] + (size_t)l * 160 * 512 + h * 64; const float* vup = a.in[I_VRES_UP] + h * 64;
        { const int k0 = tid >> 6, ch = tid & 63;
          float dv[8], av_[8], gv[20], vv_[4];
#pragma unroll
          for (int j = 0; j < 8; ++j) { dv[j] = dup[(k0 + 8 * j) * 512 + ch]; av_[j] = aup[(k0 + 8 * j) * 512 + ch]; }
#pragma unroll
          for (int j = 0; j < 4; ++j) vv_[j] = vup[(k0 + 8 * j) * 512 + ch];
#pragma unroll
          for (int j = 0; j < 20; ++j) gv[j] = gup[(k0 + 8 * j) * 512 + ch];
#pragma unroll
          for (int j = 0; j < 8; ++j) { Wd[ch * P72 + k0 + 8 * j] = (bf16)f2bf(dv[j]); Wa[ch * P72 + k0 + 8 * j] = (bf16)f2bf(av_[j]); }
#pragma unroll
          for (int j = 0; j < 4; ++j) Wv[ch * P40 + k0 + 8 * j] = (bf16)f2bf(vv_[j]);
#pragma unroll
          for (int j = 0; j < 20; ++j) Wg[ch * P168 + k0 + 8 * j] = (bf16)f2bf(gv[j]); }
        { const int p = tid >> 6, cc = h * 64 + (tid & 63); const float* mu_ = a.in[I_RW_MU] + l * 1824;
          float pv0 = 0.f, pv1 = 0.f;
          pv0 = (p == 0) ? mu_[cc] : (p == 1) ? mu_[512 + cc] : (p == 2) ? mu_[1024 + cc] : (p == 3) ? a.in[I_RW_W0][l * 512 + cc] : (p == 4) ? a.in[I_RW_A0][l * 512 + cc] : (p == 5) ? a.in[I_VRES_V0][cc] : (p == 6) ? a.in[I_RW_KK][l * 512 + cc] : a.in[I_RW_KA][l * 512 + cc];
          if (tid < 64) pv1 = a.in[I_RW_RK][l * 512 + cc];
          LAS float* par_ = (LAS float*)(lds + RW_PAR); par_[tid] = pv0; if (tid < 64) par_[512 + tid] = pv1; } }
    const float* mu = a.in[I_RW_MU] + l * 1824;
    const int tok = lt >> 3, c0 = 8 * (lt & 7), C0 = h * 64 + c0;
    const size_t t0 = (size_t)b * SEQ + c * RT;
    const u32x4 zz4 = {0u, 0u, 0u, 0u}; const bool ftok = (c == 0 && tok == 0);
    const u32x4 wzr = pf.wzr, wzk = pf.wzk, wzv = pf.wzv, wpr = ftok ? zz4 : pf.wpr, wpk = ftok ? zz4 : pf.wpk, wpv = ftok ? zz4 : pf.wpv, wvf = pf.wvf;
#pragma unroll
    for (int i = 0; i < 5; ++i) { const int it = lt + 256 * i, tk = it / 40, q = it - tk * 40; *(LAS u32x4*)(Xlr + tk * P328 + 8 * q) = pf.xl[i]; }
    __syncthreads();
    { const int cb = lw;
#pragma unroll
      for (int p = 0; p < 4; ++p) { const LAS bf16* Wp = (p == 0) ? Wd : (p == 1) ? Wa : (p == 2) ? Wg : Wv; const int wp = (p == 2) ? P168 : (p == 3) ? P40 : P72; const int kb0 = (p == 0) ? 0 : (p == 1) ? 64 : (p == 2) ? 128 : 288;
          const int nks = (p == 2) ? 5 : (p == 3) ? 1 : 2;
#pragma unroll
          for (int rb = 0; rb < 2; ++rb) { acc4 ac = (acc4){0.f, 0.f, 0.f, 0.f};
#pragma unroll
              for (int ks = 0; ks < nks; ++ks) ac = MFMA16(frag_nat(Xlr, P328, 16 * rb + fr, kb0 + 32 * ks, g), frag_nat(Wp, wp, 16 * cb + fr, 32 * ks, g), ac);
#pragma unroll
              for (int r = 0; r < 4; ++r) Proj[(p * RT + 16 * rb + 4 * g + r) * P72 + 16 * cb + fr] = (bf16)f2bf(ac[r]); } } }
    __syncthreads();
    f32x4 rr[2], kk_[2], vv[2], ap[2], bp[2];
    { const size_t row = t0 + tok; f32x4 zr[2], zk[2], zv[2], pr[2], pk[2], pv[2], dw[2], da[2], gg[2], vm[2], vf[2];
      unpack8(wzr, zr[0], zr[1]); unpack8(wzk, zk[0], zk[1]); unpack8(wzv, zv[0], zv[1]); unpack8(wpr, pr[0], pr[1]); unpack8(wpk, pk[0], pk[1]); unpack8(wpv, pv[0], pv[1]); unpack8(wvf, vf[0], vf[1]);
      unpack8(*(const LAS u32x4*)(Proj + (0 * RT + tok) * P72 + c0), dw[0], dw[1]); unpack8(*(const LAS u32x4*)(Proj + (1 * RT + tok) * P72 + c0), da[0], da[1]);
      unpack8(*(const LAS u32x4*)(Proj + (2 * RT + tok) * P72 + c0), gg[0], gg[1]); unpack8(*(const LAS u32x4*)(Proj + (3 * RT + tok) * P72 + c0), vm[0], vm[1]);
      f32x4 ee[2], av[2], vraw[2], kraw[2]; float n2 = 0.f;
#pragma unroll
      for (int hq = 0; hq < 2; ++hq) { const int Cq = C0 + 4 * hq;
          const LAS float* pq = (const LAS float*)(lds + RW_PAR) + c0 + 4 * hq; (void)Cq;
          const f32x4 mur = *(const LAS f32x4*)(pq), muk = *(const LAS f32x4*)(pq + 64), muv = *(const LAS f32x4*)(pq + 128);
          const f32x4 w0c = *(const LAS f32x4*)(pq + 192), a0c = *(const LAS f32x4*)(pq + 256), v0c = *(const LAS f32x4*)(pq + 320), kkc = *(const LAS f32x4*)(pq + 384);
          rr[hq] = zr[hq] + (pr[hq] - zr[hq]) * mur; kraw[hq] = zk[hq] + (pk[hq] - zk[hq]) * muk; vraw[hq] = zv[hq] + (pv[hq] - zv[hq]) * muv;
#pragma unroll
          for (int e = 0; e < 4; ++e) { ee[hq][e] = 0.60653066f * sigmoidf_(w0c[e] + dw[hq][e]); av[hq][e] = sigmoidf_(a0c[e] + da[hq][e]); const float kq = kraw[hq][e] * kkc[e]; n2 += kq * kq;
              vv[hq][e] = (l == 1) ? vraw[hq][e] + (vf[hq][e] - vraw[hq][e]) * sigmoidf_(v0c[e] + vm[hq][e]) : vraw[hq][e]; } }
      if (l == 0) *(u32x4*)(vfirst + row * 512 + C0) = pack8(vraw[0], vraw[1]);
      n2 = red8_sum(n2);
      const float inn = 1.0f / fmaxf(sqrtf(n2), 1e-12f); float bq = 0.f;
#pragma unroll
      for (int hq = 0; hq < 2; ++hq) { const LAS float* pq = (const LAS float*)(lds + RW_PAR) + c0 + 4 * hq; const f32x4 kkc = *(const LAS f32x4*)(pq + 384), kac = *(const LAS f32x4*)(pq + 448), rkc = *(const LAS f32x4*)(pq + 512);
#pragma unroll
          for (int e = 0; e < 4; ++e) { const float kkn = kraw[hq][e] * kkc[e] * inn; kk_[hq][e] = kraw[hq][e] * (1.0f + (av[hq][e] - 1.0f) * kac[e]); ap[hq][e] = -kkn; bp[hq][e] = kkn * av[hq][e]; bq += rr[hq][e] * kk_[hq][e] * rkc[e]; } }
      bq = red8_sum(bq);
      if ((lt & 7) == 0) bon[tok] = bq;
      *(LAS f32x4*)(Lc + tok * 68 + c0) = -ee[0]; *(LAS f32x4*)(Lc + tok * 68 + c0 + 4) = -ee[1];
      *(u32x4*)(o + row * 2048 + C0) = pack8(gg[0], gg[1]); }
    __syncthreads();
#pragma unroll
    for (int q = 0; q < 8; ++q) { const int ch = 16 * lw + 2 * q + (lane >> 5), tk = lane & 31; float x = Lc[tk * 68 + ch];
        x = scan32(x);
        Lc[tk * 68 + ch] = x; }
    __syncthreads();
#pragma unroll
    for (int hq = 0; hq < 2; ++hq) { const int cq = c0 + 4 * hq;
      const f32x4 Lt = *(const LAS f32x4*)(Lc + tok * 68 + cq), Ll = *(const LAS f32x4*)(Lc + (RT - 1) * 68 + cq); f32x4 Lp = (f32x4){0.f, 0.f, 0.f, 0.f}; if (tok > 0) Lp = *(const LAS f32x4*)(Lc + (tok - 1) * 68 + cq);
      f32x4 at_, rt_, kh_, bh_;
#pragma unroll
      for (int e = 0; e < 4; ++e) { const float ep = __expf(Lt[e]), em = __expf(-Lt[e]), el = __expf(Ll[e] - Lt[e]); at_[e] = ap[hq][e] * __expf(Lp[e]); rt_[e] = rr[hq][e] * ep; kh_[e] = kk_[hq][e] * em; bh_[e] = bp[hq][e] * em;
          const int tr_ = (cq + e) * P40 + rcol4(tok, cq >> 4);
          KpT[tr_] = (bf16)f2bf(kk_[hq][e] * el); BpT[tr_] = (bf16)f2bf(bp[hq][e] * el); VT[tr_] = (bf16)f2bf(vv[hq][e]); }
      u32x2 w; w.x = pk2(at_[0], at_[1]); w.y = pk2(at_[2], at_[3]); *(LAS u32x2*)(At + tok * P72 + cq) = w; w.x = pk2(rt_[0], rt_[1]); w.y = pk2(rt_[2], rt_[3]); *(LAS u32x2*)(Rt + tok * P72 + cq) = w;
      w.x = pk2(kh_[0], kh_[1]); w.y = pk2(kh_[2], kh_[3]); *(LAS u32x2*)(Kh + tok * P72 + cq) = w; w.x = pk2(bh_[0], bh_[1]); w.y = pk2(bh_[2], bh_[3]); *(LAS u32x2*)(Bh + tok * P72 + cq) = w;
      if (tok == 0) { f32x4 gv;
#pragma unroll
          for (int e = 0; e < 4; ++e) gv[e] = __expf(Ll[e]);
          *(LAS f32x4*)(gam + cq) = gv; } }
    __syncthreads();
    { const int rb = lw; const LAS bf16* Am = (rb < 2) ? At : Rt;
#pragma unroll
      for (int cb = 0; cb < 4; ++cb) { const LAS bf16* Bm_ = (cb < 2) ? Kh : Bh; acc4 gm = (acc4){0.f, 0.f, 0.f, 0.f};
#pragma unroll
          for (int ks = 0; ks < 2; ++ks) gm = MFMA16(frag_nat(Am, P72, 16 * (rb & 1) + fr, 32 * ks, g), frag_nat(Bm_, P72, 16 * (cb & 1) + fr, 32 * ks, g), gm);
          const int sidx = 16 * (cb & 1) + fr;
#pragma unroll
          for (int r = 0; r < 4; ++r) { const int tidx = 16 * (rb & 1) + 4 * g + r;
              if (rb < 2) { const float v = (sidx < tidx) ? gm[r] : 0.f; if (cb < 2) Mak[tidx * P40 + sidx] = (bf16)f2bf(v); else Mab[tidx * 33 + sidx] = v; }
              else { const float v = (sidx <= tidx) ? gm[r] : 0.f; if (cb < 2) Ark[tidx * P40 + sidx] = (bf16)f2bf(v); else Arb[tidx * P40 + sidx] = (bf16)f2bf(v); } } } }
    __syncthreads();
    rwkv_prep_fetch(pf, l, nh, nb, ncpair, z, vfirst, o);
    if (lw != 0) { unsigned char* rec = rw_rec_ptr(ws, h, b, c);
        for (int p = lt - 64; p < RW_NPIECE - 128; p += 192) { const int pp = (p < 1664) ? p : p + 128; *(u32x4*)(rec + 16 * pp) = *(const LAS u32x4*)(img + rw_piece_off(pp)); } }
    else {
        if (lane < 32) { const int blk = lane >> 4, cc = lane & 15; float x[16]; unsigned moff = (unsigned)((16 * blk) * 33 + 16 * blk) * 4u;
#pragma unroll
            for (int t = 0; t < 16; ++t) { float sacc = (t == cc) ? 1.0f : 0.f;
                if (t > 0) asm volatile("" : "+v"(moff) : "v"(x[t - 1]));
                const LAS float* mp = (const LAS float*)((LAS unsigned char*)Mab + moff) + t * 33;
#pragma unroll
                for (int s2 = 0; s2 < t; ++s2) sacc += mp[s2] * x[s2];
                x[t] = sacc; }
#pragma unroll
            for (int t = 0; t < 16; ++t) { if (blk == 0) { T1[t * P40 + cc] = (bf16)f2bf(x[t]); T1[t * P40 + 16 + cc] = 0; T2[t * P40 + cc] = (bf16)f2bf(Mab[(16 + t) * 33 + cc]); } else T2[t * P40 + 16 + cc] = (bf16)f2bf(x[t]); } }
        { unsigned char* rec = rw_rec_ptr(ws, h, b, c);
#pragma unroll
          for (int k = 0; k < 2; ++k) { const int p = 1664 + lane + 64 * k; *(u32x4*)(rec + 16 * p) = *(const LAS u32x4*)(img + rw_piece_off(p)); } }
    }
    __syncthreads();
}

constexpr int RC_IMG0 = 0, RC_IMG1 = ((IM_END + 255) / 256) * 256, RC_STAT = 2 * RC_IMG1, RC_EXY = RC_STAT + 2 * RT * 4 * 8, RC_EXB = RC_EXY + 2 * RT * 68 * 4, RC_DUMMY = RC_EXB + 2 * RT * 68 * 4, RC_END = RC_DUMMY + 256 * 16;
static_assert(RC_END <= NWAVES * 20352, "rwkv chain LDS");
__device__ __forceinline__ void rwkv_chain_task(const ArgsD& a, int l, int bh, LAS unsigned char* lds, bf16* o, unsigned char* ws) {
    const int tid = opq_v((int)threadIdx.x), lane = tid & 63, wid = __builtin_amdgcn_readfirstlane(tid >> 6), fr = lane & 15, g = lane >> 4;
    const int b = bh >> 3, h = bh & 7;
    const int ib = wid & 3;
    const int lt = tid & 255, etok = lt >> 3, ed0 = 8 * (lt & 7);
    f32x4 lnw0 = {0.f, 0.f, 0.f, 0.f}, lnw1 = lnw0, lnb0 = lnw0, lnb1 = lnw0;
    if (wid >= 4) { const float* pw = a.in[I_RW_LNW] + l * 512 + h * 64 + ed0; const float* pb = a.in[I_RW_LNB] + l * 512 + h * 64 + ed0; lnw0 = *(const f32x4*)pw; lnw1 = *(const f32x4*)(pw + 4); lnb0 = *(const f32x4*)pb; lnb1 = *(const f32x4*)(pb + 4); }
    acc4 St[4];
#pragma unroll
    for (int jb = 0; jb < 4; ++jb) St[jb] = (acc4){0.f, 0.f, 0.f, 0.f};
    u32x4 pv[8]; int poff[8];
#pragma unroll
    for (int i = 0; i < 8; ++i) { const int p = tid - 256 + 256 * i; poff[i] = (p >= 0 && p < RW_NPIECE) ? rw_piece_off(p) : RC_DUMMY + 16 * (tid & 255); pv[i] = (u32x4){0u, 0u, 0u, 0u}; }
#define RC_FETCH(rec_) do { _Pragma("unroll") for (int i_ = 0; i_ < 8; ++i_) { const int p_ = tid - 256 + 256 * i_; pv[i_] = *(const u32x4*)((rec_) + 16 * (p_ < RW_NPIECE ? p_ : 0)); } } while (0)
#define RC_PUT(dst_) do { _Pragma("unroll") for (int i_ = 0; i_ < 8; ++i_) { *(LAS u32x4*)(((i_ < 7 || tid < 256 + RW_NPIECE - 7 * 256) ? (dst_) : lds) + poff[i_]) = pv[i_]; } } while (0)
#define RC_EPI(cc_) do { const int pe_ = (cc_) & 1; const LAS f32x2* st_ = (const LAS f32x2*)(lds + RC_STAT) + pe_ * (RT * 4) + etok * 4; \
        const f32x4 sa_ = *(const LAS f32x4*)st_, sb_ = *(const LAS f32x4*)(st_ + 2); \
        const float mean_ = ((sa_[0] + sa_[2]) + (sb_[0] + sb_[2])) * (1.0f / 64.0f), ex2_ = ((sa_[1] + sa_[3]) + (sb_[1] + sb_[3])) * (1.0f / 64.0f); \
        const float rstd_ = rsqrtf(fmaxf(ex2_ - mean_ * mean_, 0.f) + 64e-5f); \
        const LAS float* ey_ = (const LAS float*)(lds + RC_EXY) + pe_ * (RT * 68) + etok * 68 + ed0; const LAS float* eb_ = (const LAS float*)(lds + RC_EXB) + pe_ * (RT * 68) + etok * 68 + ed0; \
        const f32x4 y0_ = *(const LAS f32x4*)ey_, y1_ = *(const LAS f32x4*)(ey_ + 4), b0_ = *(const LAS f32x4*)eb_, b1_ = *(const LAS f32x4*)(eb_ + 4); \
        f32x4 g0_, g1_; unpack8(gq, g0_, g1_); \
        const f32x4 r0_ = (((y0_ - mean_) * rstd_) * lnw0 + lnb0 + b0_) * g0_, r1_ = (((y1_ - mean_) * rstd_) * lnw1 + lnb1 + b1_) * g1_; \
        *(u32x4*)(o + ((size_t)b * SEQ + (cc_) * RT + etok) * 2048 + h * 64 + ed0) = pack8(r0_, r1_); } while (0)
    u32x4 gq = {0u, 0u, 0u, 0u};
    if (wid >= 4) { RC_FETCH(rw_rec_ptr(ws, h, b, 0)); RC_PUT(lds + RC_IMG0); RC_FETCH(rw_rec_ptr(ws, h, b, 1)); }
    __syncthreads();
    for (int c = 0; c < SEQ / RT; ++c) {
        LAS unsigned char* img = lds + ((c & 1) ? RC_IMG1 : RC_IMG0);
        if (wid >= 4) { RC_PUT(lds + ((c & 1) ? RC_IMG0 : RC_IMG1)); const int cf = (c + 2 < SEQ / RT) ? c + 2 : c; RC_FETCH(rw_rec_ptr(ws, h, b, cf));
            if (c > 0) RC_EPI(c - 1);
            gq = *(const u32x4*)(o + ((size_t)b * SEQ + c * RT + etok) * 2048 + h * 64 + ed0); }
        else {
            __builtin_amdgcn_s_setprio(2);
            const int par = c & 1;
            const LAS bf16* At = (const LAS bf16*)(img + IM_AT); const LAS bf16* Rt = (const LAS bf16*)(img + IM_RT); const LAS bf16* KpT = (const LAS bf16*)(img + IM_KPT); const LAS bf16* BpT = (const LAS bf16*)(img + IM_BPT); const LAS bf16* VT = (const LAS bf16*)(img + IM_VT);
            const LAS bf16* Mak = (const LAS bf16*)(img + IM_MAK); const LAS bf16* Ark = (const LAS bf16*)(img + IM_ARK); const LAS bf16* Arb = (const LAS bf16*)(img + IM_ARB); const LAS bf16* T1 = (const LAS bf16*)(img + IM_T1); const LAS bf16* T2 = (const LAS bf16*)(img + IM_T2);
            const LAS float* gam = (const LAS float*)(img + IM_GAM); const LAS float* bon = (const LAS float*)(img + IM_BON);
            acc4 Y0 = (acc4){0.f, 0.f, 0.f, 0.f}, Y1 = Y0;
            const bf16x8 Sb0 = frag_acc(St[0], St[1]), Sb1 = frag_acc(St[2], St[3]); const bf16x8 vtf = *(const LAS bf16x8*)(VT + (16 * ib + fr) * P40 + rcol4(8 * g, ib));
            acc4 X0 = (acc4){0.f, 0.f, 0.f, 0.f}, X1 = X0;
            X0 = MFMA16(frag_perm(At, P72, fr, 0, g), Sb0, X0); X0 = MFMA16(frag_perm(At, P72, fr, 32, g), Sb1, X0); X0 = MFMA16(frag_nat(Mak, P40, fr, 0, g), vtf, X0);
            X1 = MFMA16(frag_perm(At, P72, 16 + fr, 0, g), Sb0, X1); X1 = MFMA16(frag_perm(At, P72, 16 + fr, 32, g), Sb1, X1); X1 = MFMA16(frag_nat(Mak, P40, 16 + fr, 0, g), vtf, X1);
            Y0 = MFMA16(frag_perm(Rt, P72, fr, 0, g), Sb0, Y0); Y0 = MFMA16(frag_perm(Rt, P72, fr, 32, g), Sb1, Y0); Y0 = MFMA16(frag_nat(Ark, P40, fr, 0, g), vtf, Y0);
            Y1 = MFMA16(frag_perm(Rt, P72, 16 + fr, 0, g), Sb0, Y1); Y1 = MFMA16(frag_perm(Rt, P72, 16 + fr, 32, g), Sb1, Y1); Y1 = MFMA16(frag_nat(Ark, P40, 16 + fr, 0, g), vtf, Y1);
            const acc4 zero4 = (acc4){0.f, 0.f, 0.f, 0.f};
            const acc4 U0 = MFMA16(frag_perm(T1, P40, fr, 0, g), frag_acc(X0, zero4), zero4);
            const bf16x8 t2f = frag_perm(T2, P40, fr, 0, g);
            const acc4 W1 = MFMA16(t2f, frag_acc(U0, zero4), X1);
            const acc4 U1 = MFMA16(t2f, frag_acc(zero4, W1), zero4);
            const bf16x8 Ub = frag_acc(U0, U1);
            Y0 = MFMA16(frag_perm(Arb, P40, fr, 0, g), Ub, Y0); Y1 = MFMA16(frag_perm(Arb, P40, 16 + fr, 0, g), Ub, Y1);
#pragma unroll
            for (int jb = 0; jb < 4; ++jb) { const f32x4 gm = *(const LAS f32x4*)(gam + 16 * jb + 4 * g); St[jb] = St[jb] * gm;
                const bf16x8 kpf = *(const LAS bf16x8*)(KpT + (16 * jb + fr) * P40 + rcol4(8 * g, jb));
                const LAS bf16* bpp = BpT + (16 * jb + fr) * P40; const u32x2 bv0 = *(const LAS u32x2*)(bpp + rcol4(4 * g, jb)), bv1 = *(const LAS u32x2*)(bpp + rcol4(4 * g + 16, jb)); u32x4 bw; bw.x = bv0.x; bw.y = bv0.y; bw.z = bv1.x; bw.w = bv1.y;
                St[jb] = MFMA16(kpf, vtf, St[jb]); St[jb] = MFMA16(__builtin_bit_cast(bf16x8, bw), Ub, St[jb]); }
            LAS f32x2* stat = (LAS f32x2*)(lds + RC_STAT) + par * (RT * 4);
            LAS float* ey = (LAS float*)(lds + RC_EXY) + par * (RT * 68) + 16 * ib + fr; LAS float* eb = (LAS float*)(lds + RC_EXB) + par * (RT * 68) + 16 * ib + fr;
#pragma unroll
            for (int hb = 0; hb < 2; ++hb) { const u32x2 vw = *(const LAS u32x2*)(VT + (16 * ib + fr) * P40 + rcol4(16 * hb + 4 * g, ib)); const f32x4 vv = (f32x4){lo2f(vw.x), hi2f(vw.x), lo2f(vw.y), hi2f(vw.y)};
#pragma unroll
                for (int r = 0; r < 4; ++r) { const int t = 16 * hb + 4 * g + r; const float y = hb ? Y1[r] : Y0[r]; ey[t * 68] = y; eb[t * 68] = bon[t] * vv[r]; } }
#pragma unroll
            for (int r = 0; r < 4; ++r) { float s0 = Y0[r], q0 = Y0[r] * Y0[r], s1 = Y1[r], q1 = Y1[r] * Y1[r];
                s0 = red16_sum(s0); q0 = red16_sum(q0); s1 = red16_sum(s1); q1 = red16_sum(q1);
                if (fr == 0) { stat[(4 * g + r) * 4 + ib] = (f32x2){s0, q0}; stat[(16 + 4 * g + r) * 4 + ib] = (f32x2){s1, q1}; } }
            __builtin_amdgcn_s_setprio(0);
        }
        __syncthreads();
    }
    if (wid >= 4) RC_EPI(SEQ / RT - 1);
    __syncthreads();
#undef RC_FETCH
#undef RC_PUT
#undef RC_EPI
}

#define XB_TMO      128
#define XB_XCNT(j)  (256  + 64 * (j))
#define XB_XSUB(j)  (1280 + 64 * (j))
#define XB_XGEN(j)  (2304 + 64 * (j))
#define XB_TOP      3328
#define XB_TOPGEN   3392
#define XCD_BAR_WORDS 3456
#define XB_SPIN_CAP (1u << 20)
__device__ __forceinline__ unsigned xb_ld(unsigned* p)              { return __hip_atomic_load(p, __ATOMIC_RELAXED, __HIP_MEMORY_SCOPE_AGENT); }
__device__ __forceinline__ unsigned xb_add(unsigned* p, unsigned v) { return __hip_atomic_fetch_add(p, v, __ATOMIC_RELAXED, __HIP_MEMORY_SCOPE_AGENT); }
__device__ __forceinline__ unsigned xb_xcc_id() { return (unsigned)__builtin_amdgcn_s_getreg((3 << 11) | 20) & 0xFu; }
#define XB_SPIN(cond, bar) do { unsigned _sp = 0; while (cond) { __builtin_amdgcn_s_sleep(1); \
    if ((++_sp & 255u) == 0u) { if (xb_ld(&(bar)[XB_TMO])) break; if (_sp > XB_SPIN_CAP) { atomicAdd(&(bar)[XB_TMO], 1u); break; } } } } while (0)
__device__ __forceinline__ void xcd_barrier_complete(unsigned* bar, unsigned x, unsigned& nloc, unsigned& nx) {
    const unsigned G = gridDim.x * gridDim.y * gridDim.z;
    unsigned sum, cnt, mine, sp = 0u;
    for (;;) {
        sum = 0u; cnt = 0u; mine = 0u;
#pragma unroll
        for (unsigned j = 0; j < 16; ++j) { const unsigned c = xb_ld(&bar[XB_XCNT(j)]); sum += c; cnt += (c > 0u) ? 1u : 0u; mine = (j == x) ? c : mine; }
        if (sum == G) break;
        __builtin_amdgcn_s_sleep(1);
        if ((++sp & 255u) == 0u) { if (xb_ld(&bar[XB_TMO])) break; if (sp > XB_SPIN_CAP) { atomicAdd(&bar[XB_TMO], 1u); break; } }
    }
    nloc = mine > 0u ? mine : 1u; nx = cnt > 0u ? cnt : 1u;
}
__device__ __forceinline__ void xcd_barrier(unsigned* bar, volatile LAS unsigned* st) {
    asm volatile("s_waitcnt vmcnt(0)" ::: "memory");
    __syncthreads();
    if (threadIdx.x == 0) {
        __builtin_amdgcn_s_waitcnt(0);
        unsigned nloc = st[0], nx = st[1]; const unsigned x = st[2];
        if (nloc == 0u) { xcd_barrier_complete(bar, x, nloc, nx); st[0] = nloc; st[1] = nx; }
        const unsigned old = xb_add(&bar[XB_XSUB(x)], 1u);
        const unsigned gen = old / nloc;
        if (old + 1u == (gen + 1u) * nloc) {
            __builtin_amdgcn_fence(__ATOMIC_RELEASE, "agent");
            asm volatile("s_waitcnt vmcnt(0)" ::: "memory");
            const unsigned og = xb_add(&bar[XB_TOP], 1u);
            const unsigned tg = og / nx;
            if (og + 1u == (tg + 1u) * nx) {
#pragma unroll
                for (unsigned j = 0; j < 16; ++j) xb_add(&bar[XB_XGEN(j)], 1u);
            }
        }
        XB_SPIN(xb_ld(&bar[XB_XGEN(x)]) == gen, bar);
        __builtin_amdgcn_fence(__ATOMIC_ACQUIRE, "agent");
        asm volatile("s_waitcnt vmcnt(0)" ::: "memory");
    }
    __syncthreads();
}

constexpr int LDS_WSCR = 20352;
constexpr int LDS_TOTAL = NWAVES * LDS_WSCR + 1024;
static_assert(LDS_TOTAL <= 163840 && NWAVES * LDS_WSCR >= LDS_MAIN, "LDS map");
constexpr int NPH = 22;
#ifndef MIXMASK
#define MIXMASK 15
#endif
#define MIX_T(bit, call) do { if ((MIXMASK) & (bit)) { call; } } while (0)

#define PHASE_PTRS \
    const int tid = opq_v((int)threadIdx.x), lane = tid & 63, wid = __builtin_amdgcn_readfirstlane(tid >> 6); (void)lane; (void)wid; \
    const int G = opq_s((int)gridDim.x), bx = opq_s((int)blockIdx.x); const int gw = bx * NWAVES + wid, ngw = G * NWAVES; (void)gw; (void)ngw; \
    LAS unsigned char* lds = (LAS unsigned char*)lds_raw; LAS unsigned* lctl = (LAS unsigned*)(lds + NWAVES * LDS_WSCR); (void)lctl; \
    ArgsD a; a.in.tab = (LAS unsigned long long*)(lds + NWAVES * LDS_WSCR + 640); \
    unsigned char* ws = a.ws(); float* a_out = a.out(); (void)a_out; \
    unsigned* ctl = (unsigned*)(ws + WS_CTL); (void)ctl; \
    float* ssb = (float*)(ws + WS_SMALL + SM_SS); (void)ssb; \
    float* mssq = (float*)(ws + WS_SMALL + SM_MSSQ); (void)mssq; \
    int* tok_e = (int*)(ws + WS_SMALL + SM_TOKE); float* tok_g = (float*)(ws + WS_SMALL + SM_TOKG); float* tok_rs = (float*)(ws + WS_SMALL + SM_TOKRS); (void)tok_e; (void)tok_g; (void)tok_rs; \
    int* tok_slot = (int*)(ws + WS_SMALL + SM_TOKSLOT); int* row_tok = (int*)(ws + WS_SMALL + SM_ROWTOK); float* row_gate = (float*)(ws + WS_SMALL + SM_ROWGATE); float* row_rs = (float*)(ws + WS_SMALL + SM_ROWRS); (void)tok_slot; (void)row_tok; (void)row_gate; (void)row_rs; \
    bf16* xb = (bf16*)(ws + WS_XB); (void)xb; \
    bf16* vfirst = (bf16*)(ws + WS_X + X_VFIRST); bf16* mixed = (bf16*)(ws + WS_X + X_MIXED); bf16* obuf = (bf16*)(ws + WS_X + X_O); (void)vfirst; (void)mixed; (void)obuf; \
    unsigned char* wreg = ws + WS_X + X_W; (void)wreg; \
    bf16* zbuf = (bf16*)(ws + WS_Z); bf16* gates = zbuf; bf16* hidden = zbuf; bf16* act = zbuf; (void)gates; (void)hidden; (void)act; \
    bf16* xg = (bf16*)(ws + WS_XG); bf16* ybuf = xg; bf16* rwarr = xg; (void)ybuf; (void)rwarr; bf16* ypart = (bf16*)(ws + WS_Z + (size_t)128 * MiB); (void)ypart; bf16* bcv = (bf16*)(ws + WS_BCV); (void)bcv; float* gend = (float*)(ws + WS_GEND); (void)gend; \
    bf16* moe_w13 = (bf16*)(ws + WS_X + MOE_W13); bf16* moe_w2 = (bf16*)(ws + WS_X + MOE_W2); (void)moe_w13; (void)moe_w2;

#define IDLE_CVT_BEGIN(nwg_) { const int p0_ = (nwg_) % G; if (bx >= p0_) { CvtCtx cx; cx.gw = (bx - p0_) * NWAVES + wid; cx.ngw = (G - p0_) * NWAVES; cx.base = 0; cx.lane = lane; cx.scr = (LAS float*)(lds + wid * LDS_WSCR); \
        const int zt_ = (bx - p0_) * NTHREADS + tid, zn_ = (G - p0_) * NTHREADS; (void)zt_; (void)zn_;
#define IDLE_CVT_END } }
#define CVT_LAYER_REST(l_) do { const float* win_ = a.in[I_WIN] + (size_t)(l_) * DM * IN_COLS; const float* nm_ = a.in[I_NORM_MIX] + (l_) * DM; \
        cvt_job_gates(cx, win_, IN_COLS, DM, MIXC, nm_, (bf16*)(wreg + W_G) + (size_t)(l_) * 4096 * DM); \
        for (int i_ = 0; i_ < 4; ++i_) cvt_job(cx, a.in[I_WBRANCH] + ((size_t)(l_) * 4 + i_) * 512 * DM, DM, 512, 0, DM, nullptr, (bf16*)(wreg + W_B) + ((size_t)(l_) * 4 + i_) * DM * 512, 0, 128); \
        cvt_job(cx, a.in[I_WOUT] + (size_t)(l_) * DM * DM, DM, DM, 0, DM, nullptr, (bf16*)(wreg + W_O) + (size_t)(l_) * DM * DM, 0, 128); } while (0)
template <int LO, int HI>
__device__ __forceinline__ void mk_body(const Args& ka) {
    extern __shared__ __attribute__((aligned(16))) unsigned char lds_raw[];
    { LAS unsigned long long* ptab = (LAS unsigned long long*)((LAS unsigned char*)lds_raw + NWAVES * LDS_WSCR + 640);
      const int t0 = threadIdx.x;
      if (t0 < N_IN) ptab[t0] = (unsigned long long)ka.in[t0];
      if (t0 == N_IN) ptab[t0] = (unsigned long long)ka.out;
      if (t0 == N_IN + 1) ptab[t0] = (unsigned long long)ka.ws;
#if !MK_PER_PHASE
      if (t0 == 64) { LAS unsigned* st = (LAS unsigned*)((LAS unsigned char*)lds_raw + NWAVES * LDS_WSCR + 992); st[0] = 0u; st[1] = 0u; const unsigned x = xb_xcc_id(); st[2] = x;
          (void)xb_add((unsigned*)(ka.ws + WS_CTL) + CW_BAR + XB_XCNT(x), 1u); }
#endif
      __syncthreads(); }
#if MK_PER_PHASE
#define GRID_BAR() do { } while (0)
#else
#define GRID_BAR() do { unsigned char* ws_ = ArgsD{PT{(LAS unsigned long long*)((LAS unsigned char*)lds_raw + NWAVES * LDS_WSCR + 640)}}.ws(); \
    xcd_barrier((unsigned*)(ws_ + WS_CTL) + CW_BAR, (volatile LAS unsigned*)((LAS unsigned char*)lds_raw + NWAVES * LDS_WSCR + 992)); } while (0)
#endif
#define IN(k) (LO <= (k) && (k) < HI)
#if MK_PER_PHASE
#define SPLIT_ARRIVE(w) do { } while (0)
#define SPLIT_WAIT(w) do { } while (0)
#else
#define SPLIT_ARRIVE(w) do { asm volatile("s_waitcnt vmcnt(0)" ::: "memory"); __syncthreads(); if (threadIdx.x == 0) { unsigned* c_ = (unsigned*)(ArgsD{PT{(LAS unsigned long long*)((LAS unsigned char*)lds_raw + NWAVES * LDS_WSCR + 640)}}.ws() + WS_CTL); \
        __builtin_amdgcn_fence(__ATOMIC_RELEASE, "agent"); asm volatile("s_waitcnt vmcnt(0)" ::: "memory"); xb_add(c_ + CW_SPLIT + 64 * (w), 1u); } } while (0)
#define SPLIT_WAIT(w) do { if (threadIdx.x == 0) { unsigned* c_ = (unsigned*)(ArgsD{PT{(LAS unsigned long long*)((LAS unsigned char*)lds_raw + NWAVES * LDS_WSCR + 640)}}.ws() + WS_CTL); \
        XB_SPIN(xb_ld(c_ + CW_SPLIT + 64 * (w)) < gridDim.x, c_ + CW_BAR); __builtin_amdgcn_fence(__ATOMIC_ACQUIRE, "agent"); asm volatile("s_waitcnt vmcnt(0)" ::: "memory"); } __syncthreads(); } while (0)
#endif
#define SEAM(k) do { if (IN(k) && IN((k) + 1)) GRID_BAR(); } while (0)

    if (IN(0)) { PHASE_PTRS
        CvtCtx cx; cx.gw = gw; cx.ngw = ngw; cx.base = 0; cx.lane = lane; cx.scr = (LAS float*)(lds + wid * LDS_WSCR);
        { const float* win = a.in[I_WIN]; const float* nm = a.in[I_NORM_MIX]; bf16* winT = (bf16*)(wreg + W_IN);
          cvt_job(cx, win, IN_COLS, DM, 0, MIXC, nm, winT, 0, 128);
          zero_rows_bf16(bx * NTHREADS + tid, G * NTHREADS, winT + (size_t)C_HV * DM, (size_t)(ZC - C_HV) * DM); }
        const float* x = a.in[I_X];
        { f32x4 nv[4];
          { const int m0 = gw < T ? gw : 0; const f32x4* xr = (const f32x4*)(x + (size_t)m0 * DM) + lane;
#pragma unroll
            for (int j = 0; j < 4; ++j) nv[j] = __builtin_nontemporal_load(xr + 64 * j); }
          for (int m = gw; m < T; m += ngw) { f32x4 v[4]; float s = 0.f;
#pragma unroll
              for (int j = 0; j < 4; ++j) v[j] = nv[j];
              { const int mn = (m + ngw < T) ? m + ngw : m; const f32x4* xr = (const f32x4*)(x + (size_t)mn * DM) + lane;
#pragma unroll
                for (int j = 0; j < 4; ++j) nv[j] = __builtin_nontemporal_load(xr + 64 * j); }
#pragma unroll
              for (int j = 0; j < 4; ++j) { s += (v[j][0] * v[j][0] + v[j][1] * v[j][1]) + (v[j][2] * v[j][2] + v[j][3] * v[j][3]); u32x2 w; w.x = pk2(v[j][0], v[j][1]); w.y = pk2(v[j][2], v[j][3]); *((u32x2*)(xb + (size_t)m * DM) + lane + 64 * j) = w; }
              s = wave_sum(s); if (lane < 16) ssb[(size_t)m * 16 + lane] = (lane == 0) ? s : 0.f; } }
    }
#if MK_PER_PHASE
    SEAM(0);
#else
    if (IN(0) && IN(1)) { if (ka.ws == nullptr) cg::this_grid().sync();
                          GRID_BAR(); }
#endif

#pragma unroll
    for (int l = 0; l < 2; ++l) {
        const int pb = 1 + 9 * l;
#define ss_mix (ssb + (size_t)(l == 0 ? 0 : 2) * T * 16)
#define ss_ffn (l == 0 ? ssb + (size_t)T * 16 : (float*)nullptr)
        if (IN(pb + 0)) { PHASE_PTRS
            pg8::Gemm g{DM, DM, DM}; pg8::StaticOrder S; S.init(xb, (bf16*)(wreg + W_IN) + (size_t)l * ZC * DM, DM, DM, T, ZC, G, bx);
            EpiScaleBf16<0> E{zbuf, ZC, ss_mix};
            pg8::gemm_phase(lds, g, S, E);
            IDLE_CVT_BEGIN((T / 256) * (ZC / 256))
                CVT_LAYER_REST(l);
                if (l == 1) { for (int e = MD_EARLY; e < MD_EARLY2; ++e)
                    cvt_job8(cx, a.in[I_MOE_W2] + (size_t)e * EDIM * DM, DM, EDIM, 0, DM, nullptr, 64.0f, wreg + W_13 + (size_t)(e - MD_EARLY) * DM * EDIM, 0, 128); }
                if (l == 0) {
#if FFN_FP8
                    cvt_job8(cx, a.in[I_FFN_W1], FFN, DM, 0, FFN, a.in[I_NORM_FFN], 32.0f, wreg + W_13, 0, 256);
                    cvt_job8(cx, a.in[I_FFN_W3], FFN, DM, 0, FFN, a.in[I_NORM_FFN], 32.0f, wreg + W_13, 128, 256);
                    cvt_job8(cx, a.in[I_FFN_W2], DM, FFN, 0, DM, nullptr, 64.0f, wreg + W_2, 0, 128);
#else
                    cvt_job(cx, a.in[I_FFN_W1], FFN, DM, 0, FFN, a.in[I_NORM_FFN], (bf16*)(wreg + W_13), 0, 256);
                    cvt_job(cx, a.in[I_FFN_W3], FFN, DM, 0, FFN, a.in[I_NORM_FFN], (bf16*)(wreg + W_13), 128, 256);
#endif
                }
            IDLE_CVT_END
        }
        SEAM(pb + 0);
        if (IN(pb + 1)) { PHASE_PTRS
            rwkv_xlr_prepass(a, l, bx, G, zbuf, obuf);
            if (IN(pb + 2)) SPLIT_ARRIVE(2 + l);
            mamba_bc_prepass(a, l, gw, ngw, lane, zbuf, bcv);
            gla_prepass(a, l, bx, G, lds, zbuf, gend);
        }
        if (IN(pb + 1) && IN(pb + 2)) SPLIT_WAIT(2 + l);
        if (IN(pb + 2)) { PHASE_PTRS
            const int npair = 8 * BATCH * (SEQ / RT) / 2, ppb = (npair + G - 1) / G; int wts_h = -1;
            const int u0 = bx * ppb, u1 = ((bx + 1) * ppb < npair) ? (bx + 1) * ppb : npair;
            if (u0 < u1) { PrepPf pf; rwkv_prep_fetch(pf, l, u0 >> 8, (u0 >> 5) & 7, 2 * (u0 & 31), zbuf, vfirst, obuf);
                for (int u = u0; u < u1; ++u) { const int un = (u + 1 < u1) ? u + 1 : u;
                    rwkv_prep_pair(a, l, u >> 8, (u >> 5) & 7, 2 * (u & 31), un >> 8, (un >> 5) & 7, 2 * (un & 31), pf, wts_h, lds, zbuf, vfirst, obuf, ws); } } }
        SEAM(pb + 2);
        if (IN(pb + 3)) { PHASE_PTRS
            if (bx < 64) { MIX_T(1, rwkv_chain_task(a, l, bx, lds, obuf, ws)); }
            else if (bx < 128) { MIX_T(2, mamba_block_task(a, l, bx - 64, lds, zbuf, bcv, obuf, mssq)); }
            else if (bx < 160) { MIX_T(4, gla_block_task(a, l, bx - 128, lds, zbuf, gend, obuf)); }
            MIX_T(8, attn_drain(a, l, lds, lctl, ctl + CW_ATTQ + l, zbuf, obuf));
            if (l == 0 && (bx < 64 || bx >= 128)) {
                const int pi_ = bx < 64 ? bx : bx - 64;
                CvtCtx cx; cx.gw = pi_ * NWAVES + wid; cx.ngw = (G - 64) * NWAVES; cx.base = 0; cx.lane = lane; cx.scr = (LAS float*)(lds + wid * LDS_WSCR);
                for (int e = 0; e < MD_EARLY; ++e) cvt_job8(cx, a.in[I_MOE_W2] + (size_t)e * EDIM * DM, DM, EDIM, 0, DM, nullptr, 64.0f, wreg + W_IN + (size_t)e * DM * EDIM, 0, 128);
#if !FFN_FP8
                cvt_job(cx, a.in[I_FFN_W2], DM, FFN, 0, DM, nullptr, (bf16*)(wreg + W_2), 0, 128);
#endif
            }
            if (l == 1 && (bx < 64 || bx >= 128)) {
                const float* nf_ = a.in[I_NORM_FFN] + DM; const int pi_ = bx < 64 ? bx : bx - 64;
                CvtCtx cx; cx.gw = pi_ * NWAVES + wid; cx.ngw = (G - 64) * NWAVES; cx.base = 0; cx.lane = lane; cx.scr = (LAS float*)(lds + wid * LDS_WSCR);
                for (int e = 0; e < 2; ++e) { unsigned char* w13_8 = (unsigned char*)moe_w13 + (size_t)e * 2 * EDIM * DM;
                    cvt_job8(cx, a.in[I_MOE_W1] + (size_t)e * DM * EDIM, EDIM, DM, 0, EDIM, nf_, 32.0f, w13_8, 0, 256); cvt_job8(cx, a.in[I_MOE_W3] + (size_t)e * DM * EDIM, EDIM, DM, 0, EDIM, nf_, 32.0f, w13_8, 128, 256); } }
        }
        SEAM(pb + 3);
        if (IN(pb + 4)) { PHASE_PTRS
            const float* nw = a.in[I_SSM_NORMW] + l * 512;
            { const f32x4 n0 = *(const f32x4*)(nw + lane * 8), n1 = *(const f32x4*)(nw + lane * 8 + 4); const int gq = lane >> 5;
              for (int m0 = gw; m0 < T; m0 += 8 * ngw) {
                  u32x4 w[8]; f32x4 qv[8];
#pragma unroll
                  for (int i = 0; i < 8; ++i) { const int m = (m0 + i * ngw < T) ? m0 + i * ngw : m0; w[i] = *(const u32x4*)(obuf + (size_t)m * 2048 + 512 + lane * 8); qv[i] = *(const f32x4*)(mssq + (size_t)m * 8 + gq * 4); }
#pragma unroll
                  for (int i = 0; i < 8; ++i) { const int m = m0 + i * ngw; if (m < T) { const float sc = rsqrtf(((qv[i][0] + qv[i][1]) + (qv[i][2] + qv[i][3])) * (1.0f / 256.0f) + NORM_EPS);
                      f32x4 v0, v1; unpack8(w[i], v0, v1); *(u32x4*)(obuf + (size_t)m * 2048 + 512 + lane * 8) = pack8(v0 * n0 * sc, v1 * n1 * sc); } } } }
            pg8::Gemm g{DM, DM, DM}; pg8::StaticOrder S; S.init(xb, (bf16*)(wreg + W_G) + (size_t)l * 4096 * DM, DM, DM, T, 4096, G, bx);
            EpiGateRatio E{gates, ss_mix};
            pg8::gemm_phase(lds, g, S, E);
        }
        SEAM(pb + 4);
        if (IN(pb + 5)) { PHASE_PTRS
            pg8::Gemm g{2048, 512, 512}; MixOrder S{(const char*)obuf, (const char*)((bf16*)(wreg + W_B) + (size_t)l * 4 * DM * 512), G, bx};
            EpiMix E{gates, mixed};
            pg8::gemm_phase(lds, g, S, E);
        }
        SEAM(pb + 5);
        if (IN(pb + 6)) { PHASE_PTRS
            pg8::Gemm g{DM, DM, DM}; pg8::StaticOrder S; S.init(mixed, (bf16*)(wreg + W_O) + (size_t)l * DM * DM, DM, DM, T, DM, G, bx);
            EpiResid<false> E{l == 0 ? a.in[I_X] : a_out, a_out, xb, ss_ffn, (FFN_FP8 && l == 0) ? (unsigned char*)xg : (unsigned char*)nullptr};
            pg8::gemm_phase(lds, g, S, E);
        }
        if (l == 0) SEAM(pb + 6); else if (IN(pb + 6) && IN(pb + 7)) SPLIT_ARRIVE(0);
        if (l == 0) {
            if (IN(pb + 7)) { PHASE_PTRS
#if FFN_FP8
                pg8::Gemm g{DM / 2, DM / 2, DM / 2}; pg8::StaticOrder S; S.init(xg, (bf16*)(wreg + W_13), DM / 2, DM / 2, T, 2 * FFN, G, bx);
                EpiSwiglu<false, true> E{hidden, FFN, ss_ffn};
#else
                pg8::Gemm g{DM, DM, DM}; pg8::StaticOrder S; S.init(xb, (bf16*)(wreg + W_13), DM, DM, T, 2 * FFN, G, bx);
                EpiSwiglu<false, false> E{hidden, FFN, ss_ffn};
#endif
                pg8::gemm_phase(lds, g, S, E);
                IDLE_CVT_BEGIN((T / 256) * (2 * FFN / 256))
                    const float* win = a.in[I_WIN] + (size_t)DM * IN_COLS; const float* nm = a.in[I_NORM_MIX] + DM; bf16* winT = (bf16*)(wreg + W_IN) + (size_t)ZC * DM;
                    cvt_job(cx, win, IN_COLS, DM, 0, MIXC, nm, winT, 0, 128);
                    cvt_job(cx, a.in[I_VRES_DOWN], 32, DM, 0, 32, nm, winT, C_HV, 128);
                    zero_rows_bf16(zt_, zn_, winT + (size_t)(C_HV + 32) * DM, (size_t)(ZC - C_HV - 32) * DM);
                    cvt_job8(cx, a.in[I_MOE_W2] + (size_t)MD_EARLY2 * EDIM * DM, DM, EDIM, 0, DM, nullptr, 64.0f, wreg + W_G, 0, 128);
                IDLE_CVT_END
            }
            SEAM(pb + 7);
            if (IN(pb + 8)) { PHASE_PTRS
#if FFN_FP8
                pg8::Gemm g{FFN / 2, FFN / 2, FFN / 2}; pg8::StaticOrder S; S.init(hidden, (bf16*)(wreg + W_2), FFN / 2, FFN / 2, T, DM, G, bx);
                EpiResid<true> E{a_out, a_out, xb, ssb + (size_t)2 * T * 16, nullptr};
#else
                pg8::Gemm g{FFN, FFN, FFN}; pg8::StaticOrder S; S.init(hidden, (bf16*)(wreg + W_2), FFN, FFN, T, DM, G, bx);
                EpiResid<false> E{a_out, a_out, xb, ssb + (size_t)2 * T * 16, nullptr};
#endif
                pg8::gemm_phase(lds, g, S, E);
            }
            SEAM(pb + 8);
        }
    }
    if (IN(17)) { PHASE_PTRS
        if (tid < 8) lctl[tid] = 0u;
        __syncthreads();
        const float* nf_ = a.in[I_NORM_FFN] + DM;
        CvtCtx cx; cx.gw = gw; cx.ngw = ngw; cx.base = 0; cx.lane = lane; cx.scr = (LAS float*)(lds + wid * LDS_WSCR);
#define MOE_CVT13(e_) do { unsigned char* w13_8 = (unsigned char*)moe_w13 + (size_t)(e_) * 2 * EDIM * DM; \
            cvt_job8(cx, a.in[I_MOE_W1] + (size_t)(e_) * DM * EDIM, EDIM, DM, 0, EDIM, nf_, 32.0f, w13_8, 0, 256); cvt_job8(cx, a.in[I_MOE_W3] + (size_t)(e_) * DM * EDIM, EDIM, DM, 0, EDIM, nf_, 32.0f, w13_8, 128, 256); } while (0)
        for (int e = MD_EARLY3; e < NEXP; ++e) { unsigned char* w2_8 = (unsigned char*)moe_w13 + (size_t)NEXP * 2 * EDIM * DM + (size_t)e * DM * EDIM;
            cvt_job8(cx, a.in[I_MOE_W2] + (size_t)e * EDIM * DM, DM, EDIM, 0, DM, nullptr, 64.0f, w2_8, 0, 128); }
        if (IN(16)) SPLIT_WAIT(0);
        const float* nf = a.in[I_NORM_FFN] + DM; const float* wr = a.in[I_MOE_ROUTER];
        f32x4 nv[4];
        { const int m0 = gw < T ? gw : 0; const f32x4* xr = (const f32x4*)(a_out + (size_t)m0 * DM) + lane;
#pragma unroll
          for (int j = 0; j < 4; ++j) nv[j] = xr[64 * j]; }
        for (int m = gw; m < T; m += ngw) { f32x4 v[4]; float s = 0.f;
#pragma unroll
            for (int j = 0; j < 4; ++j) { v[j] = nv[j]; s += (v[j][0] * v[j][0] + v[j][1] * v[j][1]) + (v[j][2] * v[j][2] + v[j][3] * v[j][3]); }
            { const int mn = (m + ngw < T) ? m + ngw : m; const f32x4* xr = (const f32x4*)(a_out + (size_t)mn * DM) + lane;
#pragma unroll
              for (int j = 0; j < 4; ++j) nv[j] = xr[64 * j]; }
            const float rs = rsqrtf(wave_sum(s) * (1.0f / DM) + NORM_EPS);
            float lg[8];
#pragma unroll
            for (int e = 0; e < 8; ++e) lg[e] = 0.f;
#pragma unroll
            for (int j = 0; j < 4; ++j) { const int k0 = 4 * (lane + 64 * j); const f32x4 gn = *(const f32x4*)(nf + k0);
#pragma unroll
                for (int q = 0; q < 4; ++q) { const float hf = v[j][q] * rs * gn[q]; const f32x4 w0 = *(const f32x4*)(wr + (size_t)(k0 + q) * 8), w1 = *(const f32x4*)(wr + (size_t)(k0 + q) * 8 + 4);
                    lg[0] += hf * w0[0]; lg[1] += hf * w0[1]; lg[2] += hf * w0[2]; lg[3] += hf * w0[3]; lg[4] += hf * w1[0]; lg[5] += hf * w1[1]; lg[6] += hf * w1[2]; lg[7] += hf * w1[3]; } }
#pragma unroll
            for (int e = 0; e < 8; ++e) lg[e] = wave_sum(lg[e]);
            int e0 = 0; float v0 = lg[0];
#pragma unroll
            for (int e = 1; e < 8; ++e) if (lg[e] > v0) { v0 = lg[e]; e0 = e; }
            int e1 = -1; float v1 = -3.0e38f;
#pragma unroll
            for (int e = 0; e < 8; ++e) if (e != e0 && lg[e] > v1) { v1 = lg[e]; e1 = e; }
            if (e1 < 0) { e1 = (e0 == 0) ? 1 : 0; v1 = v0; }
            const float g0 = 1.0f / (1.0f + __expf(v1 - v0));
            if (lane == 0) { tok_e[2 * m] = e0; tok_e[2 * m + 1] = e1; tok_g[2 * m] = g0; tok_g[2 * m + 1] = 1.0f - g0; tok_rs[m] = rs;
                __hip_atomic_fetch_add(lctl + e0, 1u, __ATOMIC_RELAXED, __HIP_MEMORY_SCOPE_WORKGROUP); __hip_atomic_fetch_add(lctl + e1, 1u, __ATOMIC_RELAXED, __HIP_MEMORY_SCOPE_WORKGROUP); } }
        __syncthreads();
        if (tid < 8) atomicAdd(ctl + CW_MOECNT + tid, lctl[tid]);
        if (IN(18)) SPLIT_ARRIVE(1);
        for (int e = 2; e < NEXP; ++e) MOE_CVT13(e);
#undef MOE_CVT13
    }
    if (IN(17) && IN(18)) SPLIT_WAIT(1);

    if (IN(18)) { PHASE_PTRS
        unsigned cnt[8]; int base[8];
        { int acc = 0;
#pragma unroll
          for (int e = 0; e < 8; ++e) { cnt[e] = (unsigned)__builtin_amdgcn_readfirstlane((int)__hip_atomic_load(ctl + CW_MOECNT + e, __ATOMIC_RELAXED, __HIP_MEMORY_SCOPE_AGENT)); base[e] = acc; acc += (int)((cnt[e] + 255u) & ~255u); } }
        LAS unsigned* lcnt = lctl; LAS int* lstart = (LAS int*)(lctl + 8); LAS int* pslot = (LAS int*)(lctl + 16);
        for (int tgp = bx; tgp < T / 64; tgp += G) {
            if (tid < 8) lcnt[tid] = 0u;
            __syncthreads();
            int e0 = 0, e1 = 0, r0 = 0, r1 = 0; const int tok = tgp * 64 + tid;
            if (tid < 64) { e0 = tok_e[2 * tok]; e1 = tok_e[2 * tok + 1]; r0 = (int)__hip_atomic_fetch_add(lcnt + e0, 1u, __ATOMIC_RELAXED, __HIP_MEMORY_SCOPE_WORKGROUP); r1 = (int)__hip_atomic_fetch_add(lcnt + e1, 1u, __ATOMIC_RELAXED, __HIP_MEMORY_SCOPE_WORKGROUP); }
            __syncthreads();
            if (tid < 8) { int bsel = 0;
#pragma unroll
                for (int e = 0; e < 8; ++e) bsel = (tid == e) ? base[e] : bsel;
                lstart[tid] = bsel + (int)atomicAdd(ctl + CW_MOECUR + tid, lcnt[tid]); }
            __syncthreads();
            if (tid < 64) { const int s0 = lstart[e0] + r0, s1 = lstart[e1] + r1; pslot[2 * tid] = s0; pslot[2 * tid + 1] = s1;
                { int enc0 = s0, enc1 = s1;
#pragma unroll
                  for (int e = 0; e < 8; ++e) { const int fullr = (int)(cnt[e] & ~255u); int pi = 0;
#pragma unroll
                      for (int q = 0; q < 8; ++q) pi += (q < e && (cnt[q] & 255u)) ? 1 : 0;
                      if (e0 == e && s0 - base[e] >= fullr) enc0 = -(1 + pi * 256 + (s0 - base[e] - fullr));
                      if (e1 == e && s1 - base[e] >= fullr) enc1 = -(1 + pi * 256 + (s1 - base[e] - fullr)); }
                  tok_slot[2 * tok] = enc0; tok_slot[2 * tok + 1] = enc1; }
                const float rs = tok_rs[tok];
                row_tok[s0] = tok; row_tok[s1] = tok; row_gate[s0] = tok_g[2 * tok]; row_gate[s1] = tok_g[2 * tok + 1]; row_rs[s0] = rs; row_rs[s1] = rs; }
            __syncthreads();
            { u32x4 sv[8][2];
#pragma unroll
              for (int q = 0; q < 8; ++q) { const u32x4* src = (const u32x4*)(xb + (size_t)(tgp * 64 + wid * 8 + q) * DM) + 2 * lane; sv[q][0] = src[0]; sv[q][1] = src[1]; }
#pragma unroll
              for (int q = 0; q < 8; ++q) { const int tl = wid * 8 + q;
                f32x4 v0, v1, v2, v3; unpack8(sv[q][0], v0, v1); unpack8(sv[q][1], v2, v3); u32x4 w8; int t;
                t = 0; t = __builtin_amdgcn_cvt_pk_fp8_f32(v0[0], v0[1], t, false); t = __builtin_amdgcn_cvt_pk_fp8_f32(v0[2], v0[3], t, true); w8.x = (unsigned)t;
                t = 0; t = __builtin_amdgcn_cvt_pk_fp8_f32(v1[0], v1[1], t, false); t = __builtin_amdgcn_cvt_pk_fp8_f32(v1[2], v1[3], t, true); w8.y = (unsigned)t;
                t = 0; t = __builtin_amdgcn_cvt_pk_fp8_f32(v2[0], v2[1], t, false); t = __builtin_amdgcn_cvt_pk_fp8_f32(v2[2], v2[3], t, true); w8.z = (unsigned)t;
                t = 0; t = __builtin_amdgcn_cvt_pk_fp8_f32(v3[0], v3[1], t, false); t = __builtin_amdgcn_cvt_pk_fp8_f32(v3[2], v3[3], t, true); w8.w = (unsigned)t;
#pragma unroll
                for (int k = 0; k < 2; ++k) *((u32x4*)((unsigned char*)xg + (size_t)pslot[2 * tl + k] * DM) + lane) = w8; } }
            __syncthreads();
        }
        for (int idx = gw; idx < 8 * 256; idx += ngw) { const int e = idx >> 8, r = idx & 255; unsigned ce = 0; int be = 0;
#pragma unroll
            for (int q = 0; q < 8; ++q) { ce = (e == q) ? cnt[q] : ce; be = (e == q) ? base[q] : be; }
            const int rem = (int)(ce & 255u);
            if (rem != 0 && r >= rem) { const int slot = be + (int)(ce & ~255u) + r; u32x4 zz = {0u, 0u, 0u, 0u}; *((u32x4*)((unsigned char*)xg + (size_t)slot * DM) + lane) = zz;
                if (lane == 0) { row_tok[slot] = -1; row_gate[slot] = 0.f; row_rs[slot] = 0.f; } } }
    }
    SEAM(18);
    if (IN(19)) { PHASE_PTRS
        unsigned cnt[8];
#pragma unroll
        for (int e = 0; e < 8; ++e) cnt[e] = (unsigned)__builtin_amdgcn_readfirstlane((int)__hip_atomic_load(ctl + CW_MOECNT + e, __ATOMIC_RELAXED, __HIP_MEMORY_SCOPE_AGENT));
        pg8::Gemm g{DM / 2, DM / 2, DM / 2}; MoeOrder S; S.init(xg, DM / 2, moe_w13, DM / 2, (size_t)2 * EDIM * DM, 2 * EDIM / 256, cnt, G, bx);
        EpiSwiglu<true> E{act, EDIM, row_rs};
        pg8::gemm_phase(lds, g, S, E);
    }
    SEAM(19);
    if (IN(20)) { PHASE_PTRS
        unsigned cnt[8];
#pragma unroll
        for (int e = 0; e < 8; ++e) cnt[e] = (unsigned)__builtin_amdgcn_readfirstlane((int)__hip_atomic_load(ctl + CW_MOECNT + e, __ATOMIC_RELAXED, __HIP_MEMORY_SCOPE_AGENT));
        pg8::Gemm g{EDIM / 2, EDIM / 2, EDIM / 2}; MoeDownOrder S; S.init(act, EDIM / 2, (unsigned char*)moe_w13 + (size_t)NEXP * 2 * EDIM * DM, EDIM / 2, (size_t)DM * EDIM, cnt, G, bx); S.BtE = (const char*)(wreg + W_IN);
        EpiMoeDownSplit E{ybuf, ypart, row_gate};
        pg8::gemm_phase(lds, g, S, E);
    }
    SEAM(20);
    if (IN(21)) { PHASE_PTRS
        int ns0 = 0, ns1 = 0; if (gw < T) { ns0 = tok_slot[2 * gw]; ns1 = tok_slot[2 * gw + 1]; }
        for (int m = gw; m < T; m += ngw) { const int s0 = __builtin_amdgcn_readfirstlane(ns0), s1 = __builtin_amdgcn_readfirstlane(ns1); f32x4* xr = (f32x4*)(a_out + (size_t)m * DM) + 2 * lane;
            { const int mn = (m + ngw < T) ? m + ngw : m; ns0 = tok_slot[2 * mn]; ns1 = tok_slot[2 * mn + 1]; }
            f32x4 v[4]; u32x4 ya[2], yb[2];
            const u32x4* y0 = (const u32x4*)((s0 >= 0 ? ybuf + (size_t)s0 * DM : ypart + (size_t)(-1 - s0) * DM)) + lane;
            const u32x4* y1 = (const u32x4*)((s1 >= 0 ? ybuf + (size_t)s1 * DM : ypart + (size_t)(-1 - s1) * DM)) + lane;
#pragma unroll
            for (int jj = 0; jj < 2; ++jj) { v[2 * jj] = xr[128 * jj]; v[2 * jj + 1] = xr[128 * jj + 1]; ya[jj] = __builtin_nontemporal_load(y0 + 64 * jj); yb[jj] = __builtin_nontemporal_load(y1 + 64 * jj); }
#pragma unroll
            for (int jj = 0; jj < 2; ++jj) { f32x4 a0, a1, b0, b1; unpack8(ya[jj], a0, a1); unpack8(yb[jj], b0, b1); v[2 * jj] += a0 + b0; v[2 * jj + 1] += a1 + b1; }
#pragma unroll
            for (int k = 0; k < 2; ++k) { const int sk = k ? s1 : s0;
                if (sk < 0) { const int pr = -1 - sk;
#pragma unroll 1
                    for (int q = 1; q < MD_KSPLIT; ++q) { const u32x4* yq = (const u32x4*)(ypart + ((size_t)q * (8 * 256) + pr) * DM) + lane;
#pragma unroll
                        for (int jj = 0; jj < 2; ++jj) { f32x4 p0, p1; unpack8(yq[64 * jj], p0, p1); v[2 * jj] += p0; v[2 * jj + 1] += p1; } } } }
#pragma unroll
            for (int jj = 0; jj < 2; ++jj) { xr[128 * jj] = v[2 * jj]; xr[128 * jj + 1] = v[2 * jj + 1]; } }
    }
#undef IN
#undef SEAM
#undef GRID_BAR
#undef ss_mix
#undef ss_ffn
}
template <int LO, int HI> __global__ void __launch_bounds__(NTHREADS, 2) mk_fwd(Args a) { mk_body<LO, HI>(a); }

template <int PH> static void set_attr(bool& ok) { if constexpr (PH < NPH) { ok = ok && (hipFuncSetAttribute((const void*)mk_fwd<PH, PH + 1>, hipFuncAttributeMaxDynamicSharedMemorySize, LDS_TOTAL) == hipSuccess); set_attr<PH + 1>(ok); } }
template <int PH> static void launch_phases(const Args& a, int grid, hipStream_t stream) { if constexpr (PH < NPH) { hipLaunchKernelGGL((mk_fwd<PH, PH + 1>), dim3(grid), dim3(NTHREADS), LDS_TOTAL, stream, a); launch_phases<PH + 1>(a, grid, stream); } }
extern "C" void kernel_launch(void* const* d_in, const int* in_sizes, int n_in, void* d_out, int out_size, void* d_ws, size_t ws_size, hipStream_t stream) {
    static int grid = 0;
    if (!grid) {
        if (n_in != N_IN || out_size != T * DM || ws_size < WS_END) { fprintf(stderr, "kernel_launch: unexpected problem: n_in %d out %d ws %zu (need %zu)\n", n_in, out_size, ws_size, (size_t)WS_END); grid = -1; return; }
        int dev = 0, cus = 0, per_cu = 0;
        (void)hipGetDevice(&dev); (void)hipDeviceGetAttribute(&cus, hipDeviceAttributeMultiprocessorCount, dev);
#if MK_PER_PHASE
        { bool ok = true; set_attr<0>(ok); if (!ok) { fprintf(stderr, "kernel_launch: hipFuncSetAttribute failed\n"); grid = -1; return; } per_cu = 1; }
#else
        if (hipFuncSetAttribute((const void*)mk_fwd<0, NPH>, hipFuncAttributeMaxDynamicSharedMemorySize, LDS_TOTAL) != hipSuccess) { fprintf(stderr, "kernel_launch: hipFuncSetAttribute failed\n"); grid = -1; return; }
        if (hipOccupancyMaxActiveBlocksPerMultiprocessor(&per_cu, (const void*)mk_fwd<0, NPH>, NTHREADS, LDS_TOTAL) != hipSuccess || per_cu < 1) { fprintf(stderr, "kernel_launch: occupancy query failed (%d)\n", per_cu); grid = -1; return; }
#endif
        grid = cus;
    }
    if (grid <= 0) return;
    (void)hipMemsetAsync((char*)d_ws + WS_CTL, 0, 32768, stream);
    Args a{};
    for (int i = 0; i < N_IN; ++i) a.in[i] = (const float*)d_in[i];
    a.out = (float*)d_out; a.ws = (unsigned char*)d_ws;
#if MK_PER_PHASE
    launch_phases<0>(a, grid, stream);
#else
    void* args[] = {&a};
    hipError_t e = hipLaunchCooperativeKernel((const void*)mk_fwd<0, NPH>, dim3(grid), dim3(NTHREADS), args, LDS_TOTAL, stream);
    if (e != hipSuccess) fprintf(stderr, "cooperative launch failed: %s (grid %d)\n", hipGetErrorString(e), grid);
#endif
}
```
